# Optimizing an MI355X kernel written in HIP

```python
import math
import jax, jax.numpy as jnp
from jax import lax
import numpy as np

D_MODEL = 1024
BATCH = 8
SEQ = 8192
DEPTH = 2
DEC_BATCH = 32
DEC_SEQ = 2048
PAST_LEN = 128

N_BRANCH = 4
BR_W = 256
A_HEADS = 4
A_DK = 32
A_DV = 2 * A_DK
B_HEADS = 4
B_DK = 64
B_DV = 64
C_HEADS = 4
C_NOPE = 32
C_ROPE = 16
C_V = 64
C_Q_LORA = 192
C_KV_LORA = 128
ROPE_BASE = 10000.0
D_BLOCKS = 4
D_BLOCK_W = BR_W // D_BLOCKS
CONV_W = 4
CONV_LEFT = 2
RG_C = 8.0
N_EXPERTS = 16
D_EXPERT = 2048
CAPACITY_FACTOR = 2
Q_BLOCK = 128
CHUNK = 128
LN_EPS = 1e-5
RMS_EPS = 1e-6
ALPHA = (2 * DEPTH) ** 0.25
BETA = (8 * DEPTH) ** -0.25
ALIBI_SLOPES = tuple(2.0 ** (-8.0 * (h + 1) / A_HEADS) for h in range(A_HEADS))

_IN_WIDTHS = (
    A_HEADS * 2 * A_DK,
    A_HEADS * 2 * A_DK,
    A_HEADS * A_DV,
    B_HEADS * B_DK,
    B_HEADS * B_DK,
    B_HEADS * B_DK,
    B_HEADS * B_DV,
    B_HEADS * B_DV,
    C_Q_LORA,
    C_KV_LORA,
    C_ROPE,
    BR_W,
    BR_W,
    N_BRANCH * D_MODEL,
)
IN_W = sum(_IN_WIDTHS)
IN_SPLITS = tuple(int(s) for s in np.cumsum(_IN_WIDTHS)[:-1])

kernel_name = 'hybrid_bidir_encoder_gated_merge'


def layer_norm(x, g, b):
    xf = x.astype(jnp.float32)
    mu = jnp.mean(xf, axis=-1, keepdims=True)
    var = jnp.mean(jnp.square(xf - mu), axis=-1, keepdims=True)
    return ((xf - mu) * lax.rsqrt(var + LN_EPS) * g + b).astype(x.dtype)


def rms_norm(x, g):
    xf = x.astype(jnp.float32)
    return (xf * lax.rsqrt(jnp.mean(xf * xf, axis=-1, keepdims=True) + RMS_EPS) * g).astype(x.dtype)


def sweep_query_blocks(fn, q_arrays):
    S = q_arrays[0].shape[1]
    nb = S // Q_BLOCK
    blocks = tuple(jnp.moveaxis(a.reshape(a.shape[0], nb, Q_BLOCK, *a.shape[2:]), 1, 0) for a in q_arrays)
    starts = jnp.arange(nb, dtype=jnp.int32) * Q_BLOCK
    out = lax.map(lambda xs: fn(*xs), (blocks, starts))
    out = jnp.moveaxis(out, 0, 1)
    return out.reshape(out.shape[0], S, *out.shape[3:])


def diff_attention(q, k, v, lam_params, subln_g, layer_idx):
    B, S = k.shape[0], k.shape[1]
    lambda_init = 0.8 - 0.6 * math.exp(-0.3 * layer_idx)
    lp = lam_params.astype(jnp.float32)
    lam = jnp.exp(jnp.sum(lp[0] * lp[1])) - jnp.exp(jnp.sum(lp[2] * lp[3])) + lambda_init
    slopes = jnp.asarray(ALIBI_SLOPES, dtype=jnp.float32)
    k_pos = jnp.arange(S, dtype=jnp.int32)
    scale = A_DK ** -0.5

    def block(qs, start):
        (qb,) = qs
        q_pos = start + jnp.arange(Q_BLOCK, dtype=jnp.int32)
        dist = jnp.abs(q_pos[:, None] - k_pos[None, :]).astype(jnp.float32)
        bias = -slopes[:, None, None] * dist
        s = jnp.einsum('bqhmd,bkhmd->bhmqk', qb, k).astype(jnp.float32) * scale + bias[None, :, None]
        p = jax.nn.softmax(s, axis=-1)
        w = p[:, :, 0] - lam * p[:, :, 1]
        return jnp.einsum('bhqk,bkhd->bqhd', w.astype(v.dtype), v)

    o = sweep_query_blocks(block, (q,))
    o = rms_norm(o, subln_g) * (1.0 - lambda_init)
    return o.reshape(B, S, A_HEADS * A_DV)


def rope_tables(S, d):
    inv = ROPE_BASE ** (-jnp.arange(0, d, 2, dtype=jnp.float32) / d)
    ang = jnp.arange(S, dtype=jnp.float32)[:, None] * inv[None, :]
    return jnp.cos(ang), jnp.sin(ang)


def apply_rope(x, cos, sin):
    half = x.shape[-1] // 2
    x1, x2 = x[..., :half], x[..., half:]
    c, s = cos.astype(x.dtype), sin.astype(x.dtype)
    return jnp.concatenate([x1 * c - x2 * s, x1 * s + x2 * c], axis=-1)


def mla_attention(c_q, c_kv, k_r, q_norm_g, w_uq, kv_norm_g, w_ukv):
    B, S, _ = c_q.shape
    q = (rms_norm(c_q, q_norm_g) @ w_uq).reshape(B, S, C_HEADS, C_NOPE + C_ROPE)
    kv = (rms_norm(c_kv, kv_norm_g) @ w_ukv).reshape(B, S, C_HEADS, C_NOPE + C_V)
    q_nope, q_rope = q[..., :C_NOPE], q[..., C_NOPE:]
    k_nope, v = kv[..., :C_NOPE], kv[..., C_NOPE:]
    cos, sin = rope_tables(S, C_ROPE)
    q_rope = apply_rope(q_rope, cos[:, None, :], sin[:, None, :])
    k_rope = apply_rope(k_r, cos, sin)
    scale = (C_NOPE + C_ROPE) ** -0.5

    def block(qs, start):
        qn, qr = qs
        s = (jnp.einsum('bqhd,bkhd->bhqk', qn, k_nope)
             + jnp.einsum('bqhd,bkd->bhqk', qr, k_rope)).astype(jnp.float32) * scale
        p = jax.nn.softmax(s, axis=-1)
        return jnp.einsum('bhqk,bkhd->bqhd', p.astype(v.dtype), v)

    o = sweep_query_blocks(block, (q_nope, q_rope))
    return o.reshape(B, S, C_HEADS * C_V)


def chunked_gated_recurrence(q, k, v, log_f):
    B, S, H, DK = q.shape
    DV = v.shape[-1]
    n = S // CHUNK

    def to_chunks(a):
        return a.astype(jnp.float32).reshape(B, n, CHUNK, H, a.shape[-1]).transpose(1, 0, 3, 2, 4)

    qc, kc, vc, fc = (to_chunks(a) for a in (q, k, v, log_f))
    tri = jnp.tril(jnp.ones((CHUNK, CHUNK), dtype=bool))[:, :, None]

    def step(state, xs):
        qi, ki, vi, fi = xs
        b = jnp.cumsum(fi, axis=2)
        diff = b[:, :, :, None, :] - b[:, :, None, :, :]
        decay = jnp.exp(jnp.where(tri, diff, -jnp.inf))
        scores = jnp.einsum('bhtd,bhsd,bhtsd->bhts', qi, ki, decay)
        o = scores @ vi + jnp.einsum('bhtd,bhdv->bhtv', qi * jnp.exp(b), state)
        b_last = b[:, :, -1:, :]
        new_state = (jnp.exp(b_last[:, :, 0, :])[..., None] * state
                     + jnp.einsum('bhsd,bhsv->bhdv', ki * jnp.exp(b_last - b), vi))
        return new_state, o

    state0 = jnp.zeros((B, H, DK, DV), jnp.float32)
    _, o = lax.scan(step, state0, (qc, kc, vc, fc))
    return o.transpose(1, 0, 3, 2, 4).reshape(B, S, H, DV)


def hgrn2_direction(q, v, f_logits, lb, reverse):
    B, S, H, DK = q.shape
    f = (lb + (1.0 - lb) * jax.nn.sigmoid(f_logits.astype(jnp.float32))).reshape(B, S, H, DK)
    k = 1.0 - f
    log_f = jnp.log(f)
    if reverse:
        q, k, v, log_f = (jnp.flip(a, axis=1) for a in (q, k, v, log_f))
    o = chunked_gated_recurrence(q, k, v, log_f)
    return jnp.flip(o, axis=1) if reverse else o


def hgrn2_mixer(b_q, b_ff, b_fb, b_i, b_g, lb, norm_g):
    B, S, _ = b_q.shape
    q = jax.nn.silu(b_q.astype(jnp.float32)).reshape(B, S, B_HEADS, B_DK)
    v = b_i.astype(jnp.float32).reshape(B, S, B_HEADS, B_DV)
    o = hgrn2_direction(q, v, b_ff, lb[0], False) + hgrn2_direction(q, v, b_fb, lb[1], True)
    o = rms_norm(o, norm_g.reshape(B_HEADS, B_DV)).reshape(B, S, B_HEADS * B_DV)
    return (o * jax.nn.silu(b_g.astype(jnp.float32))).astype(b_q.dtype)


def linear_scan_combine(e1, e2):
    a1, b1 = e1
    a2, b2 = e2
    return a1 * a2, a2 * b1 + b2


def rglru_mixer(d_x, d_g, conv_w, conv_b, w_a, b_a, w_x, b_x, lam):
    B, S, W = d_x.shape
    pad = jnp.pad(d_x, ((0, 0), (CONV_LEFT, CONV_W - 1 - CONV_LEFT), (0, 0)))
    xc = (sum(pad[:, j:j + S] * conv_w[j] for j in range(CONV_W)) + conv_b).astype(jnp.float32)
    xb = xc.reshape(B, S, D_BLOCKS, D_BLOCK_W)
    h_sum = jnp.zeros_like(xc)
    for d, reverse in ((0, False), (1, True)):
        r = jax.nn.sigmoid(jnp.einsum('bsnc,ncd->bsnd', xb, w_a[d]).reshape(B, S, W) + b_a[d])
        i = jax.nn.sigmoid(jnp.einsum('bsnc,ncd->bsnd', xb, w_x[d]).reshape(B, S, W) + b_x[d])
        log_a = -RG_C * r * jax.nn.softplus(-lam[d].astype(jnp.float32))
        a = jnp.exp(log_a)
        u = jnp.sqrt(-jnp.expm1(2.0 * log_a)) * (i * xc)
        _, h = lax.associative_scan(linear_scan_combine, (a, u), axis=1, reverse=reverse)
        h_sum = h_sum + h
    return (h_sum * jax.nn.gelu(d_g.astype(jnp.float32))).astype(d_x.dtype)


def expert_choice_ffn(x, w_router, w_gate, w_up, w_down):
    B, S, D = x.shape
    T = B * S
    cap = CAPACITY_FACTOR * T // N_EXPERTS
    xt = x.reshape(T, D)
    aff = jax.nn.softmax((xt @ w_router).astype(jnp.float32), axis=-1)
    g, idx = lax.top_k(aff.T, cap)
    xe = xt[idx]
    h = jax.nn.silu(jnp.einsum('ecd,edf->ecf', xe, w_gate)) * jnp.einsum('ecd,edf->ecf', xe, w_up)
    ye = jnp.einsum('ecf,efd->ecd', h, w_down) * g[..., None].astype(x.dtype)
    y = jnp.zeros((T, D), ye.dtype).at[idx.reshape(-1)].add(ye.reshape(-1, D))
    return y.reshape(B, S, D).astype(x.dtype)


def token_mixer(x, l, p):
    B, S, _ = x.shape
    u = x @ p['w_in'][l]
    (a_q, a_k, a_v, b_q, b_ff, b_fb, b_i, b_g,
     c_q, c_kv, c_kr, d_x, d_g, gate) = jnp.split(u, IN_SPLITS, axis=-1)
    y_a = diff_attention(a_q.reshape(B, S, A_HEADS, 2, A_DK), a_k.reshape(B, S, A_HEADS, 2, A_DK),
                         a_v.reshape(B, S, A_HEADS, A_DV), p['diff_lambda'][l], p['diff_subln_g'][l], l)
    y_b = hgrn2_mixer(b_q, b_ff, b_fb, b_i, b_g, p['hgrn_lb'][l], p['hgrn_norm_g'][l])
    y_c = mla_attention(c_q, c_kv, c_kr, p['mla_q_norm_g'][l], p['mla_w_uq'][l],
                        p['mla_kv_norm_g'][l], p['mla_w_ukv'][l])
    y_d = rglru_mixer(d_x, d_g, p['rg_conv_w'][l], p['rg_conv_b'][l], p['rg_w_a'][l], p['rg_b_a'][l],
                      p['rg_w_x'][l], p['rg_b_x'][l], p['rg_lambda'][l])
    gate = jax.nn.sigmoid(gate.reshape(B, S, N_BRANCH, D_MODEL))
    mix = sum(gate[:, :, i] * (y @ p['w_branch'][l, i]) for i, y in enumerate((y_a, y_b, y_c, y_d)))
    return mix @ p['w_out'][l]


def encoder_trunk(x, p):
    for l in range(DEPTH):
        x = layer_norm(ALPHA * x + token_mixer(x, l, p), p['ln_g'][l, 0], p['ln_b'][l, 0])
        y = expert_choice_ffn(x, p['w_router'][l], p['w_e_gate'][l], p['w_e_up'][l], p['w_e_down'][l])
        x = layer_norm(ALPHA * x + y, p['ln_g'][l, 1], p['ln_b'][l, 1])
    return x


def setup_inputs(seed: int = 0) -> dict:
    key = jax.random.key(seed)
    ks = jax.random.split(key, 26)
    f32 = jnp.float32
    L = DEPTH

    def nrm(k, shape, scale):
        return jax.random.normal(k, shape, f32) * scale

    def gain(k, shape):
        return 1.0 + nrm(k, shape, 0.02)

    a0 = jax.random.uniform(ks[17], (L, 2, BR_W), f32, 0.9, 0.999)
    p_lam = a0 ** (1.0 / RG_C)
    return {
        'x_prompt': nrm(ks[0], (BATCH, SEQ, D_MODEL), 1.0),
        'x_sample': nrm(ks[1], (DEC_BATCH, DEC_SEQ, D_MODEL), 1.0),
        'w_in': nrm(ks[2], (L, D_MODEL, IN_W), D_MODEL ** -0.5),
        'diff_lambda': nrm(ks[3], (L, 4, A_DK), 0.1),
        'diff_subln_g': gain(ks[4], (L, A_DV)),
        'hgrn_lb_logits': nrm(ks[5], (L, 2, B_HEADS * B_DK), 0.5),
        'hgrn_norm_g': gain(ks[6], (L, B_HEADS * B_DV)),
        'mla_q_norm_g': gain(ks[7], (L, C_Q_LORA)),
        'mla_w_uq': nrm(ks[8], (L, C_Q_LORA, C_HEADS * (C_NOPE + C_ROPE)), C_Q_LORA ** -0.5),
        'mla_kv_norm_g': gain(ks[9], (L, C_KV_LORA)),
        'mla_w_ukv': nrm(ks[10], (L, C_KV_LORA, C_HEADS * (C_NOPE + C_V)), C_KV_LORA ** -0.5),
        'rg_conv_w': nrm(ks[11], (L, CONV_W, BR_W), CONV_W ** -0.5),
        'rg_conv_b': nrm(ks[12], (L, BR_W), 0.02),
        'rg_w_a': nrm(ks[13], (L, 2, D_BLOCKS, D_BLOCK_W, D_BLOCK_W), D_BLOCK_W ** -0.5),
        'rg_b_a': nrm(ks[14], (L, 2, BR_W), 0.02),
        'rg_w_x': nrm(ks[15], (L, 2, D_BLOCKS, D_BLOCK_W, D_BLOCK_W), D_BLOCK_W ** -0.5),
        'rg_b_x': nrm(ks[16], (L, 2, BR_W), 0.02),
        'rg_lambda': jnp.log(p_lam) - jnp.log1p(-p_lam),
        'w_branch': nrm(ks[18], (L, N_BRANCH, BR_W, D_MODEL), BR_W ** -0.5),
        'w_out': nrm(ks[19], (L, D_MODEL, D_MODEL), BETA * D_MODEL ** -0.5),
        'ln_g': gain(ks[20], (L, 2, D_MODEL)),
        'ln_b': nrm(ks[21], (L, 2, D_MODEL), 0.02),
        'w_router': nrm(ks[22], (L, D_MODEL, N_EXPERTS), D_MODEL ** -0.5),
        'w_e_gate': nrm(ks[23], (L, N_EXPERTS, D_MODEL, D_EXPERT), D_MODEL ** -0.5),
        'w_e_up': nrm(ks[24], (L, N_EXPERTS, D_MODEL, D_EXPERT), D_MODEL ** -0.5),
        'w_e_down': nrm(ks[25], (L, N_EXPERTS, D_EXPERT, D_MODEL), BETA * D_EXPERT ** -0.5),
    }


def reference(x_prompt, x_sample, w_in, diff_lambda, diff_subln_g, hgrn_lb_logits, hgrn_norm_g,
              mla_q_norm_g, mla_w_uq, mla_kv_norm_g, mla_w_ukv, rg_conv_w, rg_conv_b, rg_w_a, rg_b_a,
              rg_w_x, rg_b_x, rg_lambda, w_branch, w_out, ln_g, ln_b, w_router, w_e_gate, w_e_up,
              w_e_down):
    lb_all = jnp.cumsum(jax.nn.softmax(hgrn_lb_logits.astype(jnp.float32), axis=0), axis=0)
    lb_all = lb_all - lb_all[:1]
    params = dict(w_in=w_in, diff_lambda=diff_lambda, diff_subln_g=diff_subln_g, hgrn_lb=lb_all,
                  hgrn_norm_g=hgrn_norm_g, mla_q_norm_g=mla_q_norm_g, mla_w_uq=mla_w_uq,
                  mla_kv_norm_g=mla_kv_norm_g, mla_w_ukv=mla_w_ukv, rg_conv_w=rg_conv_w,
                  rg_conv_b=rg_conv_b, rg_w_a=rg_w_a, rg_b_a=rg_b_a, rg_w_x=rg_w_x, rg_b_x=rg_b_x,
                  rg_lambda=rg_lambda, w_branch=w_branch, w_out=w_out, ln_g=ln_g, ln_b=ln_b,
                  w_router=w_router, w_e_gate=w_e_gate, w_e_up=w_e_up, w_e_down=w_e_down)
    y_prompt = encoder_trunk(x_prompt, params)
    y_sample = encoder_trunk(x_sample, params)
    return (y_prompt, y_sample)
```

```cpp
#include <hip/hip_runtime.h>
#include <cstdio>
#include <cstdint>

#ifndef MK_PER_PHASE_LAUNCH
#define MK_PER_PHASE_LAUNCH 0
#endif

#define LAS __attribute__((address_space(3)))
#define GAS __attribute__((address_space(1)))
typedef unsigned short bf16_t;
typedef short bf16x8 __attribute__((ext_vector_type(8)));
typedef short s16x4 __attribute__((ext_vector_type(4)));
typedef float f32x2 __attribute__((ext_vector_type(2)));
typedef float f32x4 __attribute__((ext_vector_type(4)));
typedef float f32x16 __attribute__((ext_vector_type(16)));
typedef unsigned u32x2 __attribute__((ext_vector_type(2)));
typedef unsigned u32x4 __attribute__((ext_vector_type(4)));
#define DI __device__ __forceinline__
#define LDS_WAIT() asm volatile("s_waitcnt lgkmcnt(0)" ::: "memory")
#define VM_WAIT() asm volatile("s_waitcnt vmcnt(0)" ::: "memory")

constexpr int DM = 1024, NTOK = 131072, NTOKG = 65536, NSEQ = 40, NCHUNK = 1024  ;
constexpr int IN_W = 6992, COL_B = 768, COL_CD = 2048, COL_GATE = 2896;
constexpr int NEXP = 16, DEXP = 2048, CAP = 8192;
constexpr float ALPHA = 1.41421356237309515f, INV_ALPHA = 0.70710678118654752f;
constexpr float LOG2E = 1.4426950408889634f;
constexpr float LN_EPS = 1e-5f, RMS_EPS = 1e-6f;

constexpr size_t MiB = (size_t)1 << 20;
constexpr size_t WS_CTL = 0, CTL_ZERO_BYTES = 1 * MiB;
constexpr size_t WS_KN2 = 256 * 1024;
constexpr size_t WS_WSMALL = 2 * MiB, WSMALL_LAYER = 18 * MiB;
constexpr size_t OFF_WA = 0, OFF_WB = (size_t)768 * 1024 * 2, OFF_WCD = OFF_WB + (size_t)1280 * 1024 * 2, OFF_WG = OFF_WCD + (size_t)1024 * 1024 * 2,
                 OFF_WBR = OFF_WG + (size_t)4096 * 1024 * 2, OFF_WOUT = OFF_WBR + (size_t)4096 * 256 * 2;
static_assert(OFF_WOUT + (size_t)1024 * 1024 * 2 <= WSMALL_LAYER, "small weights");
constexpr size_t WS_WC = 38 * MiB, WC_LAYER = 256 * 1024;
constexpr size_t OFF_WQ = 0, OFF_WKV = 96 * 1024;
constexpr size_t WS_WRG = 39 * MiB;
constexpr size_t WS_AFF = 40 * MiB;
constexpr size_t WS_IDX = 48 * MiB, WS_GSEL = 49 * MiB;
constexpr size_t WS_GAM = 50 * MiB;
constexpr size_t WS_DC = 52 * MiB;
constexpr size_t WS_SM = 56 * MiB;
constexpr size_t WS_XB0 = 64 * MiB, WS_XB1 = 320 * MiB, WS_Y = 576 * MiB, WS_U = 832 * MiB, WS_EW = 1152 * MiB, WS_END = 1344 * MiB;
constexpr size_t OFF_QC = 0, OFF_KC = 48 * MiB, OFF_VC = 96 * MiB;
constexpr size_t OFF_WGU8 = 0, OFF_WD8 = (size_t)16 * 4096 * 1024;

DI unsigned f2bf(float f) { unsigned u = __builtin_bit_cast(unsigned, f); return (u + 0x7fffu + ((u >> 16) & 1u)) >> 16; }
DI unsigned pk2(float lo, float hi) { return f2bf(lo) | (f2bf(hi) << 16); }
DI float bf2f(unsigned short b) { return __builtin_bit_cast(float, ((unsigned)b) << 16); }
DI float bflo(unsigned w) { return __builtin_bit_cast(float, w << 16); }
DI float bfhi(unsigned w) { return __builtin_bit_cast(float, w & 0xffff0000u); }
DI unsigned cvt_pk_bf16(float lo, float hi) { unsigned r; asm volatile("v_cvt_pk_bf16_f32 %0, %1, %2" : "=v"(r) : "v"(lo), "v"(hi)); return r; }
typedef __bf16 bf16x2_t __attribute__((ext_vector_type(2)));
DI unsigned cvt_pk_bf16_b(float lo, float hi) { const f32x2 v = {lo, hi}; const bf16x2_t b = __builtin_convertvector(v, bf16x2_t); return __builtin_bit_cast(unsigned, b); }
DI float sigmoidf_(float x) { return __builtin_amdgcn_rcpf(1.0f + __builtin_amdgcn_exp2f(-x * LOG2E)); }
DI float siluf_(float x) { return x * sigmoidf_(x); }
DI float wave_sum(float v) {
#pragma unroll
    for (int o = 1; o < 64; o <<= 1) v += __shfl_xor(v, o);
    return v;
}
DI float wave_max(float v) {
#pragma unroll
    for (int o = 1; o < 64; o <<= 1) v = fmaxf(v, __shfl_xor(v, o));
    return v;
}
DI int seq_start_row(int s) { return s < 8 ? s * 8192 : 65536 + (s - 8) * 2048; }
DI int row_pos(int row) { return row < 65536 ? (row & 8191) : (row & 2047); }
DI int row_seq_begin(int row) { return row < 65536 ? (row & ~8191) : (row & ~2047); }
DI int row_seq_len(int row) { return row < 65536 ? 8192 : 2048; }

namespace pg8 {
constexpr int BM = 256, BK = 64, HALF = 128, HTB = HALF * BK * 2, STAGE_BYTES = 8 * HTB, NXCD = 8, WGM = 8;
DI int lds_byte(int r, int c) { const int st = (r >> 4) * 2 + (c >> 5), rr = r & 15, cc = c & 31, ob = rr * 64 + cc * 2; return st * 1024 + (ob ^ (((ob >> 9) & 1) << 5)); }
DI void stage_rc(int b, int& R, int& C) { const int st = b / 1024, sb = b % 1024, swz = sb ^ (((sb >> 9) & 1) << 5); R = (st >> 1) * 16 + swz / 64; C = (st & 1) * 32 + (swz % 64) / 2; }
DI int perm32(int rho) { const int n = rho >> 4, i = rho & 15; return 8 * (i >> 2) + 4 * n + (i & 3); }

struct Unit { int pm, pn; };
struct Gemm { const bf16_t* A; const bf16_t* Bt; int M, N, K, lda, ldb, an_shift; size_t an_off; int bm_shift = 30; size_t bm_off = 0; const int* gidx = nullptr; };

struct StaticOrder {
    int nM, nN, nwg, G, c;
    DI void init(int M, int N, int G_, int c_) { nM = M / BM; nN = N / BM; nwg = nM * nN; G = G_; c = c_; }
    DI bool next(int i, Unit& u) const {
        const long L = (long)i * G + c; if (L >= nwg) return false;
        int wgid = (int)L; { const int q = nwg / NXCD, r = nwg % NXCD, xcd = wgid % NXCD, off = wgid / NXCD; wgid = (xcd < r ? xcd * (q + 1) : r * (q + 1) + (xcd - r) * q) + off; }
        const int nig = WGM * nN, gid = wgid / nig, fm = gid * WGM, gsz = (nM - fm) < WGM ? (nM - fm) : WGM;
        u.pm = fm + ((wgid % nig) % gsz); u.pn = (wgid % nig) / gsz; return true;
    }
};

typedef f32x4 Acc[2][2][4][2];

typedef int v8i_t __attribute__((ext_vector_type(8)));
DI void mfma8_tied(f32x4& c, const v8i_t& a, const v8i_t& b) { asm volatile("v_mfma_f32_16x16x128_f8f6f4 %0, %1, %2, %0" : "+v"(c) : "v"(a), "v"(b)); }
DI void glds_sv(const void* sbase, unsigned voff, unsigned lds_dst) { unsigned keep;
    asm volatile("s_mov_b32 %0, m0\n\ts_mov_b32 m0, %3\n\ts_nop 0\n\tglobal_load_lds_dwordx4 %1, %2\n\ts_mov_b32 m0, %0" : "=&s"(keep) : "v"(voff), "s"(sbase), "s"(lds_dst) : "memory"); }
constexpr int GIDX_OFF = 131072 + 1024, GIDX_TILES = 14;
template <class Epi, class Sched, bool FP8 = false, bool GATHER = false>
DI void gemm_phase(LAS unsigned char* lds, const Gemm g, const Sched& S, const Epi& E) {
    int tid = threadIdx.x; asm volatile("" : "+v"(tid));
    const int wid = __builtin_amdgcn_readfirstlane(tid >> 6), lane = tid & 63, wr = wid >> 2, wc = wid & 3, fr = lane & 15, fq = lane >> 4;
    const int K = g.K, nt = FP8 ? K / 128 : K / BK;
    const int pitchA = FP8 ? g.lda : g.lda * 2, pitchB = FP8 ? g.ldb : g.ldb * 2;
    unsigned voffA[2], voffB[2];
#pragma unroll
    for (int i = 0; i < 2; ++i) { int R, C; stage_rc(tid * 16 + i * 8192, R, C); const int Rb = Epi::PERM ? ((R & ~31) + perm32(R & 31)) : R;
        voffA[i] = (unsigned)(R * pitchA + C * 2); voffB[i] = (unsigned)(Rb * pitchB + C * 2); }
    const size_t kstep = (size_t)(BK * 2);
    const size_t hstepA = (size_t)HALF * pitchA, hstepB = (size_t)HALF * pitchB;
    const size_t tstepA = 2 * hstepA, tstepB = 2 * hstepB;
    const unsigned ldsw = (unsigned)wid * 1024u;
    const int aoff = lds_byte(wr * 64 + fr, fq * 8), boff = lds_byte(wc * 32 + fr, fq * 8);
#define PG8_SA(b, h) (((b) * 2 + (h)) * HTB)
#define PG8_SB(b, h) ((4 + (b) * 2 + (h)) * HTB)
#define PG8_STAGE(bufoff, gbase, voff) do { _Pragma("unroll") for (int _i = 0; _i < 2; ++_i) \
        glds_sv((const void*)(gbase), (voff)[_i], (unsigned)(uintptr_t)(lds + (bufoff) + ldsw + _i * 8192)); } while (0)
#define PG8_LD1(p) ([&]() { if constexpr (FP8) { const u32x4 lo_ = *(const LAS u32x4*)(p), hi_ = *(const LAS u32x4*)((p) + 1024); return Frag{__builtin_bit_cast(v8i_t, __builtin_shufflevector(lo_, hi_, 0, 1, 2, 3, 4, 5, 6, 7))}; } \
        else { Frag f_; f_.h[0] = *(const LAS bf16x8*)(p); f_.h[1] = *(const LAS bf16x8*)((p) + 1024); return f_; } }())
#define PG8_LDA(dst, b, h) do { _Pragma("unroll") for (int m = 0; m < 4; ++m) dst[m] = PG8_LD1(lds + PG8_SA(b, h) + aoff + m * 2048); } while (0)
#define PG8_LDB(dst, b, h) do { _Pragma("unroll") for (int n = 0; n < 2; ++n) dst[n] = PG8_LD1(lds + PG8_SB(b, h) + boff + n * 2048); } while (0)
#define PG8_MMA(ai, bj, At, Bt) do { __builtin_amdgcn_s_setprio(1); _Pragma("unroll") for (int m = 0; m < 4; ++m) _Pragma("unroll") for (int n = 0; n < 2; ++n) { \
        if constexpr (FP8) mfma8_tied(acc[ai][bj][m][n], Bt[n].w, At[m].w); \
        else { _Pragma("unroll") for (int k = 0; k < 2; ++k) acc[ai][bj][m][n] = __builtin_amdgcn_mfma_f32_16x16x32_bf16(Bt[n].h[k], At[m].h[k], acc[ai][bj][m][n], 0, 0, 0); } } \
        __builtin_amdgcn_s_setprio(0); } while (0)
#define PG8_WAIT_V(n) asm volatile("s_waitcnt vmcnt(" #n ")" ::: "memory")
#define PG8_WAIT_L(n) asm volatile("s_waitcnt lgkmcnt(" #n ")" ::: "memory")
#define PG8_BAR __builtin_amdgcn_s_barrier()
#define PG8_SCHED __builtin_amdgcn_sched_barrier(0)
    Unit cur, nxt; int ui = 0;
    unsigned vg[2][2] = {{0u, 0u}, {0u, 0u}};
    if constexpr (GATHER) { LAS unsigned* tab = (LAS unsigned*)(lds + GIDX_OFF); Unit u_;
        for (int i = 0; i < GIDX_TILES && S.next(i, u_); ++i) { if (tid < 256) tab[i * 256 + tid] = (unsigned)g.gidx[u_.pm * BM + tid]; }
        __syncthreads(); }
#define PG8_GOFF(ord) do { int tq_ = tid; asm volatile("" : "+v"(tq_)); int R_, C_; stage_rc(tq_ * 16, R_, C_); const LAS unsigned* tb_ = (const LAS unsigned*)(lds + GIDX_OFF) + (ord) * 256 + R_; \
        _Pragma("unroll") for (int h_ = 0; h_ < 2; ++h_) _Pragma("unroll") for (int i_ = 0; i_ < 2; ++i_) vg[h_][i_] = tb_[h_ * 128 + i_ * 64] * (unsigned)pitchA + (unsigned)(C_ * 2); } while (0)
#define PG8_STAGE_A(bufoff, base, h) do { if constexpr (GATHER) PG8_STAGE(bufoff, base, vg[h]); else PG8_STAGE(bufoff, (base) + (h) * hstepA, voffA); } while (0)
    if (!S.next(0, cur)) return;
    if constexpr (GATHER) PG8_GOFF(0);
    float zf = 0.f; asm volatile("" : "+v"(zf));
    Acc acc;
#pragma unroll
    for (int a = 0; a < 2; ++a)
#pragma unroll
        for (int b = 0; b < 2; ++b)
#pragma unroll
            for (int m = 0; m < 4; ++m)
#pragma unroll
                for (int n = 0; n < 2; ++n) acc[a][b][m][n] = (f32x4){zf, zf, zf, zf};
    union Frag { v8i_t w; bf16x8 h[2]; };
    Frag At[4], B0[2], B1[2];
    const char* cA = GATHER ? (const char*)g.A : (const char*)g.A + (size_t)cur.pm * tstepA + (size_t)(cur.pn >> g.an_shift) * g.an_off; const char* cB = (const char*)g.Bt + (size_t)cur.pn * tstepB + (size_t)(cur.pm >> g.bm_shift) * g.bm_off;
    PG8_STAGE(PG8_SB(0, 0), cB, voffB); PG8_STAGE(PG8_SB(0, 1), cB + hstepB, voffB); PG8_STAGE_A(PG8_SA(0, 0), cA, 0); PG8_STAGE_A(PG8_SA(0, 1), cA, 1);
    if (wr == 1) PG8_BAR;
    PG8_WAIT_V(2); PG8_BAR;
    PG8_STAGE(PG8_SB(1, 0), cB + kstep, voffB); PG8_STAGE_A(PG8_SA(1, 0), cA + kstep, 0); PG8_STAGE(PG8_SB(1, 1), cB + hstepB + kstep, voffB);
    PG8_WAIT_V(6); PG8_BAR;
    for (;;) {
        const bool has_next = S.next(ui + 1, nxt);
        const char* nA = (has_next && !GATHER) ? (const char*)g.A + (size_t)nxt.pm * tstepA + (size_t)(nxt.pn >> g.an_shift) * g.an_off : cA;
        const char* nB = has_next ? (const char*)g.Bt + (size_t)nxt.pn * tstepB + (size_t)(nxt.pm >> g.bm_shift) * g.bm_off : cB;
#pragma unroll 1
        for (int t = 0; t < nt; t += 2) {
            const bool last = (t == nt - 2);
            const char* a1 = cA + (size_t)(t + 1) * kstep;
            const char* a2 = last ? nA : cA + (size_t)(t + 2) * kstep; const char* b2 = last ? nB : cB + (size_t)(t + 2) * kstep;
            const char* a3 = a2 + kstep; const char* b3 = b2 + kstep;
            PG8_LDB(B0, 0, 0); PG8_LDB(B1, 0, 1); PG8_SCHED; PG8_LDA(At, 0, 0); PG8_STAGE_A(PG8_SA(1, 1), a1, 1);
            if constexpr (GATHER) { if (last && has_next) PG8_GOFF(ui + 1); }
            PG8_WAIT_V(8); PG8_WAIT_L(0); PG8_BAR; PG8_MMA(0, 0, At, B0); PG8_MMA(0, 1, At, B1); PG8_BAR; PG8_SCHED;
            PG8_LDA(At, 0, 1); PG8_STAGE(PG8_SB(0, 0), b2, voffB); PG8_STAGE(PG8_SB(0, 1), b2 + hstepB, voffB); PG8_STAGE_A(PG8_SA(0, 0), a2, 0);
            PG8_WAIT_V(8); PG8_WAIT_L(0); PG8_BAR; PG8_MMA(1, 0, At, B0); PG8_MMA(1, 1, At, B1); PG8_BAR; PG8_SCHED;
            PG8_LDB(B0, 1, 0); PG8_LDB(B1, 1, 1); PG8_SCHED; PG8_LDA(At, 1, 0); PG8_STAGE_A(PG8_SA(0, 1), a2, 1);
            PG8_WAIT_V(8); PG8_WAIT_L(0); PG8_BAR; PG8_MMA(0, 0, At, B0); PG8_MMA(0, 1, At, B1); PG8_BAR; PG8_SCHED;
            PG8_LDA(At, 1, 1); PG8_STAGE(PG8_SB(1, 0), b3, voffB); PG8_STAGE(PG8_SB(1, 1), b3 + hstepB, voffB); PG8_STAGE_A(PG8_SA(1, 0), a3, 0);
            PG8_WAIT_V(8); PG8_WAIT_L(0); PG8_BAR; PG8_MMA(1, 0, At, B0); PG8_MMA(1, 1, At, B1); PG8_BAR; PG8_SCHED;
        }
        if (wr == 0) PG8_BAR;
        if constexpr (FP8) asm volatile("s_nop 15\n\ts_nop 15" ::: "memory");
        { int tz = tid; asm volatile("" : "+v"(tz));
          const int lz = tz & 63; E(acc, cur, wr, wc, lz & 15, lz >> 4); }
        if (!has_next) break;
#pragma unroll
        for (int a = 0; a < 2; ++a)
#pragma unroll
            for (int b = 0; b < 2; ++b)
#pragma unroll
                for (int m = 0; m < 4; ++m)
#pragma unroll
                    for (int n = 0; n < 2; ++n) acc[a][b][m][n] = (f32x4){0.f, 0.f, 0.f, 0.f};
        cur = nxt; cA = nA; cB = nB; ++ui;
        if (wr == 1) PG8_BAR;
    }
    PG8_WAIT_V(0);
    PG8_BAR;
#undef PG8_SA
#undef PG8_SB
#undef PG8_STAGE
#undef PG8_STAGE_A
#undef PG8_GOFF
#undef PG8_LDA
#undef PG8_LDB
#undef PG8_MMA
#undef PG8_LD1
#undef PG8_WAIT_V
#undef PG8_WAIT_L
#undef PG8_BAR
#undef PG8_SCHED
}

struct EpiProj {
    static constexpr bool PERM = true;
    bf16_t* O; int ldc; int scale_cols; float scale; unsigned* kn2;
    DI void operator()(const Acc& acc, const Unit& u, int wr, int wc, int fr, int fq) const {
        const int row0 = u.pm * BM + wr * 64 + fr, colt = u.pn * BM, col0 = colt + wc * 32 + 8 * fq;
        const float sc = (colt < scale_cols) ? scale : 1.f;
        const bool donorm = (kn2 != nullptr) && (colt == 256);
#pragma unroll
        for (int ai = 0; ai < 2; ++ai) { float mx0 = 0.f, mx1 = 0.f;
#pragma unroll
            for (int m = 0; m < 4; ++m) { bf16_t* rowp = O + (size_t)(row0 + ai * HALF + m * 16) * ldc + col0;
#pragma unroll
                for (int bj = 0; bj < 2; ++bj) { const f32x4 v0 = acc[ai][bj][m][0] * sc, v1 = acc[ai][bj][m][1] * sc;
                    u32x4 w; w.x = cvt_pk_bf16(v0[0], v0[1]); w.y = cvt_pk_bf16(v0[2], v0[3]); w.z = cvt_pk_bf16(v1[0], v1[1]); w.w = cvt_pk_bf16(v1[2], v1[3]);
                    *(u32x4*)(rowp + bj * HALF) = w;
                    if (donorm) { float ss = bflo(w.x) * bflo(w.x) + bfhi(w.x) * bfhi(w.x) + bflo(w.y) * bflo(w.y) + bfhi(w.y) * bfhi(w.y) + bflo(w.z) * bflo(w.z) + bfhi(w.z) * bfhi(w.z) + bflo(w.w) * bflo(w.w) + bfhi(w.w) * bfhi(w.w);
                        ss += __shfl_xor(ss, 16); ss += __shfl_xor(ss, 32); if (bj == 0) mx0 = fmaxf(mx0, ss); else mx1 = fmaxf(mx1, ss); } } }
            if (donorm) {
#pragma unroll
                for (int o = 1; o < 16; o <<= 1) { mx0 = fmaxf(mx0, __shfl_xor(mx0, o)); mx1 = fmaxf(mx1, __shfl_xor(mx1, o)); }
                if (fr == 0 && fq == 0) { const int tile = 4 * u.pm + 2 * ai + wr;
                    atomicMax(kn2 + (size_t)(wc) * 2048 + tile, __builtin_bit_cast(unsigned, mx0)); atomicMax(kn2 + (size_t)(4 + wc) * 2048 + tile, __builtin_bit_cast(unsigned, mx1)); } } }
    }
};
struct EpiSiluMul {
    static constexpr bool PERM = true;
    bf16_t* H; int ldh;
    DI void operator()(const Acc& acc, const Unit& u, int wr, int wc, int fr, int fq) const {
        const int row0 = u.pm * BM + wr * 64 + fr, col0 = u.pn * HALF + wc * 32 + 8 * fq;
#pragma unroll
        for (int ai = 0; ai < 2; ++ai)
#pragma unroll
            for (int m = 0; m < 4; ++m) { bf16_t* rowp = H + (size_t)(row0 + ai * HALF + m * 16) * ldh + col0;
                float h[8];
#pragma unroll
                for (int n = 0; n < 2; ++n)
#pragma unroll
                    for (int j = 0; j < 4; ++j) h[n * 4 + j] = siluf_(acc[ai][0][m][n][j]) * acc[ai][1][m][n][j];
                u32x4 w; w.x = cvt_pk_bf16(h[0], h[1]); w.y = cvt_pk_bf16(h[2], h[3]); w.z = cvt_pk_bf16(h[4], h[5]); w.w = cvt_pk_bf16(h[6], h[7]);
                *(u32x4*)rowp = w; }
    }
};
DI unsigned pk4_fp8(float a, float b, float c, float d) { int w = 0; a = __builtin_amdgcn_fmed3f(a, -448.f, 448.f); b = __builtin_amdgcn_fmed3f(b, -448.f, 448.f); c = __builtin_amdgcn_fmed3f(c, -448.f, 448.f); d = __builtin_amdgcn_fmed3f(d, -448.f, 448.f);     w = __builtin_amdgcn_cvt_pk_fp8_f32(a, b, w, false); w = __builtin_amdgcn_cvt_pk_fp8_f32(c, d, w, true); return (unsigned)w; }
constexpr float FP8_W1_SCALE = 32.f, FP8_W2_SCALE = 64.f, FP8_H_SCALE = 4.f;
struct EpiSiluMul8 {
    static constexpr bool PERM = true;
    unsigned char* H; int ldh;
    DI void operator()(const Acc& acc, const Unit& u, int wr, int wc, int fr, int fq) const {
        const int row0 = u.pm * BM + wr * 64 + fr, col0 = u.pn * HALF + wc * 32 + 8 * fq;
        constexpr float k1 = -LOG2E / FP8_W1_SCALE; static_assert(FP8_W1_SCALE * FP8_W1_SCALE / FP8_H_SCALE == 256.f, "scale folding");
#pragma unroll
        for (int ai = 0; ai < 2; ++ai)
#pragma unroll
            for (int m = 0; m < 4; ++m) { unsigned char* rowp = H + (size_t)(row0 + ai * HALF + m * 16) * ldh + col0;
                float t[8], h[8];
#pragma unroll
                for (int q = 0; q < 8; ++q) t[q] = __builtin_fmaf(acc[ai][0][m][q >> 2][q & 3], k1, 8.f);
#pragma unroll
                for (int q = 0; q < 8; ++q) t[q] = __builtin_amdgcn_exp2f(t[q]);
#pragma unroll
                for (int q = 0; q < 8; ++q) { t[q] += 256.f; h[q] = acc[ai][0][m][q >> 2][q & 3] * acc[ai][1][m][q >> 2][q & 3]; }
#pragma unroll
                for (int q = 0; q < 8; ++q) t[q] = __builtin_amdgcn_rcpf(t[q]);
#pragma unroll
                for (int q = 0; q < 8; ++q) h[q] *= t[q];
                u32x2 w; w.x = pk4_fp8(h[0], h[1], h[2], h[3]); w.y = pk4_fp8(h[4], h[5], h[6], h[7]);
                *(u32x2*)rowp = w; }
    }
};
struct EpiMoeDown {
    static constexpr bool PERM = false;
    float* out; const int* idx; const float* gs; float sc;
    DI void operator()(const Acc& acc, const Unit& u, int wr, int wc, int fr, int fq) const {
        const int row0 = u.pm * BM + wr * 64 + fr, col0 = u.pn * BM + wc * 32 + 4 * fq;
#pragma unroll
        for (int ai = 0; ai < 2; ++ai)
#pragma unroll
            for (int m = 0; m < 4; ++m) { const int rl = row0 + ai * HALF + m * 16; const int tok = idx[rl]; const float g = gs[rl] * sc;
                float* rowp = out + (size_t)tok * DM + col0;
#pragma unroll
                for (int bj = 0; bj < 2; ++bj)
#pragma unroll
                    for (int n = 0; n < 2; ++n) { f32x4* p = (f32x4*)(rowp + bj * HALF + n * 16); f32x4 v = *p; v += acc[ai][bj][m][n] * g; *p = v; }
                asm volatile("" ::: "memory"); }
    }
};
struct EpiYe {
    static constexpr bool PERM = true;
    bf16_t* O; const float* gs; float sc;
    DI void operator()(const Acc& acc, const Unit& u, int wr, int wc, int fr, int fq) const {
        const int row0 = u.pm * BM + wr * 64 + fr, col0 = u.pn * BM + wc * 32 + 8 * fq;
        float gv[8];
#pragma unroll
        for (int c = 0; c < 8; ++c) gv[c] = gs[row0 + (c >> 2) * HALF + (c & 3) * 16];
#pragma unroll
        for (int ai = 0; ai < 2; ++ai)
#pragma unroll
            for (int m = 0; m < 4; ++m) { const int rl = row0 + ai * HALF + m * 16; const float g = gv[ai * 4 + m] * sc; bf16_t* rowp = O + (size_t)rl * DM + col0;
#pragma unroll
                for (int bj = 0; bj < 2; ++bj) { const f32x4 v0 = acc[ai][bj][m][0] * g, v1 = acc[ai][bj][m][1] * g;
                    u32x4 w; w.x = cvt_pk_bf16(v0[0], v0[1]); w.y = cvt_pk_bf16(v0[2], v0[3]); w.z = cvt_pk_bf16(v1[0], v1[1]); w.w = cvt_pk_bf16(v1[2], v1[3]);
                    *(u32x4*)(rowp + bj * HALF) = w; } }
    }
};
struct EpiResid {
    static constexpr bool PERM = false;
    const float* xa; const float* xb; float* out;
    DI void operator()(const Acc& acc, const Unit& u, int wr, int wc, int fr, int fq) const {
        const int row0 = u.pm * BM + wr * 64 + fr, col0 = u.pn * BM + wc * 32 + 4 * fq;
#pragma unroll
        for (int ai = 0; ai < 2; ++ai) {
            f32x4 sv[4][4];
#pragma unroll
            for (int m = 0; m < 4; ++m) { const int r = row0 + ai * HALF + m * 16;
                const float* srow = (r < NTOKG ? xa + (size_t)r * DM : xb + (size_t)(r - NTOKG) * DM) + col0;
#pragma unroll
                for (int q = 0; q < 4; ++q) sv[m][q] = *(const f32x4*)(srow + (q >> 1) * HALF + (q & 1) * 16); }
#pragma unroll
            for (int m = 0; m < 4; ++m) { const int r = row0 + ai * HALF + m * 16; float* orow = out + (size_t)r * DM + col0;
#pragma unroll
                for (int q = 0; q < 4; ++q) *(f32x4*)(orow + (q >> 1) * HALF + (q & 1) * 16) = sv[m][q] + acc[ai][q >> 1][m][q & 1] * INV_ALPHA; } }
    }
};
struct EpiGateMix {
    static constexpr bool PERM = false;
    const bf16_t* Z; bf16_t* mix; float si;
    DI void operator()(const Acc& acc, const Unit& u, int wr, int wc, int fr, int fq) const {
        const int row0 = u.pm * BM + wr * 64 + fr, J0 = u.pn * 64 + wc * 16 + fq * 4;
        u32x2 zall[8][4];
#pragma unroll
        for (int c = 0; c < 8; ++c) { const bf16_t* zrow = Z + (size_t)(row0 + (c >> 2) * HALF + (c & 3) * 16) * 4096 + J0;
#pragma unroll
            for (int b = 0; b < 4; ++b) zall[c][b] = *(const u32x2*)(zrow + b * 1024); }
#pragma unroll
        for (int ai = 0; ai < 2; ++ai)
#pragma unroll
            for (int m = 0; m < 4; ++m) { const int r = row0 + ai * HALF + m * 16;
                u32x2 zw[4];
#pragma unroll
                for (int b = 0; b < 4; ++b) zw[b] = zall[ai * 4 + m][b];
                const float kq = -si * LOG2E; float t[16];
#pragma unroll
                for (int q = 0; q < 16; ++q) t[q] = acc[ai][q >> 3][m][(q >> 2) & 1][q & 3] * kq;
#pragma unroll
                for (int q = 0; q < 16; ++q) t[q] = __builtin_amdgcn_exp2f(t[q]);
#pragma unroll
                for (int q = 0; q < 16; ++q) t[q] += 1.f;
#pragma unroll
                for (int q = 0; q < 16; ++q) t[q] = __builtin_amdgcn_rcpf(t[q]);
                f32x4 s = (f32x4){0.f, 0.f, 0.f, 0.f};
#pragma unroll
                for (int b = 0; b < 4; ++b) { s[0] += t[4 * b] * bflo(zw[b].x); s[1] += t[4 * b + 1] * bfhi(zw[b].x); s[2] += t[4 * b + 2] * bflo(zw[b].y); s[3] += t[4 * b + 3] * bfhi(zw[b].y); }
                u32x2 w; w.x = cvt_pk_bf16(s[0], s[1]); w.y = cvt_pk_bf16(s[2], s[3]);
                *(u32x2*)(mix + (size_t)r * DM + J0) = w; }
    }
};
}

#define XB_TMO      128
#define XB_XCNT(j)  (256  + 64 * (j))
#define XB_XSUB(j)  (1280 + 64 * (j))
#define XB_XGEN(j)  (2304 + 64 * (j))
#define XB_TOP      3328
#define XB_TOPGEN   3392
#define XCD_BAR_WORDS 3456
#define XB_SPIN_CAP (1u << 24)
DI unsigned xb_ld(unsigned* p)              { return __hip_atomic_load(p, __ATOMIC_RELAXED, __HIP_MEMORY_SCOPE_AGENT); }
DI unsigned xb_add(unsigned* p, unsigned v) { return __hip_atomic_fetch_add(p, v, __ATOMIC_RELAXED, __HIP_MEMORY_SCOPE_AGENT); }
DI unsigned xb_xcc_id() { return (unsigned)__builtin_amdgcn_s_getreg((3 << 11) | 20) & 0xFu; }
#define XB_SPIN(cond, bar) do { unsigned _sp = 0; while (cond) { __builtin_amdgcn_s_sleep(1); \
    if ((++_sp & 255u) == 0u) { if (xb_ld(&(bar)[XB_TMO])) break; if (_sp > XB_SPIN_CAP) { atomicAdd(&(bar)[XB_TMO], 1u); break; } } } } while (0)
struct XcdBarrier { unsigned* bar; unsigned x; volatile LAS unsigned* st; };
DI XcdBarrier xcd_barrier_post(unsigned* bar, volatile LAS unsigned* st) {
    XcdBarrier b; b.bar = bar; b.x = xb_xcc_id(); b.st = st;
    if (threadIdx.x == 0) (void)xb_add(&bar[XB_XCNT(b.x)], 1u);
    return b;
}
DI void xcd_barrier_complete(unsigned* bar, unsigned x, unsigned& nloc, unsigned& nx) {
    const unsigned G = gridDim.x * gridDim.y * gridDim.z;
    unsigned sum, cnt, mine, sp = 0u;
    for (;;) {
        sum = 0u; cnt = 0u; mine = 0u;
#pragma unroll
        for (unsigned j = 0; j < 16; ++j) { const unsigned c = xb_ld(&bar[XB_XCNT(j)]); sum += c; cnt += (c > 0u) ? 1u : 0u; mine = (j == x) ? c : mine; }
        if (sum == G) break;
        __builtin_amdgcn_s_sleep(1);
        if ((++sp & 255u) == 0u) { if (xb_ld(&bar[XB_TMO])) break; if (sp > XB_SPIN_CAP) { atomicAdd(&bar[XB_TMO], 1u); break; } }
    }
    nloc = mine > 0u ? mine : 1u; nx = cnt > 0u ? cnt : 1u;
}
DI void xcd_barrier(const XcdBarrier& b) {
    asm volatile("s_waitcnt vmcnt(0)" ::: "memory");
    __syncthreads();
    if (threadIdx.x == 0) {
        unsigned* bar = b.bar;
        __builtin_amdgcn_s_waitcnt(0);
        unsigned nloc = b.st[0], nx = b.st[1];
        if (nloc == 0u) { xcd_barrier_complete(bar, b.x, nloc, nx); b.st[0] = nloc; b.st[1] = nx; }
        const unsigned old = xb_add(&bar[XB_XSUB(b.x)], 1u);
        const unsigned gen = old / nloc;
        if (old + 1u == (gen + 1u) * nloc) {
            __builtin_amdgcn_fence(__ATOMIC_RELEASE, "agent");
            asm volatile("s_waitcnt vmcnt(0)" ::: "memory");
            const unsigned og = xb_add(&bar[XB_TOP], 1u);
            const unsigned tg = og / nx;
            if (og + 1u == (tg + 1u) * nx) xb_add(&bar[XB_TOPGEN], 1u);
            else XB_SPIN(xb_ld(&bar[XB_TOPGEN]) == tg, bar);
            __builtin_amdgcn_fence(__ATOMIC_ACQUIRE, "agent");
            xb_add(&bar[XB_XGEN(b.x)], 1u);
            asm volatile("s_waitcnt vmcnt(0)" ::: "memory");
        } else {
            XB_SPIN(xb_ld(&bar[XB_XGEN(b.x)]) == gen, bar);
            __builtin_amdgcn_fence(__ATOMIC_ACQUIRE, "agent");
            asm volatile("s_waitcnt vmcnt(0)" ::: "memory");
        }
    }
    __syncthreads();
}

struct Args { const float* in[26]; float* out; unsigned char* ws; int ph_lo, ph_hi; };
struct Ctx {
    LAS unsigned char* lds;
    GAS unsigned char* ws;
    int tid, lane, wave, G, bid, gw, NGW;
    const struct Args* A;
    GAS float* out;
};
constexpr int RING_BYTES = 131072, MISC_OFF = RING_BYTES + 320, LDS_BYTES = 147456;

DI void tr_item(const float* __restrict__ W, int ldw, int k0, int src, const float* kscale, bf16_t* WT, int ldt, int orow0, LAS float* scr, int lane) {
    float tv[32];
#pragma unroll
    for (int i = 0; i < 32; ++i) { const int kk = 2 * i + (lane >> 5); tv[i] = (src >= 0) ? W[(size_t)(k0 + kk) * ldw + src] : 0.f; }
#pragma unroll
    for (int i = 0; i < 32; ++i) { const int kk = 2 * i + (lane >> 5); float v = tv[i]; if (kscale) v *= kscale[k0 + kk]; scr[kk * 33 + (lane & 31)] = v; }
    LDS_WAIT();
    const int c = lane & 7;
#pragma unroll
    for (int j = 0; j < 4; ++j) { const int n = (lane >> 3) + 8 * j; const LAS float* s = scr + (8 * c) * 33 + n;
        u32x4 o; o.x = pk2(s[0 * 33], s[1 * 33]); o.y = pk2(s[2 * 33], s[3 * 33]); o.z = pk2(s[4 * 33], s[5 * 33]); o.w = pk2(s[6 * 33], s[7 * 33]);
        *(u32x4*)(WT + (size_t)(orow0 + n) * ldt + k0 + 8 * c) = o; }
    LDS_WAIT();
}
DI void tr_item8(const float* __restrict__ W, int ldw, int k0, int src, float scale, unsigned char* WT, int ldt, int orow0, LAS float* scr, int lane) {
    float tv[32];
#pragma unroll
    for (int i = 0; i < 32; ++i) { const int kk = 2 * i + (lane >> 5); tv[i] = W[(size_t)(k0 + kk) * ldw + src]; }
#pragma unroll
    for (int i = 0; i < 32; ++i) { const int kk = 2 * i + (lane >> 5); scr[kk * 33 + (lane & 31)] = tv[i] * scale; }
    LDS_WAIT();
    const int c = lane & 7;
#pragma unroll
    for (int j = 0; j < 4; ++j) { const int n = (lane >> 3) + 8 * j; const LAS float* s = scr + (8 * c) * 33 + n;
        u32x2 o; o.x = pg8::pk4_fp8(s[0 * 33], s[1 * 33], s[2 * 33], s[3 * 33]); o.y = pg8::pk4_fp8(s[4 * 33], s[5 * 33], s[6 * 33], s[7 * 33]);
        *(u32x2*)(WT + (size_t)(orow0 + n) * ldt + k0 + 8 * c) = o; }
    LDS_WAIT();
}
constexpr int SW_ITEMS[8] = {16 * 24, 16 * 40, 16 * 32, 16 * 128, 4 * 4 * 32, 16 * 32, 3 * 6, 2 * 12};
constexpr int SW_TOTAL = 16 * 24 + 16 * 40 + 16 * 32 + 16 * 128 + 4 * 4 * 32 + 16 * 32 + 3 * 6 + 2 * 12;
DI void small_weight_item(const Ctx& C, int l, int it, LAS float* scr) {
    unsigned char* wl = (unsigned char*)(C.ws + WS_WSMALL + (size_t)l * WSMALL_LAYER); unsigned char* wc = (unsigned char*)(C.ws + WS_WC + (size_t)l * WC_LAYER);
    const float* win = C.A->in[2] + (size_t)l * DM * IN_W; const int ln = C.lane & 31;
    if (it < 384) { const int kb = it / 24, nb = it % 24; tr_item(win, IN_W, kb * 64, nb * 32 + ln, nullptr, (bf16_t*)(wl + OFF_WA), 1024, nb * 32, scr, C.lane); return; } it -= 384;
    if (it < 640) { const int kb = it / 40, nb = it % 40; tr_item(win, IN_W, kb * 64, COL_B + nb * 32 + ln, nullptr, (bf16_t*)(wl + OFF_WB), 1024, nb * 32, scr, C.lane); return; } it -= 640;
    if (it < 512) { const int kb = it / 32, nb = it % 32; const int n = nb * 32 + ln; tr_item(win, IN_W, kb * 64, n < 848 ? COL_CD + n : -1, nullptr, (bf16_t*)(wl + OFF_WCD), 1024, nb * 32, scr, C.lane); return; } it -= 512;
    if (it < 2048) { const int kb = it / 128, nb = it % 128; const int n = nb * 32 + ln, pn = n >> 8, c = n & 255;
        const int bj = c >> 7, wcc = (c >> 5) & 3, nn = (c >> 4) & 1, fq = (c >> 2) & 3, j = c & 3;
        const int src = COL_GATE + (2 * bj + nn) * 1024 + 64 * pn + 16 * wcc + 4 * fq + j;
        tr_item8(win, IN_W, kb * 64, src, pg8::FP8_W1_SCALE, wl + OFF_WG, 1024, nb * 32, scr, C.lane); return; } it -= 2048;
    if (it < 512) { const int b = it / 128, r = it % 128, kb = r / 32, nb = r % 32;
        tr_item(C.A->in[18] + (size_t)(l * 4 + b) * 256 * 1024, 1024, kb * 64, nb * 32 + ln, nullptr, (bf16_t*)(wl + OFF_WBR), 256, b * 1024 + nb * 32, scr, C.lane); return; } it -= 512;
    if (it < 512) { const int kb = it / 32, nb = it % 32; tr_item(C.A->in[19] + (size_t)l * DM * DM, 1024, kb * 64, nb * 32 + ln, nullptr, (bf16_t*)(wl + OFF_WOUT), 1024, nb * 32, scr, C.lane); return; } it -= 512;
    if (it < 18) { const int kb = it / 6, nb = it % 6; tr_item(C.A->in[8] + (size_t)l * 192 * 192, 192, kb * 64, nb * 32 + ln, C.A->in[7] + l * 192, (bf16_t*)(wc + OFF_WQ), 192, nb * 32, scr, C.lane); return; } it -= 18;
    { const int kb = it / 12, nb = it % 12; tr_item(C.A->in[10] + (size_t)l * 128 * 384, 384, kb * 64, nb * 32 + ln, C.A->in[9] + l * 128, (bf16_t*)(wc + OFF_WKV), 128, nb * 32, scr, C.lane); }
}
DI void ph_prologue(const Ctx& C) {
    LAS float* scr = (LAS float*)(C.lds + C.wave * 16384);
    for (int it = C.gw; it < 2 * SW_TOTAL; it += C.NGW) small_weight_item(C, it / SW_TOTAL, it % SW_TOTAL, scr);
    for (int it = C.gw; it < 2 * 2 * 4 * 2 * 4 * 2; it += C.NGW) {
        const int ks = it & 1, nt = (it >> 1) & 3, gt = (it >> 3) & 1, n = (it >> 4) & 3, dir = (it >> 6) & 1, l = it >> 7;
        const float* wp = (gt == 0 ? C.A->in[13] : C.A->in[15]) + ((size_t)((l * 2 + dir) * 4 + n) * 64) * 64;
        const int l15 = C.lane & 15, g = C.lane >> 4; u32x4 wv;
#pragma unroll
        for (int p = 0; p < 4; ++p) { const int k = 32 * ks + 8 * g + 2 * p; wv[p] = cvt_pk_bf16(wp[(size_t)k * 64 + 16 * nt + l15], wp[(size_t)(k + 1) * 64 + 16 * nt + l15]); }
        ((u32x4*)(C.ws + WS_WRG))[(size_t)it * 64 + C.lane] = wv;
    }
    bf16_t* XB0 = (bf16_t*)(C.ws + WS_XB0);
    for (int row0 = C.gw; row0 < NTOK; row0 += 4 * C.NGW) {
        f32x4 v[4][4];
#pragma unroll
        for (int i = 0; i < 4; ++i) { const int row = min(row0 + i * C.NGW, NTOK - 1);
            const float* src = row < NTOKG ? C.A->in[0] + (size_t)row * DM : C.A->in[1] + (size_t)(row - NTOKG) * DM; const f32x4* xr = (const f32x4*)src + C.lane;
#pragma unroll
            for (int j = 0; j < 4; ++j) v[i][j] = xr[64 * j]; }
#pragma unroll
        for (int i = 0; i < 4; ++i) { const int row = row0 + i * C.NGW; if (row < NTOK) { u32x2* o = (u32x2*)(XB0 + (size_t)row * DM) + C.lane;
#pragma unroll
            for (int j = 0; j < 4; ++j) { u32x2 w; w.x = cvt_pk_bf16(v[i][j][0], v[i][j][1]); w.y = cvt_pk_bf16(v[i][j][2], v[i][j][3]); o[64 * j] = w; } } }
    }
}
DI void expert_weight_items(const Ctx& C, int l) {
    __syncthreads();
    LAS float* scr = (LAS float*)(C.lds + C.wave * 16384);
    unsigned char* WGU = (unsigned char*)(C.ws + WS_EW + OFF_WGU8); unsigned char* WD = (unsigned char*)(C.ws + WS_EW + OFF_WD8);
    const int ln = C.lane & 31;
    const int gw0 = (C.G > 64) ? C.gw - 32 * 8 : C.gw, ngw = (C.G > 64) ? C.NGW - 32 * 8 : C.NGW;
    for (int it = gw0; it < 32768 + 16384; it += ngw) {
        if (it < 32768) { const int e = it >> 11, r = it & 2047, kb = r >> 7, nb = r & 127; const int n = nb * 32 + ln, pn = n >> 8, c = n & 255;
            const float* W = (c < 128 ? C.A->in[23] : C.A->in[24]) + (size_t)(l * NEXP + e) * DM * DEXP;
            tr_item8(W, DEXP, kb * 64, 128 * pn + (c & 127), pg8::FP8_W1_SCALE, WGU + (size_t)e * 4096 * 1024, 1024, nb * 32, scr, C.lane);
        } else { const int i2 = it - 32768, e = i2 >> 10, r = i2 & 1023, kb = r >> 5, nb = r & 31;
            tr_item8(C.A->in[25] + (size_t)(l * NEXP + e) * DEXP * DM, DM, kb * 64, nb * 32 + ln, pg8::FP8_W2_SCALE, WD + (size_t)e * 1024 * 2048, 2048, nb * 32, scr, C.lane); }
    }
}

template <bool ROUTER>
DI void ph_ln(const Ctx& C, int l, int which, bf16_t* XB) {
    LAS float* wr = (LAS float*)C.lds;
    if (ROUTER) { const float* src = C.A->in[22] + (size_t)l * DM * NEXP;
        for (int t = C.tid; t < DM * NEXP / 4; t += 512) { const int k = t >> 2, q = t & 3, ln = (k & 255) >> 2, ii = k & 3, jj = k >> 8;
            ((LAS f32x4*)wr)[((jj * 4 + ii) * 4 + q) * 64 + ln] = ((const f32x4*)src)[t]; }
        __syncthreads(); }
    const float* gp = C.A->in[20] + (size_t)(l * 2 + which) * DM; const float* bp = C.A->in[21] + (size_t)(l * 2 + which) * DM;
    f32x4 gv[4], bv[4];
#pragma unroll
    for (int j = 0; j < 4; ++j) { gv[j] = ((const f32x4*)gp)[C.lane + 64 * j]; bv[j] = ((const f32x4*)bp)[C.lane + 64 * j]; }
    float* affT = (float*)(C.ws + WS_AFF);
    f32x4 nx[4], ny[4];
    { const f32x4* xr0 = (const f32x4*)(C.out + (size_t)C.gw * DM) + C.lane;
#pragma unroll
      for (int j = 0; j < 4; ++j) nx[j] = xr0[64 * j];
      { const f32x4* xr1 = (const f32x4*)(C.out + (size_t)min(C.gw + C.NGW, NTOK - 1) * DM) + C.lane;
#pragma unroll
          for (int j = 0; j < 4; ++j) ny[j] = xr1[64 * j]; } }
    u32x4 sm0 = {0u, 0u, 0u, 0u}, sm1 = {0u, 0u, 0u, 0u};
    if (!ROUTER) { const u32x4* smr = (const u32x4*)(C.ws + WS_SM + (size_t)C.gw * 32); sm0 = smr[0]; sm1 = smr[1]; }
    for (int row = C.gw; row < NTOK; row += C.NGW) {
        f32x4* xr = (f32x4*)(C.out + (size_t)row * DM) + C.lane;
        f32x4 v[4]; float s = 0.f;
#pragma unroll
        for (int j = 0; j < 4; ++j) v[j] = nx[j] * ALPHA;
        if (!ROUTER) {
            const unsigned sw[8] = {sm0.x, sm0.y, sm0.z, sm0.w, sm1.x, sm1.y, sm1.z, sm1.w};
            { const u32x4* smr = (const u32x4*)(C.ws + WS_SM + (size_t)min(row + C.NGW, NTOK - 1) * 32); sm0 = smr[0]; sm1 = smr[1]; }
            const bf16_t* YE = (const bf16_t*)(C.ws + WS_Y); const int gofs = (row >> 16) * CAP;
            unsigned msk = 0u;
#pragma unroll
            for (int e = 0; e < 16; ++e) { const int slot = (int)(short)((e & 1) ? (sw[e >> 1] >> 16) : (sw[e >> 1] & 0xffffu)); if (slot >= 0) msk |= 1u << e; }
            msk = (unsigned)__builtin_amdgcn_readfirstlane((int)msk);
            while (msk) {
                const int e1 = __builtin_ctz(msk); msk &= msk - 1u; const bool two = msk != 0u; const int e2 = two ? __builtin_ctz(msk) : e1; if (two) msk &= msk - 1u;
                unsigned w1 = sw[0], w2 = sw[0];
#pragma unroll
                for (int q = 1; q < 8; ++q) { w1 = ((e1 >> 1) == q) ? sw[q] : w1; w2 = ((e2 >> 1) == q) ? sw[q] : w2; }
                const int s1 = (int)((e1 & 1) ? (w1 >> 16) : (w1 & 0xffffu)), s2 = (int)((e2 & 1) ? (w2 >> 16) : (w2 & 0xffffu));
                const u32x2* y1 = (const u32x2*)(YE + ((size_t)e1 * 16384 + gofs + s1) * DM) + C.lane; const u32x2* y2 = (const u32x2*)(YE + ((size_t)e2 * 16384 + gofs + s2) * DM) + C.lane;
                u32x2 a[4], b[4];
#pragma unroll
                for (int j = 0; j < 4; ++j) { a[j] = y1[64 * j]; b[j] = y2[64 * j]; }
                const float f2 = two ? 1.f : 0.f;
#pragma unroll
                for (int j = 0; j < 4; ++j) { v[j][0] += bflo(a[j].x) + f2 * bflo(b[j].x); v[j][1] += bfhi(a[j].x) + f2 * bfhi(b[j].x); v[j][2] += bflo(a[j].y) + f2 * bflo(b[j].y); v[j][3] += bfhi(a[j].y) + f2 * bfhi(b[j].y); }
            }
        }
#pragma unroll
        for (int j = 0; j < 4; ++j) s += (v[j][0] + v[j][1]) + (v[j][2] + v[j][3]);
#pragma unroll
        for (int j = 0; j < 4; ++j) nx[j] = ny[j];
        { const int rn = row + 2 * C.NGW < NTOK ? row + 2 * C.NGW : row; const f32x4* xn = (const f32x4*)(C.out + (size_t)rn * DM) + C.lane;
#pragma unroll
            for (int j = 0; j < 4; ++j) ny[j] = xn[64 * j]; }
        const float mean = wave_sum(s) * (1.f / DM); float s2 = 0.f;
#pragma unroll
        for (int j = 0; j < 4; ++j) { v[j] = v[j] - mean; s2 += (v[j][0] * v[j][0] + v[j][1] * v[j][1]) + (v[j][2] * v[j][2] + v[j][3] * v[j][3]); }
        const float rstd = 1.0f / sqrtf(wave_sum(s2) * (1.f / DM) + LN_EPS);
        u32x2* o8 = (u32x2*)(XB + (size_t)row * DM) + C.lane; unsigned* o4 = (unsigned*)((unsigned char*)XB + (size_t)row * DM) + C.lane;
#pragma unroll
        for (int j = 0; j < 4; ++j) { v[j] = v[j] * rstd * gv[j] + bv[j]; xr[64 * j] = v[j];
            if constexpr (ROUTER) { o4[64 * j] = pg8::pk4_fp8(v[j][0], v[j][1], v[j][2], v[j][3]); asm volatile("" ::: "memory"); }
            else if (XB) { u32x2 w; w.x = cvt_pk_bf16(v[j][0], v[j][1]); w.y = cvt_pk_bf16(v[j][2], v[j][3]); o8[64 * j] = w; } }
        if (ROUTER) {
            float p[16];
#pragma unroll
            for (int e = 0; e < 16; ++e) p[e] = 0.f;
#pragma unroll
            for (int j = 0; j < 4; ++j)
#pragma unroll
                for (int i = 0; i < 4; ++i) { const float xv = v[j][i];
#pragma unroll
                    for (int q = 0; q < 4; ++q) { const f32x4 w4 = ((const LAS f32x4*)wr)[((j * 4 + i) * 4 + q) * 64 + C.lane]; p[4 * q] += xv * w4[0]; p[4 * q + 1] += xv * w4[1]; p[4 * q + 2] += xv * w4[2]; p[4 * q + 3] += xv * w4[3]; } }
            const bool b5 = (C.lane & 32) != 0, b4 = (C.lane & 16) != 0, b3 = (C.lane & 8) != 0, b2 = (C.lane & 4) != 0;
            float r8[8], r4[4], r2[2], lg;
#pragma unroll
            for (int i = 0; i < 8; ++i) { const float keep = b5 ? p[8 + i] : p[i], send = b5 ? p[i] : p[8 + i]; r8[i] = keep + __shfl_xor(send, 32); }
#pragma unroll
            for (int i = 0; i < 4; ++i) { const float keep = b4 ? r8[4 + i] : r8[i], send = b4 ? r8[i] : r8[4 + i]; r4[i] = keep + __shfl_xor(send, 16); }
#pragma unroll
            for (int i = 0; i < 2; ++i) { const float keep = b3 ? r4[2 + i] : r4[i], send = b3 ? r4[i] : r4[2 + i]; r2[i] = keep + __shfl_xor(send, 8); }
            { const float keep = b2 ? r2[1] : r2[0], send = b2 ? r2[0] : r2[1]; lg = keep + __shfl_xor(send, 4); }
            lg += __shfl_xor(lg, 2); lg += __shfl_xor(lg, 1);
            float mx = lg;
            mx = fmaxf(mx, __shfl_xor(mx, 4)); mx = fmaxf(mx, __shfl_xor(mx, 8)); mx = fmaxf(mx, __shfl_xor(mx, 16)); mx = fmaxf(mx, __shfl_xor(mx, 32));
            const float ex = __expf(lg - mx); float den = ex;
            den += __shfl_xor(den, 4); den += __shfl_xor(den, 8); den += __shfl_xor(den, 16); den += __shfl_xor(den, 32);
            const int eL = (b5 ? 8 : 0) + (b4 ? 4 : 0) + (b3 ? 2 : 0) + (b2 ? 1 : 0);
            if ((C.lane & 3) == 0) affT[((size_t)(row >> 16) * 16 + eL) * NTOKG + (row & 65535)] = ex / den;
            if (C.lane < 8) ((unsigned*)(C.ws + WS_SM))[(size_t)row * 8 + C.lane] = 0xFFFFFFFFu;
        }
    }
}

namespace att {
DI int crow(int r, int hi) { return (r & 3) + 8 * (r >> 2) + 4 * hi; }
DI int v_st(int k, int c) { const int kk = (k & ~0xC) | ((k & 4) << 1) | ((k & 8) >> 1); return ((kk >> 3) * 2 + (c >> 5)) * 512 + ((kk & 7) * 32 + (c & 31)) * 2; }
DI int v_rd_base(int lane) { return ((lane & 3) << 3) | (((lane >> 2) & 3) << 6) | (((lane >> 4) & 1) << 5) | (((lane >> 5) & 1) << 8); }
constexpr int v_rd_off(int d0, int ks, int half) { return d0 * 512 + ks * 2048 + half * 1024; }
template <int OFF> DI s16x4 tr_read(int vb) { s16x4 r; asm volatile("ds_read_b64_tr_b16 %0, %1 offset:%2" : "=&v"(r) : "v"(vb), "i"(OFF) : "memory"); return r; }
template <int D0> DI void pv_one(f32x16& od, int vb, bf16x8 pa0, bf16x8 pa1, bf16x8 pa2, bf16x8 pa3) {
    const s16x4 l0 = tr_read<v_rd_off(D0, 0, 0)>(vb), h0 = tr_read<v_rd_off(D0, 0, 1)>(vb), l1 = tr_read<v_rd_off(D0, 1, 0)>(vb), h1 = tr_read<v_rd_off(D0, 1, 1)>(vb);
    const s16x4 l2 = tr_read<v_rd_off(D0, 2, 0)>(vb), h2 = tr_read<v_rd_off(D0, 2, 1)>(vb), l3 = tr_read<v_rd_off(D0, 3, 0)>(vb), h3 = tr_read<v_rd_off(D0, 3, 1)>(vb);
    asm volatile("s_waitcnt lgkmcnt(0)" ::: "memory"); __builtin_amdgcn_sched_barrier(0);
#define PKV(L, H) (bf16x8){L[0], L[1], L[2], L[3], H[0], H[1], H[2], H[3]}
    od = __builtin_amdgcn_mfma_f32_32x32x16_bf16(pa0, PKV(l0, h0), od, 0, 0, 0);
    od = __builtin_amdgcn_mfma_f32_32x32x16_bf16(pa1, PKV(l1, h1), od, 0, 0, 0);
    od = __builtin_amdgcn_mfma_f32_32x32x16_bf16(pa2, PKV(l2, h2), od, 0, 0, 0);
    od = __builtin_amdgcn_mfma_f32_32x32x16_bf16(pa3, PKV(l3, h3), od, 0, 0, 0);
#undef PKV
}
DI void pv_ones(f32x16& o2, bf16x8 pa0, bf16x8 pa1, bf16x8 pa2, bf16x8 pa3) {
    const u32x4 onesw = {0x3F803F80u, 0x3F803F80u, 0x3F803F80u, 0x3F803F80u}; const bf16x8 ones = __builtin_bit_cast(bf16x8, onesw);
    o2 = __builtin_amdgcn_mfma_f32_32x32x16_bf16(pa0, ones, o2, 0, 0, 0); o2 = __builtin_amdgcn_mfma_f32_32x32x16_bf16(pa1, ones, o2, 0, 0, 0);
    o2 = __builtin_amdgcn_mfma_f32_32x32x16_bf16(pa2, ones, o2, 0, 0, 0); o2 = __builtin_amdgcn_mfma_f32_32x32x16_bf16(pa3, ones, o2, 0, 0, 0);
}
constexpr int KROW(int KS) { return KS * 32 + 16; }
constexpr int KTILE = 64 * 112, VTILE = 8192, LDS_ATT = 2 * KTILE + 2 * VTILE + 8 * 256;

DI void split3(float x, unsigned& w_hm, unsigned& w_l0) {
    const unsigned h = f2bf(x); const float r1 = x - __builtin_bit_cast(float, h << 16);
    const unsigned m = f2bf(r1); const float r2 = r1 - __builtin_bit_cast(float, m << 16);
    const unsigned l = f2bf(r2);
    w_hm = h | (m << 16); w_l0 = l;
}
template <int KS, bool ALIBI>
DI void attn_unit(const bf16_t* __restrict__ Qb, int ldq, const bf16_t* __restrict__ Kb, int ldk, const bf16_t* __restrict__ Vb, int ldv,
                  bf16_t* __restrict__ Ob, int ldo, int seq_len, int q0, float slope2, const unsigned* __restrict__ kn2, LAS unsigned char* lds) {
    int tid = threadIdx.x; asm volatile("" : "+v"(tid));
    const int wid = tid >> 6, lane = tid & 63, r32 = lane & 31, hi = lane >> 5;
    LAS unsigned char* K_lds = lds; LAS unsigned char* V_lds = lds + 2 * KTILE;
    LAS float* wsl = (LAS float*)(lds + 2 * KTILE + 2 * VTILE) + wid * 64; LAS float* li_l = wsl; LAS float* al_l = wsl + 32;
    LAS float* blk = (LAS float*)(lds + LDS_ATT);
    LAS int* tl = (LAS int*)(lds + LDS_ATT + 128);
    constexpr int KR = KROW(KS), KP = 2 * KS;
    constexpr float THR = 8.f, SKIP = -40.f;
    float mt = 0.f; f32x16 o[3];
#pragma unroll
    for (int d = 0; d < 3; ++d)
#pragma unroll
        for (int r = 0; r < 16; ++r) o[d][r] = 0.f;
    bf16x8 qr[KS];
    const bf16_t* Qw = Qb + (size_t)(wid * 32 + r32) * ldq + hi * 8;
#pragma unroll
    for (int d0 = 0; d0 < KS; ++d0) qr[d0] = *(const bf16x8*)(Qw + d0 * 16);
    if (ALIBI) { float qn = 0.f;
#pragma unroll
        for (int d0 = 0; d0 < KS; ++d0)
#pragma unroll
            for (int j = 0; j < 8; ++j) { const float f = bf2f((unsigned short)qr[d0][j]); qn += f * f; }
        qn += __shfl_xor(qn, 32); qn = wave_max(qn); if (lane == 0) blk[wid] = qn; }
    const int vkey = tid >> 3, vcol = (tid & 7) * 8, vst = v_st(vkey, vcol);
    const bool kact = tid < 64 * KP; const int kkey = kact ? tid / KP : 0, kpc = kact ? tid % KP : 0;
    const int vb0 = (int)(uintptr_t)V_lds + v_rd_base(lane);
    const int w0 = q0 + wid * 32; const float qpos = (float)(w0 + r32);
    const int NT = seq_len / 64, jd0 = q0 >> 6;
    bf16x8 kx0, kx1;
    { u32x4 a = {0u, 0u, 0u, 0u}, b = {0u, 0u, 0u, 0u};
        if (hi == 0) {
            a.z = 0x3F803F80u; a.w = 0x00003F80u; b.z = 0x3F803F80u; b.w = 0x00003F80u;
            if (ALIBI) { const float c0 = slope2 * (float)r32, c1 = slope2 * (float)(32 + r32);
                const unsigned h0 = f2bf(c0), l0 = f2bf(c0 - __builtin_bit_cast(float, h0 << 16)), h1 = f2bf(c1), l1 = f2bf(c1 - __builtin_bit_cast(float, h1 << 16));
                a.x = h0 | (l0 << 16); a.y = (h0 | (l0 << 16)) ^ 0x80008000u; b.x = h1 | (l1 << 16); b.y = (h1 | (l1 << 16)) ^ 0x80008000u; } }
        kx0 = __builtin_bit_cast(bf16x8, a); kx1 = __builtin_bit_cast(bf16x8, b); }
    bf16x8 vs, ks_;
    bool first = true;
#define SLOAD(k0) do { vs = *(const bf16x8*)(Vb + (size_t)((k0) + vkey) * ldv + vcol); ks_ = *(const bf16x8*)(Kb + (size_t)((k0) + kkey) * ldk + kpc * 8); } while (0)
#define SWRITE(b) do { *(LAS bf16x8*)(V_lds + (b) * VTILE + vst) = vs; if (kact) *(LAS bf16x8*)(K_lds + (b) * KTILE + kkey * KR + kpc * 16) = ks_; } while (0)
#define PK4(P, BASE, OUT) do { unsigned a0 = cvt_pk_bf16_b(P[BASE + 0], P[BASE + 1]), a1 = cvt_pk_bf16_b(P[BASE + 2], P[BASE + 3]); \
        unsigned b0_ = cvt_pk_bf16_b(P[BASE + 4], P[BASE + 5]), b1_ = cvt_pk_bf16_b(P[BASE + 6], P[BASE + 7]); \
        auto r0 = __builtin_amdgcn_permlane32_swap(a0, b0_, false, false); auto r1 = __builtin_amdgcn_permlane32_swap(a1, b1_, false, false); \
        u32x4 w = {r0[0], r1[0], r0[1], r1[1]}; OUT = __builtin_bit_cast(bf16x8, w); } while (0)
#define PKV2(L, H) (bf16x8){L[0], L[1], L[2], L[3], H[0], H[1], H[2], H[3]}
#define ATT_GRP(P, BASE, VA, VC, VD, VE) do { \
        _Pragma("unroll") for (int r_ = 0; r_ < 8; ++r_) P[BASE + r_] = __builtin_amdgcn_exp2f(P[BASE + r_]); \
        bf16x8 pa_; PK4(P, BASE, pa_); \
        o[0] = __builtin_amdgcn_mfma_f32_32x32x16_bf16(pa_, PKV2(VA, VC), o[0], 0, 0, 0); o[1] = __builtin_amdgcn_mfma_f32_32x32x16_bf16(pa_, PKV2(VD, VE), o[1], 0, 0, 0); \
        o[2] = __builtin_amdgcn_mfma_f32_32x32x16_bf16(pa_, ones, o[2], 0, 0, 0); __builtin_amdgcn_sched_barrier(0); } while (0)
#define ATT_TILE(j, cur) do { \
        f32x16 p0, p1; \
        _Pragma("unroll") for (int r = 0; r < 16; ++r) { p0[r] = 0.f; p1[r] = 0.f; } \
        const LAS unsigned char* Kc = K_lds + (cur) * KTILE; \
        _Pragma("unroll") for (int d0 = 0; d0 < KS; ++d0) { const int cb = (d0 * 16 + hi * 8) * 2;     \
            const bf16x8 b0 = *(const LAS bf16x8*)(Kc + r32 * KR + cb); const bf16x8 b1 = *(const LAS bf16x8*)(Kc + (32 + r32) * KR + cb); \
            p0 = __builtin_amdgcn_mfma_f32_32x32x16_bf16(b0, qr[d0], p0, 0, 0, 0); p1 = __builtin_amdgcn_mfma_f32_32x32x16_bf16(b1, qr[d0], p1, 0, 0, 0); } \
        int cls = 0; float Bq = 0.f; \
        if (ALIBI) { if (64 * (j) + 64 <= w0) { cls = 1; Bq = slope2 * ((float)(64 * (j)) - qpos); } else if (64 * (j) >= w0 + 32) { cls = 2; Bq = slope2 * (qpos - (float)(64 * (j))); } } \
        bf16x8 qx; { u32x4 w = {0u, 0u, 0u, 0u}; if (hi == 0) { unsigned whm, wl0; split3(Bq - mt, whm, wl0); w.z = whm; w.w = wl0; w.x = (cls == 1) ? 0x3F803F80u : 0u; w.y = (cls == 2) ? 0x3F803F80u : 0u; } qx = __builtin_bit_cast(bf16x8, w); } \
        p0 = __builtin_amdgcn_mfma_f32_32x32x16_bf16(kx0, qx, p0, 0, 0, 0); p1 = __builtin_amdgcn_mfma_f32_32x32x16_bf16(kx1, qx, p1, 0, 0, 0); \
        if (ALIBI && cls == 0) { const float dq = qpos - (float)((j) * 64 + 4 * hi); \
            _Pragma("unroll") for (int r = 0; r < 16; ++r) { const float kc = (float)((r & 3) + 8 * (r >> 2)); p0[r] = fmaf(fabsf(dq - kc), -slope2, p0[r]); p1[r] = fmaf(fabsf(dq - (kc + 32.f)), -slope2, p1[r]); } } \
        float tmax = p0[0]; \
        _Pragma("unroll") for (int r = 1; r < 16; ++r) tmax = fmaxf(tmax, p0[r]); \
        _Pragma("unroll") for (int r = 0; r < 16; ++r) tmax = fmaxf(tmax, p1[r]); \
        { auto rr = __builtin_amdgcn_permlane32_swap(__float_as_uint(tmax), __float_as_uint(tmax), false, false); tmax = fmaxf(__uint_as_float(rr[0]), __uint_as_float(rr[1])); } \
        const bool skip = !first && __all(tmax < SKIP); \
        if (!skip) { \
            if (first || !__all(tmax <= THR)) { \
                const float delta = first ? tmax : fmaxf(tmax, 0.f); const float alpha = first ? 1.f : __builtin_amdgcn_exp2f(-delta); \
                mt += delta; \
                _Pragma("unroll") for (int r = 0; r < 16; ++r) { p0[r] -= delta; p1[r] -= delta; } \
                if (!first) { if (hi == 0) al_l[r32] = alpha; LDS_WAIT(); \
                    _Pragma("unroll") for (int r = 0; r < 16; ++r) { const float a = al_l[crow(r, hi)]; o[0][r] *= a; o[1][r] *= a; o[2][r] *= a; } } \
            } \
              \
            const int vb = vb0 + (cur) * VTILE; \
            const s16x4 va0 = tr_read<v_rd_off(0, 0, 0)>(vb), vc0 = tr_read<v_rd_off(0, 0, 1)>(vb), vd0 = tr_read<v_rd_off(1, 0, 0)>(vb), ve0 = tr_read<v_rd_off(1, 0, 1)>(vb); \
            const s16x4 va1 = tr_read<v_rd_off(0, 1, 0)>(vb), vc1 = tr_read<v_rd_off(0, 1, 1)>(vb), vd1 = tr_read<v_rd_off(1, 1, 0)>(vb), ve1 = tr_read<v_rd_off(1, 1, 1)>(vb); \
            const s16x4 va2 = tr_read<v_rd_off(0, 2, 0)>(vb), vc2 = tr_read<v_rd_off(0, 2, 1)>(vb), vd2 = tr_read<v_rd_off(1, 2, 0)>(vb), ve2 = tr_read<v_rd_off(1, 2, 1)>(vb); \
            const s16x4 va3 = tr_read<v_rd_off(0, 3, 0)>(vb), vc3 = tr_read<v_rd_off(0, 3, 1)>(vb), vd3 = tr_read<v_rd_off(1, 3, 0)>(vb), ve3 = tr_read<v_rd_off(1, 3, 1)>(vb); \
            const u32x4 onesw = {0x3F803F80u, 0x3F803F80u, 0x3F803F80u, 0x3F803F80u}; const bf16x8 ones = __builtin_bit_cast(bf16x8, onesw); \
            asm volatile("s_waitcnt lgkmcnt(0)" ::: "memory"); __builtin_amdgcn_sched_barrier(0); \
            ATT_GRP(p0, 0, va0, vc0, vd0, ve0); ATT_GRP(p0, 8, va1, vc1, vd1, ve1); ATT_GRP(p1, 0, va2, vc2, vd2, ve2); ATT_GRP(p1, 8, va3, vc3, vd3, ve3); \
            first = false; \
        } } while (0)
#define ATT_RUN(COUNT, TILE_EXPR) do { const int cnt_ = (COUNT); if (cnt_ > 0) { \
        { const int jj = 0; SLOAD((TILE_EXPR) * 64); } SWRITE(0); __syncthreads(); \
        if (cnt_ > 1) { const int jj = 1; SLOAD((TILE_EXPR) * 64); } \
        for (int jj0 = 0; jj0 < cnt_; ++jj0) { const int cur_ = jj0 & 1; int j_; { const int jj = jj0; j_ = (TILE_EXPR); } \
            ATT_TILE(j_, cur_); \
            if (jj0 + 1 < cnt_) SWRITE(cur_ ^ 1); \
            __syncthreads(); \
            if (jj0 + 2 < cnt_) { const int jj = jj0 + 2; SLOAD((TILE_EXPR) * 64); } } } } while (0)
    if (wid >= 4) __builtin_amdgcn_s_setprio(1);
    ATT_RUN(4, jd0 + jj);
    if (ALIBI) {
        { const float mm = -wave_max(-mt); if (lane == 0) blk[8 + wid] = mm; }
        __syncthreads();
        if (wid == 0) {
            float qn2 = blk[0], mmin = blk[8];
#pragma unroll
            for (int i = 1; i < 8; ++i) { qn2 = fmaxf(qn2, blk[i]); mmin = fminf(mmin, blk[8 + i]); }
            int base = 0;
            for (int c0 = 0; c0 < NT - 4; c0 += 64) { const int c = c0 + lane; bool act = false; int t = 0;
                if (c < NT - 4) { t = (c < jd0) ? jd0 - 1 - c : c + 4;
                    const float dist = (t < jd0) ? (float)(q0 - (64 * t + 63)) : (float)(64 * t - (q0 + 255));
                    const float kn = __builtin_bit_cast(float, kn2[t]);
                    act = (sqrtf(qn2 * kn) * 1.02f - slope2 * dist - mmin >= SKIP); }
                const unsigned long long bm = __ballot(act);
                if (act) tl[base + __builtin_popcountll(bm & ((1ull << lane) - 1ull))] = t;
                base += __builtin_popcountll(bm); }
            if (lane == 0) blk[16] = __builtin_bit_cast(float, base);
        }
        __syncthreads();
        const int nact = __builtin_bit_cast(int, blk[16]);
        ATT_RUN(nact, tl[jj]);
    } else {
        ATT_RUN(NT - 4, (jj < jd0 ? jd0 - 1 - jj : jj + 4));
    }
#undef ATT_RUN
#undef ATT_TILE
#undef ATT_GRP
#undef PKV2
#undef PK4
#undef SLOAD
#undef SWRITE
    __builtin_amdgcn_s_setprio(0);
    bf16_t* Ow = Ob + (size_t)(wid * 32) * ldo;
#pragma unroll
    for (int r = 0; r < 16; ++r) { const int orow = crow(r, hi); const float rl = __builtin_amdgcn_rcpf(o[2][r]);
#pragma unroll
        for (int d0 = 0; d0 < 2; ++d0) Ow[(size_t)orow * ldo + d0 * 32 + r32] = (bf16_t)f2bf(o[d0][r] * rl); }
    __syncthreads();
}
}

DI void ph_attn_a(const Ctx& C, int l) {
    const bf16_t* UA = (const bf16_t*)(C.ws + WS_U); bf16_t* OA = (bf16_t*)(C.ws + WS_XB1);
    for (int u = C.bid; u < 4096; u += C.G) {
        int qb, vh, seq, len;
        if (u < 2048) { const int i = u >> 8, c = u & 255; seq = c >> 5; qb = c & 31; vh = (i + seq) & 7; len = 8192; }
        else { const int v = u - 2048, i = v >> 8, c = v & 255; seq = 8 + (c >> 3); qb = c & 7; vh = (i + (c >> 3)) & 7; len = 2048; }
        const int r0 = seq_start_row(seq); const int h = vh >> 1;
        const float slope2 = exp2f(-2.0f * (float)(h + 1)) * LOG2E;
        att::attn_unit<2, true>(UA + (size_t)(r0 + qb * 256) * 768 + vh * 32, 768, UA + (size_t)r0 * 768 + 256 + vh * 32, 768, UA + (size_t)r0 * 768 + 512 + h * 64, 768,
                                OA + (size_t)(r0 + qb * 256) * 512 + vh * 64, 512, len, qb * 256, slope2, (const unsigned*)(C.ws + WS_KN2) + ((size_t)l * 8 + vh) * 2048 + (r0 >> 6), C.lds);
    }
}
DI void ph_attn_c(const Ctx& C) {
    const bf16_t* Qc = (const bf16_t*)(C.ws + WS_XB1 + OFF_QC); const bf16_t* Kc = (const bf16_t*)(C.ws + WS_XB1 + OFF_KC); const bf16_t* Vc = (const bf16_t*)(C.ws + WS_XB1 + OFF_VC);
    bf16_t* Y = (bf16_t*)(C.ws + WS_Y);
    for (int u = C.bid; u < 2048; u += C.G) {
        int qb, h, seq, len;
        if (u < 1024) { qb = u & 31; h = (u >> 5) & 3; seq = u >> 7; len = 8192; } else { const int v = u - 1024; qb = v & 7; h = (v >> 3) & 3; seq = 8 + (v >> 5); len = 2048; }
        const int r0 = seq_start_row(seq);
        att::attn_unit<3, false>(Qc + (size_t)(r0 + qb * 256) * 192 + h * 48, 192, Kc + (size_t)r0 * 192 + h * 48, 192, Vc + (size_t)r0 * 256 + h * 64, 256,
                                 Y + (size_t)(r0 + qb * 256) * DM + 512 + h * 64, DM, len, qb * 256, 0.f, nullptr, C.lds);
    }
}
DI void ph_a_post(const Ctx& C, int l) {
    const bf16_t* OA = (const bf16_t*)(C.ws + WS_XB1); bf16_t* Y = (bf16_t*)(C.ws + WS_Y);
    const float linit = 0.8f - 0.6f * expf(-0.3f * (float)l);
    const float* lp = C.A->in[3] + l * 128;
    float sa = 0.f, sb = 0.f; if (C.lane < 32) { sa = lp[C.lane] * lp[32 + C.lane]; sb = lp[64 + C.lane] * lp[96 + C.lane]; }
    const float lam = expf(wave_sum(sa)) - expf(wave_sum(sb)) + linit;
    const int h = C.lane >> 4, d4 = (C.lane & 15) * 4;
    const f32x4 gg = *(const f32x4*)(C.A->in[4] + l * 64 + d4);
    for (int row0 = C.gw; row0 < NTOK; row0 += 4 * C.NGW) {
        u32x2 a[4], b[4];
#pragma unroll
        for (int i = 0; i < 4; ++i) { const size_t row = (size_t)row0 + (size_t)i * C.NGW; a[i] = *(const u32x2*)(OA + row * 512 + (2 * h) * 64 + d4); b[i] = *(const u32x2*)(OA + row * 512 + (2 * h + 1) * 64 + d4); }
#pragma unroll
        for (int i = 0; i < 4; ++i) { const size_t row = (size_t)row0 + (size_t)i * C.NGW;
            float o0 = bflo(a[i].x) - lam * bflo(b[i].x), o1 = bfhi(a[i].x) - lam * bfhi(b[i].x), o2 = bflo(a[i].y) - lam * bflo(b[i].y), o3 = bfhi(a[i].y) - lam * bfhi(b[i].y);
            float ss = o0 * o0 + o1 * o1 + o2 * o2 + o3 * o3;
            ss += __shfl_xor(ss, 1); ss += __shfl_xor(ss, 2); ss += __shfl_xor(ss, 4); ss += __shfl_xor(ss, 8);
            const float r = (1.0f / sqrtf(ss * (1.f / 64.f) + RMS_EPS)) * (1.0f - linit);
            u32x2 w; w.x = cvt_pk_bf16(o0 * r * gg[0], o1 * r * gg[1]); w.y = cvt_pk_bf16(o2 * r * gg[2], o3 * r * gg[3]);
            *(u32x2*)(Y + row * DM + h * 64 + d4) = w; }
    }
}

DI float hgrn_lb(const Ctx& C, int l, int dir, int ch) {
    if (l == 0) return 0.f;
    const float a = C.A->in[5][(0 * 2 + dir) * 256 + ch], b = C.A->in[5][(1 * 2 + dir) * 256 + ch];
    const float m = fmaxf(a, b), ea = expf(a - m), eb = expf(b - m); return eb / (ea + eb);
}
DI float dpp_shr_add(float x, int k) {
    float y;
    if (k == 1) y = __builtin_bit_cast(float, __builtin_amdgcn_update_dpp(0, __builtin_bit_cast(int, x), 0x111, 0xF, 0xF, true));
    else if (k == 2) y = __builtin_bit_cast(float, __builtin_amdgcn_update_dpp(0, __builtin_bit_cast(int, x), 0x112, 0xF, 0xF, true));
    else if (k == 4) y = __builtin_bit_cast(float, __builtin_amdgcn_update_dpp(0, __builtin_bit_cast(int, x), 0x114, 0xF, 0xF, true));
    else y = __builtin_bit_cast(float, __builtin_amdgcn_update_dpp(0, __builtin_bit_cast(int, x), 0x118, 0xF, 0xF, true));
    return x + y;
}
DI s16x4 tr16(unsigned addr) { s16x4 r; asm volatile("ds_read_b64_tr_b16 %0, %1\n\ts_waitcnt lgkmcnt(0)" : "=&v"(r) : "v"(addr) : "memory"); return r; }
constexpr int HG_ROW = 144, HG_ARR = 16 * HG_ROW;
template <int MODE>
DI void hgrn_pass(const Ctx& C, int l, int chunk, int h, int dir, LAS unsigned char* wl, float* ofs) {
    const bf16_t* UB = (const bf16_t*)(C.ws + WS_U); float* ST = (float*)(C.ws + WS_XB1); float* GAM = (float*)(C.ws + WS_GAM); bf16_t* Y = (bf16_t*)(C.ws + WS_Y);
    const int lane = C.lane, l15 = lane & 15, g = lane >> 4, r0 = chunk * 128; const size_t sbase = (size_t)((chunk * 4 + h) * 2 + dir);
    const unsigned QLa = (unsigned)(uintptr_t)wl, FLa = QLa + HG_ARR, VLa = QLa + 2 * HG_ARR, GLa = QLa + 3 * HG_ARR;
    LAS float* lbT = (LAS float*)(wl + 4 * HG_ARR);
    lbT[lane] = hgrn_lb(C, l, dir, h * 64 + lane);
    LDS_WAIT();
    f32x4 S[4][4];
#pragma unroll
    for (int dt = 0; dt < 4; ++dt)
#pragma unroll
        for (int et = 0; et < 4; ++et)
#pragma unroll
            for (int r = 0; r < 4; ++r) S[dt][et][r] = (MODE == 0) ? 0.f : ST[sbase * 4096 + (size_t)(16 * dt + 4 * g + r) * 64 + 16 * et + l15];
    float gsum[4] = {0.f, 0.f, 0.f, 0.f};
    const float* ngp = C.A->in[6] + l * 256 + h * 64 + l15;
    const int srow = lane >> 2, spc = lane & 3;
    u32x4 pq[2], pf[2], pv[2];
#define HG_LOAD(sc) do { const int t_ = (sc) * 16 + srow; const bf16_t* rp_ = UB + (size_t)(r0 + (dir ? 127 - t_ : t_)) * 1280 + h * 64 + spc * 16; \
        pf[0] = *(const u32x4*)(rp_ + (dir ? 512 : 256)); pf[1] = *(const u32x4*)(rp_ + (dir ? 512 : 256) + 8); pv[0] = *(const u32x4*)(rp_ + 768); pv[1] = *(const u32x4*)(rp_ + 768 + 8); \
        if (MODE != 0) { pq[0] = *(const u32x4*)(rp_); pq[1] = *(const u32x4*)(rp_ + 8); } } while (0)
#define HG_STORE() do { const int o_ = srow * HG_ROW + spc * 32; \
        *(LAS u32x4*)(wl + HG_ARR + o_) = pf[0]; *(LAS u32x4*)(wl + HG_ARR + o_ + 16) = pf[1]; *(LAS u32x4*)(wl + 2 * HG_ARR + o_) = pv[0]; *(LAS u32x4*)(wl + 2 * HG_ARR + o_ + 16) = pv[1]; \
        if (MODE != 0) { *(LAS u32x4*)(wl + o_) = pq[0]; *(LAS u32x4*)(wl + o_ + 16) = pq[1]; } } while (0)
    HG_LOAD(0);
    const unsigned tr_off = (unsigned)((4 * g + (l15 >> 2)) * HG_ROW + (l15 & 3) * 8);
    for (int sc = 0; sc < 8; ++sc) {
        LDS_WAIT();
        HG_STORE();
        if (MODE == 2) {
#pragma unroll
            for (int k = 0; k < 2; ++k) { const int t_ = sc * 16 + 8 * k + (lane >> 3);
                __builtin_amdgcn_global_load_lds((const unsigned*)(UB + (size_t)(r0 + 127 - t_) * 1280 + 1024 + h * 64 + (lane & 7) * 8), (LAS unsigned*)(wl + 3 * HG_ARR + k * 1024), 16, 0, 0); } }
        if (sc + 1 < 8) HG_LOAD(sc + 1);
        LDS_WAIT();
        bf16x8 vf[4];
#pragma unroll
        for (int et = 0; et < 4; ++et) { const s16x4 t4 = tr16(VLa + tr_off + et * 32); vf[et] = (bf16x8){t4[0], t4[1], t4[2], t4[3], 0, 0, 0, 0}; }
        __builtin_amdgcn_sched_barrier(0);
        bf16x8 khf[4]; float tot[4];
#pragma unroll
        for (int dt = 0; dt < 4; ++dt) { const s16x4 t4 = tr16(FLa + tr_off + dt * 32);
            float fv[4], lf[4];
            const float lbv = lbT[16 * dt + l15];
#pragma unroll
            for (int j = 0; j < 4; ++j) { fv[j] = lbv + (1.f - lbv) * sigmoidf_(bf2f((unsigned short)t4[j])); lf[j] = __builtin_amdgcn_logf(fv[j]); }
            const float Tg = (lf[0] + lf[1]) + (lf[2] + lf[3]);
            const float T1 = __shfl_down(Tg, 16), T2 = __shfl_down(Tg, 32), T3 = __shfl_down(Tg, 48);
            const float after = (g < 3 ? T1 : 0.f) + (g < 2 ? T2 : 0.f) + (g < 1 ? T3 : 0.f);
            float tt_ = Tg; tt_ += __shfl_xor(tt_, 16); tt_ += __shfl_xor(tt_, 32); tot[dt] = tt_; gsum[dt] += tt_;
            const float c3 = after, c2 = c3 + lf[3], c1 = c2 + lf[2], c0 = c1 + lf[1];
            const unsigned w0 = cvt_pk_bf16((1.f - fv[0]) * __builtin_amdgcn_exp2f(c0), (1.f - fv[1]) * __builtin_amdgcn_exp2f(c1));
            const unsigned w1 = cvt_pk_bf16((1.f - fv[2]) * __builtin_amdgcn_exp2f(c2), (1.f - fv[3]) * __builtin_amdgcn_exp2f(c3));
            const u32x4 w = {w0, w1, 0u, 0u}; khf[dt] = __builtin_bit_cast(bf16x8, w); }
        __builtin_amdgcn_sched_barrier(0);
        f32x4 O[4];
        if (MODE != 0) {
            bf16x8 qhf[2], ktf[2];
#pragma unroll
            for (int ks = 0; ks < 2; ++ks) { float b2[8], qv[8], kv[8];
#pragma unroll
                for (int dd = 0; dd < 2; ++dd) { const int dt = 2 * ks + dd;
                    const u32x2 fw = *(const LAS u32x2*)(wl + HG_ARR + l15 * HG_ROW + (16 * dt + 4 * g) * 2); const u32x2 qw = *(const LAS u32x2*)(wl + l15 * HG_ROW + (16 * dt + 4 * g) * 2);
                    const f32x4 lb4 = *(const LAS f32x4*)(lbT + 16 * dt + 4 * g);
                    const float fl4[4] = {bflo(fw.x), bfhi(fw.x), bflo(fw.y), bfhi(fw.y)}, ql4[4] = {bflo(qw.x), bfhi(qw.x), bflo(qw.y), bfhi(qw.y)};
#pragma unroll
                    for (int r = 0; r < 4; ++r) { const int i = 4 * dd + r; const float f = lb4[r] + (1.f - lb4[r]) * sigmoidf_(fl4[r]); b2[i] = __builtin_amdgcn_logf(f); kv[i] = 1.f - f; qv[i] = siluf_(ql4[r]); } }
#pragma unroll
                for (int i = 0; i < 8; ++i) { float x = b2[i]; x = dpp_shr_add(x, 1); x = dpp_shr_add(x, 2); x = dpp_shr_add(x, 4); x = dpp_shr_add(x, 8); b2[i] = x; }
                u32x4 wq, wk;
#pragma unroll
                for (int p = 0; p < 4; ++p) { const int i = 2 * p; const float e0 = __builtin_amdgcn_exp2f(b2[i]), e1 = __builtin_amdgcn_exp2f(b2[i + 1]);
                    wq[p] = cvt_pk_bf16(qv[i] * e0, qv[i + 1] * e1); wk[p] = cvt_pk_bf16(kv[i] * __builtin_amdgcn_exp2f(fminf(-b2[i], 120.f)), kv[i + 1] * __builtin_amdgcn_exp2f(fminf(-b2[i + 1], 120.f))); }
                qhf[ks] = __builtin_bit_cast(bf16x8, wq); ktf[ks] = __builtin_bit_cast(bf16x8, wk); }
            __builtin_amdgcn_sched_barrier(0);
            f32x4 aT = (f32x4){0.f, 0.f, 0.f, 0.f};
            aT = __builtin_amdgcn_mfma_f32_16x16x32_bf16(ktf[0], qhf[0], aT, 0, 0, 0);
            aT = __builtin_amdgcn_mfma_f32_16x16x32_bf16(ktf[1], qhf[1], aT, 0, 0, 0);
#pragma unroll
            for (int r = 0; r < 4; ++r) aT[r] = (4 * g + r > l15) ? 0.f : aT[r];
            const u32x4 aw = {cvt_pk_bf16(aT[0], aT[1]), cvt_pk_bf16(aT[2], aT[3]), 0u, 0u}; const bf16x8 atf = __builtin_bit_cast(bf16x8, aw);
#pragma unroll
            for (int et = 0; et < 4; ++et) { f32x4 o = (f32x4){0.f, 0.f, 0.f, 0.f};
                o = __builtin_amdgcn_mfma_f32_16x16x32_bf16(atf, vf[et], o, 0, 0, 0);
#pragma unroll
                for (int ks = 0; ks < 2; ++ks) { const u32x4 sw = {cvt_pk_bf16(S[2 * ks][et][0], S[2 * ks][et][1]), cvt_pk_bf16(S[2 * ks][et][2], S[2 * ks][et][3]), cvt_pk_bf16(S[2 * ks + 1][et][0], S[2 * ks + 1][et][1]), cvt_pk_bf16(S[2 * ks + 1][et][2], S[2 * ks + 1][et][3])};
                    o = __builtin_amdgcn_mfma_f32_16x16x32_bf16(qhf[ks], __builtin_bit_cast(bf16x8, sw), o, 0, 0, 0); }
                O[et] = o; }
        }
        __builtin_amdgcn_sched_barrier(0);
#pragma unroll
        for (int dt = 0; dt < 4; ++dt) { float dec[4];
#pragma unroll
            for (int r = 0; r < 4; ++r) dec[r] = __builtin_amdgcn_exp2f(__shfl(tot[dt], 4 * g + r));
#pragma unroll
            for (int et = 0; et < 4; ++et) { f32x4 s = S[dt][et];
#pragma unroll
                for (int r = 0; r < 4; ++r) s[r] *= dec[r];
                S[dt][et] = __builtin_amdgcn_mfma_f32_16x16x32_bf16(khf[dt], vf[et], s, 0, 0, 0); } }
        __builtin_amdgcn_sched_barrier(0);
        if (MODE == 1) {
#pragma unroll
            for (int et = 0; et < 4; ++et)
#pragma unroll
                for (int r = 0; r < 4; ++r) ofs[(sc * 16 + 4 * g + r) * 64 + 16 * et + l15] = O[et][r];
        }
        if (MODE == 2) {
            float rr[4];
#pragma unroll
            for (int r = 0; r < 4; ++r) { const int at = 127 - (sc * 16 + 4 * g + r); float ss = 0.f;
#pragma unroll
                for (int et = 0; et < 4; ++et) { const float of = ofs[at * 64 + 16 * et + l15]; O[et][r] += of; ss += O[et][r] * O[et][r]; }
                ss += __shfl_xor(ss, 1); ss += __shfl_xor(ss, 2); ss += __shfl_xor(ss, 4); ss += __shfl_xor(ss, 8);
                rr[r] = 1.0f / sqrtf(ss * (1.f / 64.f) + RMS_EPS); }
            VM_WAIT();
#pragma unroll
            for (int et = 0; et < 4; ++et) { const s16x4 t4 = tr16(GLa + (unsigned)((4 * g + (l15 >> 2)) * 128 + (l15 & 3) * 8) + et * 32); const float ngv = ngp[16 * et];
#pragma unroll
                for (int r = 0; r < 4; ++r) { const int at = 127 - (sc * 16 + 4 * g + r);
                    Y[(size_t)(r0 + at) * DM + 256 + h * 64 + 16 * et + l15] = (bf16_t)f2bf(O[et][r] * rr[r] * ngv * siluf_(bf2f((unsigned short)t4[r]))); } }
        }
    }
#undef HG_LOAD
#undef HG_STORE
    if (MODE == 0) {
#pragma unroll
        for (int dt = 0; dt < 4; ++dt)
#pragma unroll
            for (int et = 0; et < 4; ++et)
#pragma unroll
                for (int r = 0; r < 4; ++r) ST[sbase * 4096 + (size_t)(16 * dt + 4 * g + r) * 64 + 16 * et + l15] = S[dt][et][r];
        if (g == 0) {
#pragma unroll
            for (int dt = 0; dt < 4; ++dt) GAM[sbase * 64 + 16 * dt + l15] = __builtin_amdgcn_exp2f(gsum[dt]);
        }
    }
}
DI void ph_hgrn_local(const Ctx& C, int l) {
    LAS unsigned char* wl = C.lds + C.wave * 16384;
    for (int w = C.gw; w < NCHUNK * 8; w += C.NGW) hgrn_pass<0>(C, l, w >> 3, (w >> 1) & 3, w & 1, wl, nullptr);
}
DI void ph_hgrn_scan(const Ctx& C) {
    float* ST = (float*)(C.ws + WS_XB1); const float* GAM = (const float*)(C.ws + WS_GAM);
    for (int idx = C.bid * 512 + C.tid; idx < NSEQ * 8 * 4096; idx += C.G * 512) {
        const int e = idx & 4095, hd = (idx >> 12) & 7, seq = idx >> 15, h = hd >> 1, dir = hd & 1, d = e >> 6;
        const int c0 = seq < 8 ? seq * 64 : 512 + (seq - 8) * 16, nc = seq < 8 ? 64 : 16;
        float s = 0.f;
        for (int i0 = 0; i0 < nc; i0 += 16) {
            float tmp[16], gg[16];
#pragma unroll
            for (int i = 0; i < 16; ++i) { const int c = dir ? c0 + nc - 1 - (i0 + i) : c0 + i0 + i; const size_t base = (size_t)((c * 4 + h) * 2 + dir); tmp[i] = ST[base * 4096 + e]; gg[i] = GAM[base * 64 + d]; }
#pragma unroll
            for (int i = 0; i < 16; ++i) { const float t = tmp[i]; tmp[i] = s; s = fmaf(gg[i], s, t); }
#pragma unroll
            for (int i = 0; i < 16; ++i) { const int c = dir ? c0 + nc - 1 - (i0 + i) : c0 + i0 + i; const size_t base = (size_t)((c * 4 + h) * 2 + dir); ST[base * 4096 + e] = tmp[i]; }
        }
    }
}
template <int MODE>
DI void ph_hgrn_out(const Ctx& C, int l) {
    LAS unsigned char* wl = C.lds + C.wave * 16384;
    for (int w = C.gw; w < NCHUNK * 4; w += C.NGW) hgrn_pass<MODE>(C, l, w >> 2, w & 3, MODE == 2 ? 1 : 0, wl, (float*)(C.ws + WS_EW) + (size_t)w * 8192);
}

DI void ph_c_prep(const Ctx& C, int l) {
    const bf16_t* UCD = (const bf16_t*)(C.ws + WS_U);
    const bf16_t* WQ = (const bf16_t*)(C.ws + WS_WC + (size_t)l * WC_LAYER + OFF_WQ); const bf16_t* WKV = (const bf16_t*)(C.ws + WS_WC + (size_t)l * WC_LAYER + OFF_WKV);
    bf16_t* Qc = (bf16_t*)(C.ws + WS_XB1 + OFF_QC); bf16_t* Kc = (bf16_t*)(C.ws + WS_XB1 + OFF_KC); bf16_t* Vc = (bf16_t*)(C.ws + WS_XB1 + OFF_VC);
    const int lane = C.lane, r32 = lane & 31, hi = lane >> 5;
    const float C2c = 0.14433756729740643f * LOG2E;
    constexpr int PQ = 400, PKV = 272;
    for (int i = C.tid; i < 192 * 24; i += 512) { const int r = i / 24, p = i % 24; *(LAS u32x4*)(C.lds + r * PQ + p * 16) = *(const u32x4*)(WQ + (size_t)r * 192 + p * 8); }
    __syncthreads();
    for (int w = C.gw; w < NTOK / 32; w += C.NGW) {
        const int row = w * 32 + r32; const bf16_t* xr = UCD + (size_t)row * 1024;
        float cs[4], sn[4];
        { const float pos = (float)row_pos(row); const float inv[8] = {1.0f, 0.316227766016837933f, 0.1f, 0.0316227766016837933f, 0.01f, 0.00316227766016837933f, 0.001f, 0.000316227766016837933f};
#pragma unroll
            for (int ii = 0; ii < 4; ++ii) { const float invv = hi ? inv[4 + ii] : inv[ii]; const float ang = pos * invv;
                const double ad = (double)ang; const double k = __builtin_rint(ad * 0.15915494309189535); const float red = (float)(ad - k * 6.283185307179586);
                cs[ii] = __cosf(red); sn[ii] = __sinf(red); } }
        bf16x8 xq[12]; float ssq = 0.f;
#pragma unroll
        for (int ks = 0; ks < 12; ++ks) { xq[ks] = *(const bf16x8*)(xr + ks * 16 + hi * 8);
#pragma unroll
            for (int j = 0; j < 8; ++j) { const float f = bf2f((unsigned short)xq[ks][j]); ssq += f * f; } }
        ssq += __shfl_xor(ssq, 32);
        const float rq = (1.0f / sqrtf(ssq * (1.f / 192.f) + RMS_EPS)) * C2c;
#pragma unroll 1
        for (int nt = 0; nt < 6; ++nt) {
            f32x16 acc;
#pragma unroll
            for (int r = 0; r < 16; ++r) acc[r] = 0.f;
#pragma unroll
            for (int ks = 0; ks < 12; ++ks) { const bf16x8 a = *(const LAS bf16x8*)(C.lds + (32 * nt + r32) * PQ + (ks * 16 + hi * 8) * 2); acc = __builtin_amdgcn_mfma_f32_32x32x16_bf16(a, xq[ks], acc, 0, 0, 0); }
#pragma unroll
            for (int r = 0; r < 16; ++r) acc[r] *= rq;
            if (nt == 1 || nt == 4) {
#pragma unroll
                for (int ii = 0; ii < 4; ++ii) { const float x1 = acc[ii], x2 = acc[4 + ii]; acc[ii] = x1 * cs[ii] - x2 * sn[ii]; acc[4 + ii] = x1 * sn[ii] + x2 * cs[ii]; } }
            if (nt == 2 || nt == 5) {
#pragma unroll
                for (int ii = 0; ii < 4; ++ii) { const float x1 = acc[8 + ii], x2 = acc[12 + ii]; acc[8 + ii] = x1 * cs[ii] - x2 * sn[ii]; acc[12 + ii] = x1 * sn[ii] + x2 * cs[ii]; } }
#pragma unroll
            for (int g = 0; g < 4; ++g) { u32x2 wv; wv.x = cvt_pk_bf16(acc[4 * g], acc[4 * g + 1]); wv.y = cvt_pk_bf16(acc[4 * g + 2], acc[4 * g + 3]);
                *(u32x2*)(Qc + (size_t)row * 192 + 32 * nt + 8 * g + 4 * hi) = wv; }
        }
        { const u32x2 a = *(const u32x2*)(xr + 320 + 4 * hi), b = *(const u32x2*)(xr + 328 + 4 * hi);
            const float x1[4] = {bflo(a.x), bfhi(a.x), bflo(a.y), bfhi(a.y)}, x2[4] = {bflo(b.x), bfhi(b.x), bflo(b.y), bfhi(b.y)};
            float o1[4], o2[4];
#pragma unroll
            for (int ii = 0; ii < 4; ++ii) { o1[ii] = x1[ii] * cs[ii] - x2[ii] * sn[ii]; o2[ii] = x1[ii] * sn[ii] + x2[ii] * cs[ii]; }
            u32x2 w1, w2; w1.x = cvt_pk_bf16(o1[0], o1[1]); w1.y = cvt_pk_bf16(o1[2], o1[3]); w2.x = cvt_pk_bf16(o2[0], o2[1]); w2.y = cvt_pk_bf16(o2[2], o2[3]);
#pragma unroll
            for (int h = 0; h < 4; ++h) { *(u32x2*)(Kc + (size_t)row * 192 + h * 48 + 32 + 4 * hi) = w1; *(u32x2*)(Kc + (size_t)row * 192 + h * 48 + 40 + 4 * hi) = w2; } }
    }
    __syncthreads();
    for (int i = C.tid; i < 384 * 16; i += 512) { const int r = i / 16, p = i % 16; *(LAS u32x4*)(C.lds + r * PKV + p * 16) = *(const u32x4*)(WKV + (size_t)r * 128 + p * 8); }
    __syncthreads();
    for (int w = C.gw; w < NTOK / 32; w += C.NGW) {
        const int row = w * 32 + r32; const bf16_t* xr = UCD + (size_t)row * 1024;
        bf16x8 xk[8]; float ssk = 0.f;
#pragma unroll
        for (int ks = 0; ks < 8; ++ks) { xk[ks] = *(const bf16x8*)(xr + 192 + ks * 16 + hi * 8);
#pragma unroll
            for (int j = 0; j < 8; ++j) { const float f = bf2f((unsigned short)xk[ks][j]); ssk += f * f; } }
        ssk += __shfl_xor(ssk, 32);
        const float rk = 1.0f / sqrtf(ssk * (1.f / 128.f) + RMS_EPS);
#pragma unroll 1
        for (int nt = 0; nt < 12; ++nt) {
            f32x16 acc;
#pragma unroll
            for (int r = 0; r < 16; ++r) acc[r] = 0.f;
#pragma unroll
            for (int ks = 0; ks < 8; ++ks) { const bf16x8 a = *(const LAS bf16x8*)(C.lds + (32 * nt + r32) * PKV + (ks * 16 + hi * 8) * 2); acc = __builtin_amdgcn_mfma_f32_32x32x16_bf16(a, xk[ks], acc, 0, 0, 0); }
            const int h = nt / 3, part = nt % 3;
            bf16_t* dst = (part == 0) ? Kc + (size_t)row * 192 + h * 48 : Vc + (size_t)row * 256 + h * 64 + (part - 1) * 32;
#pragma unroll
            for (int g = 0; g < 4; ++g) { u32x2 wv; wv.x = cvt_pk_bf16(acc[4 * g] * rk, acc[4 * g + 1] * rk); wv.y = cvt_pk_bf16(acc[4 * g + 2] * rk, acc[4 * g + 3] * rk);
                *(u32x2*)(dst + 8 * g + 4 * hi) = wv; }
        }
    }
}

DI float one_minus_a2(float y, float a) {
    const float p = -y * (1.0f + y * (0.5f + y * (0.16666667f + y * (0.041666668f + y * (0.0083333338f + y * 0.0013888889f)))));
    return (y > -0.25f) ? p : (1.0f - a * a);
}
template <bool FINAL, int DIR>
DI void rglru_units(const Ctx& C, int l) {
    const bf16_t* UCD = (const bf16_t*)(C.ws + WS_U); f32x2* DC = (f32x2*)(C.ws + WS_DC);
    bf16_t* HFB = (bf16_t*)(C.ws + WS_EW);
    const int lane = C.lane, l15 = lane & 15, g = lane >> 4;
    LAS unsigned char* wl = C.lds + C.wave * 16384;
    LAS unsigned char* xcb = wl;
    LAS float* gs = (LAS float*)(wl + 2304);
    const int n = C.gw & 3, ch = n * 64 + lane;
    bf16x8 Wf[2][4][2];
    { const bf16x8* fp = (const bf16x8*)(C.ws + WS_WRG) + (size_t)((((l * 2 + DIR) * 4 + n) * 2) * 8) * 64 + lane;
#pragma unroll
      for (int gt = 0; gt < 2; ++gt)
#pragma unroll
        for (int nt = 0; nt < 4; ++nt)
#pragma unroll
            for (int ks = 0; ks < 2; ++ks) Wf[gt][nt][ks] = fp[(size_t)((gt * 4 + nt) * 2 + ks) * 64]; }
    const float ba = C.A->in[14][(l * 2 + DIR) * 256 + ch], bx = C.A->in[16][(l * 2 + DIR) * 256 + ch];
    const float lam = C.A->in[17][(l * 2 + DIR) * 256 + ch];
    const float c8sp = -8.0f * log1pf(expf(-lam));
    float cw[4];
#pragma unroll
    for (int j = 0; j < 4; ++j) cw[j] = C.A->in[11][(l * 4 + j) * 256 + ch];
    const float cb = C.A->in[12][l * 256 + ch];
    for (int w = C.gw; w < NCHUNK * 4; w += C.NGW) {
        const int chunk = w >> 2;
        const int r0 = chunk * 128; const int sb = row_seq_begin(r0), se = sb + row_seq_len(r0);
        float h = FINAL ? DC[(size_t)(chunk * 2 + DIR) * 256 + ch][1] : 0.f, P = 1.f;
        float xr[19];
#define RG_LOADX(dst, sc_) do { const int tb_ = r0 + 16 * (DIR ? 7 - (sc_) : (sc_)) - 2; \
            _Pragma("unroll") for (int i_ = 0; i_ < 19; ++i_) { const int rr_ = tb_ + i_; dst[i_] = (rr_ >= sb && rr_ < se) ? bf2f(UCD[(size_t)rr_ * 1024 + 336 + ch]) : 0.f; } } while (0)
        RG_LOADX(xr, 0);
        for (int sc = 0; sc < 8; ++sc) {
            const int t0 = r0 + 16 * (DIR ? 7 - sc : sc);
            float xcr[16];
#pragma unroll
            for (int a = 0; a < 16; ++a) { const int tt = DIR ? 15 - a : a;
                xcr[tt] = cb + cw[0] * xr[a] + cw[1] * xr[a + 1] + cw[2] * xr[a + 2] + cw[3] * xr[a + 3];
                *(LAS bf16_t*)(xcb + tt * 144 + lane * 2) = (bf16_t)f2bf(xcr[tt]); }
            if (sc + 1 < 8) RG_LOADX(xr, sc + 1);
            LDS_WAIT();
            const bf16x8 A0 = *(const LAS bf16x8*)(xcb + l15 * 144 + (8 * g) * 2), A1 = *(const LAS bf16x8*)(xcb + l15 * 144 + (32 + 8 * g) * 2);
#pragma unroll
            for (int gt = 0; gt < 2; ++gt)
#pragma unroll
                for (int nt = 0; nt < 4; ++nt) { f32x4 acc = (f32x4){0.f, 0.f, 0.f, 0.f};
                    acc = __builtin_amdgcn_mfma_f32_16x16x32_bf16(A0, Wf[gt][nt][0], acc, 0, 0, 0);
                    acc = __builtin_amdgcn_mfma_f32_16x16x32_bf16(A1, Wf[gt][nt][1], acc, 0, 0, 0);
#pragma unroll
                    for (int r = 0; r < 4; ++r) gs[(gt * 16 + 4 * g + r) * 68 + 16 * nt + l15] = acc[r]; }
            LDS_WAIT();
#pragma unroll
            for (int tt = 0; tt < 16; ++tt) {
                const float ra = gs[tt * 68 + lane] + ba, ia = gs[(16 + tt) * 68 + lane] + bx;
                const float r = sigmoidf_(ra), ig = sigmoidf_(ia);
                const float la = c8sp * r, a = __expf(la), u = __builtin_amdgcn_sqrtf(one_minus_a2(2.0f * la, a)) * (ig * xcr[tt]);
                h = fmaf(a, h, u); P *= a;
                if (FINAL) { const int tok = DIR ? t0 + 15 - tt : t0 + tt; HFB[((size_t)DIR * NTOK + tok) * 256 + ch] = (bf16_t)f2bf(h); } }
            LDS_WAIT();
        }
        if (!FINAL) DC[(size_t)(chunk * 2 + DIR) * 256 + ch] = (f32x2){P, h};
#undef RG_LOADX
    }
}
template <bool FINAL>
DI void ph_rglru(const Ctx& C, int l) { rglru_units<FINAL, 0>(C, l); rglru_units<FINAL, 1>(C, l); }
DI void ph_rglru_scan(const Ctx& C) {
    f32x2* DC = (f32x2*)(C.ws + WS_DC);
    for (int idx = C.bid * 512 + C.tid; idx < NSEQ * 512; idx += C.G * 512) {
        const int ch = idx & 255, dir = (idx >> 8) & 1, seq = idx >> 9;
        const int c0 = seq < 8 ? seq * 64 : 512 + (seq - 8) * 16, nc = seq < 8 ? 64 : 16;
        float hin = 0.f;
        for (int i0 = 0; i0 < nc; i0 += 16) {
            f32x2 vv[16];
#pragma unroll
            for (int i = 0; i < 16; ++i) { const int c = dir ? c0 + nc - 1 - (i0 + i) : c0 + i0 + i; vv[i] = DC[(size_t)(c * 2 + dir) * 256 + ch]; }
#pragma unroll
            for (int i = 0; i < 16; ++i) { const float P = vv[i][0], H = vv[i][1]; vv[i][1] = hin; hin = fmaf(P, hin, H); }
#pragma unroll
            for (int i = 0; i < 16; ++i) { const int c = dir ? c0 + nc - 1 - (i0 + i) : c0 + i0 + i; DC[(size_t)(c * 2 + dir) * 256 + ch] = vv[i]; }
        }
    }
}
DI float gelu_tanh(float x) { const float u = 0.7978845608028654f * (x + 0.044715f * x * x * x); const float e = __expf(2.0f * u); const float th = 1.0f - 2.0f / (e + 1.0f); return 0.5f * x * (1.0f + th); }
DI void ph_d_post(const Ctx& C) {
    const bf16_t* UCD = (const bf16_t*)(C.ws + WS_U); const bf16_t* HF = (const bf16_t*)(C.ws + WS_EW); const bf16_t* HB = HF + (size_t)NTOK * 256; bf16_t* Y = (bf16_t*)(C.ws + WS_Y);
    const int c4 = C.lane * 4;
    for (int row0 = C.gw; row0 < NTOK; row0 += 4 * C.NGW) {
        u32x2 a[4], b[4], g[4];
#pragma unroll
        for (int i = 0; i < 4; ++i) { const size_t row = (size_t)row0 + (size_t)i * C.NGW; a[i] = *(const u32x2*)(HF + row * 256 + c4); b[i] = *(const u32x2*)(HB + row * 256 + c4); g[i] = *(const u32x2*)(UCD + row * 1024 + 592 + c4); }
#pragma unroll
        for (int i = 0; i < 4; ++i) { const size_t row = (size_t)row0 + (size_t)i * C.NGW;
            const float y0 = (bflo(a[i].x) + bflo(b[i].x)) * gelu_tanh(bflo(g[i].x)), y1 = (bfhi(a[i].x) + bfhi(b[i].x)) * gelu_tanh(bfhi(g[i].x));
            const float y2 = (bflo(a[i].y) + bflo(b[i].y)) * gelu_tanh(bflo(g[i].y)), y3 = (bfhi(a[i].y) + bfhi(b[i].y)) * gelu_tanh(bfhi(g[i].y));
            u32x2 w; w.x = cvt_pk_bf16(y0, y1); w.y = cvt_pk_bf16(y2, y3);
            *(u32x2*)(Y + row * DM + 768 + c4) = w; }
    }
}

DI void ph_topk(const Ctx& C) {
    const float* affT = (const float*)(C.ws + WS_AFF); int* idx2 = (int*)(C.ws + WS_IDX); float* gsel2 = (float*)(C.ws + WS_GSEL);
    LAS unsigned* hist = (LAS unsigned*)C.lds;
    LAS unsigned* misc = hist + 4096;
    LAS unsigned* cg = misc + 8;
    LAS unsigned* ce = cg + 512;
    for (int u = C.bid; u < 32; u += C.G) {
        const int g = u >> 4, e = u & 15; const unsigned* a = (const unsigned*)(affT + (size_t)(g * 16 + e) * NTOKG);
        const int i0 = C.tid * 128; unsigned v[128];
        { const u32x4* p = (const u32x4*)(a + i0);
#pragma unroll
          for (int j = 0; j < 32; ++j) { const u32x4 q = p[j]; v[4 * j] = q.x; v[4 * j + 1] = q.y; v[4 * j + 2] = q.z; v[4 * j + 3] = q.w; } }
        unsigned prefix = 0u, mask = 0u, krem = CAP;
#pragma unroll 1
        for (int pass = 0; pass < 3; ++pass) {
            const int shift = pass == 0 ? 19 : (pass == 1 ? 7 : 0); const unsigned dm = pass == 2 ? 127u : 4095u; const int per = pass == 2 ? 2 : 64;
            for (int i = C.tid; i < 4096; i += 512) hist[i] = 0u;
            __syncthreads();
#pragma unroll
            for (int i = 0; i < 128; ++i) {
                const unsigned bin = ((v[i] & mask) == prefix) ? ((v[i] >> shift) & dm) : (5120u + (unsigned)C.lane);
                atomicAdd((unsigned*)&hist[bin], 1u); if ((i & 7) == 7) asm volatile("" : "+v"(prefix) :: "memory"); }
            __syncthreads();
            if (C.tid < 64) {
                unsigned t = 0; for (int b = 0; b < per; ++b) t += hist[per * C.tid + b];
                unsigned S = t;
#pragma unroll
                for (int off = 1; off < 64; off <<= 1) { const unsigned y = __shfl_down(S, off); if (C.tid + off < 64) S += y; }
                const unsigned above = S - t;
                if (above < krem && krem <= above + t) { unsigned cum = above; int D = per * C.tid + per - 1;
                    for (; D > per * C.tid; --D) { const unsigned c = hist[D]; if (cum + c >= krem) break; cum += c; }
                    misc[0] = (unsigned)D; misc[1] = cum; }
            }
            __syncthreads();
            prefix |= misc[0] << shift; mask |= dm << shift; krem -= misc[1];
            __syncthreads();
        }
        unsigned ngt = 0, neq = 0;
#pragma unroll
        for (int i = 0; i < 128; ++i) { ngt += (v[i] > prefix); neq += (v[i] == prefix); if ((i & 15) == 15) asm volatile("" : "+v"(prefix)); }
        unsigned ig = ngt, ie = neq;
#pragma unroll
        for (int off = 1; off < 64; off <<= 1) { const unsigned yg = __shfl_up(ig, off), ye = __shfl_up(ie, off); if (C.lane >= off) { ig += yg; ie += ye; } }
        if (C.lane == 63) { cg[C.wave] = ig; ce[C.wave] = ie; }
        __syncthreads();
        unsigned bg = 0, be = 0, allg = 0;
#pragma unroll
        for (int w = 0; w < 8; ++w) { const unsigned x = cg[w], y = ce[w]; if (w < C.wave) { bg += x; be += y; } allg += x; }
        unsigned pg = bg + ig - ngt, pe = be + ie - neq; const unsigned ngt_all = allg;
        int* io = idx2 + (size_t)e * 16384 + g * CAP; float* go = gsel2 + (size_t)e * 16384 + g * CAP; short* sm = (short*)(C.ws + WS_SM) + (size_t)(g * NTOKG + i0) * 16 + e;
#pragma unroll
        for (int i = 0; i < 128; ++i) {
            if (v[i] > prefix) { io[pg] = g * NTOKG + i0 + i; go[pg] = __builtin_bit_cast(float, v[i]); sm[i * 16] = (short)pg; ++pg; }
            else if (v[i] == prefix) { if (pe < krem) { io[ngt_all + pe] = g * NTOKG + i0 + i; go[ngt_all + pe] = __builtin_bit_cast(float, v[i]); sm[i * 16] = (short)(ngt_all + pe); } ++pe; }
            if ((i & 3) == 3) asm volatile("" : "+v"(prefix) :: "memory"); }
        __syncthreads();
    }
}

constexpr int MERGE_CHUNKS = 8, MERGE_ROWS = NTOK / MERGE_CHUNKS;
constexpr int EPB = 2;
constexpr int NPH_LAYER = 12 + 2 * MERGE_CHUNKS + 3 + (NEXP / EPB + 1) + 1, NPH = 1 + 2 * NPH_LAYER;
__global__ void __launch_bounds__(512, 2) mk_fwd(Args args) {
    extern __shared__ __attribute__((aligned(16))) unsigned char lds_raw[];
    Ctx C;
    C.lds = (LAS unsigned char*)lds_raw; C.ws = (GAS unsigned char*)args.ws; C.out = (GAS float*)args.out;
    C.tid = threadIdx.x; C.lane = C.tid & 63; C.wave = __builtin_amdgcn_readfirstlane(C.tid >> 6); C.G = gridDim.x; C.bid = blockIdx.x;
    C.gw = C.bid * 8 + C.wave; C.NGW = C.G * 8;
    C.A = &args;
    volatile LAS unsigned* MISC = (volatile LAS unsigned*)(C.lds + MISC_OFF);
    for (int u = C.tid; u < (LDS_BYTES - RING_BYTES) / 4; u += 512) ((LAS unsigned*)(C.lds + RING_BYTES))[u] = 0u;
    __syncthreads();
    const int lo = args.ph_lo, hi = args.ph_hi;
    unsigned* barw = (unsigned*)(C.ws + WS_CTL) + 4096;
    XcdBarrier bar; bar.bar = barw; bar.x = 0; bar.st = nullptr;
    if (hi - lo > 1) bar = xcd_barrier_post(barw, MISC + 8);
    int ph = 0;
#ifndef PHASE_MASK
#define PHASE_MASK 0xFFFFFFFFu
#endif
#ifndef REPEAT_MASK
#define REPEAT_MASK 0u
#endif
#define SITE(id) if constexpr (((PHASE_MASK) >> (id)) & 1u) for (int rep_ = 0; rep_ < ((((REPEAT_MASK) >> (id)) & 1u) ? 2 : 1); ++rep_)
#define PH_BEGIN if (ph >= lo && ph < hi) { { int tz_ = threadIdx.x; asm volatile("" : "+v"(tz_)); C.tid = tz_; C.lane = tz_ & 63; C.wave = __builtin_amdgcn_readfirstlane(tz_ >> 6); C.gw = C.bid * 8 + C.wave; unsigned char* wz_ = args.ws; asm volatile("" : "+s"(wz_)); C.ws = (GAS unsigned char*)wz_; float* oz_ = args.out; asm volatile("" : "+s"(oz_)); C.out = (GAS float*)oz_; }
#define PH_END } if (ph >= lo && ph + 1 < hi) xcd_barrier(bar); ++ph;

#define XB0 ((bf16_t*)(C.ws + WS_XB0))
#define XB1 ((bf16_t*)(C.ws + WS_XB1))
#define Yb ((bf16_t*)(C.ws + WS_Y))
#define Ub ((bf16_t*)(C.ws + WS_U))
    const int big = 30;

    PH_BEGIN SITE(1) ph_prologue(C); PH_END

    for (int l = 0; l < 2; ++l) {
#define wl (C.ws + WS_WSMALL + (size_t)l * WSMALL_LAYER)
        PH_BEGIN SITE(2) { pg8::Gemm g{XB0, (const bf16_t*)(wl + OFF_WA), NTOK, 768, 1024, 1024, 1024, big, 0}; pg8::StaticOrder S; S.init(NTOK, 768, C.G, C.bid);
            pg8::EpiProj E{Ub, 768, 256, 0.17677669529663689f * LOG2E, (unsigned*)(C.ws + WS_KN2) + (size_t)l * 8 * 2048}; pg8::gemm_phase(C.lds, g, S, E); } PH_END
        PH_BEGIN SITE(3) ph_attn_a(C, l); PH_END
        PH_BEGIN SITE(4) { ph_a_post(C, l); __syncthreads();
            pg8::Gemm g{XB0, (const bf16_t*)(wl + OFF_WB), NTOK, 1280, 1024, 1024, 1024, big, 0}; pg8::StaticOrder S; S.init(NTOK, 1280, C.G, C.bid);
            pg8::EpiProj E{Ub, 1280, 0, 1.f, nullptr}; pg8::gemm_phase(C.lds, g, S, E); } PH_END
        PH_BEGIN SITE(5) ph_hgrn_local(C, l); PH_END
        PH_BEGIN SITE(6) ph_hgrn_scan(C); PH_END
        PH_BEGIN SITE(7) ph_hgrn_out<1>(C, l); PH_END
        PH_BEGIN SITE(20) ph_hgrn_out<2>(C, l); PH_END
        PH_BEGIN SITE(8) { pg8::Gemm g{XB0, (const bf16_t*)(wl + OFF_WCD), NTOK, 1024, 1024, 1024, 1024, big, 0}; pg8::StaticOrder S; S.init(NTOK, 1024, C.G, C.bid);
            pg8::EpiProj E{Ub, 1024, 0, 1.f, nullptr}; pg8::gemm_phase(C.lds, g, S, E); } PH_END
        PH_BEGIN SITE(9) { ph_c_prep(C, l); __syncthreads(); ph_rglru<false>(C, l); } PH_END
        PH_BEGIN SITE(10) { if (rep_ == 0) { ph_rglru_scan(C); __syncthreads(); } ph_attn_c(C); } PH_END
        PH_BEGIN SITE(11) ph_rglru<true>(C, l); PH_END
        PH_BEGIN SITE(12) ph_d_post(C); PH_END
        for (int q = 0; q < MERGE_CHUNKS; ++q) {
            const size_t r0 = (size_t)q * MERGE_ROWS;
            PH_BEGIN SITE(13) {
                { unsigned char* X8 = (unsigned char*)(C.ws + WS_U) + (size_t)MERGE_ROWS * 8192;
                  for (int rb = C.gw; rb < MERGE_ROWS; rb += 8 * C.NGW) {
                      u32x4 a[8], b[8];
#pragma unroll
                      for (int i = 0; i < 8; ++i) { const int r = min(rb + i * C.NGW, MERGE_ROWS - 1); const u32x4* s = (const u32x4*)(XB0 + (r0 + r) * DM) + 2 * C.lane; a[i] = s[0]; b[i] = s[1]; }
#pragma unroll
                      for (int i = 0; i < 8; ++i) { const int r = rb + i * C.NGW; if (r < MERGE_ROWS) {
                          u32x4 o; o.x = pg8::pk4_fp8(bflo(a[i].x), bfhi(a[i].x), bflo(a[i].y), bfhi(a[i].y)); o.y = pg8::pk4_fp8(bflo(a[i].z), bfhi(a[i].z), bflo(a[i].w), bfhi(a[i].w));
                          o.z = pg8::pk4_fp8(bflo(b[i].x), bfhi(b[i].x), bflo(b[i].y), bfhi(b[i].y)); o.w = pg8::pk4_fp8(bflo(b[i].z), bfhi(b[i].z), bflo(b[i].w), bfhi(b[i].w));
                          ((u32x4*)(X8 + (size_t)r * DM))[C.lane] = o; } } }
                  __syncthreads(); }
                pg8::Gemm g{Yb + r0 * DM, (const bf16_t*)(wl + OFF_WBR), MERGE_ROWS, 4096, 256, 1024, 256, 2, 512}; pg8::StaticOrder S; S.init(MERGE_ROWS, 4096, C.G, C.bid);
                pg8::EpiProj E{Ub, 4096, 0, 1.f, nullptr}; pg8::gemm_phase(C.lds, g, S, E); } PH_END
            PH_BEGIN SITE(14) { pg8::Gemm g{(const bf16_t*)(C.ws + WS_U + (size_t)MERGE_ROWS * 8192), (const bf16_t*)(wl + OFF_WG), MERGE_ROWS, 4096, 1024, 1024, 1024, big, 0}; pg8::StaticOrder S; S.init(MERGE_ROWS, 4096, C.G, C.bid);
                pg8::EpiGateMix E{Ub, XB1 + r0 * DM, 1.f / pg8::FP8_W1_SCALE}; pg8::gemm_phase<pg8::EpiGateMix, pg8::StaticOrder, true>(C.lds, g, S, E); } PH_END
        }
        PH_BEGIN SITE(15) { pg8::Gemm g{XB1, (const bf16_t*)(wl + OFF_WOUT), NTOK, 1024, 1024, 1024, 1024, big, 0}; pg8::StaticOrder S; S.init(NTOK, 1024, C.G, C.bid);
            pg8::EpiResid E{l == 0 ? C.A->in[0] : (const float*)C.out, l == 0 ? C.A->in[1] : (const float*)(C.out + (size_t)NTOKG * DM), (float*)C.out}; pg8::gemm_phase(C.lds, g, S, E); } PH_END
        PH_BEGIN SITE(16) { ph_ln<true>(C, l, 0, XB1); } PH_END
        PH_BEGIN SITE(17) { if (C.bid < 32 && C.G > 64) ph_topk(C); else expert_weight_items(C, l); if (C.G <= 64) { __syncthreads(); if (C.bid < 32) ph_topk(C); } } PH_END
        for (int k = 0; k < NEXP / EPB + 1; ++k) {
            PH_BEGIN SITE(18) {
                constexpr size_t H_B = (size_t)EPB * 16384 * 2048;
                unsigned char* Hb = (unsigned char*)(C.ws + WS_XB0);
                if (k < NEXP / EPB) { const int e0 = k * EPB;
                    pg8::Gemm g{(const bf16_t*)(C.ws + WS_XB1), (const bf16_t*)(C.ws + WS_EW + OFF_WGU8 + (size_t)e0 * 4096 * 1024), EPB * 16384, 4096, 1024, 1024, 1024, big, 0, 6, (size_t)4096 * 1024, (const int*)(C.ws + WS_IDX) + (size_t)e0 * 16384}; pg8::StaticOrder S; S.init(EPB * 16384, 4096, C.G, C.bid);
                    pg8::EpiSiluMul8 E{Hb + (size_t)(k & 1) * H_B, 2048}; pg8::gemm_phase<pg8::EpiSiluMul8, pg8::StaticOrder, true, true>(C.lds, g, S, E); }
                if (k >= 1) { const int e0 = (k - 1) * EPB; __syncthreads();
                    pg8::Gemm g{(const bf16_t*)(Hb + (size_t)((k - 1) & 1) * H_B), (const bf16_t*)(C.ws + WS_EW + OFF_WD8 + (size_t)e0 * 1024 * 2048), EPB * 16384, 1024, 2048, 2048, 2048, big, 0, 6, (size_t)1024 * 2048}; pg8::StaticOrder S; S.init(EPB * 16384, 1024, C.G, C.bid);
                    pg8::EpiYe E{(bf16_t*)(C.ws + WS_Y) + (size_t)e0 * 16384 * DM, (const float*)(C.ws + WS_GSEL) + (size_t)e0 * 16384, 1.f / (pg8::FP8_H_SCALE * pg8::FP8_W2_SCALE)}; pg8::gemm_phase<pg8::EpiYe, pg8::StaticOrder, true>(C.lds, g, S, E); }
            } PH_END
        }
        PH_BEGIN SITE(19) ph_ln<false>(C, l, 1, l + 1 < 2 ? XB0 : nullptr); PH_END
    }
#undef PH_BEGIN
#undef PH_END
#undef XB0
#undef XB1
#undef Yb
#undef Ub
#undef wl
}

extern "C" void kernel_launch(void* const* d_in, const int* in_sizes, int n_in, void* d_out, int out_size, void* d_ws, size_t ws_size, hipStream_t stream) {
    static int grid = 0;
    if (grid == 0) {
        if (n_in != 26 || out_size != NTOK * DM || ws_size < WS_END) { fprintf(stderr, "kernel_launch: unexpected shapes: n_in %d out %d ws %zu (need %zu)\n", n_in, out_size, ws_size, (size_t)WS_END); grid = -1; return; }
        int dev = 0, cus = 0, per_cu = 0;
        if (hipGetDevice(&dev) != hipSuccess || hipDeviceGetAttribute(&cus, hipDeviceAttributeMultiprocessorCount, dev) != hipSuccess) { grid = -1; return; }
        if (hipFuncSetAttribute((const void*)mk_fwd, hipFuncAttributeMaxDynamicSharedMemorySize, LDS_BYTES) != hipSuccess) { fprintf(stderr, "kernel_launch: hipFuncSetAttribute failed\n"); grid = -1; return; }
        if (hipOccupancyMaxActiveBlocksPerMultiprocessor(&per_cu, (const void*)mk_fwd, 512, LDS_BYTES) != hipSuccess || per_cu < 1) { fprintf(stderr, "kernel_launch: occupancy query says %d\n", per_cu); }
        (void)hipGetLastError();
        grid = cus;
    }
    if (grid < 0) return;
    if (hipMemsetAsync((char*)d_ws + WS_CTL, 0, CTL_ZERO_BYTES, stream) != hipSuccess) return;
    Args a{};
    for (int i = 0; i < 26; ++i) a.in[i] = (const float*)d_in[i];
    a.out = (float*)d_out; a.ws = (unsigned char*)d_ws;
#if MK_PER_PHASE_LAUNCH
    for (int p = 0; p < NPH; ++p) { a.ph_lo = p; a.ph_hi = p + 1; hipLaunchKernelGGL(mk_fwd, dim3(grid), dim3(512), LDS_BYTES, stream, a); }
#else
    a.ph_lo = 0; a.ph_hi = NPH; hipLaunchKernelGGL(mk_fwd, dim3(grid), dim3(512), LDS_BYTES, stream, a);
#endif
    const hipError_t le = hipPeekAtLastError();
    if (le != hipSuccess) fprintf(stderr, "kernel_launch: launch failed: %s\n", hipGetErrorName(le));
}
```

```cpp
#include <hip/hip_runtime.h>
#include <cstdio>
#include <cstdint>

#ifndef MK_PER_PHASE_LAUNCH
#define MK_PER_PHASE_LAUNCH 0
#endif

#define LAS __attribute__((address_space(3)))
#define GAS __attribute__((address_space(1)))
typedef unsigned short bf16_t;
typedef short bf16x8 __attribute__((ext_vector_type(8)));
typedef short s16x4 __attribute__((ext_vector_type(4)));
typedef float f32x2 __attribute__((ext_vector_type(2)));
typedef float f32x4 __attribute__((ext_vector_type(4)));
typedef float f32x16 __attribute__((ext_vector_type(16)));
typedef unsigned u32x2 __attribute__((ext_vector_type(2)));
typedef unsigned u32x4 __attribute__((ext_vector_type(4)));
#define DI __device__ __forceinline__
#define LDS_WAIT() asm volatile("s_waitcnt lgkmcnt(0)" ::: "memory")
#define VM_WAIT() asm volatile("s_waitcnt vmcnt(0)" ::: "memory")

constexpr int DM = 1024, NTOK = 131072, NTOKG = 65536, NSEQ = 40, NCHUNK = 1024  ;
constexpr int IN_W = 6992, COL_B = 768, COL_CD = 2048, COL_GATE = 2896;
constexpr int NEXP = 16, DEXP = 2048, CAP = 8192;
constexpr float ALPHA = 1.41421356237309515f, INV_ALPHA = 0.70710678118654752f;
constexpr float LOG2E = 1.4426950408889634f;
constexpr float LN_EPS = 1e-5f, RMS_EPS = 1e-6f;

constexpr size_t MiB = (size_t)1 << 20;
constexpr size_t WS_CTL = 0, CTL_ZERO_BYTES = 1 * MiB;
constexpr size_t WS_KN2 = 256 * 1024;
constexpr size_t WS_WSMALL = 2 * MiB, WSMALL_LAYER = 18 * MiB;
constexpr size_t OFF_WA = 0, OFF_WB = (size_t)768 * 1024 * 2, OFF_WCD = OFF_WB + (size_t)1280 * 1024 * 2, OFF_WG = OFF_WCD + (size_t)1024 * 1024 * 2,
                 OFF_WBR = OFF_WG + (size_t)4096 * 1024 * 2, OFF_WOUT = OFF_WBR + (size_t)4096 * 256 * 2;
static_assert(OFF_WOUT + (size_t)1024 * 1024 * 2 <= WSMALL_LAYER, "small weights");
constexpr size_t WS_WC = 38 * MiB, WC_LAYER = 256 * 1024;
constexpr size_t OFF_WQ = 0, OFF_WKV = 96 * 1024;
constexpr size_t WS_WRG = 39 * MiB;
constexpr size_t WS_AFF = 40 * MiB;
constexpr size_t WS_IDX = 48 * MiB, WS_GSEL = 49 * MiB;
constexpr size_t WS_GAM = 50 * MiB;
constexpr size_t WS_DC = 52 * MiB;
constexpr size_t WS_SM = 56 * MiB;
constexpr size_t WS_XB0 = 64 * MiB, WS_XB1 = 320 * MiB, WS_Y = 576 * MiB, WS_U = 832 * MiB, WS_EW = 1152 * MiB, WS_END = 1344 * MiB;
constexpr size_t OFF_QC = 0, OFF_KC = 48 * MiB, OFF_VC = 96 * MiB;
constexpr size_t OFF_WGU8 = 0, OFF_WD8 = (size_t)16 * 4096 * 1024;

DI unsigned f2bf(float f) { unsigned u = __builtin_bit_cast(unsigned, f); return (u + 0x7fffu + ((u >> 16) & 1u)) >> 16; }
DI unsigned pk2(float lo, float hi) { return f2bf(lo) | (f2bf(hi) << 16); }
DI float bf2f(unsigned short b) { return __builtin_bit_cast(float, ((unsigned)b) << 16); }
DI float bflo(unsigned w) { return __builtin_bit_cast(float, w << 16); }
DI float bfhi(unsigned w) { return __builtin_bit_cast(float, w & 0xffff0000u); }
DI unsigned cvt_pk_bf16(float lo, float hi) { unsigned r; asm volatile("v_cvt_pk_bf16_f32 %0, %1, %2" : "=v"(r) : "v"(lo), "v"(hi)); return r; }
typedef __bf16 bf16x2_t __attribute__((ext_vector_type(2)));
DI unsigned cvt_pk_bf16_b(float lo, float hi) { const f32x2 v = {lo, hi}; const bf16x2_t b = __builtin_convertvector(v, bf16x2_t); return __builtin_bit_cast(unsigned, b); }
DI float sigmoidf_(float x) { return __builtin_amdgcn_rcpf(1.0f + __builtin_amdgcn_exp2f(-x * LOG2E)); }
DI float siluf_(float x) { return x * sigmoidf_(x); }
DI float wave_sum(float v) {
#pragma unroll
    for (int o = 1; o < 64; o <<= 1) v += __shfl_xor(v, o);
    return v;
}
DI float wave_max(float v) {
#pragma unroll
    for (int o = 1; o < 64; o <<= 1) v = fmaxf(v, __shfl_xor(v, o));
    return v;
}
DI int seq_start_row(int s) { return s < 8 ? s * 8192 : 65536 + (s - 8) * 2048; }
DI int row_pos(int row) { return row < 65536 ? (row & 8191) : (row & 2047); }
DI int row_seq_begin(int row) { return row < 65536 ? (row & ~8191) : (row & ~2047); }
DI int row_seq_len(int row) { return row < 65536 ? 8192 : 2048; }

namespace pg8 {
constexpr int BM = 256, BK = 64, HALF = 128, HTB = HALF * BK * 2, STAGE_BYTES = 8 * HTB, NXCD = 8, WGM = 8;
DI int lds_byte(int r, int c) { const int st = (r >> 4) * 2 + (c >> 5), rr = r & 15, cc = c & 31, ob = rr * 64 + cc * 2; return st * 1024 + (ob ^ (((ob >> 9) & 1) << 5)); }
DI void stage_rc(int b, int& R, int& C) { const int st = b / 1024, sb = b % 1024, swz = sb ^ (((sb >> 9) & 1) << 5); R = (st >> 1) * 16 + swz / 64; C = (st & 1) * 32 + (swz % 64) / 2; }
DI int perm32(int rho) { const int n = rho >> 4, i = rho & 15; return 8 * (i >> 2) + 4 * n + (i & 3); }

struct Unit { int pm, pn; };
struct Gemm { const bf16_t* A; const bf16_t* Bt; int M, N, K, lda, ldb, an_shift; size_t an_off; int bm_shift = 30; size_t bm_off = 0; const int* gidx = nullptr; };

struct StaticOrder {
    int nM, nN, nwg, G, c;
    DI void init(int M, int N, int G_, int c_) { nM = M / BM; nN = N / BM; nwg = nM * nN; G = G_; c = c_; }
    DI bool next(int i, Unit& u) const {
        const long L = (long)i * G + c; if (L >= nwg) return false;
        int wgid = (int)L; { const int q = nwg / NXCD, r = nwg % NXCD, xcd = wgid % NXCD, off = wgid / NXCD; wgid = (xcd < r ? xcd * (q + 1) : r * (q + 1) + (xcd - r) * q) + off; }
        const int nig = WGM * nN, gid = wgid / nig, fm = gid * WGM, gsz = (nM - fm) < WGM ? (nM - fm) : WGM;
        u.pm = fm + ((wgid % nig) % gsz); u.pn = (wgid % nig) / gsz; return true;
    }
};

typedef f32x4 Acc[2][2][4][2];

typedef int v8i_t __attribute__((ext_vector_type(8)));
DI void mfma8_tied(f32x4& c, const v8i_t& a, const v8i_t& b) { asm volatile("v_mfma_f32_16x16x128_f8f6f4 %0, %1, %2, %0" : "+v"(c) : "v"(a), "v"(b)); }
DI void glds_sv(const void* sbase, unsigned voff, unsigned lds_dst) { unsigned keep;
    asm volatile("s_mov_b32 %0, m0\n\ts_mov_b32 m0, %3\n\ts_nop 0\n\tglobal_load_lds_dwordx4 %1, %2\n\ts_mov_b32 m0, %0" : "=&s"(keep) : "v"(voff), "s"(sbase), "s"(lds_dst) : "memory"); }
constexpr int GIDX_OFF = 131072 + 1024, GIDX_TILES = 14;
template <class Epi, class Sched, bool FP8 = false, bool GATHER = false>
DI void gemm_phase(LAS unsigned char* lds, const Gemm g, const Sched& S, const Epi& E) {
    int tid = threadIdx.x; asm volatile("" : "+v"(tid));
    const int wid = __builtin_amdgcn_readfirstlane(tid >> 6), lane = tid & 63, wr = wid >> 2, wc = wid & 3, fr = lane & 15, fq = lane >> 4;
    const int K = g.K, nt = FP8 ? K / 128 : K / BK;
    const int pitchA = FP8 ? g.lda : g.lda * 2, pitchB = FP8 ? g.ldb : g.ldb * 2;
    unsigned voffA[2], voffB[2];
#pragma unroll
    for (int i = 0; i < 2; ++i) { int R, C; stage_rc(tid * 16 + i * 8192, R, C); const int Rb = Epi::PERM ? ((R & ~31) + perm32(R & 31)) : R;
        voffA[i] = (unsigned)(R * pitchA + C * 2); voffB[i] = (unsigned)(Rb * pitchB + C * 2); }
    const size_t kstep = (size_t)(BK * 2);
    const size_t hstepA = (size_t)HALF * pitchA, hstepB = (size_t)HALF * pitchB;
    const size_t tstepA = 2 * hstepA, tstepB = 2 * hstepB;
    const unsigned ldsw = (unsigned)wid * 1024u;
    const int aoff = lds_byte(wr * 64 + fr, fq * 8), boff = lds_byte(wc * 32 + fr, fq * 8);
#define PG8_SA(b, h) (((b) * 2 + (h)) * HTB)
#define PG8_SB(b, h) ((4 + (b) * 2 + (h)) * HTB)
#define PG8_STAGE(bufoff, gbase, voff) do { _Pragma("unroll") for (int _i = 0; _i < 2; ++_i) \
        glds_sv((const void*)(gbase), (voff)[_i], (unsigned)(uintptr_t)(lds + (bufoff) + ldsw + _i * 8192)); } while (0)
#define PG8_LD1(p) ([&]() { if constexpr (FP8) { const u32x4 lo_ = *(const LAS u32x4*)(p), hi_ = *(const LAS u32x4*)((p) + 1024); return Frag{__builtin_bit_cast(v8i_t, __builtin_shufflevector(lo_, hi_, 0, 1, 2, 3, 4, 5, 6, 7))}; } \
        else { Frag f_; f_.h[0] = *(const LAS bf16x8*)(p); f_.h[1] = *(const LAS bf16x8*)((p) + 1024); return f_; } }())
#define PG8_LDA(dst, b, h) do { _Pragma("unroll") for (int m = 0; m < 4; ++m) dst[m] = PG8_LD1(lds + PG8_SA(b, h) + aoff + m * 2048); } while (0)
#define PG8_LDB(dst, b, h) do { _Pragma("unroll") for (int n = 0; n < 2; ++n) dst[n] = PG8_LD1(lds + PG8_SB(b, h) + boff + n * 2048); } while (0)
#define PG8_MMA(ai, bj, At, Bt) do { __builtin_amdgcn_s_setprio(1); _Pragma("unroll") for (int m = 0; m < 4; ++m) _Pragma("unroll") for (int n = 0; n < 2; ++n) { \
        if constexpr (FP8) mfma8_tied(acc[ai][bj][m][n], Bt[n].w, At[m].w); \
        else { _Pragma("unroll") for (int k = 0; k < 2; ++k) acc[ai][bj][m][n] = __builtin_amdgcn_mfma_f32_16x16x32_bf16(Bt[n].h[k], At[m].h[k], acc[ai][bj][m][n], 0, 0, 0); } } \
        __builtin_amdgcn_s_setprio(0); } while (0)
#define PG8_WAIT_V(n) asm volatile("s_waitcnt vmcnt(" #n ")" ::: "memory")
#define PG8_WAIT_L(n) asm volatile("s_waitcnt lgkmcnt(" #n ")" ::: "memory")
#define PG8_BAR __builtin_amdgcn_s_barrier()
#define PG8_SCHED __builtin_amdgcn_sched_barrier(0)
    Unit cur, nxt; int ui = 0;
    unsigned vg[2][2] = {{0u, 0u}, {0u, 0u}};
    if constexpr (GATHER) { LAS unsigned* tab = (LAS unsigned*)(lds + GIDX_OFF); Unit u_;
        for (int i = 0; i < GIDX_TILES && S.next(i, u_); ++i) { if (tid < 256) tab[i * 256 + tid] = (unsigned)g.gidx[u_.pm * BM + tid]; }
        __syncthreads(); }
#define PG8_GOFF(ord) do { int tq_ = tid; asm volatile("" : "+v"(tq_)); int R_, C_; stage_rc(tq_ * 16, R_, C_); const LAS unsigned* tb_ = (const LAS unsigned*)(lds + GIDX_OFF) + (ord) * 256 + R_; \
        _Pragma("unroll") for (int h_ = 0; h_ < 2; ++h_) _Pragma("unroll") for (int i_ = 0; i_ < 2; ++i_) vg[h_][i_] = tb_[h_ * 128 + i_ * 64] * (unsigned)pitchA + (unsigned)(C_ * 2); } while (0)
#define PG8_STAGE_A(bufoff, base, h) do { if constexpr (GATHER) PG8_STAGE(bufoff, base, vg[h]); else PG8_STAGE(bufoff, (base) + (h) * hstepA, voffA); } while (0)
    if (!S.next(0, cur)) return;
    if constexpr (GATHER) PG8_GOFF(0);
    float zf = 0.f; asm volatile("" : "+v"(zf));
    Acc acc;
#pragma unroll
    for (int a = 0; a < 2; ++a)
#pragma unroll
        for (int b = 0; b < 2; ++b)
#pragma unroll
            for (int m = 0; m < 4; ++m)
#pragma unroll
                for (int n = 0; n < 2; ++n) acc[a][b][m][n] = (f32x4){zf, zf, zf, zf};
    union Frag { v8i_t w; bf16x8 h[2]; };
    Frag At[4], B0[2], B1[2];
    const char* cA = GATHER ? (const char*)g.A : (const char*)g.A + (size_t)cur.pm * tstepA + (size_t)(cur.pn >> g.an_shift) * g.an_off; const char* cB = (const char*)g.Bt + (size_t)cur.pn * tstepB + (size_t)(cur.pm >> g.bm_shift) * g.bm_off;
    PG8_STAGE(PG8_SB(0, 0), cB, voffB); PG8_STAGE(PG8_SB(0, 1), cB + hstepB, voffB); PG8_STAGE_A(PG8_SA(0, 0), cA, 0); PG8_STAGE_A(PG8_SA(0, 1), cA, 1);
    if (wr == 1) PG8_BAR;
    PG8_WAIT_V(2); PG8_BAR;
    PG8_STAGE(PG8_SB(1, 0), cB + kstep, voffB); PG8_STAGE_A(PG8_SA(1, 0), cA + kstep, 0); PG8_STAGE(PG8_SB(1, 1), cB + hstepB + kstep, voffB);
    PG8_WAIT_V(6); PG8_BAR;
    for (;;) {
        const bool has_next = S.next(ui + 1, nxt);
        const char* nA = (has_next && !GATHER) ? (const char*)g.A + (size_t)nxt.pm * tstepA + (size_t)(nxt.pn >> g.an_shift) * g.an_off : cA;
        const char* nB = has_next ? (const char*)g.Bt + (size_t)nxt.pn * tstepB + (size_t)(nxt.pm >> g.bm_shift) * g.bm_off : cB;
#pragma unroll 1
        for (int t = 0; t < nt; t += 2) {
            const bool last = (t == nt - 2);
            const char* a1 = cA + (size_t)(t + 1) * kstep;
            const char* a2 = last ? nA : cA + (size_t)(t + 2) * kstep; const char* b2 = last ? nB : cB + (size_t)(t + 2) * kstep;
            const char* a3 = a2 + kstep; const char* b3 = b2 + kstep;
            PG8_LDB(B0, 0, 0); PG8_LDB(B1, 0, 1); PG8_SCHED; PG8_LDA(At, 0, 0); PG8_STAGE_A(PG8_SA(1, 1), a1, 1);
            if constexpr (GATHER) { if (last && has_next) PG8_GOFF(ui + 1); }
            PG8_WAIT_V(8); PG8_WAIT_L(0); PG8_BAR; PG8_MMA(0, 0, At, B0); PG8_MMA(0, 1, At, B1); PG8_BAR; PG8_SCHED;
            PG8_LDA(At, 0, 1); PG8_STAGE(PG8_SB(0, 0), b2, voffB); PG8_STAGE(PG8_SB(0, 1), b2 + hstepB, voffB); PG8_STAGE_A(PG8_SA(0, 0), a2, 0);
            PG8_WAIT_V(8); PG8_WAIT_L(0); PG8_BAR; PG8_MMA(1, 0, At, B0); PG8_MMA(1, 1, At, B1); PG8_BAR; PG8_SCHED;
            PG8_LDB(B0, 1, 0); PG8_LDB(B1, 1, 1); PG8_SCHED; PG8_LDA(At, 1, 0); PG8_STAGE_A(PG8_SA(0, 1), a2, 1);
            PG8_WAIT_V(8); PG8_WAIT_L(0); PG8_BAR; PG8_MMA(0, 0, At, B0); PG8_MMA(0, 1, At, B1); PG8_BAR; PG8_SCHED;
            PG8_LDA(At, 1, 1); PG8_STAGE(PG8_SB(1, 0), b3, voffB); PG8_STAGE(PG8_SB(1, 1), b3 + hstepB, voffB); PG8_STAGE_A(PG8_SA(1, 0), a3, 0);
            PG8_WAIT_V(8); PG8_WAIT_L(0); PG8_BAR; PG8_MMA(1, 0, At, B0); PG8_MMA(1, 1, At, B1); PG8_BAR; PG8_SCHED;
        }
        if (wr == 0) PG8_BAR;
        if constexpr (FP8) asm volatile("s_nop 15\n\ts_nop 15" ::: "memory");
        { int tz = tid; asm volatile("" : "+v"(tz));
          const int lz = tz & 63; E(acc, cur, wr, wc, lz & 15, lz >> 4); }
        if (!has_next) break;
#pragma unroll
        for (int a = 0; a < 2; ++a)
#pragma unroll
            for (int b = 0; b < 2; ++b)
#pragma unroll
                for (int m = 0; m < 4; ++m)
#pragma unroll
                    for (int n = 0; n < 2; ++n) acc[a][b][m][n] = (f32x4){0.f, 0.f, 0.f, 0.f};
        cur = nxt; cA = nA; cB = nB; ++ui;
        if (wr == 1) PG8_BAR;
    }
    PG8_WAIT_V(0);
    PG8_BAR;
#undef PG8_SA
#undef PG8_SB
#undef PG8_STAGE
#undef PG8_STAGE_A
#undef PG8_GOFF
#undef PG8_LDA
#undef PG8_LDB
#undef PG8_MMA
#undef PG8_LD1
#undef PG8_WAIT_V
#undef PG8_WAIT_L
#undef PG8_BAR
#undef PG8_SCHED
}

struct EpiProj {
    static constexpr bool PERM = true;
    bf16_t* O; int ldc; int scale_cols; float scale; unsigned* kn2;
    DI void operator()(const Acc& acc, const Unit& u, int wr, int wc, int fr, int fq) const {
        const int row0 = u.pm * BM + wr * 64 + fr, colt = u.pn * BM, col0 = colt + wc * 32 + 8 * fq;
        const float sc = (colt < scale_cols) ? scale : 1.f;
        const bool donorm = (kn2 != nullptr) && (colt == 256);
#pragma unroll
        for (int ai = 0; ai < 2; ++ai) { float mx0 = 0.f, mx1 = 0.f;
#pragma unroll
            for (int m = 0; m < 4; ++m) { bf16_t* rowp = O + (size_t)(row0 + ai * HALF + m * 16) * ldc + col0;
#pragma unroll
                for (int bj = 0; bj < 2; ++bj) { const f32x4 v0 = acc[ai][bj][m][0] * sc, v1 = acc[ai][bj][m][1] * sc;
                    u32x4 w; w.x = cvt_pk_bf16(v0[0], v0[1]); w.y = cvt_pk_bf16(v0[2], v0[3]); w.z = cvt_pk_bf16(v1[0], v1[1]); w.w = cvt_pk_bf16(v1[2], v1[3]);
                    *(u32x4*)(rowp + bj * HALF) = w;
                    if (donorm) { float ss = bflo(w.x) * bflo(w.x) + bfhi(w.x) * bfhi(w.x) + bflo(w.y) * bflo(w.y) + bfhi(w.y) * bfhi(w.y) + bflo(w.z) * bflo(w.z) + bfhi(w.z) * bfhi(w.z) + bflo(w.w) * bflo(w.w) + bfhi(w.w) * bfhi(w.w);
                        ss += __shfl_xor(ss, 16); ss += __shfl_xor(ss, 32); if (bj == 0) mx0 = fmaxf(mx0, ss); else mx1 = fmaxf(mx1, ss); } } }
            if (donorm) {
#pragma unroll
                for (int o = 1; o < 16; o <<= 1) { mx0 = fmaxf(mx0, __shfl_xor(mx0, o)); mx1 = fmaxf(mx1, __shfl_xor(mx1, o)); }
                if (fr == 0 && fq == 0) { const int tile = 4 * u.pm + 2 * ai + wr;
                    atomicMax(kn2 + (size_t)(wc) * 2048 + tile, __builtin_bit_cast(unsigned, mx0)); atomicMax(kn2 + (size_t)(4 + wc) * 2048 + tile, __builtin_bit_cast(unsigned, mx1)); } } }
    }
};
struct EpiSiluMul {
    static constexpr bool PERM = true;
    bf16_t* H; int ldh;
    DI void operator()(const Acc& acc, const Unit& u, int wr, int wc, int fr, int fq) const {
        const int row0 = u.pm * BM + wr * 64 + fr, col0 = u.pn * HALF + wc * 32 + 8 * fq;
#pragma unroll
        for (int ai = 0; ai < 2; ++ai)
#pragma unroll
            for (int m = 0; m < 4; ++m) { bf16_t* rowp = H + (size_t)(row0 + ai * HALF + m * 16) * ldh + col0;
                float h[8];
#pragma unroll
                for (int n = 0; n < 2; ++n)
#pragma unroll
                    for (int j = 0; j < 4; ++j) h[n * 4 + j] = siluf_(acc[ai][0][m][n][j]) * acc[ai][1][m][n][j];
                u32x4 w; w.x = cvt_pk_bf16(h[0], h[1]); w.y = cvt_pk_bf16(h[2], h[3]); w.z = cvt_pk_bf16(h[4], h[5]); w.w = cvt_pk_bf16(h[6], h[7]);
                *(u32x4*)rowp = w; }
    }
};
DI unsigned pk4_fp8(float a, float b, float c, float d) { int w = 0; a = __builtin_amdgcn_fmed3f(a, -448.f, 448.f); b = __builtin_amdgcn_fmed3f(b, -448.f, 448.f); c = __builtin_amdgcn_fmed3f(c, -448.f, 448.f); d = __builtin_amdgcn_fmed3f(d, -448.f, 448.f);     w = __builtin_amdgcn_cvt_pk_fp8_f32(a, b, w, false); w = __builtin_amdgcn_cvt_pk_fp8_f32(c, d, w, true); return (unsigned)w; }
constexpr float FP8_W1_SCALE = 32.f, FP8_W2_SCALE = 64.f, FP8_H_SCALE = 4.f;
struct EpiSiluMul8 {
    static constexpr bool PERM = true;
    unsigned char* H; int ldh;
    DI void operator()(const Acc& acc, const Unit& u, int wr, int wc, int fr, int fq) const {
        const int row0 = u.pm * BM + wr * 64 + fr, col0 = u.pn * HALF + wc * 32 + 8 * fq;
        constexpr float k1 = -LOG2E / FP8_W1_SCALE; static_assert(FP8_W1_SCALE * FP8_W1_SCALE / FP8_H_SCALE == 256.f, "scale folding");
#pragma unroll
        for (int ai = 0; ai < 2; ++ai)
#pragma unroll
            for (int m = 0; m < 4; ++m) { unsigned char* rowp = H + (size_t)(row0 + ai * HALF + m * 16) * ldh + col0;
                float t[8], h[8];
#pragma unroll
                for (int q = 0; q < 8; ++q) t[q] = __builtin_fmaf(acc[ai][0][m][q >> 2][q & 3], k1, 8.f);
#pragma unroll
                for (int q = 0; q < 8; ++q) t[q] = __builtin_amdgcn_exp2f(t[q]);
#pragma unroll
                for (int q = 0; q < 8; ++q) { t[q] += 256.f; h[q] = acc[ai][0][m][q >> 2][q & 3] * acc[ai][1][m][q >> 2][q & 3]; }
#pragma unroll
                for (int q = 0; q < 8; ++q) t[q] = __builtin_amdgcn_rcpf(t[q]);
#pragma unroll
                for (int q = 0; q < 8; ++q) h[q] *= t[q];
                u32x2 w; w.x = pk4_fp8(h[0], h[1], h[2], h[3]); w.y = pk4_fp8(h[4], h[5], h[6], h[7]);
                *(u32x2*)rowp = w; }
    }
};
struct EpiMoeDown {
    static constexpr bool PERM = false;
    float* out; const int* idx; const float* gs; float sc;
    DI void operator()(const Acc& acc, const Unit& u, int wr, int wc, int fr, int fq) const {
        const int row0 = u.pm * BM + wr * 64 + fr, col0 = u.pn * BM + wc * 32 + 4 * fq;
#pragma unroll
        for (int ai = 0; ai < 2; ++ai)
#pragma unroll
            for (int m = 0; m < 4; ++m) { const int rl = row0 + ai * HALF + m * 16; const int tok = idx[rl]; const float g = gs[rl] * sc;
                float* rowp = out + (size_t)tok * DM + col0;
#pragma unroll
                for (int bj = 0; bj < 2; ++bj)
#pragma unroll
                    for (int n = 0; n < 2; ++n) { f32x4* p = (f32x4*)(rowp + bj * HALF + n * 16); f32x4 v = *p; v += acc[ai][bj][m][n] * g; *p = v; }
                asm volatile("" ::: "memory"); }
    }
};
struct EpiYe {
    static constexpr bool PERM = true;
    bf16_t* O; const float* gs; float sc;
    DI void operator()(const Acc& acc, const Unit& u, int wr, int wc, int fr, int fq) const {
        const int row0 = u.pm * BM + wr * 64 + fr, col0 = u.pn * BM + wc * 32 + 8 * fq;
        float gv[8];
#pragma unroll
        for (int c = 0; c < 8; ++c) gv[c] = gs[row0 + (c >> 2) * HALF + (c & 3) * 16];
#pragma unroll
        for (int ai = 0; ai < 2; ++ai)
#pragma unroll
            for (int m = 0; m < 4; ++m) { const int rl = row0 + ai * HALF + m * 16; const float g = gv[ai * 4 + m] * sc; bf16_t* rowp = O + (size_t)rl * DM + col0;
#pragma unroll
                for (int bj = 0; bj < 2; ++bj) { const f32x4 v0 = acc[ai][bj][m][0] * g, v1 = acc[ai][bj][m][1] * g;
                    u32x4 w; w.x = cvt_pk_bf16(v0[0], v0[1]); w.y = cvt_pk_bf16(v0[2], v0[3]); w.z = cvt_pk_bf16(v1[0], v1[1]); w.w = cvt_pk_bf16(v1[2], v1[3]);
                    *(u32x4*)(rowp + bj * HALF) = w; } }
    }
};
struct EpiResid {
    static constexpr bool PERM = false;
    const float* xa; const float* xb; float* out;
    DI void operator()(const Acc& acc, const Unit& u, int wr, int wc, int fr, int fq) const {
        const int row0 = u.pm * BM + wr * 64 + fr, col0 = u.pn * BM + wc * 32 + 4 * fq;
#pragma unroll
        for (int ai = 0; ai < 2; ++ai) {
            f32x4 sv[4][4];
#pragma unroll
            for (int m = 0; m < 4; ++m) { const int r = row0 + ai * HALF + m * 16;
                const float* srow = (r < NTOKG ? xa + (size_t)r * DM : xb + (size_t)(r - NTOKG) * DM) + col0;
#pragma unroll
                for (int q = 0; q < 4; ++q) sv[m][q] = *(const f32x4*)(srow + (q >> 1) * HALF + (q & 1) * 16); }
#pragma unroll
            for (int m = 0; m < 4; ++m) { const int r = row0 + ai * HALF + m * 16; float* orow = out + (size_t)r * DM + col0;
#pragma unroll
                for (int q = 0; q < 4; ++q) *(f32x4*)(orow + (q >> 1) * HALF + (q & 1) * 16) = sv[m][q] + acc[ai][q >> 1][m][q & 1] * INV_ALPHA; } }
    }
};
struct EpiGateMix {
    static constexpr bool PERM = false;
    const bf16_t* Z; bf16_t* mix; float si;
    DI void operator()(const Acc& acc, const Unit& u, int wr, int wc, int fr, int fq) const {
        const int row0 = u.pm * BM + wr * 64 + fr, J0 = u.pn * 64 + wc * 16 + fq * 4;
        u32x2 zall[8][4];
#pragma unroll
        for (int c = 0; c < 8; ++c) { const bf16_t* zrow = Z + (size_t)(row0 + (c >> 2) * HALF + (c & 3) * 16) * 4096 + J0;
#pragma unroll
            for (int b = 0; b < 4; ++b) zall[c][b] = *(const u32x2*)(zrow + b * 1024); }
#pragma unroll
        for (int ai = 0; ai < 2; ++ai)
#pragma unroll
            for (int m = 0; m < 4; ++m) { const int r = row0 + ai * HALF + m * 16;
                u32x2 zw[4];
#pragma unroll
                for (int b = 0; b < 4; ++b) zw[b] = zall[ai * 4 + m][b];
                const float kq = -si * LOG2E; float t[16];
#pragma unroll
                for (int q = 0; q < 16; ++q) t[q] = acc[ai][q >> 3][m][(q >> 2) & 1][q & 3] * kq;
#pragma unroll
                for (int q = 0; q < 16; ++q) t[q] = __builtin_amdgcn_exp2f(t[q]);
#pragma unroll
                for (int q = 0; q < 16; ++q) t[q] += 1.f;
#pragma unroll
                for (int q = 0; q < 16; ++q) t[q] = __builtin_amdgcn_rcpf(t[q]);
                f32x4 s = (f32x4){0.f, 0.f, 0.f, 0.f};
#pragma unroll
                for (int b = 0; b < 4; ++b) { s[0] += t[4 * b] * bflo(zw[b].x); s[1] += t[4 * b + 1] * bfhi(zw[b].x); s[2] += t[4 * b + 2] * bflo(zw[b].y); s[3] += t[4 * b + 3] * bfhi(zw[b].y); }
                u32x2 w; w.x = cvt_pk_bf16(s[0], s[1]); w.y = cvt_pk_bf16(s[2], s[3]);
                *(u32x2*)(mix + (size_t)r * DM + J0) = w; }
    }
};
}

#define XB_TMO      128
#define XB_XCNT(j)  (256  + 64 * (j))
#define XB_XSUB(j)  (1280 + 64 * (j))
#define XB_XGEN(j)  (2304 + 64 * (j))
#define XB_TOP      3328
#define XB_TOPGEN   3392
#define XCD_BAR_WORDS 3456
#define XB_SPIN_CAP (1u << 24)
DI unsigned xb_ld(unsigned* p)              { return __hip_atomic_load(p, __ATOMIC_RELAXED, __HIP_MEMORY_SCOPE_AGENT); }
DI unsigned xb_add(unsigned* p, unsigned v) { return __hip_atomic_fetch_add(p, v, __ATOMIC_RELAXED, __HIP_MEMORY_SCOPE_AGENT); }
DI unsigned xb_xcc_id() { return (unsigned)__builtin_amdgcn_s_getreg((3 << 11) | 20) & 0xFu; }
#define XB_SPIN(cond, bar) do { unsigned _sp = 0; while (cond) { __builtin_amdgcn_s_sleep(1); \
    if ((++_sp & 255u) == 0u) { if (xb_ld(&(bar)[XB_TMO])) break; if (_sp > XB_SPIN_CAP) { atomicAdd(&(bar)[XB_TMO], 1u); break; } } } } while (0)
struct XcdBarrier { unsigned* bar; unsigned x; volatile LAS unsigned* st; };
DI XcdBarrier xcd_barrier_post(unsigned* bar, volatile LAS unsigned* st) {
    XcdBarrier b; b.bar = bar; b.x = xb_xcc_id(); b.st = st;
    if (threadIdx.x == 0) (void)xb_add(&bar[XB_XCNT(b.x)], 1u);
    return b;
}
DI void xcd_barrier_complete(unsigned* bar, unsigned x, unsigned& nloc, unsigned& nx) {
    const unsigned G = gridDim.x * gridDim.y * gridDim.z;
    unsigned sum, cnt, mine, sp = 0u;
    for (;;) {
        sum = 0u; cnt = 0u; mine = 0u;
#pragma unroll
        for (unsigned j = 0; j < 16; ++j) { const unsigned c = xb_ld(&bar[XB_XCNT(j)]); sum += c; cnt += (c > 0u) ? 1u : 0u; mine = (j == x) ? c : mine; }
        if (sum == G) break;
        __builtin_amdgcn_s_sleep(1);
        if ((++sp & 255u) == 0u) { if (xb_ld(&bar[XB_TMO])) break; if (sp > XB_SPIN_CAP) { atomicAdd(&bar[XB_TMO], 1u); break; } }
    }
    nloc = mine > 0u ? mine : 1u; nx = cnt > 0u ? cnt : 1u;
}
DI void xcd_barrier(const XcdBarrier& b) {
    asm volatile("s_waitcnt vmcnt(0)" ::: "memory");
    __syncthreads();
    if (threadIdx.x == 0) {
        unsigned* bar = b.bar;
        __builtin_amdgcn_s_waitcnt(0);
        unsigned nloc = b.st[0], nx = b.st[1];
        if (nloc == 0u) { xcd_barrier_complete(bar, b.x, nloc, nx); b.st[0] = nloc; b.st[1] = nx; }
        const unsigned old = xb_add(&bar[XB_XSUB(b.x)], 1u);
        const unsigned gen = old / nloc;
        if (old + 1u == (gen + 1u) * nloc) {
            __builtin_amdgcn_fence(__ATOMIC_RELEASE, "agent");
            asm volatile("s_waitcnt vmcnt(0)" ::: "memory");
            const unsigned og = xb_add(&bar[XB_TOP], 1u);
            const unsigned tg = og / nx;
            if (og + 1u == (tg + 1u) * nx) xb_add(&bar[XB_TOPGEN], 1u);
            else XB_SPIN(xb_ld(&bar[XB_TOPGEN]) == tg, bar);
            __builtin_amdgcn_fence(__ATOMIC_ACQUIRE, "agent");
            xb_add(&bar[XB_XGEN(b.x)], 1u);
            asm volatile("s_waitcnt vmcnt(0)" ::: "memory");
        } else {
            XB_SPIN(xb_ld(&bar[XB_XGEN(b.x)]) == gen, bar);
            __builtin_amdgcn_fence(__ATOMIC_ACQUIRE, "agent");
            asm volatile("s_waitcnt vmcnt(0)" ::: "memory");
        }
    }
    __syncthreads();
}

struct Args { const float* in[26]; float* out; unsigned char* ws; int ph_lo, ph_hi; };
struct Ctx {
    LAS unsigned char* lds;
    GAS unsigned char* ws;
    int tid, lane, wave, G, bid, gw, NGW;
    const struct Args* A;
    GAS float* out;
};
constexpr int RING_BYTES = 131072, MISC_OFF = RING_BYTES + 320, LDS_BYTES = 147456;

DI void tr_item(const float* __restrict__ W, int ldw, int k0, int src, const float* kscale, bf16_t* WT, int ldt, int orow0, LAS float* scr, int lane) {
    float tv[32];
#pragma unroll
    for (int i = 0; i < 32; ++i) { const int kk = 2 * i + (lane >> 5); tv[i] = (src >= 0) ? W[(size_t)(k0 + kk) * ldw + src] : 0.f; }
#pragma unroll
    for (int i = 0; i < 32; ++i) { const int kk = 2 * i + (lane >> 5); float v = tv[i]; if (kscale) v *= kscale[k0 + kk]; scr[kk * 33 + (lane & 31)] = v; }
    LDS_WAIT();
    const int c = lane & 7;
#pragma unroll
    for (int j = 0; j < 4; ++j) { const int n = (lane >> 3) + 8 * j; const LAS float* s = scr + (8 * c) * 33 + n;
        u32x4 o; o.x = pk2(s[0 * 33], s[1 * 33]); o.y = pk2(s[2 * 33], s[3 * 33]); o.z = pk2(s[4 * 33], s[5 * 33]); o.w = pk2(s[6 * 33], s[7 * 33]);
        *(u32x4*)(WT + (size_t)(orow0 + n) * ldt + k0 + 8 * c) = o; }
    LDS_WAIT();
}
DI void tr_item8(const float* __restrict__ W, int ldw, int k0, int src, float scale, unsigned char* WT, int ldt, int orow0, LAS float* scr, int lane) {
    float tv[32];
#pragma unroll
    for (int i = 0; i < 32; ++i) { const int kk = 2 * i + (lane >> 5); tv[i] = W[(size_t)(k0 + kk) * ldw + src]; }
#pragma unroll
    for (int i = 0; i < 32; ++i) { const int kk = 2 * i + (lane >> 5); scr[kk * 33 + (lane & 31)] = tv[i] * scale; }
    LDS_WAIT();
    const int c = lane & 7;
#pragma unroll
    for (int j = 0; j < 4; ++j) { const int n = (lane >> 3) + 8 * j; const LAS float* s = scr + (8 * c) * 33 + n;
        u32x2 o; o.x = pg8::pk4_fp8(s[0 * 33], s[1 * 33], s[2 * 33], s[3 * 33]); o.y = pg8::pk4_fp8(s[4 * 33], s[5 * 33], s[6 * 33], s[7 * 33]);
        *(u32x2*)(WT + (size_t)(orow0 + n) * ldt + k0 + 8 * c) = o; }
    LDS_WAIT();
}
constexpr int SW_ITEMS[8] = {16 * 24, 16 * 40, 16 * 32, 16 * 128, 4 * 4 * 32, 16 * 32, 3 * 6, 2 * 12};
constexpr int SW_TOTAL = 16 * 24 + 16 * 40 + 16 * 32 + 16 * 128 + 4 * 4 * 32 + 16 * 32 + 3 * 6 + 2 * 12;
DI void small_weight_item(const Ctx& C, int l, int it, LAS float* scr) {
    unsigned char* wl = (unsigned char*)(C.ws + WS_WSMALL + (size_t)l * WSMALL_LAYER); unsigned char* wc = (unsigned char*)(C.ws + WS_WC + (size_t)l * WC_LAYER);
    const float* win = C.A->in[2] + (size_t)l * DM * IN_W; const int ln = C.lane & 31;
    if (it < 384) { const int kb = it / 24, nb = it % 24; tr_item(win, IN_W, kb * 64, nb * 32 + ln, nullptr, (bf16_t*)(wl + OFF_WA), 1024, nb * 32, scr, C.lane); return; } it -= 384;
    if (it < 640) { const int kb = it / 40, nb = it % 40; tr_item(win, IN_W, kb * 64, COL_B + nb * 32 + ln, nullptr, (bf16_t*)(wl + OFF_WB), 1024, nb * 32, scr, C.lane); return; } it -= 640;
    if (it < 512) { const int kb = it / 32, nb = it % 32; const int n = nb * 32 + ln; tr_item(win, IN_W, kb * 64, n < 848 ? COL_CD + n : -1, nullptr, (bf16_t*)(wl + OFF_WCD), 1024, nb * 32, scr, C.lane); return; } it -= 512;
    if (it < 2048) { const int kb = it / 128, nb = it % 128; const int n = nb * 32 + ln, pn = n >> 8, c = n & 255;
        const int bj = c >> 7, wcc = (c >> 5) & 3, nn = (c >> 4) & 1, fq = (c >> 2) & 3, j = c & 3;
        const int src = COL_GATE + (2 * bj + nn) * 1024 + 64 * pn + 16 * wcc + 4 * fq + j;
        tr_item8(win, IN_W, kb * 64, src, pg8::FP8_W1_SCALE, wl + OFF_WG, 1024, nb * 32, scr, C.lane); return; } it -= 2048;
    if (it < 512) { const int b = it / 128, r = it % 128, kb = r / 32, nb = r % 32;
        tr_item(C.A->in[18] + (size_t)(l * 4 + b) * 256 * 1024, 1024, kb * 64, nb * 32 + ln, nullptr, (bf16_t*)(wl + OFF_WBR), 256, b * 1024 + nb * 32, scr, C.lane); return; } it -= 512;
    if (it < 512) { const int kb = it / 32, nb = it % 32; tr_item(C.A->in[19] + (size_t)l * DM * DM, 1024, kb * 64, nb * 32 + ln, nullptr, (bf16_t*)(wl + OFF_WOUT), 1024, nb * 32, scr, C.lane); return; } it -= 512;
    if (it < 18) { const int kb = it / 6, nb = it % 6; tr_item(C.A->in[8] + (size_t)l * 192 * 192, 192, kb * 64, nb * 32 + ln, C.A->in[7] + l * 192, (bf16_t*)(wc + OFF_WQ), 192, nb * 32, scr, C.lane); return; } it -= 18;
    { const int kb = it / 12, nb = it % 12; tr_item(C.A->in[10] + (size_t)l * 128 * 384, 384, kb * 64, nb * 32 + ln, C.A->in[9] + l * 128, (bf16_t*)(wc + OFF_WKV), 128, nb * 32, scr, C.lane); }
}
DI void ph_prologue(const Ctx& C) {
    LAS float* scr = (LAS float*)(C.lds + C.wave * 16384);
    for (int it = C.gw; it < 2 * SW_TOTAL; it += C.NGW) small_weight_item(C, it / SW_TOTAL, it % SW_TOTAL, scr);
    for (int it = C.gw; it < 2 * 2 * 4 * 2 * 4 * 2; it += C.NGW) {
        const int ks = it & 1, nt = (it >> 1) & 3, gt = (it >> 3) & 1, n = (it >> 4) & 3, dir = (it >> 6) & 1, l = it >> 7;
        const float* wp = (gt == 0 ? C.A->in[13] : C.A->in[15]) + ((size_t)((l * 2 + dir) * 4 + n) * 64) * 64;
        const int l15 = C.lane & 15, g = C.lane >> 4; u32x4 wv;
#pragma unroll
        for (int p = 0; p < 4; ++p) { const int k = 32 * ks + 8 * g + 2 * p; wv[p] = cvt_pk_bf16(wp[(size_t)k * 64 + 16 * nt + l15], wp[(size_t)(k + 1) * 64 + 16 * nt + l15]); }
        ((u32x4*)(C.ws + WS_WRG))[(size_t)it * 64 + C.lane] = wv;
    }
    bf16_t* XB0 = (bf16_t*)(C.ws + WS_XB0);
    for (int row0 = C.gw; row0 < NTOK; row0 += 4 * C.NGW) {
        f32x4 v[4][4];
#pragma unroll
        for (int i = 0; i < 4; ++i) { const int row = min(row0 + i * C.NGW, NTOK - 1);
            const float* src = row < NTOKG ? C.A->in[0] + (size_t)row * DM : C.A->in[1] + (size_t)(row - NTOKG) * DM; const f32x4* xr = (const f32x4*)src + C.lane;
#pragma unroll
            for (int j = 0; j < 4; ++j) v[i][j] = xr[64 * j]; }
#pragma unroll
        for (int i = 0; i < 4; ++i) { const int row = row0 + i * C.NGW; if (row < NTOK) { u32x2* o = (u32x2*)(XB0 + (size_t)row * DM) + C.lane;
#pragma unroll
            for (int j = 0; j < 4; ++j) { u32x2 w; w.x = cvt_pk_bf16(v[i][j][0], v[i][j][1]); w.y = cvt_pk_bf16(v[i][j][2], v[i][j][3]); o[64 * j] = w; } } }
    }
}
DI void expert_weight_items(const Ctx& C, int l) {
    __syncthreads();
    LAS float* scr = (LAS float*)(C.lds + C.wave * 16384);
    unsigned char* WGU = (unsigned char*)(C.ws + WS_EW + OFF_WGU8); unsigned char* WD = (unsigned char*)(C.ws + WS_EW + OFF_WD8);
    const int ln = C.lane & 31;
    const int gw0 = (C.G > 64) ? C.gw - 32 * 8 : C.gw, ngw = (C.G > 64) ? C.NGW - 32 * 8 : C.NGW;
    for (int it = gw0; it < 32768 + 16384; it += ngw) {
        if (it < 32768) { const int e = it >> 11, r = it & 2047, kb = r >> 7, nb = r & 127; const int n = nb * 32 + ln, pn = n >> 8, c = n & 255;
            const float* W = (c < 128 ? C.A->in[23] : C.A->in[24]) + (size_t)(l * NEXP + e) * DM * DEXP;
            tr_item8(W, DEXP, kb * 64, 128 * pn + (c & 127), pg8::FP8_W1_SCALE, WGU + (size_t)e * 4096 * 1024, 1024, nb * 32, scr, C.lane);
        } else { const int i2 = it - 32768, e = i2 >> 10, r = i2 & 1023, kb = r >> 5, nb = r & 31;
            tr_item8(C.A->in[25] + (size_t)(l * NEXP + e) * DEXP * DM, DM, kb * 64, nb * 32 + ln, pg8::FP8_W2_SCALE, WD + (size_t)e * 1024 * 2048, 2048, nb * 32, scr, C.lane); }
    }
}

template <bool ROUTER>
DI void ph_ln(const Ctx& C, int l, int which, bf16_t* XB) {
    LAS float* wr = (LAS float*)C.lds;
    if (ROUTER) { const float* src = C.A->in[22] + (size_t)l * DM * NEXP;
        for (int t = C.tid; t < DM * NEXP / 4; t += 512) { const int k = t >> 2, q = t & 3, ln = (k & 255) >> 2, ii = k & 3, jj = k >> 8;
            ((LAS f32x4*)wr)[((jj * 4 + ii) * 4 + q) * 64 + ln] = ((const f32x4*)src)[t]; }
        __syncthreads(); }
    const float* gp = C.A->in[20] + (size_t)(l * 2 + which) * DM; const float* bp = C.A->in[21] + (size_t)(l * 2 + which) * DM;
    f32x4 gv[4], bv[4];
#pragma unroll
    for (int j = 0; j < 4; ++j) { gv[j] = ((const f32x4*)gp)[C.lane + 64 * j]; bv[j] = ((const f32x4*)bp)[C.lane + 64 * j]; }
    float* affT = (float*)(C.ws + WS_AFF);
    f32x4 nx[4], ny[4], nz[4];
    { const f32x4* xr0 = (const f32x4*)(C.out + (size_t)C.gw * DM) + C.lane;
#pragma unroll
      for (int j = 0; j < 4; ++j) nx[j] = xr0[64 * j];
      { const f32x4* xr1 = (const f32x4*)(C.out + (size_t)min(C.gw + C.NGW, NTOK - 1) * DM) + C.lane;
#pragma unroll
          for (int j = 0; j < 4; ++j) ny[j] = xr1[64 * j]; }
      { const f32x4* xr2 = (const f32x4*)(C.out + (size_t)min(C.gw + 2 * C.NGW, NTOK - 1) * DM) + C.lane;
#pragma unroll
          for (int j = 0; j < 4; ++j) nz[j] = xr2[64 * j]; } }
    u32x4 sm0 = {0u, 0u, 0u, 0u}, sm1 = {0u, 0u, 0u, 0u};
    if (!ROUTER) { const u32x4* smr = (const u32x4*)(C.ws + WS_SM + (size_t)C.gw * 32); sm0 = smr[0]; sm1 = smr[1]; }
    for (int row = C.gw; row < NTOK; row += C.NGW) {
        f32x4* xr = (f32x4*)(C.out + (size_t)row * DM) + C.lane;
        f32x4 v[4]; float s = 0.f;
#pragma unroll
        for (int j = 0; j < 4; ++j) v[j] = nx[j] * ALPHA;
        if (!ROUTER) {
            const unsigned sw[8] = {sm0.x, sm0.y, sm0.z, sm0.w, sm1.x, sm1.y, sm1.z, sm1.w};
            { const u32x4* smr = (const u32x4*)(C.ws + WS_SM + (size_t)min(row + C.NGW, NTOK - 1) * 32); sm0 = smr[0]; sm1 = smr[1]; }
            const bf16_t* YE = (const bf16_t*)(C.ws + WS_Y); const int gofs = (row >> 16) * CAP;
            unsigned msk = 0u;
#pragma unroll
            for (int e = 0; e < 16; ++e) { const int slot = (int)(short)((e & 1) ? (sw[e >> 1] >> 16) : (sw[e >> 1] & 0xffffu)); if (slot >= 0) msk |= 1u << e; }
            msk = (unsigned)__builtin_amdgcn_readfirstlane((int)msk);
            while (msk) {
                const int e1 = __builtin_ctz(msk); msk &= msk - 1u; const bool two = msk != 0u; const int e2 = two ? __builtin_ctz(msk) : e1; if (two) msk &= msk - 1u;
                unsigned w1 = sw[0], w2 = sw[0];
#pragma unroll
                for (int q = 1; q < 8; ++q) { w1 = ((e1 >> 1) == q) ? sw[q] : w1; w2 = ((e2 >> 1) == q) ? sw[q] : w2; }
                const int s1 = (int)((e1 & 1) ? (w1 >> 16) : (w1 & 0xffffu)), s2 = (int)((e2 & 1) ? (w2 >> 16) : (w2 & 0xffffu));
                const u32x2* y1 = (const u32x2*)(YE + ((size_t)e1 * 16384 + gofs + s1) * DM) + C.lane; const u32x2* y2 = (const u32x2*)(YE + ((size_t)e2 * 16384 + gofs + s2) * DM) + C.lane;
                u32x2 a[4], b[4];
#pragma unroll
                for (int j = 0; j < 4; ++j) { a[j] = y1[64 * j]; b[j] = y2[64 * j]; }
                const float f2 = two ? 1.f : 0.f;
#pragma unroll
                for (int j = 0; j < 4; ++j) { v[j][0] += bflo(a[j].x) + f2 * bflo(b[j].x); v[j][1] += bfhi(a[j].x) + f2 * bfhi(b[j].x); v[j][2] += bflo(a[j].y) + f2 * bflo(b[j].y); v[j][3] += bfhi(a[j].y) + f2 * bfhi(b[j].y); }
            }
        }
#pragma unroll
        for (int j = 0; j < 4; ++j) s += (v[j][0] + v[j][1]) + (v[j][2] + v[j][3]);
#pragma unroll
        for (int j = 0; j < 4; ++j) { nx[j] = ny[j]; ny[j] = nz[j]; }
        { const int rn = row + 3 * C.NGW < NTOK ? row + 3 * C.NGW : row; const f32x4* xn = (const f32x4*)(C.out + (size_t)rn * DM) + C.lane;
#pragma unroll
            for (int j = 0; j < 4; ++j) nz[j] = xn[64 * j]; }
        const float mean = wave_sum(s) * (1.f / DM); float s2 = 0.f;
#pragma unroll
        for (int j = 0; j < 4; ++j) { v[j] = v[j] - mean; s2 += (v[j][0] * v[j][0] + v[j][1] * v[j][1]) + (v[j][2] * v[j][2] + v[j][3] * v[j][3]); }
        const float rstd = 1.0f / sqrtf(wave_sum(s2) * (1.f / DM) + LN_EPS);
        u32x2* o8 = (u32x2*)(XB + (size_t)row * DM) + C.lane; unsigned* o4 = (unsigned*)((unsigned char*)XB + (size_t)row * DM) + C.lane;
#pragma unroll
        for (int j = 0; j < 4; ++j) { v[j] = v[j] * rstd * gv[j] + bv[j]; xr[64 * j] = v[j];
            if constexpr (ROUTER) { o4[64 * j] = pg8::pk4_fp8(v[j][0], v[j][1], v[j][2], v[j][3]); asm volatile("" ::: "memory"); }
            else if (XB) { u32x2 w; w.x = cvt_pk_bf16(v[j][0], v[j][1]); w.y = cvt_pk_bf16(v[j][2], v[j][3]); o8[64 * j] = w; } }
        if (ROUTER) {
            float p[16];
#pragma unroll
            for (int e = 0; e < 16; ++e) p[e] = 0.f;
#pragma unroll
            for (int j = 0; j < 4; ++j)
#pragma unroll
                for (int i = 0; i < 4; ++i) { const float xv = v[j][i];
#pragma unroll
                    for (int q = 0; q < 4; ++q) { const f32x4 w4 = ((const LAS f32x4*)wr)[((j * 4 + i) * 4 + q) * 64 + C.lane]; p[4 * q] += xv * w4[0]; p[4 * q + 1] += xv * w4[1]; p[4 * q + 2] += xv * w4[2]; p[4 * q + 3] += xv * w4[3]; } }
            const bool b5 = (C.lane & 32) != 0, b4 = (C.lane & 16) != 0, b3 = (C.lane & 8) != 0, b2 = (C.lane & 4) != 0;
            float r8[8], r4[4], r2[2], lg;
#pragma unroll
            for (int i = 0; i < 8; ++i) { const float keep = b5 ? p[8 + i] : p[i], send = b5 ? p[i] : p[8 + i]; r8[i] = keep + __shfl_xor(send, 32); }
#pragma unroll
            for (int i = 0; i < 4; ++i) { const float keep = b4 ? r8[4 + i] : r8[i], send = b4 ? r8[i] : r8[4 + i]; r4[i] = keep + __shfl_xor(send, 16); }
#pragma unroll
            for (int i = 0; i < 2; ++i) { const float keep = b3 ? r4[2 + i] : r4[i], send = b3 ? r4[i] : r4[2 + i]; r2[i] = keep + __shfl_xor(send, 8); }
            { const float keep = b2 ? r2[1] : r2[0], send = b2 ? r2[0] : r2[1]; lg = keep + __shfl_xor(send, 4); }
            lg += __shfl_xor(lg, 2); lg += __shfl_xor(lg, 1);
            float mx = lg;
            mx = fmaxf(mx, __shfl_xor(mx, 4)); mx = fmaxf(mx, __shfl_xor(mx, 8)); mx = fmaxf(mx, __shfl_xor(mx, 16)); mx = fmaxf(mx, __shfl_xor(mx, 32));
            const float ex = __expf(lg - mx); float den = ex;
            den += __shfl_xor(den, 4); den += __shfl_xor(den, 8); den += __shfl_xor(den, 16); den += __shfl_xor(den, 32);
            const int eL = (b5 ? 8 : 0) + (b4 ? 4 : 0) + (b3 ? 2 : 0) + (b2 ? 1 : 0);
            if ((C.lane & 3) == 0) affT[((size_t)(row >> 16) * 16 + eL) * NTOKG + (row & 65535)] = ex / den;
            if (C.lane < 8) ((unsigned*)(C.ws + WS_SM))[(size_t)row * 8 + C.lane] = 0xFFFFFFFFu;
        }
    }
}

namespace att {
DI int crow(int r, int hi) { return (r & 3) + 8 * (r >> 2) + 4 * hi; }
DI int v_st(int k, int c) { const int kk = (k & ~0xC) | ((k & 4) << 1) | ((k & 8) >> 1); return ((kk >> 3) * 2 + (c >> 5)) * 512 + ((kk & 7) * 32 + (c & 31)) * 2; }
DI int v_rd_base(int lane) { return ((lane & 3) << 3) | (((lane >> 2) & 3) << 6) | (((lane >> 4) & 1) << 5) | (((lane >> 5) & 1) << 8); }
constexpr int v_rd_off(int d0, int ks, int half) { return d0 * 512 + ks * 2048 + half * 1024; }
template <int OFF> DI s16x4 tr_read(int vb) { s16x4 r; asm volatile("ds_read_b64_tr_b16 %0, %1 offset:%2" : "=&v"(r) : "v"(vb), "i"(OFF) : "memory"); return r; }
template <int D0> DI void pv_one(f32x16& od, int vb, bf16x8 pa0, bf16x8 pa1, bf16x8 pa2, bf16x8 pa3) {
    const s16x4 l0 = tr_read<v_rd_off(D0, 0, 0)>(vb), h0 = tr_read<v_rd_off(D0, 0, 1)>(vb), l1 = tr_read<v_rd_off(D0, 1, 0)>(vb), h1 = tr_read<v_rd_off(D0, 1, 1)>(vb);
    const s16x4 l2 = tr_read<v_rd_off(D0, 2, 0)>(vb), h2 = tr_read<v_rd_off(D0, 2, 1)>(vb), l3 = tr_read<v_rd_off(D0, 3, 0)>(vb), h3 = tr_read<v_rd_off(D0, 3, 1)>(vb);
    asm volatile("s_waitcnt lgkmcnt(0)" ::: "memory"); __builtin_amdgcn_sched_barrier(0);
#define PKV(L, H) (bf16x8){L[0], L[1], L[2], L[3], H[0], H[1], H[2], H[3]}
    od = __builtin_amdgcn_mfma_f32_32x32x16_bf16(pa0, PKV(l0, h0), od, 0, 0, 0);
    od = __builtin_amdgcn_mfma_f32_32x32x16_bf16(pa1, PKV(l1, h1), od, 0, 0, 0);
    od = __builtin_amdgcn_mfma_f32_32x32x16_bf16(pa2, PKV(l2, h2), od, 0, 0, 0);
    od = __builtin_amdgcn_mfma_f32_32x32x16_bf16(pa3, PKV(l3, h3), od, 0, 0, 0);
#undef PKV
}
DI void pv_ones(f32x16& o2, bf16x8 pa0, bf16x8 pa1, bf16x8 pa2, bf16x8 pa3) {
    const u32x4 onesw = {0x3F803F80u, 0x3F803F80u, 0x3F803F80u, 0x3F803F80u}; const bf16x8 ones = __builtin_bit_cast(bf16x8, onesw);
    o2 = __builtin_amdgcn_mfma_f32_32x32x16_bf16(pa0, ones, o2, 0, 0, 0); o2 = __builtin_amdgcn_mfma_f32_32x32x16_bf16(pa1, ones, o2, 0, 0, 0);
    o2 = __builtin_amdgcn_mfma_f32_32x32x16_bf16(pa2, ones, o2, 0, 0, 0); o2 = __builtin_amdgcn_mfma_f32_32x32x16_bf16(pa3, ones, o2, 0, 0, 0);
}
constexpr int KROW(int KS) { return KS * 32 + 16; }
constexpr int KTILE = 64 * 112, VTILE = 8192, LDS_ATT = 2 * KTILE + 2 * VTILE + 8 * 256;

DI void split3(float x, unsigned& w_hm, unsigned& w_l0) {
    const unsigned h = f2bf(x); const float r1 = x - __builtin_bit_cast(float, h << 16);
    const unsigned m = f2bf(r1); const float r2 = r1 - __builtin_bit_cast(float, m << 16);
    const unsigned l = f2bf(r2);
    w_hm = h | (m << 16); w_l0 = l;
}
template <int KS, bool ALIBI>
DI void attn_unit(const bf16_t* __restrict__ Qb, int ldq, const bf16_t* __restrict__ Kb, int ldk, const bf16_t* __restrict__ Vb, int ldv,
                  bf16_t* __restrict__ Ob, int ldo, int seq_len, int q0, float slope2, const unsigned* __restrict__ kn2, LAS unsigned char* lds) {
    int tid = threadIdx.x; asm volatile("" : "+v"(tid));
    const int wid = tid >> 6, lane = tid & 63, r32 = lane & 31, hi = lane >> 5;
    LAS unsigned char* K_lds = lds; LAS unsigned char* V_lds = lds + 2 * KTILE;
    LAS float* wsl = (LAS float*)(lds + 2 * KTILE + 2 * VTILE) + wid * 64; LAS float* li_l = wsl; LAS float* al_l = wsl + 32;
    LAS float* blk = (LAS float*)(lds + LDS_ATT);
    LAS int* tl = (LAS int*)(lds + LDS_ATT + 128);
    constexpr int KR = KROW(KS), KP = 2 * KS;
    constexpr float THR = 8.f, SKIP = -40.f;
    float mt = 0.f; f32x16 o[3];
#pragma unroll
    for (int d = 0; d < 3; ++d)
#pragma unroll
        for (int r = 0; r < 16; ++r) o[d][r] = 0.f;
    bf16x8 qr[KS];
    const bf16_t* Qw = Qb + (size_t)(wid * 32 + r32) * ldq + hi * 8;
#pragma unroll
    for (int d0 = 0; d0 < KS; ++d0) qr[d0] = *(const bf16x8*)(Qw + d0 * 16);
    if (ALIBI) { float qn = 0.f;
#pragma unroll
        for (int d0 = 0; d0 < KS; ++d0)
#pragma unroll
            for (int j = 0; j < 8; ++j) { const float f = bf2f((unsigned short)qr[d0][j]); qn += f * f; }
        qn += __shfl_xor(qn, 32); qn = wave_max(qn); if (lane == 0) blk[wid] = qn; }
    const int vkey = tid >> 3, vcol = (tid & 7) * 8, vst = v_st(vkey, vcol);
    const bool kact = tid < 64 * KP; const int kkey = kact ? tid / KP : 0, kpc = kact ? tid % KP : 0;
    const int vb0 = (int)(uintptr_t)V_lds + v_rd_base(lane);
    const int w0 = q0 + wid * 32; const float qpos = (float)(w0 + r32);
    const int NT = seq_len / 64, jd0 = q0 >> 6;
    bf16x8 kx0, kx1;
    { u32x4 a = {0u, 0u, 0u, 0u}, b = {0u, 0u, 0u, 0u};
        if (hi == 0) {
            a.z = 0x3F803F80u; a.w = 0x00003F80u; b.z = 0x3F803F80u; b.w = 0x00003F80u;
            if (ALIBI) { const float c0 = slope2 * (float)r32, c1 = slope2 * (float)(32 + r32);
                const unsigned h0 = f2bf(c0), l0 = f2bf(c0 - __builtin_bit_cast(float, h0 << 16)), h1 = f2bf(c1), l1 = f2bf(c1 - __builtin_bit_cast(float, h1 << 16));
                a.x = h0 | (l0 << 16); a.y = (h0 | (l0 << 16)) ^ 0x80008000u; b.x = h1 | (l1 << 16); b.y = (h1 | (l1 << 16)) ^ 0x80008000u; } }
        kx0 = __builtin_bit_cast(bf16x8, a); kx1 = __builtin_bit_cast(bf16x8, b); }
    bf16x8 vs, ks_;
    bool first = true;
#define SLOAD(k0) do { vs = *(const bf16x8*)(Vb + (size_t)((k0) + vkey) * ldv + vcol); ks_ = *(const bf16x8*)(Kb + (size_t)((k0) + kkey) * ldk + kpc * 8); } while (0)
#define SWRITE(b) do { *(LAS bf16x8*)(V_lds + (b) * VTILE + vst) = vs; if (kact) *(LAS bf16x8*)(K_lds + (b) * KTILE + kkey * KR + kpc * 16) = ks_; } while (0)
#define PK4(P, BASE, OUT) do { unsigned a0 = cvt_pk_bf16_b(P[BASE + 0], P[BASE + 1]), a1 = cvt_pk_bf16_b(P[BASE + 2], P[BASE + 3]); \
        unsigned b0_ = cvt_pk_bf16_b(P[BASE + 4], P[BASE + 5]), b1_ = cvt_pk_bf16_b(P[BASE + 6], P[BASE + 7]); \
        auto r0 = __builtin_amdgcn_permlane32_swap(a0, b0_, false, false); auto r1 = __builtin_amdgcn_permlane32_swap(a1, b1_, false, false); \
        u32x4 w = {r0[0], r1[0], r0[1], r1[1]}; OUT = __builtin_bit_cast(bf16x8, w); } while (0)
#define PKV2(L, H) (bf16x8){L[0], L[1], L[2], L[3], H[0], H[1], H[2], H[3]}
#define ATT_GRP(P, BASE, VA, VC, VD, VE) do { \
        _Pragma("unroll") for (int r_ = 0; r_ < 8; ++r_) P[BASE + r_] = __builtin_amdgcn_exp2f(P[BASE + r_]); \
        bf16x8 pa_; PK4(P, BASE, pa_); \
        o[0] = __builtin_amdgcn_mfma_f32_32x32x16_bf16(pa_, PKV2(VA, VC), o[0], 0, 0, 0); o[1] = __builtin_amdgcn_mfma_f32_32x32x16_bf16(pa_, PKV2(VD, VE), o[1], 0, 0, 0); \
        o[2] = __builtin_amdgcn_mfma_f32_32x32x16_bf16(pa_, ones, o[2], 0, 0, 0); __builtin_amdgcn_sched_barrier(0); } while (0)
#define ATT_TILE(j, cur) do { \
        f32x16 p0, p1; \
        _Pragma("unroll") for (int r = 0; r < 16; ++r) { p0[r] = 0.f; p1[r] = 0.f; } \
        const LAS unsigned char* Kc = K_lds + (cur) * KTILE; \
        _Pragma("unroll") for (int d0 = 0; d0 < KS; ++d0) { const int cb = (d0 * 16 + hi * 8) * 2;     \
            const bf16x8 b0 = *(const LAS bf16x8*)(Kc + r32 * KR + cb); const bf16x8 b1 = *(const LAS bf16x8*)(Kc + (32 + r32) * KR + cb); \
            p0 = __builtin_amdgcn_mfma_f32_32x32x16_bf16(b0, qr[d0], p0, 0, 0, 0); p1 = __builtin_amdgcn_mfma_f32_32x32x16_bf16(b1, qr[d0], p1, 0, 0, 0); } \
        int cls = 0; float Bq = 0.f; \
        if (ALIBI) { if (64 * (j) + 64 <= w0) { cls = 1; Bq = slope2 * ((float)(64 * (j)) - qpos); } else if (64 * (j) >= w0 + 32) { cls = 2; Bq = slope2 * (qpos - (float)(64 * (j))); } } \
        bf16x8 qx; { u32x4 w = {0u, 0u, 0u, 0u}; if (hi == 0) { unsigned whm, wl0; split3(Bq - mt, whm, wl0); w.z = whm; w.w = wl0; w.x = (cls == 1) ? 0x3F803F80u : 0u; w.y = (cls == 2) ? 0x3F803F80u : 0u; } qx = __builtin_bit_cast(bf16x8, w); } \
        p0 = __builtin_amdgcn_mfma_f32_32x32x16_bf16(kx0, qx, p0, 0, 0, 0); p1 = __builtin_amdgcn_mfma_f32_32x32x16_bf16(kx1, qx, p1, 0, 0, 0); \
        if (ALIBI && cls == 0) { const float dq = qpos - (float)((j) * 64 + 4 * hi); \
            _Pragma("unroll") for (int r = 0; r < 16; ++r) { const float kc = (float)((r & 3) + 8 * (r >> 2)); p0[r] = fmaf(fabsf(dq - kc), -slope2, p0[r]); p1[r] = fmaf(fabsf(dq - (kc + 32.f)), -slope2, p1[r]); } } \
        float tmax = p0[0]; \
        _Pragma("unroll") for (int r = 1; r < 16; ++r) tmax = fmaxf(tmax, p0[r]); \
        _Pragma("unroll") for (int r = 0; r < 16; ++r) tmax = fmaxf(tmax, p1[r]); \
        { auto rr = __builtin_amdgcn_permlane32_swap(__float_as_uint(tmax), __float_as_uint(tmax), false, false); tmax = fmaxf(__uint_as_float(rr[0]), __uint_as_float(rr[1])); } \
        const bool skip = !first && __all(tmax < SKIP); \
        if (!skip) { \
            if (first || !__all(tmax <= THR)) { \
                const float delta = first ? tmax : fmaxf(tmax, 0.f); const float alpha = first ? 1.f : __builtin_amdgcn_exp2f(-delta); \
                mt += delta; \
                _Pragma("unroll") for (int r = 0; r < 16; ++r) { p0[r] -= delta; p1[r] -= delta; } \
                if (!first) { if (hi == 0) al_l[r32] = alpha; LDS_WAIT(); \
                    _Pragma("unroll") for (int r = 0; r < 16; ++r) { const float a = al_l[crow(r, hi)]; o[0][r] *= a; o[1][r] *= a; o[2][r] *= a; } } \
            } \
              \
            const int vb = vb0 + (cur) * VTILE; \
            const s16x4 va0 = tr_read<v_rd_off(0, 0, 0)>(vb), vc0 = tr_read<v_rd_off(0, 0, 1)>(vb), vd0 = tr_read<v_rd_off(1, 0, 0)>(vb), ve0 = tr_read<v_rd_off(1, 0, 1)>(vb); \
            const s16x4 va1 = tr_read<v_rd_off(0, 1, 0)>(vb), vc1 = tr_read<v_rd_off(0, 1, 1)>(vb), vd1 = tr_read<v_rd_off(1, 1, 0)>(vb), ve1 = tr_read<v_rd_off(1, 1, 1)>(vb); \
            const s16x4 va2 = tr_read<v_rd_off(0, 2, 0)>(vb), vc2 = tr_read<v_rd_off(0, 2, 1)>(vb), vd2 = tr_read<v_rd_off(1, 2, 0)>(vb), ve2 = tr_read<v_rd_off(1, 2, 1)>(vb); \
            const s16x4 va3 = tr_read<v_rd_off(0, 3, 0)>(vb), vc3 = tr_read<v_rd_off(0, 3, 1)>(vb), vd3 = tr_read<v_rd_off(1, 3, 0)>(vb), ve3 = tr_read<v_rd_off(1, 3, 1)>(vb); \
            const u32x4 onesw = {0x3F803F80u, 0x3F803F80u, 0x3F803F80u, 0x3F803F80u}; const bf16x8 ones = __builtin_bit_cast(bf16x8, onesw); \
            asm volatile("s_waitcnt lgkmcnt(0)" ::: "memory"); __builtin_amdgcn_sched_barrier(0); \
            ATT_GRP(p0, 0, va0, vc0, vd0, ve0); ATT_GRP(p0, 8, va1, vc1, vd1, ve1); ATT_GRP(p1, 0, va2, vc2, vd2, ve2); ATT_GRP(p1, 8, va3, vc3, vd3, ve3); \
            first = false; \
        } } while (0)
#define ATT_RUN(COUNT, TILE_EXPR) do { const int cnt_ = (COUNT); if (cnt_ > 0) { \
        { const int jj = 0; SLOAD((TILE_EXPR) * 64); } SWRITE(0); __syncthreads(); \
        if (cnt_ > 1) { const int jj = 1; SLOAD((TILE_EXPR) * 64); } \
        for (int jj0 = 0; jj0 < cnt_; ++jj0) { const int cur_ = jj0 & 1; int j_; { const int jj = jj0; j_ = (TILE_EXPR); } \
            ATT_TILE(j_, cur_); \
            if (jj0 + 1 < cnt_) SWRITE(cur_ ^ 1); \
            __syncthreads(); \
            if (jj0 + 2 < cnt_) { const int jj = jj0 + 2; SLOAD((TILE_EXPR) * 64); } } } } while (0)
    if (wid >= 4) __builtin_amdgcn_s_setprio(1);
    ATT_RUN(4, jd0 + jj);
    if (ALIBI) {
        { const float mm = -wave_max(-mt); if (lane == 0) blk[8 + wid] = mm; }
        __syncthreads();
        if (wid == 0) {
            float qn2 = blk[0], mmin = blk[8];
#pragma unroll
            for (int i = 1; i < 8; ++i) { qn2 = fmaxf(qn2, blk[i]); mmin = fminf(mmin, blk[8 + i]); }
            int base = 0;
            for (int c0 = 0; c0 < NT - 4; c0 += 64) { const int c = c0 + lane; bool act = false; int t = 0;
                if (c < NT - 4) { t = (c < jd0) ? jd0 - 1 - c : c + 4;
                    const float dist = (t < jd0) ? (float)(q0 - (64 * t + 63)) : (float)(64 * t - (q0 + 255));
                    const float kn = __builtin_bit_cast(float, kn2[t]);
                    act = (sqrtf(qn2 * kn) * 1.02f - slope2 * dist - mmin >= SKIP); }
                const unsigned long long bm = __ballot(act);
                if (act) tl[base + __builtin_popcountll(bm & ((1ull << lane) - 1ull))] = t;
                base += __builtin_popcountll(bm); }
            if (lane == 0) blk[16] = __builtin_bit_cast(float, base);
        }
        __syncthreads();
        const int nact = __builtin_bit_cast(int, blk[16]);
        ATT_RUN(nact, tl[jj]);
    } else {
        ATT_RUN(NT - 4, (jj < jd0 ? jd0 - 1 - jj : jj + 4));
    }
#undef ATT_RUN
#undef ATT_TILE
#undef ATT_GRP
#undef PKV2
#undef PK4
#undef SLOAD
#undef SWRITE
    __builtin_amdgcn_s_setprio(0);
    bf16_t* Ow = Ob + (size_t)(wid * 32) * ldo;
#pragma unroll
    for (int r = 0; r < 16; ++r) { const int orow = crow(r, hi); const float rl = __builtin_amdgcn_rcpf(o[2][r]);
#pragma unroll
        for (int d0 = 0; d0 < 2; ++d0) Ow[(size_t)orow * ldo + d0 * 32 + r32] = (bf16_t)f2bf(o[d0][r] * rl); }
    __syncthreads();
}
}

DI void ph_attn_a(const Ctx& C, int l) {
    const bf16_t* UA = (const bf16_t*)(C.ws + WS_U); bf16_t* OA = (bf16_t*)(C.ws + WS_XB1);
    for (int u = C.bid; u < 4096; u += C.G) {
        int qb, vh, seq, len;
        if (u < 2048) { const int i = u >> 8, c = u & 255; seq = c >> 5; qb = c & 31; vh = (i + seq) & 7; len = 8192; }
        else { const int v = u - 2048, i = v >> 8, c = v & 255; seq = 8 + (c >> 3); qb = c & 7; vh = (i + (c >> 3)) & 7; len = 2048; }
        const int r0 = seq_start_row(seq); const int h = vh >> 1;
        const float slope2 = exp2f(-2.0f * (float)(h + 1)) * LOG2E;
        att::attn_unit<2, true>(UA + (size_t)(r0 + qb * 256) * 768 + vh * 32, 768, UA + (size_t)r0 * 768 + 256 + vh * 32, 768, UA + (size_t)r0 * 768 + 512 + h * 64, 768,
                                OA + (size_t)(r0 + qb * 256) * 512 + vh * 64, 512, len, qb * 256, slope2, (const unsigned*)(C.ws + WS_KN2) + ((size_t)l * 8 + vh) * 2048 + (r0 >> 6), C.lds);
    }
}
DI void ph_attn_c(const Ctx& C) {
    const bf16_t* Qc = (const bf16_t*)(C.ws + WS_XB1 + OFF_QC); const bf16_t* Kc = (const bf16_t*)(C.ws + WS_XB1 + OFF_KC); const bf16_t* Vc = (const bf16_t*)(C.ws + WS_XB1 + OFF_VC);
    bf16_t* Y = (bf16_t*)(C.ws + WS_Y);
    for (int u = C.bid; u < 2048; u += C.G) {
        int qb, h, seq, len;
        if (u < 1024) { qb = u & 31; h = (u >> 5) & 3; seq = u >> 7; len = 8192; } else { const int v = u - 1024; qb = v & 7; h = (v >> 3) & 3; seq = 8 + (v >> 5); len = 2048; }
        const int r0 = seq_start_row(seq);
        att::attn_unit<3, false>(Qc + (size_t)(r0 + qb * 256) * 192 + h * 48, 192, Kc + (size_t)r0 * 192 + h * 48, 192, Vc + (size_t)r0 * 256 + h * 64, 256,
                                 Y + (size_t)(r0 + qb * 256) * DM + 512 + h * 64, DM, len, qb * 256, 0.f, nullptr, C.lds);
    }
}
DI void ph_a_post(const Ctx& C, int l) {
    const bf16_t* OA = (const bf16_t*)(C.ws + WS_XB1); bf16_t* Y = (bf16_t*)(C.ws + WS_Y);
    const float linit = 0.8f - 0.6f * expf(-0.3f * (float)l);
    const float* lp = C.A->in[3] + l * 128;
    float sa = 0.f, sb = 0.f; if (C.lane < 32) { sa = lp[C.lane] * lp[32 + C.lane]; sb = lp[64 + C.lane] * lp[96 + C.lane]; }
    const float lam = expf(wave_sum(sa)) - expf(wave_sum(sb)) + linit;
    const int h = C.lane >> 4, d4 = (C.lane & 15) * 4;
    const f32x4 gg = *(const f32x4*)(C.A->in[4] + l * 64 + d4);
    for (int row0 = C.gw; row0 < NTOK; row0 += 4 * C.NGW) {
        u32x2 a[4], b[4];
#pragma unroll
        for (int i = 0; i < 4; ++i) { const size_t row = (size_t)row0 + (size_t)i * C.NGW; a[i] = *(const u32x2*)(OA + row * 512 + (2 * h) * 64 + d4); b[i] = *(const u32x2*)(OA + row * 512 + (2 * h + 1) * 64 + d4); }
#pragma unroll
        for (int i = 0; i < 4; ++i) { const size_t row = (size_t)row0 + (size_t)i * C.NGW;
            float o0 = bflo(a[i].x) - lam * bflo(b[i].x), o1 = bfhi(a[i].x) - lam * bfhi(b[i].x), o2 = bflo(a[i].y) - lam * bflo(b[i].y), o3 = bfhi(a[i].y) - lam * bfhi(b[i].y);
            float ss = o0 * o0 + o1 * o1 + o2 * o2 + o3 * o3;
            ss += __shfl_xor(ss, 1); ss += __shfl_xor(ss, 2); ss += __shfl_xor(ss, 4); ss += __shfl_xor(ss, 8);
            const float r = (1.0f / sqrtf(ss * (1.f / 64.f) + RMS_EPS)) * (1.0f - linit);
            u32x2 w; w.x = cvt_pk_bf16(o0 * r * gg[0], o1 * r * gg[1]); w.y = cvt_pk_bf16(o2 * r * gg[2], o3 * r * gg[3]);
            *(u32x2*)(Y + row * DM + h * 64 + d4) = w; }
    }
}

DI float hgrn_lb(const Ctx& C, int l, int dir, int ch) {
    if (l == 0) return 0.f;
    const float a = C.A->in[5][(0 * 2 + dir) * 256 + ch], b = C.A->in[5][(1 * 2 + dir) * 256 + ch];
    const float m = fmaxf(a, b), ea = expf(a - m), eb = expf(b - m); return eb / (ea + eb);
}
DI float dpp_shr_add(float x, int k) {
    float y;
    if (k == 1) y = __builtin_bit_cast(float, __builtin_amdgcn_update_dpp(0, __builtin_bit_cast(int, x), 0x111, 0xF, 0xF, true));
    else if (k == 2) y = __builtin_bit_cast(float, __builtin_amdgcn_update_dpp(0, __builtin_bit_cast(int, x), 0x112, 0xF, 0xF, true));
    else if (k == 4) y = __builtin_bit_cast(float, __builtin_amdgcn_update_dpp(0, __builtin_bit_cast(int, x), 0x114, 0xF, 0xF, true));
    else y = __builtin_bit_cast(float, __builtin_amdgcn_update_dpp(0, __builtin_bit_cast(int, x), 0x118, 0xF, 0xF, true));
    return x + y;
}
DI s16x4 tr16(unsigned addr) { s16x4 r; asm volatile("ds_read_b64_tr_b16 %0, %1\n\ts_waitcnt lgkmcnt(0)" : "=&v"(r) : "v"(addr) : "memory"); return r; }
constexpr int HG_ROW = 144, HG_ARR = 16 * HG_ROW;
template <int MODE>
DI void hgrn_pass(const Ctx& C, int l, int chunk, int h, int dir, LAS unsigned char* wl, float* ofs) {
    const bf16_t* UB = (const bf16_t*)(C.ws + WS_U); float* ST = (float*)(C.ws + WS_XB1); float* GAM = (float*)(C.ws + WS_GAM); bf16_t* Y = (bf16_t*)(C.ws + WS_Y);
    const int lane = C.lane, l15 = lane & 15, g = lane >> 4, r0 = chunk * 128; const size_t sbase = (size_t)((chunk * 4 + h) * 2 + dir);
    const unsigned QLa = (unsigned)(uintptr_t)wl, FLa = QLa + HG_ARR, VLa = QLa + 2 * HG_ARR, GLa = QLa + 3 * HG_ARR;
    LAS float* lbT = (LAS float*)(wl + 4 * HG_ARR);
    lbT[lane] = hgrn_lb(C, l, dir, h * 64 + lane);
    LDS_WAIT();
    f32x4 S[4][4];
#pragma unroll
    for (int dt = 0; dt < 4; ++dt)
#pragma unroll
        for (int et = 0; et < 4; ++et)
#pragma unroll
            for (int r = 0; r < 4; ++r) S[dt][et][r] = (MODE == 0) ? 0.f : ST[sbase * 4096 + (size_t)(16 * dt + 4 * g + r) * 64 + 16 * et + l15];
    float gsum[4] = {0.f, 0.f, 0.f, 0.f};
    const float* ngp = C.A->in[6] + l * 256 + h * 64 + l15;
    const int srow = lane >> 2, spc = lane & 3;
    u32x4 pq[2], pf[2], pv[2];
#define HG_LOAD(sc) do { const int t_ = (sc) * 16 + srow; const bf16_t* rp_ = UB + (size_t)(r0 + (dir ? 127 - t_ : t_)) * 1280 + h * 64 + spc * 16; \
        pf[0] = *(const u32x4*)(rp_ + (dir ? 512 : 256)); pf[1] = *(const u32x4*)(rp_ + (dir ? 512 : 256) + 8); pv[0] = *(const u32x4*)(rp_ + 768); pv[1] = *(const u32x4*)(rp_ + 768 + 8); \
        if (MODE != 0) { pq[0] = *(const u32x4*)(rp_); pq[1] = *(const u32x4*)(rp_ + 8); } } while (0)
#define HG_STORE() do { const int o_ = srow * HG_ROW + spc * 32; \
        *(LAS u32x4*)(wl + HG_ARR + o_) = pf[0]; *(LAS u32x4*)(wl + HG_ARR + o_ + 16) = pf[1]; *(LAS u32x4*)(wl + 2 * HG_ARR + o_) = pv[0]; *(LAS u32x4*)(wl + 2 * HG_ARR + o_ + 16) = pv[1]; \
        if (MODE != 0) { *(LAS u32x4*)(wl + o_) = pq[0]; *(LAS u32x4*)(wl + o_ + 16) = pq[1]; } } while (0)
    HG_LOAD(0);
    const unsigned tr_off = (unsigned)((4 * g + (l15 >> 2)) * HG_ROW + (l15 & 3) * 8);
    for (int sc = 0; sc < 8; ++sc) {
        LDS_WAIT();
        HG_STORE();
        if (MODE == 2) {
#pragma unroll
            for (int k = 0; k < 2; ++k) { const int t_ = sc * 16 + 8 * k + (lane >> 3);
                __builtin_amdgcn_global_load_lds((const unsigned*)(UB + (size_t)(r0 + 127 - t_) * 1280 + 1024 + h * 64 + (lane & 7) * 8), (LAS unsigned*)(wl + 3 * HG_ARR + k * 1024), 16, 0, 0); } }
        if (sc + 1 < 8) HG_LOAD(sc + 1);
        LDS_WAIT();
        bf16x8 vf[4];
#pragma unroll
        for (int et = 0; et < 4; ++et) { const s16x4 t4 = tr16(VLa + tr_off + et * 32); vf[et] = (bf16x8){t4[0], t4[1], t4[2], t4[3], 0, 0, 0, 0}; }
        __builtin_amdgcn_sched_barrier(0);
        bf16x8 khf[4]; float tot[4];
#pragma unroll
        for (int dt = 0; dt < 4; ++dt) { const s16x4 t4 = tr16(FLa + tr_off + dt * 32);
            float fv[4], lf[4];
            const float lbv = lbT[16 * dt + l15];
#pragma unroll
            for (int j = 0; j < 4; ++j) { fv[j] = lbv + (1.f - lbv) * sigmoidf_(bf2f((unsigned short)t4[j])); lf[j] = __builtin_amdgcn_logf(fv[j]); }
            const float Tg = (lf[0] + lf[1]) + (lf[2] + lf[3]);
            const float T1 = __shfl_down(Tg, 16), T2 = __shfl_down(Tg, 32), T3 = __shfl_down(Tg, 48);
            const float after = (g < 3 ? T1 : 0.f) + (g < 2 ? T2 : 0.f) + (g < 1 ? T3 : 0.f);
            float tt_ = Tg; tt_ += __shfl_xor(tt_, 16); tt_ += __shfl_xor(tt_, 32); tot[dt] = tt_; gsum[dt] += tt_;
            const float c3 = after, c2 = c3 + lf[3], c1 = c2 + lf[2], c0 = c1 + lf[1];
            const unsigned w0 = cvt_pk_bf16((1.f - fv[0]) * __builtin_amdgcn_exp2f(c0), (1.f - fv[1]) * __builtin_amdgcn_exp2f(c1));
            const unsigned w1 = cvt_pk_bf16((1.f - fv[2]) * __builtin_amdgcn_exp2f(c2), (1.f - fv[3]) * __builtin_amdgcn_exp2f(c3));
            const u32x4 w = {w0, w1, 0u, 0u}; khf[dt] = __builtin_bit_cast(bf16x8, w); }
        __builtin_amdgcn_sched_barrier(0);
        f32x4 O[4];
        if (MODE != 0) {
            bf16x8 qhf[2], ktf[2];
#pragma unroll
            for (int ks = 0; ks < 2; ++ks) { float b2[8], qv[8], kv[8];
#pragma unroll
                for (int dd = 0; dd < 2; ++dd) { const int dt = 2 * ks + dd;
                    const u32x2 fw = *(const LAS u32x2*)(wl + HG_ARR + l15 * HG_ROW + (16 * dt + 4 * g) * 2); const u32x2 qw = *(const LAS u32x2*)(wl + l15 * HG_ROW + (16 * dt + 4 * g) * 2);
                    const f32x4 lb4 = *(const LAS f32x4*)(lbT + 16 * dt + 4 * g);
                    const float fl4[4] = {bflo(fw.x), bfhi(fw.x), bflo(fw.y), bfhi(fw.y)}, ql4[4] = {bflo(qw.x), bfhi(qw.x), bflo(qw.y), bfhi(qw.y)};
#pragma unroll
                    for (int r = 0; r < 4; ++r) { const int i = 4 * dd + r; const float f = lb4[r] + (1.f - lb4[r]) * sigmoidf_(fl4[r]); b2[i] = __builtin_amdgcn_logf(f); kv[i] = 1.f - f; qv[i] = siluf_(ql4[r]); } }
#pragma unroll
                for (int i = 0; i < 8; ++i) { float x = b2[i]; x = dpp_shr_add(x, 1); x = dpp_shr_add(x, 2); x = dpp_shr_add(x, 4); x = dpp_shr_add(x, 8); b2[i] = x; }
                u32x4 wq, wk;
#pragma unroll
                for (int p = 0; p < 4; ++p) { const int i = 2 * p; const float e0 = __builtin_amdgcn_exp2f(b2[i]), e1 = __builtin_amdgcn_exp2f(b2[i + 1]);
                    wq[p] = cvt_pk_bf16(qv[i] * e0, qv[i + 1] * e1); wk[p] = cvt_pk_bf16(kv[i] * __builtin_amdgcn_exp2f(fminf(-b2[i], 120.f)), kv[i + 1] * __builtin_amdgcn_exp2f(fminf(-b2[i + 1], 120.f))); }
                qhf[ks] = __builtin_bit_cast(bf16x8, wq); ktf[ks] = __builtin_bit_cast(bf16x8, wk); }
            __builtin_amdgcn_sched_barrier(0);
            f32x4 aT = (f32x4){0.f, 0.f, 0.f, 0.f};
            aT = __builtin_amdgcn_mfma_f32_16x16x32_bf16(ktf[0], qhf[0], aT, 0, 0, 0);
            aT = __builtin_amdgcn_mfma_f32_16x16x32_bf16(ktf[1], qhf[1], aT, 0, 0, 0);
#pragma unroll
            for (int r = 0; r < 4; ++r) aT[r] = (4 * g + r > l15) ? 0.f : aT[r];
            const u32x4 aw = {cvt_pk_bf16(aT[0], aT[1]), cvt_pk_bf16(aT[2], aT[3]), 0u, 0u}; const bf16x8 atf = __builtin_bit_cast(bf16x8, aw);
#pragma unroll
            for (int et = 0; et < 4; ++et) { f32x4 o = (f32x4){0.f, 0.f, 0.f, 0.f};
                o = __builtin_amdgcn_mfma_f32_16x16x32_bf16(atf, vf[et], o, 0, 0, 0);
#pragma unroll
                for (int ks = 0; ks < 2; ++ks) { const u32x4 sw = {cvt_pk_bf16(S[2 * ks][et][0], S[2 * ks][et][1]), cvt_pk_bf16(S[2 * ks][et][2], S[2 * ks][et][3]), cvt_pk_bf16(S[2 * ks + 1][et][0], S[2 * ks + 1][et][1]), cvt_pk_bf16(S[2 * ks + 1][et][2], S[2 * ks + 1][et][3])};
                    o = __builtin_amdgcn_mfma_f32_16x16x32_bf16(qhf[ks], __builtin_bit_cast(bf16x8, sw), o, 0, 0, 0); }
                O[et] = o; }
        }
        __builtin_amdgcn_sched_barrier(0);
#pragma unroll
        for (int dt = 0; dt < 4; ++dt) { float dec[4];
#pragma unroll
            for (int r = 0; r < 4; ++r) dec[r] = __builtin_amdgcn_exp2f(__shfl(tot[dt], 4 * g + r));
#pragma unroll
            for (int et = 0; et < 4; ++et) { f32x4 s = S[dt][et];
#pragma unroll
                for (int r = 0; r < 4; ++r) s[r] *= dec[r];
                S[dt][et] = __builtin_amdgcn_mfma_f32_16x16x32_bf16(khf[dt], vf[et], s, 0, 0, 0); } }
        __builtin_amdgcn_sched_barrier(0);
        if (MODE == 1) {
#pragma unroll
            for (int et = 0; et < 4; ++et)
#pragma unroll
                for (int r = 0; r < 4; ++r) ofs[(sc * 16 + 4 * g + r) * 64 + 16 * et + l15] = O[et][r];
        }
        if (MODE == 2) {
            float rr[4];
#pragma unroll
            for (int r = 0; r < 4; ++r) { const int at = 127 - (sc * 16 + 4 * g + r); float ss = 0.f;
#pragma unroll
                for (int et = 0; et < 4; ++et) { const float of = ofs[at * 64 + 16 * et + l15]; O[et][r] += of; ss += O[et][r] * O[et][r]; }
                ss += __shfl_xor(ss, 1); ss += __shfl_xor(ss, 2); ss += __shfl_xor(ss, 4); ss += __shfl_xor(ss, 8);
                rr[r] = 1.0f / sqrtf(ss * (1.f / 64.f) + RMS_EPS); }
            VM_WAIT();
#pragma unroll
            for (int et = 0; et < 4; ++et) { const s16x4 t4 = tr16(GLa + (unsigned)((4 * g + (l15 >> 2)) * 128 + (l15 & 3) * 8) + et * 32); const float ngv = ngp[16 * et];
#pragma unroll
                for (int r = 0; r < 4; ++r) { const int at = 127 - (sc * 16 + 4 * g + r);
                    Y[(size_t)(r0 + at) * DM + 256 + h * 64 + 16 * et + l15] = (bf16_t)f2bf(O[et][r] * rr[r] * ngv * siluf_(bf2f((unsigned short)t4[r]))); } }
        }
    }
#undef HG_LOAD
#undef HG_STORE
    if (MODE == 0) {
#pragma unroll
        for (int dt = 0; dt < 4; ++dt)
#pragma unroll
            for (int et = 0; et < 4; ++et)
#pragma unroll
                for (int r = 0; r < 4; ++r) ST[sbase * 4096 + (size_t)(16 * dt + 4 * g + r) * 64 + 16 * et + l15] = S[dt][et][r];
        if (g == 0) {
#pragma unroll
            for (int dt = 0; dt < 4; ++dt) GAM[sbase * 64 + 16 * dt + l15] = __builtin_amdgcn_exp2f(gsum[dt]);
        }
    }
}
DI void ph_hgrn_local(const Ctx& C, int l) {
    LAS unsigned char* wl = C.lds + C.wave * 16384;
    for (int w = C.gw; w < NCHUNK * 8; w += C.NGW) hgrn_pass<0>(C, l, w >> 3, (w >> 1) & 3, w & 1, wl, nullptr);
}
DI void ph_hgrn_scan(const Ctx& C) {
    float* ST = (float*)(C.ws + WS_XB1); const float* GAM = (const float*)(C.ws + WS_GAM);
    for (int idx = C.bid * 512 + C.tid; idx < NSEQ * 8 * 4096; idx += C.G * 512) {
        const int e = idx & 4095, hd = (idx >> 12) & 7, seq = idx >> 15, h = hd >> 1, dir = hd & 1, d = e >> 6;
        const int c0 = seq < 8 ? seq * 64 : 512 + (seq - 8) * 16, nc = seq < 8 ? 64 : 16;
        float s = 0.f;
        for (int i0 = 0; i0 < nc; i0 += 16) {
            float tmp[16], gg[16];
#pragma unroll
            for (int i = 0; i < 16; ++i) { const int c = dir ? c0 + nc - 1 - (i0 + i) : c0 + i0 + i; const size_t base = (size_t)((c * 4 + h) * 2 + dir); tmp[i] = ST[base * 4096 + e]; gg[i] = GAM[base * 64 + d]; }
#pragma unroll
            for (int i = 0; i < 16; ++i) { const float t = tmp[i]; tmp[i] = s; s = fmaf(gg[i], s, t); }
#pragma unroll
            for (int i = 0; i < 16; ++i) { const int c = dir ? c0 + nc - 1 - (i0 + i) : c0 + i0 + i; const size_t base = (size_t)((c * 4 + h) * 2 + dir); ST[base * 4096 + e] = tmp[i]; }
        }
    }
}
template <int MODE>
DI void ph_hgrn_out(const Ctx& C, int l) {
    LAS unsigned char* wl = C.lds + C.wave * 16384;
    for (int w = C.gw; w < NCHUNK * 4; w += C.NGW) hgrn_pass<MODE>(C, l, w >> 2, w & 3, MODE == 2 ? 1 : 0, wl, (float*)(C.ws + WS_EW) + (size_t)w * 8192);
}

DI void ph_c_prep(const Ctx& C, int l) {
    const bf16_t* UCD = (const bf16_t*)(C.ws + WS_U);
    const bf16_t* WQ = (const bf16_t*)(C.ws + WS_WC + (size_t)l * WC_LAYER + OFF_WQ); const bf16_t* WKV = (const bf16_t*)(C.ws + WS_WC + (size_t)l * WC_LAYER + OFF_WKV);
    bf16_t* Qc = (bf16_t*)(C.ws + WS_XB1 + OFF_QC); bf16_t* Kc = (bf16_t*)(C.ws + WS_XB1 + OFF_KC); bf16_t* Vc = (bf16_t*)(C.ws + WS_XB1 + OFF_VC);
    const int lane = C.lane, r32 = lane & 31, hi = lane >> 5;
    const float C2c = 0.14433756729740643f * LOG2E;
    constexpr int PQ = 400, PKV = 272;
    for (int i = C.tid; i < 192 * 24; i += 512) { const int r = i / 24, p = i % 24; *(LAS u32x4*)(C.lds + r * PQ + p * 16) = *(const u32x4*)(WQ + (size_t)r * 192 + p * 8); }
    __syncthreads();
    for (int w = C.gw; w < NTOK / 32; w += C.NGW) {
        const int row = w * 32 + r32; const bf16_t* xr = UCD + (size_t)row * 1024;
        float cs[4], sn[4];
        { const float pos = (float)row_pos(row); const float inv[8] = {1.0f, 0.316227766016837933f, 0.1f, 0.0316227766016837933f, 0.01f, 0.00316227766016837933f, 0.001f, 0.000316227766016837933f};
#pragma unroll
            for (int ii = 0; ii < 4; ++ii) { const float invv = hi ? inv[4 + ii] : inv[ii]; const float ang = pos * invv;
                const double ad = (double)ang; const double k = __builtin_rint(ad * 0.15915494309189535); const float red = (float)(ad - k * 6.283185307179586);
                cs[ii] = __cosf(red); sn[ii] = __sinf(red); } }
        bf16x8 xq[12]; float ssq = 0.f;
#pragma unroll
        for (int ks = 0; ks < 12; ++ks) { xq[ks] = *(const bf16x8*)(xr + ks * 16 + hi * 8);
#pragma unroll
            for (int j = 0; j < 8; ++j) { const float f = bf2f((unsigned short)xq[ks][j]); ssq += f * f; } }
        ssq += __shfl_xor(ssq, 32);
        const float rq = (1.0f / sqrtf(ssq * (1.f / 192.f) + RMS_EPS)) * C2c;
#pragma unroll 1
        for (int nt = 0; nt < 6; ++nt) {
            f32x16 acc;
#pragma unroll
            for (int r = 0; r < 16; ++r) acc[r] = 0.f;
#pragma unroll
            for (int ks = 0; ks < 12; ++ks) { const bf16x8 a = *(const LAS bf16x8*)(C.lds + (32 * nt + r32) * PQ + (ks * 16 + hi * 8) * 2); acc = __builtin_amdgcn_mfma_f32_32x32x16_bf16(a, xq[ks], acc, 0, 0, 0); }
#pragma unroll
            for (int r = 0; r < 16; ++r) acc[r] *= rq;
            if (nt == 1 || nt == 4) {
#pragma unroll
                for (int ii = 0; ii < 4; ++ii) { const float x1 = acc[ii], x2 = acc[4 + ii]; acc[ii] = x1 * cs[ii] - x2 * sn[ii]; acc[4 + ii] = x1 * sn[ii] + x2 * cs[ii]; } }
            if (nt == 2 || nt == 5) {
#pragma unroll
                for (int ii = 0; ii < 4; ++ii) { const float x1 = acc[8 + ii], x2 = acc[12 + ii]; acc[8 + ii] = x1 * cs[ii] - x2 * sn[ii]; acc[12 + ii] = x1 * sn[ii] + x2 * cs[ii]; } }
#pragma unroll
            for (int g = 0; g < 4; ++g) { u32x2 wv; wv.x = cvt_pk_bf16(acc[4 * g], acc[4 * g + 1]); wv.y = cvt_pk_bf16(acc[4 * g + 2], acc[4 * g + 3]);
                *(u32x2*)(Qc + (size_t)row * 192 + 32 * nt + 8 * g + 4 * hi) = wv; }
        }
        { const u32x2 a = *(const u32x2*)(xr + 320 + 4 * hi), b = *(const u32x2*)(xr + 328 + 4 * hi);
            const float x1[4] = {bflo(a.x), bfhi(a.x), bflo(a.y), bfhi(a.y)}, x2[4] = {bflo(b.x), bfhi(b.x), bflo(b.y), bfhi(b.y)};
            float o1[4], o2[4];
#pragma unroll
            for (int ii = 0; ii < 4; ++ii) { o1[ii] = x1[ii] * cs[ii] - x2[ii] * sn[ii]; o2[ii] = x1[ii] * sn[ii] + x2[ii] * cs[ii]; }
            u32x2 w1, w2; w1.x = cvt_pk_bf16(o1[0], o1[1]); w1.y = cvt_pk_bf16(o1[2], o1[3]); w2.x = cvt_pk_bf16(o2[0], o2[1]); w2.y = cvt_pk_bf16(o2[2], o2[3]);
#pragma unroll
            for (int h = 0; h < 4; ++h) { *(u32x2*)(Kc + (size_t)row * 192 + h * 48 + 32 + 4 * hi) = w1; *(u32x2*)(Kc + (size_t)row * 192 + h * 48 + 40 + 4 * hi) = w2; } }
    }
    __syncthreads();
    for (int i = C.tid; i < 384 * 16; i += 512) { const int r = i / 16, p = i % 16; *(LAS u32x4*)(C.lds + r * PKV + p * 16) = *(const u32x4*)(WKV + (size_t)r * 128 + p * 8); }
    __syncthreads();
    for (int w = C.gw; w < NTOK / 32; w += C.NGW) {
        const int row = w * 32 + r32; const bf16_t* xr = UCD + (size_t)row * 1024;
        bf16x8 xk[8]; float ssk = 0.f;
#pragma unroll
        for (int ks = 0; ks < 8; ++ks) { xk[ks] = *(const bf16x8*)(xr + 192 + ks * 16 + hi * 8);
#pragma unroll
            for (int j = 0; j < 8; ++j) { const float f = bf2f((unsigned short)xk[ks][j]); ssk += f * f; } }
        ssk += __shfl_xor(ssk, 32);
        const float rk = 1.0f / sqrtf(ssk * (1.f / 128.f) + RMS_EPS);
#pragma unroll 1
        for (int nt = 0; nt < 12; ++nt) {
            f32x16 acc;
#pragma unroll
            for (int r = 0; r < 16; ++r) acc[r] = 0.f;
#pragma unroll
            for (int ks = 0; ks < 8; ++ks) { const bf16x8 a = *(const LAS bf16x8*)(C.lds + (32 * nt + r32) * PKV + (ks * 16 + hi * 8) * 2); acc = __builtin_amdgcn_mfma_f32_32x32x16_bf16(a, xk[ks], acc, 0, 0, 0); }
            const int h = nt / 3, part = nt % 3;
            bf16_t* dst = (part == 0) ? Kc + (size_t)row * 192 + h * 48 : Vc + (size_t)row * 256 + h * 64 + (part - 1) * 32;
#pragma unroll
            for (int g = 0; g < 4; ++g) { u32x2 wv; wv.x = cvt_pk_bf16(acc[4 * g] * rk, acc[4 * g + 1] * rk); wv.y = cvt_pk_bf16(acc[4 * g + 2] * rk, acc[4 * g + 3] * rk);
                *(u32x2*)(dst + 8 * g + 4 * hi) = wv; }
        }
    }
}

DI float one_minus_a2(float y, float a) {
    const float p = -y * (1.0f + y * (0.5f + y * (0.16666667f + y * (0.041666668f + y * (0.0083333338f + y * 0.0013888889f)))));
    return (y > -0.25f) ? p : (1.0f - a * a);
}
template <bool FINAL, int DIR>
DI void rglru_units(const Ctx& C, int l) {
    const bf16_t* UCD = (const bf16_t*)(C.ws + WS_U); f32x2* DC = (f32x2*)(C.ws + WS_DC);
    bf16_t* HFB = (bf16_t*)(C.ws + WS_EW);
    const int lane = C.lane, l15 = lane & 15, g = lane >> 4;
    LAS unsigned char* wl = C.lds + C.wave * 16384;
    LAS unsigned char* xcb = wl;
    LAS float* gs = (LAS float*)(wl + 2304);
    const int n = C.gw & 3, ch = n * 64 + lane;
    bf16x8 Wf[2][4][2];
    { const bf16x8* fp = (const bf16x8*)(C.ws + WS_WRG) + (size_t)((((l * 2 + DIR) * 4 + n) * 2) * 8) * 64 + lane;
#pragma unroll
      for (int gt = 0; gt < 2; ++gt)
#pragma unroll
        for (int nt = 0; nt < 4; ++nt)
#pragma unroll
            for (int ks = 0; ks < 2; ++ks) Wf[gt][nt][ks] = fp[(size_t)((gt * 4 + nt) * 2 + ks) * 64]; }
    const float ba = C.A->in[14][(l * 2 + DIR) * 256 + ch], bx = C.A->in[16][(l * 2 + DIR) * 256 + ch];
    const float lam = C.A->in[17][(l * 2 + DIR) * 256 + ch];
    const float c8sp = -8.0f * log1pf(expf(-lam));
    float cw[4];
#pragma unroll
    for (int j = 0; j < 4; ++j) cw[j] = C.A->in[11][(l * 4 + j) * 256 + ch];
    const float cb = C.A->in[12][l * 256 + ch];
    for (int w = C.gw; w < NCHUNK * 4; w += C.NGW) {
        const int chunk = w >> 2;
        const int r0 = chunk * 128; const int sb = row_seq_begin(r0), se = sb + row_seq_len(r0);
        float h = FINAL ? DC[(size_t)(chunk * 2 + DIR) * 256 + ch][1] : 0.f, P = 1.f;
        float xr[19];
#define RG_LOADX(dst, sc_) do { const int tb_ = r0 + 16 * (DIR ? 7 - (sc_) : (sc_)) - 2; \
            _Pragma("unroll") for (int i_ = 0; i_ < 19; ++i_) { const int rr_ = tb_ + i_; dst[i_] = (rr_ >= sb && rr_ < se) ? bf2f(UCD[(size_t)rr_ * 1024 + 336 + ch]) : 0.f; } } while (0)
        RG_LOADX(xr, 0);
        for (int sc = 0; sc < 8; ++sc) {
            const int t0 = r0 + 16 * (DIR ? 7 - sc : sc);
            float xcr[16];
#pragma unroll
            for (int a = 0; a < 16; ++a) { const int tt = DIR ? 15 - a : a;
                xcr[tt] = cb + cw[0] * xr[a] + cw[1] * xr[a + 1] + cw[2] * xr[a + 2] + cw[3] * xr[a + 3];
                *(LAS bf16_t*)(xcb + tt * 144 + lane * 2) = (bf16_t)f2bf(xcr[tt]); }
            if (sc + 1 < 8) RG_LOADX(xr, sc + 1);
            LDS_WAIT();
            const bf16x8 A0 = *(const LAS bf16x8*)(xcb + l15 * 144 + (8 * g) * 2), A1 = *(const LAS bf16x8*)(xcb + l15 * 144 + (32 + 8 * g) * 2);
#pragma unroll
            for (int gt = 0; gt < 2; ++gt)
#pragma unroll
                for (int nt = 0; nt < 4; ++nt) { f32x4 acc = (f32x4){0.f, 0.f, 0.f, 0.f};
                    acc = __builtin_amdgcn_mfma_f32_16x16x32_bf16(A0, Wf[gt][nt][0], acc, 0, 0, 0);
                    acc = __builtin_amdgcn_mfma_f32_16x16x32_bf16(A1, Wf[gt][nt][1], acc, 0, 0, 0);
#pragma unroll
                    for (int r = 0; r < 4; ++r) gs[(gt * 16 + 4 * g + r) * 68 + 16 * nt + l15] = acc[r]; }
            LDS_WAIT();
#pragma unroll
            for (int tt = 0; tt < 16; ++tt) {
                const float ra = gs[tt * 68 + lane] + ba, ia = gs[(16 + tt) * 68 + lane] + bx;
                const float r = sigmoidf_(ra), ig = sigmoidf_(ia);
                const float la = c8sp * r, a = __expf(la), u = __builtin_amdgcn_sqrtf(one_minus_a2(2.0f * la, a)) * (ig * xcr[tt]);
                h = fmaf(a, h, u); P *= a;
                if (FINAL) { const int tok = DIR ? t0 + 15 - tt : t0 + tt; HFB[((size_t)DIR * NTOK + tok) * 256 + ch] = (bf16_t)f2bf(h); } }
            LDS_WAIT();
        }
        if (!FINAL) DC[(size_t)(chunk * 2 + DIR) * 256 + ch] = (f32x2){P, h};
#undef RG_LOADX
    }
}
template <bool FINAL>
DI void ph_rglru(const Ctx& C, int l) { rglru_units<FINAL, 0>(C, l); rglru_units<FINAL, 1>(C, l); }
DI void ph_rglru_scan(const Ctx& C) {
    f32x2* DC = (f32x2*)(C.ws + WS_DC);
    for (int idx = C.bid * 512 + C.tid; idx < NSEQ * 512; idx += C.G * 512) {
        const int ch = idx & 255, dir = (idx >> 8) & 1, seq = idx >> 9;
        const int c0 = seq < 8 ? seq * 64 : 512 + (seq - 8) * 16, nc = seq < 8 ? 64 : 16;
        float hin = 0.f;
        for (int i0 = 0; i0 < nc; i0 += 16) {
            f32x2 vv[16];
#pragma unroll
            for (int i = 0; i < 16; ++i) { const int c = dir ? c0 + nc - 1 - (i0 + i) : c0 + i0 + i; vv[i] = DC[(size_t)(c * 2 + dir) * 256 + ch]; }
#pragma unroll
            for (int i = 0; i < 16; ++i) { const float P = vv[i][0], H = vv[i][1]; vv[i][1] = hin; hin = fmaf(P, hin, H); }
#pragma unroll
            for (int i = 0; i < 16; ++i) { const int c = dir ? c0 + nc - 1 - (i0 + i) : c0 + i0 + i; DC[(size_t)(c * 2 + dir) * 256 + ch] = vv[i]; }
        }
    }
}
DI float gelu_tanh(float x) { const float u = 0.7978845608028654f * (x + 0.044715f * x * x * x); const float e = __expf(2.0f * u); const float th = 1.0f - 2.0f / (e + 1.0f); return 0.5f * x * (1.0f + th); }
DI void ph_d_post(const Ctx& C) {
    const bf16_t* UCD = (const bf16_t*)(C.ws + WS_U); const bf16_t* HF = (const bf16_t*)(C.ws + WS_EW); const bf16_t* HB = HF + (size_t)NTOK * 256; bf16_t* Y = (bf16_t*)(C.ws + WS_Y);
    const int c4 = C.lane * 4;
    for (int row0 = C.gw; row0 < NTOK; row0 += 4 * C.NGW) {
        u32x2 a[4], b[4], g[4];
#pragma unroll
        for (int i = 0; i < 4; ++i) { const size_t row = (size_t)row0 + (size_t)i * C.NGW; a[i] = *(const u32x2*)(HF + row * 256 + c4); b[i] = *(const u32x2*)(HB + row * 256 + c4); g[i] = *(const u32x2*)(UCD + row * 1024 + 592 + c4); }
#pragma unroll
        for (int i = 0; i < 4; ++i) { const size_t row = (size_t)row0 + (size_t)i * C.NGW;
            const float y0 = (bflo(a[i].x) + bflo(b[i].x)) * gelu_tanh(bflo(g[i].x)), y1 = (bfhi(a[i].x) + bfhi(b[i].x)) * gelu_tanh(bfhi(g[i].x));
            const float y2 = (bflo(a[i].y) + bflo(b[i].y)) * gelu_tanh(bflo(g[i].y)), y3 = (bfhi(a[i].y) + bfhi(b[i].y)) * gelu_tanh(bfhi(g[i].y));
            u32x2 w; w.x = cvt_pk_bf16(y0, y1); w.y = cvt_pk_bf16(y2, y3);
            *(u32x2*)(Y + row * DM + 768 + c4) = w; }
    }
}

DI void ph_topk(const Ctx& C) {
    const float* affT = (const float*)(C.ws + WS_AFF); int* idx2 = (int*)(C.ws + WS_IDX); float* gsel2 = (float*)(C.ws + WS_GSEL);
    LAS unsigned* hist = (LAS unsigned*)C.lds;
    LAS unsigned* misc = hist + 4096;
    LAS unsigned* cg = misc + 8;
    LAS unsigned* ce = cg + 512;
    for (int u = C.bid; u < 32; u += C.G) {
        const int g = u >> 4, e = u & 15; const unsigned* a = (const unsigned*)(affT + (size_t)(g * 16 + e) * NTOKG);
        const int i0 = C.tid * 128; unsigned v[128];
        { const u32x4* p = (const u32x4*)(a + i0);
#pragma unroll
          for (int j = 0; j < 32; ++j) { const u32x4 q = p[j]; v[4 * j] = q.x; v[4 * j + 1] = q.y; v[4 * j + 2] = q.z; v[4 * j + 3] = q.w; } }
        unsigned prefix = 0u, mask = 0u, krem = CAP;
#pragma unroll 1
        for (int pass = 0; pass < 3; ++pass) {
            const int shift = pass == 0 ? 19 : (pass == 1 ? 7 : 0); const unsigned dm = pass == 2 ? 127u : 4095u; const int per = pass == 2 ? 2 : 64;
            for (int i = C.tid; i < 4096; i += 512) hist[i] = 0u;
            __syncthreads();
#pragma unroll
            for (int i = 0; i < 128; ++i) {
                const unsigned bin = ((v[i] & mask) == prefix) ? ((v[i] >> shift) & dm) : (5120u + (unsigned)C.lane);
                atomicAdd((unsigned*)&hist[bin], 1u); if ((i & 7) == 7) asm volatile("" : "+v"(prefix) :: "memory"); }
            __syncthreads();
            if (C.tid < 64) {
                unsigned t = 0; for (int b = 0; b < per; ++b) t += hist[per * C.tid + b];
                unsigned S = t;
#pragma unroll
                for (int off = 1; off < 64; off <<= 1) { const unsigned y = __shfl_down(S, off); if (C.tid + off < 64) S += y; }
                const unsigned above = S - t;
                if (above < krem && krem <= above + t) { unsigned cum = above; int D = per * C.tid + per - 1;
                    for (; D > per * C.tid; --D) { const unsigned c = hist[D]; if (cum + c >= krem) break; cum += c; }
                    misc[0] = (unsigned)D; misc[1] = cum; }
            }
            __syncthreads();
            prefix |= misc[0] << shift; mask |= dm << shift; krem -= misc[1];
            __syncthreads();
        }
        unsigned ngt = 0, neq = 0;
#pragma unroll
        for (int i = 0; i < 128; ++i) { ngt += (v[i] > prefix); neq += (v[i] == prefix); if ((i & 15) == 15) asm volatile("" : "+v"(prefix)); }
        unsigned ig = ngt, ie = neq;
#pragma unroll
        for (int off = 1; off < 64; off <<= 1) { const unsigned yg = __shfl_up(ig, off), ye = __shfl_up(ie, off); if (C.lane >= off) { ig += yg; ie += ye; } }
        if (C.lane == 63) { cg[C.wave] = ig; ce[C.wave] = ie; }
        __syncthreads();
        unsigned bg = 0, be = 0, allg = 0;
#pragma unroll
        for (int w = 0; w < 8; ++w) { const unsigned x = cg[w], y = ce[w]; if (w < C.wave) { bg += x; be += y; } allg += x; }
        unsigned pg = bg + ig - ngt, pe = be + ie - neq; const unsigned ngt_all = allg;
        int* io = idx2 + (size_t)e * 16384 + g * CAP; float* go = gsel2 + (size_t)e * 16384 + g * CAP; short* sm = (short*)(C.ws + WS_SM) + (size_t)(g * NTOKG + i0) * 16 + e;
#pragma unroll
        for (int i = 0; i < 128; ++i) {
            if (v[i] > prefix) { io[pg] = g * NTOKG + i0 + i; go[pg] = __builtin_bit_cast(float, v[i]); sm[i * 16] = (short)pg; ++pg; }
            else if (v[i] == prefix) { if (pe < krem) { io[ngt_all + pe] = g * NTOKG + i0 + i; go[ngt_all + pe] = __builtin_bit_cast(float, v[i]); sm[i * 16] = (short)(ngt_all + pe); } ++pe; }
            if ((i & 3) == 3) asm volatile("" : "+v"(prefix) :: "memory"); }
        __syncthreads();
    }
}

constexpr int MERGE_CHUNKS = 8, MERGE_ROWS = NTOK / MERGE_CHUNKS;
constexpr int EPB = 2;
constexpr int NPH_LAYER = 12 + 2 * MERGE_CHUNKS + 3 + (NEXP / EPB + 1) + 1, NPH = 1 + 2 * NPH_LAYER;
__global__ void __launch_bounds__(512, 2) mk_fwd(Args args) {
    extern __shared__ __attribute__((aligned(16))) unsigned char lds_raw[];
    Ctx C;
    C.lds = (LAS unsigned char*)lds_raw; C.ws = (GAS unsigned char*)args.ws; C.out = (GAS float*)args.out;
    C.tid = threadIdx.x; C.lane = C.tid & 63; C.wave = __builtin_amdgcn_readfirstlane(C.tid >> 6); C.G = gridDim.x; C.bid = blockIdx.x;
    C.gw = C.bid * 8 + C.wave; C.NGW = C.G * 8;
    C.A = &args;
    volatile LAS unsigned* MISC = (volatile LAS unsigned*)(C.lds + MISC_OFF);
    for (int u = C.tid; u < (LDS_BYTES - RING_BYTES) / 4; u += 512) ((LAS unsigned*)(C.lds + RING_BYTES))[u] = 0u;
    __syncthreads();
    const int lo = args.ph_lo, hi = args.ph_hi;
    unsigned* barw = (unsigned*)(C.ws + WS_CTL) + 4096;
    XcdBarrier bar; bar.bar = barw; bar.x = 0; bar.st = nullptr;
    if (hi - lo > 1) bar = xcd_barrier_post(barw, MISC + 8);
    int ph = 0;
#ifndef PHASE_MASK
#define PHASE_MASK 0xFFFFFFFFu
#endif
#ifndef REPEAT_MASK
#define REPEAT_MASK 0u
#endif
#define SITE(id) if constexpr (((PHASE_MASK) >> (id)) & 1u) for (int rep_ = 0; rep_ < ((((REPEAT_MASK) >> (id)) & 1u) ? 2 : 1); ++rep_)
#define PH_BEGIN if (ph >= lo && ph < hi) { { int tz_ = threadIdx.x; asm volatile("" : "+v"(tz_)); C.tid = tz_; C.lane = tz_ & 63; C.wave = __builtin_amdgcn_readfirstlane(tz_ >> 6); C.gw = C.bid * 8 + C.wave; unsigned char* wz_ = args.ws; asm volatile("" : "+s"(wz_)); C.ws = (GAS unsigned char*)wz_; float* oz_ = args.out; asm volatile("" : "+s"(oz_)); C.out = (GAS float*)oz_; }
#define PH_END } if (ph >= lo && ph + 1 < hi) xcd_barrier(bar); ++ph;

#define XB0 ((bf16_t*)(C.ws + WS_XB0))
#define XB1 ((bf16_t*)(C.ws + WS_XB1))
#define Yb ((bf16_t*)(C.ws + WS_Y))
#define Ub ((bf16_t*)(C.ws + WS_U))
    const int big = 30;

    PH_BEGIN SITE(1) ph_prologue(C); PH_END

    for (int l = 0; l < 2; ++l) {
#define wl (C.ws + WS_WSMALL + (size_t)l * WSMALL_LAYER)
        PH_BEGIN SITE(2) { pg8::Gemm g{XB0, (const bf16_t*)(wl + OFF_WA), NTOK, 768, 1024, 1024, 1024, big, 0}; pg8::StaticOrder S; S.init(NTOK, 768, C.G, C.bid);
            pg8::EpiProj E{Ub, 768, 256, 0.17677669529663689f * LOG2E, (unsigned*)(C.ws + WS_KN2) + (size_t)l * 8 * 2048}; pg8::gemm_phase(C.lds, g, S, E); } PH_END
        PH_BEGIN SITE(3) ph_attn_a(C, l); PH_END
        PH_BEGIN SITE(4) { ph_a_post(C, l); __syncthreads();
            pg8::Gemm g{XB0, (const bf16_t*)(wl + OFF_WB), NTOK, 1280, 1024, 1024, 1024, big, 0}; pg8::StaticOrder S; S.init(NTOK, 1280, C.G, C.bid);
            pg8::EpiProj E{Ub, 1280, 0, 1.f, nullptr}; pg8::gemm_phase(C.lds, g, S, E); } PH_END
        PH_BEGIN SITE(5) ph_hgrn_local(C, l); PH_END
        PH_BEGIN SITE(6) ph_hgrn_scan(C); PH_END
        PH_BEGIN SITE(7) ph_hgrn_out<1>(C, l); PH_END
        PH_BEGIN SITE(20) ph_hgrn_out<2>(C, l); PH_END
        PH_BEGIN SITE(8) { pg8::Gemm g{XB0, (const bf16_t*)(wl + OFF_WCD), NTOK, 1024, 1024, 1024, 1024, big, 0}; pg8::StaticOrder S; S.init(NTOK, 1024, C.G, C.bid);
            pg8::EpiProj E{Ub, 1024, 0, 1.f, nullptr}; pg8::gemm_phase(C.lds, g, S, E); } PH_END
        PH_BEGIN SITE(9) { ph_c_prep(C, l); __syncthreads(); ph_rglru<false>(C, l); } PH_END
        PH_BEGIN SITE(10) { if (rep_ == 0) { ph_rglru_scan(C); __syncthreads(); } ph_attn_c(C); } PH_END
        PH_BEGIN SITE(11) ph_rglru<true>(C, l); PH_END
        PH_BEGIN SITE(12) ph_d_post(C); PH_END
        for (int q = 0; q < MERGE_CHUNKS; ++q) {
            const size_t r0 = (size_t)q * MERGE_ROWS;
            PH_BEGIN SITE(13) {
                { unsigned char* X8 = (unsigned char*)(C.ws + WS_U) + (size_t)MERGE_ROWS * 8192;
                  for (int rb = C.gw; rb < MERGE_ROWS; rb += 8 * C.NGW) {
                      u32x4 a[8], b[8];
#pragma unroll
                      for (int i = 0; i < 8; ++i) { const int r = min(rb + i * C.NGW, MERGE_ROWS - 1); const u32x4* s = (const u32x4*)(XB0 + (r0 + r) * DM) + 2 * C.lane; a[i] = s[0]; b[i] = s[1]; }
#pragma unroll
                      for (int i = 0; i < 8; ++i) { const int r = rb + i * C.NGW; if (r < MERGE_ROWS) {
                          u32x4 o; o.x = pg8::pk4_fp8(bflo(a[i].x), bfhi(a[i].x), bflo(a[i].y), bfhi(a[i].y)); o.y = pg8::pk4_fp8(bflo(a[i].z), bfhi(a[i].z), bflo(a[i].w), bfhi(a[i].w));
                          o.z = pg8::pk4_fp8(bflo(b[i].x), bfhi(b[i].x), bflo(b[i].y), bfhi(b[i].y)); o.w = pg8::pk4_fp8(bflo(b[i].z), bfhi(b[i].z), bflo(b[i].w), bfhi(b[i].w));
                          ((u32x4*)(X8 + (size_t)r * DM))[C.lane] = o; } } }
                  __syncthreads(); }
                pg8::Gemm g{Yb + r0 * DM, (const bf16_t*)(wl + OFF_WBR), MERGE_ROWS, 4096, 256, 1024, 256, 2, 512}; pg8::StaticOrder S; S.init(MERGE_ROWS, 4096, C.G, C.bid);
                pg8::EpiProj E{Ub, 4096, 0, 1.f, nullptr}; pg8::gemm_phase(C.lds, g, S, E); } PH_END
            PH_BEGIN SITE(14) { pg8::Gemm g{(const bf16_t*)(C.ws + WS_U + (size_t)MERGE_ROWS * 8192), (const bf16_t*)(wl + OFF_WG), MERGE_ROWS, 4096, 1024, 1024, 1024, big, 0}; pg8::StaticOrder S; S.init(MERGE_ROWS, 4096, C.G, C.bid);
                pg8::EpiGateMix E{Ub, XB1 + r0 * DM, 1.f / pg8::FP8_W1_SCALE}; pg8::gemm_phase<pg8::EpiGateMix, pg8::StaticOrder, true>(C.lds, g, S, E); } PH_END
        }
        PH_BEGIN SITE(15) { pg8::Gemm g{XB1, (const bf16_t*)(wl + OFF_WOUT), NTOK, 1024, 1024, 1024, 1024, big, 0}; pg8::StaticOrder S; S.init(NTOK, 1024, C.G, C.bid);
            pg8::EpiResid E{l == 0 ? C.A->in[0] : (const float*)C.out, l == 0 ? C.A->in[1] : (const float*)(C.out + (size_t)NTOKG * DM), (float*)C.out}; pg8::gemm_phase(C.lds, g, S, E); } PH_END
        PH_BEGIN SITE(16) { ph_ln<true>(C, l, 0, XB1); } PH_END
        PH_BEGIN SITE(17) { if (C.bid < 32 && C.G > 64) ph_topk(C); else expert_weight_items(C, l); if (C.G <= 64) { __syncthreads(); if (C.bid < 32) ph_topk(C); } } PH_END
        for (int k = 0; k < NEXP / EPB + 1; ++k) {
            PH_BEGIN SITE(18) {
                constexpr size_t H_B = (size_t)EPB * 16384 * 2048;
                unsigned char* Hb = (unsigned char*)(C.ws + WS_XB0);
                if (k < NEXP / EPB) { const int e0 = k * EPB;
                    pg8::Gemm g{(const bf16_t*)(C.ws + WS_XB1), (const bf16_t*)(C.ws + WS_EW + OFF_WGU8 + (size_t)e0 * 4096 * 1024), EPB * 16384, 4096, 1024, 1024, 1024, big, 0, 6, (size_t)4096 * 1024, (const int*)(C.ws + WS_IDX) + (size_t)e0 * 16384}; pg8::StaticOrder S; S.init(EPB * 16384, 4096, C.G, C.bid);
                    pg8::EpiSiluMul8 E{Hb + (size_t)(k & 1) * H_B, 2048}; pg8::gemm_phase<pg8::EpiSiluMul8, pg8::StaticOrder, true, true>(C.lds, g, S, E); }
                if (k >= 1) { const int e0 = (k - 1) * EPB; __syncthreads();
                    pg8::Gemm g{(const bf16_t*)(Hb + (size_t)((k - 1) & 1) * H_B), (const bf16_t*)(C.ws + WS_EW + OFF_WD8 + (size_t)e0 * 1024 * 2048), EPB * 16384, 1024, 2048, 2048, 2048, big, 0, 6, (size_t)1024 * 2048}; pg8::StaticOrder S; S.init(EPB * 16384, 1024, C.G, C.bid);
                    pg8::EpiYe E{(bf16_t*)(C.ws + WS_Y) + (size_t)e0 * 16384 * DM, (const float*)(C.ws + WS_GSEL) + (size_t)e0 * 16384, 1.f / (pg8::FP8_H_SCALE * pg8::FP8_W2_SCALE)}; pg8::gemm_phase<pg8::EpiYe, pg8::StaticOrder, true>(C.lds, g, S, E); }
            } PH_END
        }
        PH_BEGIN SITE(19) ph_ln<false>(C, l, 1, l + 1 < 2 ? XB0 : nullptr); PH_END
    }
#undef PH_BEGIN
#undef PH_END
#undef XB0
#undef XB1
#undef Yb
#undef Ub
#undef wl
}

extern "C" void kernel_launch(void* const* d_in, const int* in_sizes, int n_in, void* d_out, int out_size, void* d_ws, size_t ws_size, hipStream_t stream) {
    static int grid = 0;
    if (grid == 0) {
        if (n_in != 26 || out_size != NTOK * DM || ws_size < WS_END) { fprintf(stderr, "kernel_launch: unexpected shapes: n_in %d out %d ws %zu (need %zu)\n", n_in, out_size, ws_size, (size_t)WS_END); grid = -1; return; }
        int dev = 0, cus = 0, per_cu = 0;
        if (hipGetDevice(&dev) != hipSuccess || hipDeviceGetAttribute(&cus, hipDeviceAttributeMultiprocessorCount, dev) != hipSuccess) { grid = -1; return; }
        if (hipFuncSetAttribute((const void*)mk_fwd, hipFuncAttributeMaxDynamicSharedMemorySize, LDS_BYTES) != hipSuccess) { fprintf(stderr, "kernel_launch: hipFuncSetAttribute failed\n"); grid = -1; return; }
        if (hipOccupancyMaxActiveBlocksPerMultiprocessor(&per_cu, (const void*)mk_fwd, 512, LDS_BYTES) != hipSuccess || per_cu < 1) { fprintf(stderr, "kernel_launch: occupancy query says %d\n", per_cu); }
        (void)hipGetLastError();
        grid = cus;
    }
    if (grid < 0) return;
    if (hipMemsetAsync((char*)d_ws + WS_CTL, 0, CTL_ZERO_BYTES, stream) != hipSuccess) return;
    Args a{};
    for (int i = 0; i < 26; ++i) a.in[i] = (const float*)d_in[i];
    a.out = (float*)d_out; a.ws = (unsigned char*)d_ws;
#if MK_PER_PHASE_LAUNCH
    for (int p = 0; p < NPH; ++p) { a.ph_lo = p; a.ph_hi = p + 1; hipLaunchKernelGGL(mk_fwd, dim3(grid), dim3(512), LDS_BYTES, stream, a); }
#else
    a.ph_lo = 0; a.ph_hi = NPH; hipLaunchKernelGGL(mk_fwd, dim3(grid), dim3(512), LDS_BYTES, stream, a);
#endif
    const hipError_t le = hipPeekAtLastError();
    if (le != hipSuccess) fprintf(stderr, "kernel_launch: launch failed: %s\n", hipGetErrorName(le));
}
```

```cpp
#include <hip/hip_runtime.h>
#include <cstdio>
#include <cstdint>

#ifndef MK_PER_PHASE_LAUNCH
#define MK_PER_PHASE_LAUNCH 0
#endif

#define LAS __attribute__((address_space(3)))
#define GAS __attribute__((address_space(1)))
typedef unsigned short bf16_t;
typedef short bf16x8 __attribute__((ext_vector_type(8)));
typedef short s16x4 __attribute__((ext_vector_type(4)));
typedef float f32x2 __attribute__((ext_vector_type(2)));
typedef float f32x4 __attribute__((ext_vector_type(4)));
typedef float f32x16 __attribute__((ext_vector_type(16)));
typedef unsigned u32x2 __attribute__((ext_vector_type(2)));
typedef unsigned u32x4 __attribute__((ext_vector_type(4)));
#define DI __device__ __forceinline__
#define LDS_WAIT() asm volatile("s_waitcnt lgkmcnt(0)" ::: "memory")
#define VM_WAIT() asm volatile("s_waitcnt vmcnt(0)" ::: "memory")

constexpr int DM = 1024, NTOK = 131072, NTOKG = 65536, NSEQ = 40, NCHUNK = 1024  ;
constexpr int IN_W = 6992, COL_B = 768, COL_CD = 2048, COL_GATE = 2896;
constexpr int NEXP = 16, DEXP = 2048, CAP = 8192;
constexpr float ALPHA = 1.41421356237309515f, INV_ALPHA = 0.70710678118654752f;
constexpr float LOG2E = 1.4426950408889634f;
constexpr float LN_EPS = 1e-5f, RMS_EPS = 1e-6f;

constexpr size_t MiB = (size_t)1 << 20;
constexpr size_t WS_CTL = 0, CTL_ZERO_BYTES = 1 * MiB;
constexpr size_t WS_KN2 = 256 * 1024;
constexpr size_t WS_WSMALL = 2 * MiB, WSMALL_LAYER = 18 * MiB;
constexpr size_t OFF_WA = 0, OFF_WB = (size_t)768 * 1024 * 2, OFF_WCD = OFF_WB + (size_t)1280 * 1024 * 2, OFF_WG = OFF_WCD + (size_t)1024 * 1024 * 2,
                 OFF_WBR = OFF_WG + (size_t)4096 * 1024 * 2, OFF_WOUT = OFF_WBR + (size_t)4096 * 256 * 2;
static_assert(OFF_WOUT + (size_t)1024 * 1024 * 2 <= WSMALL_LAYER, "small weights");
constexpr size_t WS_WC = 38 * MiB, WC_LAYER = 256 * 1024;
constexpr size_t OFF_WQ = 0, OFF_WKV = 96 * 1024;
constexpr size_t WS_WRG = 39 * MiB;
constexpr size_t WS_AFF = 40 * MiB;
constexpr size_t WS_IDX = 48 * MiB, WS_GSEL = 49 * MiB;
constexpr size_t WS_GAM = 50 * MiB;
constexpr size_t WS_DC = 52 * MiB;
constexpr size_t WS_SM = 56 * MiB;
constexpr size_t WS_XB0 = 64 * MiB, WS_XB1 = 320 * MiB, WS_Y = 576 * MiB, WS_U = 832 * MiB, WS_EW = 1152 * MiB, WS_END = 1344 * MiB;
constexpr size_t OFF_QC = 0, OFF_KC = 48 * MiB, OFF_VC = 96 * MiB;
constexpr size_t OFF_WGU8 = 0, OFF_WD8 = (size_t)16 * 4096 * 1024;

DI unsigned f2bf(float f) { unsigned u = __builtin_bit_cast(unsigned, f); return (u + 0x7fffu + ((u >> 16) & 1u)) >> 16; }
DI unsigned pk2(float lo, float hi) { return f2bf(lo) | (f2bf(hi) << 16); }
DI float bf2f(unsigned short b) { return __builtin_bit_cast(float, ((unsigned)b) << 16); }
DI float bflo(unsigned w) { return __builtin_bit_cast(float, w << 16); }
DI float bfhi(unsigned w) { return __builtin_bit_cast(float, w & 0xffff0000u); }
DI unsigned cvt_pk_bf16(float lo, float hi) { unsigned r; asm volatile("v_cvt_pk_bf16_f32 %0, %1, %2" : "=v"(r) : "v"(lo), "v"(hi)); return r; }
typedef __bf16 bf16x2_t __attribute__((ext_vector_type(2)));
DI unsigned cvt_pk_bf16_b(float lo, float hi) { const f32x2 v = {lo, hi}; const bf16x2_t b = __builtin_convertvector(v, bf16x2_t); return __builtin_bit_cast(unsigned, b); }
DI float sigmoidf_(float x) { return __builtin_amdgcn_rcpf(1.0f + __builtin_amdgcn_exp2f(-x * LOG2E)); }
DI float siluf_(float x) { return x * sigmoidf_(x); }
DI float wave_sum(float v) {
#pragma unroll
    for (int o = 1; o < 64; o <<= 1) v += __shfl_xor(v, o);
    return v;
}
DI float wave_max(float v) {
#pragma unroll
    for (int o = 1; o < 64; o <<= 1) v = fmaxf(v, __shfl_xor(v, o));
    return v;
}
DI int seq_start_row(int s) { return s < 8 ? s * 8192 : 65536 + (s - 8) * 2048; }
DI int row_pos(int row) { return row < 65536 ? (row & 8191) : (row & 2047); }
DI int row_seq_begin(int row) { return row < 65536 ? (row & ~8191) : (row & ~2047); }
DI int row_seq_len(int row) { return row < 65536 ? 8192 : 2048; }

namespace pg8 {
constexpr int BM = 256, BK = 64, HALF = 128, HTB = HALF * BK * 2, STAGE_BYTES = 8 * HTB, NXCD = 8, WGM = 8;
DI int lds_byte(int r, int c) { const int st = (r >> 4) * 2 + (c >> 5), rr = r & 15, cc = c & 31, ob = rr * 64 + cc * 2; return st * 1024 + (ob ^ (((ob >> 9) & 1) << 5)); }
DI void stage_rc(int b, int& R, int& C) { const int st = b / 1024, sb = b % 1024, swz = sb ^ (((sb >> 9) & 1) << 5); R = (st >> 1) * 16 + swz / 64; C = (st & 1) * 32 + (swz % 64) / 2; }
DI int perm32(int rho) { const int n = rho >> 4, i = rho & 15; return 8 * (i >> 2) + 4 * n + (i & 3); }

struct Unit { int pm, pn; };
struct Gemm { const bf16_t* A; const bf16_t* Bt; int M, N, K, lda, ldb, an_shift; size_t an_off; int bm_shift = 30; size_t bm_off = 0; const int* gidx = nullptr; };

struct StaticOrder {
    int nM, nN, nwg, G, c;
    DI void init(int M, int N, int G_, int c_) { nM = M / BM; nN = N / BM; nwg = nM * nN; G = G_; c = c_; }
    DI bool next(int i, Unit& u) const {
        const long L = (long)i * G + c; if (L >= nwg) return false;
        int wgid = (int)L; { const int q = nwg / NXCD, r = nwg % NXCD, xcd = wgid % NXCD, off = wgid / NXCD; wgid = (xcd < r ? xcd * (q + 1) : r * (q + 1) + (xcd - r) * q) + off; }
        const int nig = WGM * nN, gid = wgid / nig, fm = gid * WGM, gsz = (nM - fm) < WGM ? (nM - fm) : WGM;
        u.pm = fm + ((wgid % nig) % gsz); u.pn = (wgid % nig) / gsz; return true;
    }
};

typedef f32x4 Acc[2][2][4][2];

typedef int v8i_t __attribute__((ext_vector_type(8)));
DI void mfma8_tied(f32x4& c, const v8i_t& a, const v8i_t& b) { asm volatile("v_mfma_f32_16x16x128_f8f6f4 %0, %1, %2, %0" : "+v"(c) : "v"(a), "v"(b)); }
DI void glds_sv(const void* sbase, unsigned voff, unsigned lds_dst) { unsigned keep;
    asm volatile("s_mov_b32 %0, m0\n\ts_mov_b32 m0, %3\n\ts_nop 0\n\tglobal_load_lds_dwordx4 %1, %2\n\ts_mov_b32 m0, %0" : "=&s"(keep) : "v"(voff), "s"(sbase), "s"(lds_dst) : "memory"); }
constexpr int GIDX_OFF = 131072 + 1024, GIDX_TILES = 14;
template <class Epi, class Sched, bool FP8 = false, bool GATHER = false>
DI void gemm_phase(LAS unsigned char* lds, const Gemm g, const Sched& S, const Epi& E) {
    int tid = threadIdx.x; asm volatile("" : "+v"(tid));
    const int wid = __builtin_amdgcn_readfirstlane(tid >> 6), lane = tid & 63, wr = wid >> 2, wc = wid & 3, fr = lane & 15, fq = lane >> 4;
    const int K = g.K, nt = FP8 ? K / 128 : K / BK;
    const int pitchA = FP8 ? g.lda : g.lda * 2, pitchB = FP8 ? g.ldb : g.ldb * 2;
    unsigned voffA[2], voffB[2];
#pragma unroll
    for (int i = 0; i < 2; ++i) { int R, C; stage_rc(tid * 16 + i * 8192, R, C); const int Rb = Epi::PERM ? ((R & ~31) + perm32(R & 31)) : R;
        voffA[i] = (unsigned)(R * pitchA + C * 2); voffB[i] = (unsigned)(Rb * pitchB + C * 2); }
    const size_t kstep = (size_t)(BK * 2);
    const size_t hstepA = (size_t)HALF * pitchA, hstepB = (size_t)HALF * pitchB;
    const size_t tstepA = 2 * hstepA, tstepB = 2 * hstepB;
    const unsigned ldsw = (unsigned)wid * 1024u;
    const int aoff = lds_byte(wr * 64 + fr, fq * 8), boff = lds_byte(wc * 32 + fr, fq * 8);
#define PG8_SA(b, h) (((b) * 2 + (h)) * HTB)
#define PG8_SB(b, h) ((4 + (b) * 2 + (h)) * HTB)
#define PG8_STAGE(bufoff, gbase, voff) do { _Pragma("unroll") for (int _i = 0; _i < 2; ++_i) \
        glds_sv((const void*)(gbase), (voff)[_i], (unsigned)(uintptr_t)(lds + (bufoff) + ldsw + _i * 8192)); } while (0)
#define PG8_LD1(p) ([&]() { if constexpr (FP8) { const u32x4 lo_ = *(const LAS u32x4*)(p), hi_ = *(const LAS u32x4*)((p) + 1024); return Frag{__builtin_bit_cast(v8i_t, __builtin_shufflevector(lo_, hi_, 0, 1, 2, 3, 4, 5, 6, 7))}; } \
        else { Frag f_; f_.h[0] = *(const LAS bf16x8*)(p); f_.h[1] = *(const LAS bf16x8*)((p) + 1024); return f_; } }())
#define PG8_LDA(dst, b, h) do { _Pragma("unroll") for (int m = 0; m < 4; ++m) dst[m] = PG8_LD1(lds + PG8_SA(b, h) + aoff + m * 2048); } while (0)
#define PG8_LDB(dst, b, h) do { _Pragma("unroll") for (int n = 0; n < 2; ++n) dst[n] = PG8_LD1(lds + PG8_SB(b, h) + boff + n * 2048); } while (0)
#define PG8_MMA(ai, bj, At, Bt) do { __builtin_amdgcn_s_setprio(1); _Pragma("unroll") for (int m = 0; m < 4; ++m) _Pragma("unroll") for (int n = 0; n < 2; ++n) { \
        if constexpr (FP8) mfma8_tied(acc[ai][bj][m][n], Bt[n].w, At[m].w); \
        else { _Pragma("unroll") for (int k = 0; k < 2; ++k) acc[ai][bj][m][n] = __builtin_amdgcn_mfma_f32_16x16x32_bf16(Bt[n].h[k], At[m].h[k], acc[ai][bj][m][n], 0, 0, 0); } } \
        __builtin_amdgcn_s_setprio(0); } while (0)
#define PG8_WAIT_V(n) asm volatile("s_waitcnt vmcnt(" #n ")" ::: "memory")
#define PG8_WAIT_L(n) asm volatile("s_waitcnt lgkmcnt(" #n ")" ::: "memory")
#define PG8_BAR __builtin_amdgcn_s_barrier()
#define PG8_SCHED __builtin_amdgcn_sched_barrier(0)
    Unit cur, nxt; int ui = 0;
    unsigned vg[2][2] = {{0u, 0u}, {0u, 0u}};
    if constexpr (GATHER) { LAS unsigned* tab = (LAS unsigned*)(lds + GIDX_OFF); Unit u_;
        for (int i = 0; i < GIDX_TILES && S.next(i, u_); ++i) { if (tid < 256) tab[i * 256 + tid] = (unsigned)g.gidx[u_.pm * BM + tid]; }
        __syncthreads(); }
#define PG8_GOFF(ord) do { int tq_ = tid; asm volatile("" : "+v"(tq_)); int R_, C_; stage_rc(tq_ * 16, R_, C_); const LAS unsigned* tb_ = (const LAS unsigned*)(lds + GIDX_OFF) + (ord) * 256 + R_; \
        _Pragma("unroll") for (int h_ = 0; h_ < 2; ++h_) _Pragma("unroll") for (int i_ = 0; i_ < 2; ++i_) vg[h_][i_] = tb_[h_ * 128 + i_ * 64] * (unsigned)pitchA + (unsigned)(C_ * 2); } while (0)
#define PG8_STAGE_A(bufoff, base, h) do { if constexpr (GATHER) PG8_STAGE(bufoff, base, vg[h]); else PG8_STAGE(bufoff, (base) + (h) * hstepA, voffA); } while (0)
    if (!S.next(0, cur)) return;
    if constexpr (GATHER) PG8_GOFF(0);
    float zf = 0.f; asm volatile("" : "+v"(zf));
    Acc acc;
#pragma unroll
    for (int a = 0; a < 2; ++a)
#pragma unroll
        for (int b = 0; b < 2; ++b)
#pragma unroll
            for (int m = 0; m < 4; ++m)
#pragma unroll
                for (int n = 0; n < 2; ++n) acc[a][b][m][n] = (f32x4){zf, zf, zf, zf};
    union Frag { v8i_t w; bf16x8 h[2]; };
    Frag At[4], B0[2], B1[2];
    const char* cA = GATHER ? (const char*)g.A : (const char*)g.A + (size_t)cur.pm * tstepA + (size_t)(cur.pn >> g.an_shift) * g.an_off; const char* cB = (const char*)g.Bt + (size_t)cur.pn * tstepB + (size_t)(cur.pm >> g.bm_shift) * g.bm_off;
    PG8_STAGE(PG8_SB(0, 0), cB, voffB); PG8_STAGE(PG8_SB(0, 1), cB + hstepB, voffB); PG8_STAGE_A(PG8_SA(0, 0), cA, 0); PG8_STAGE_A(PG8_SA(0, 1), cA, 1);
    if (wr == 1) PG8_BAR;
    PG8_WAIT_V(2); PG8_BAR;
    PG8_STAGE(PG8_SB(1, 0), cB + kstep, voffB); PG8_STAGE_A(PG8_SA(1, 0), cA + kstep, 0); PG8_STAGE(PG8_SB(1, 1), cB + hstepB + kstep, voffB);
    PG8_WAIT_V(6); PG8_BAR;
    for (;;) {
        const bool has_next = S.next(ui + 1, nxt);
        const char* nA = (has_next && !GATHER) ? (const char*)g.A + (size_t)nxt.pm * tstepA + (size_t)(nxt.pn >> g.an_shift) * g.an_off : cA;
        const char* nB = has_next ? (const char*)g.Bt + (size_t)nxt.pn * tstepB + (size_t)(nxt.pm >> g.bm_shift) * g.bm_off : cB;
#pragma unroll 1
        for (int t = 0; t < nt; t += 2) {
            const bool last = (t == nt - 2);
            const char* a1 = cA + (size_t)(t + 1) * kstep;
            const char* a2 = last ? nA : cA + (size_t)(t + 2) * kstep; const char* b2 = last ? nB : cB + (size_t)(t + 2) * kstep;
            const char* a3 = a2 + kstep; const char* b3 = b2 + kstep;
            PG8_LDB(B0, 0, 0); PG8_LDB(B1, 0, 1); PG8_SCHED; PG8_LDA(At, 0, 0); PG8_STAGE_A(PG8_SA(1, 1), a1, 1);
            if constexpr (GATHER) { if (last && has_next) PG8_GOFF(ui + 1); }
            PG8_WAIT_V(8); PG8_WAIT_L(0); PG8_BAR; PG8_MMA(0, 0, At, B0); PG8_MMA(0, 1, At, B1); PG8_BAR; PG8_SCHED;
            PG8_LDA(At, 0, 1); PG8_STAGE(PG8_SB(0, 0), b2, voffB); PG8_STAGE(PG8_SB(0, 1), b2 + hstepB, voffB); PG8_STAGE_A(PG8_SA(0, 0), a2, 0);
            PG8_WAIT_V(8); PG8_WAIT_L(0); PG8_BAR; PG8_MMA(1, 0, At, B0); PG8_MMA(1, 1, At, B1); PG8_BAR; PG8_SCHED;
            PG8_LDB(B0, 1, 0); PG8_LDB(B1, 1, 1); PG8_SCHED; PG8_LDA(At, 1, 0); PG8_STAGE_A(PG8_SA(0, 1), a2, 1);
            PG8_WAIT_V(8); PG8_WAIT_L(0); PG8_BAR; PG8_MMA(0, 0, At, B0); PG8_MMA(0, 1, At, B1); PG8_BAR; PG8_SCHED;
            PG8_LDA(At, 1, 1); PG8_STAGE(PG8_SB(1, 0), b3, voffB); PG8_STAGE(PG8_SB(1, 1), b3 + hstepB, voffB); PG8_STAGE_A(PG8_SA(1, 0), a3, 0);
            PG8_WAIT_V(8); PG8_WAIT_L(0); PG8_BAR; PG8_MMA(1, 0, At, B0); PG8_MMA(1, 1, At, B1); PG8_BAR; PG8_SCHED;
        }
        if (wr == 0) PG8_BAR;
        if constexpr (FP8) asm volatile("s_nop 15\n\ts_nop 15" ::: "memory");
        { int tz = tid; asm volatile("" : "+v"(tz));
          const int lz = tz & 63; E(acc, cur, wr, wc, lz & 15, lz >> 4); }
        if (!has_next) break;
#pragma unroll
        for (int a = 0; a < 2; ++a)
#pragma unroll
            for (int b = 0; b < 2; ++b)
#pragma unroll
                for (int m = 0; m < 4; ++m)
#pragma unroll
                    for (int n = 0; n < 2; ++n) acc[a][b][m][n] = (f32x4){0.f, 0.f, 0.f, 0.f};
        cur = nxt; cA = nA; cB = nB; ++ui;
        if (wr == 1) PG8_BAR;
    }
    PG8_WAIT_V(0);
    PG8_BAR;
#undef PG8_SA
#undef PG8_SB
#undef PG8_STAGE
#undef PG8_STAGE_A
#undef PG8_GOFF
#undef PG8_LDA
#undef PG8_LDB
#undef PG8_MMA
#undef PG8_LD1
#undef PG8_WAIT_V
#undef PG8_WAIT_L
#undef PG8_BAR
#undef PG8_SCHED
}

struct EpiProj {
    static constexpr bool PERM = true;
    bf16_t* O; int ldc; int scale_cols; float scale; unsigned* kn2;
    DI void operator()(const Acc& acc, const Unit& u, int wr, int wc, int fr, int fq) const {
        const int row0 = u.pm * BM + wr * 64 + fr, colt = u.pn * BM, col0 = colt + wc * 32 + 8 * fq;
        const float sc = (colt < scale_cols) ? scale : 1.f;
        const bool donorm = (kn2 != nullptr) && (colt == 256);
#pragma unroll
        for (int ai = 0; ai < 2; ++ai) { float mx0 = 0.f, mx1 = 0.f;
#pragma unroll
            for (int m = 0; m < 4; ++m) { bf16_t* rowp = O + (size_t)(row0 + ai * HALF + m * 16) * ldc + col0;
#pragma unroll
                for (int bj = 0; bj < 2; ++bj) { const f32x4 v0 = acc[ai][bj][m][0] * sc, v1 = acc[ai][bj][m][1] * sc;
                    u32x4 w; w.x = cvt_pk_bf16(v0[0], v0[1]); w.y = cvt_pk_bf16(v0[2], v0[3]); w.z = cvt_pk_bf16(v1[0], v1[1]); w.w = cvt_pk_bf16(v1[2], v1[3]);
                    *(u32x4*)(rowp + bj * HALF) = w;
                    if (donorm) { float ss = bflo(w.x) * bflo(w.x) + bfhi(w.x) * bfhi(w.x) + bflo(w.y) * bflo(w.y) + bfhi(w.y) * bfhi(w.y) + bflo(w.z) * bflo(w.z) + bfhi(w.z) * bfhi(w.z) + bflo(w.w) * bflo(w.w) + bfhi(w.w) * bfhi(w.w);
                        ss += __shfl_xor(ss, 16); ss += __shfl_xor(ss, 32); if (bj == 0) mx0 = fmaxf(mx0, ss); else mx1 = fmaxf(mx1, ss); } } }
            if (donorm) {
#pragma unroll
                for (int o = 1; o < 16; o <<= 1) { mx0 = fmaxf(mx0, __shfl_xor(mx0, o)); mx1 = fmaxf(mx1, __shfl_xor(mx1, o)); }
                if (fr == 0 && fq == 0) { const int tile = 4 * u.pm + 2 * ai + wr;
                    atomicMax(kn2 + (size_t)(wc) * 2048 + tile, __builtin_bit_cast(unsigned, mx0)); atomicMax(kn2 + (size_t)(4 + wc) * 2048 + tile, __builtin_bit_cast(unsigned, mx1)); } } }
    }
};
struct EpiSiluMul {
    static constexpr bool PERM = true;
    bf16_t* H; int ldh;
    DI void operator()(const Acc& acc, const Unit& u, int wr, int wc, int fr, int fq) const {
        const int row0 = u.pm * BM + wr * 64 + fr, col0 = u.pn * HALF + wc * 32 + 8 * fq;
#pragma unroll
        for (int ai = 0; ai < 2; ++ai)
#pragma unroll
            for (int m = 0; m < 4; ++m) { bf16_t* rowp = H + (size_t)(row0 + ai * HALF + m * 16) * ldh + col0;
                float h[8];
#pragma unroll
                for (int n = 0; n < 2; ++n)
#pragma unroll
                    for (int j = 0; j < 4; ++j) h[n * 4 + j] = siluf_(acc[ai][0][m][n][j]) * acc[ai][1][m][n][j];
                u32x4 w; w.x = cvt_pk_bf16(h[0], h[1]); w.y = cvt_pk_bf16(h[2], h[3]); w.z = cvt_pk_bf16(h[4], h[5]); w.w = cvt_pk_bf16(h[6], h[7]);
                *(u32x4*)rowp = w; }
    }
};
DI unsigned pk4_fp8(float a, float b, float c, float d) { int w = 0; a = __builtin_amdgcn_fmed3f(a, -448.f, 448.f); b = __builtin_amdgcn_fmed3f(b, -448.f, 448.f); c = __builtin_amdgcn_fmed3f(c, -448.f, 448.f); d = __builtin_amdgcn_fmed3f(d, -448.f, 448.f);     w = __builtin_amdgcn_cvt_pk_fp8_f32(a, b, w, false); w = __builtin_amdgcn_cvt_pk_fp8_f32(c, d, w, true); return (unsigned)w; }
constexpr float FP8_W1_SCALE = 32.f, FP8_W2_SCALE = 64.f, FP8_H_SCALE = 4.f;
struct EpiSiluMul8 {
    static constexpr bool PERM = true;
    unsigned char* H; int ldh;
    DI void operator()(const Acc& acc, const Unit& u, int wr, int wc, int fr, int fq) const {
        const int row0 = u.pm * BM + wr * 64 + fr, col0 = u.pn * HALF + wc * 32 + 8 * fq;
        constexpr float k1 = -LOG2E / FP8_W1_SCALE; static_assert(FP8_W1_SCALE * FP8_W1_SCALE / FP8_H_SCALE == 256.f, "scale folding");
#pragma unroll
        for (int ai = 0; ai < 2; ++ai)
#pragma unroll
            for (int m = 0; m < 4; ++m) { unsigned char* rowp = H + (size_t)(row0 + ai * HALF + m * 16) * ldh + col0;
                float t[8], h[8];
#pragma unroll
                for (int q = 0; q < 8; ++q) t[q] = __builtin_fmaf(acc[ai][0][m][q >> 2][q & 3], k1, 8.f);
#pragma unroll
                for (int q = 0; q < 8; ++q) t[q] = __builtin_amdgcn_exp2f(t[q]);
#pragma unroll
                for (int q = 0; q < 8; ++q) { t[q] += 256.f; h[q] = acc[ai][0][m][q >> 2][q & 3] * acc[ai][1][m][q >> 2][q & 3]; }
#pragma unroll
                for (int q = 0; q < 8; ++q) t[q] = __builtin_amdgcn_rcpf(t[q]);
#pragma unroll
                for (int q = 0; q < 8; ++q) h[q] *= t[q];
                u32x2 w; w.x = pk4_fp8(h[0], h[1], h[2], h[3]); w.y = pk4_fp8(h[4], h[5], h[6], h[7]);
                *(u32x2*)rowp = w; }
    }
};
struct EpiMoeDown {
    static constexpr bool PERM = false;
    float* out; const int* idx; const float* gs; float sc;
    DI void operator()(const Acc& acc, const Unit& u, int wr, int wc, int fr, int fq) const {
        const int row0 = u.pm * BM + wr * 64 + fr, col0 = u.pn * BM + wc * 32 + 4 * fq;
#pragma unroll
        for (int ai = 0; ai < 2; ++ai)
#pragma unroll
            for (int m = 0; m < 4; ++m) { const int rl = row0 + ai * HALF + m * 16; const int tok = idx[rl]; const float g = gs[rl] * sc;
                float* rowp = out + (size_t)tok * DM + col0;
#pragma unroll
                for (int bj = 0; bj < 2; ++bj)
#pragma unroll
                    for (int n = 0; n < 2; ++n) { f32x4* p = (f32x4*)(rowp + bj * HALF + n * 16); f32x4 v = *p; v += acc[ai][bj][m][n] * g; *p = v; }
                asm volatile("" ::: "memory"); }
    }
};
struct EpiYe {
    static constexpr bool PERM = true;
    bf16_t* O; const float* gs; float sc;
    DI void operator()(const Acc& acc, const Unit& u, int wr, int wc, int fr, int fq) const {
        const int row0 = u.pm * BM + wr * 64 + fr, col0 = u.pn * BM + wc * 32 + 8 * fq;
        float gv[8];
#pragma unroll
        for (int c = 0; c < 8; ++c) gv[c] = gs[row0 + (c >> 2) * HALF + (c & 3) * 16];
#pragma unroll
        for (int ai = 0; ai < 2; ++ai)
#pragma unroll
            for (int m = 0; m < 4; ++m) { const int rl = row0 + ai * HALF + m * 16; const float g = gv[ai * 4 + m] * sc; bf16_t* rowp = O + (size_t)rl * DM + col0;
#pragma unroll
                for (int bj = 0; bj < 2; ++bj) { const f32x4 v0 = acc[ai][bj][m][0] * g, v1 = acc[ai][bj][m][1] * g;
                    u32x4 w; w.x = cvt_pk_bf16(v0[0], v0[1]); w.y = cvt_pk_bf16(v0[2], v0[3]); w.z = cvt_pk_bf16(v1[0], v1[1]); w.w = cvt_pk_bf16(v1[2], v1[3]);
                    *(u32x4*)(rowp + bj * HALF) = w; } }
    }
};
struct EpiResid {
    static constexpr bool PERM = false;
    const float* xa; const float* xb; float* out;
    DI void operator()(const Acc& acc, const Unit& u, int wr, int wc, int fr, int fq) const {
        const int row0 = u.pm * BM + wr * 64 + fr, col0 = u.pn * BM + wc * 32 + 4 * fq;
#pragma unroll
        for (int ai = 0; ai < 2; ++ai) {
            f32x4 sv[4][4];
#pragma unroll
            for (int m = 0; m < 4; ++m) { const int r = row0 + ai * HALF + m * 16;
                const float* srow = (r < NTOKG ? xa + (size_t)r * DM : xb + (size_t)(r - NTOKG) * DM) + col0;
#pragma unroll
                for (int q = 0; q < 4; ++q) sv[m][q] = *(const f32x4*)(srow + (q >> 1) * HALF + (q & 1) * 16); }
#pragma unroll
            for (int m = 0; m < 4; ++m) { const int r = row0 + ai * HALF + m * 16; float* orow = out + (size_t)r * DM + col0;
#pragma unroll
                for (int q = 0; q < 4; ++q) *(f32x4*)(orow + (q >> 1) * HALF + (q & 1) * 16) = sv[m][q] + acc[ai][q >> 1][m][q & 1] * INV_ALPHA; } }
    }
};
struct EpiGateMix {
    static constexpr bool PERM = false;
    const bf16_t* Z; bf16_t* mix; float si;
    DI void operator()(const Acc& acc, const Unit& u, int wr, int wc, int fr, int fq) const {
        const int row0 = u.pm * BM + wr * 64 + fr, J0 = u.pn * 64 + wc * 16 + fq * 4;
        u32x2 zall[8][4];
#pragma unroll
        for (int c = 0; c < 8; ++c) { const bf16_t* zrow = Z + (size_t)(row0 + (c >> 2) * HALF + (c & 3) * 16) * 4096 + J0;
#pragma unroll
            for (int b = 0; b < 4; ++b) zall[c][b] = *(const u32x2*)(zrow + b * 1024); }
#pragma unroll
        for (int ai = 0; ai < 2; ++ai)
#pragma unroll
            for (int m = 0; m < 4; ++m) { const int r = row0 + ai * HALF + m * 16;
                u32x2 zw[4];
#pragma unroll
                for (int b = 0; b < 4; ++b) zw[b] = zall[ai * 4 + m][b];
                const float kq = -si * LOG2E; float t[16];
#pragma unroll
                for (int q = 0; q < 16; ++q) t[q] = acc[ai][q >> 3][m][(q >> 2) & 1][q & 3] * kq;
#pragma unroll
                for (int q = 0; q < 16; ++q) t[q] = __builtin_amdgcn_exp2f(t[q]);
#pragma unroll
                for (int q = 0; q < 16; ++q) t[q] += 1.f;
#pragma unroll
                for (int q = 0; q < 16; ++q) t[q] = __builtin_amdgcn_rcpf(t[q]);
                f32x4 s = (f32x4){0.f, 0.f, 0.f, 0.f};
#pragma unroll
                for (int b = 0; b < 4; ++b) { s[0] += t[4 * b] * bflo(zw[b].x); s[1] += t[4 * b + 1] * bfhi(zw[b].x); s[2] += t[4 * b + 2] * bflo(zw[b].y); s[3] += t[4 * b + 3] * bfhi(zw[b].y); }
                u32x2 w; w.x = cvt_pk_bf16(s[0], s[1]); w.y = cvt_pk_bf16(s[2], s[3]);
                *(u32x2*)(mix + (size_t)r * DM + J0) = w; }
    }
};
}

#define XB_TMO      128
#define XB_XCNT(j)  (256  + 64 * (j))
#define XB_XSUB(j)  (1280 + 64 * (j))
#define XB_XGEN(j)  (2304 + 64 * (j))
#define XB_TOP      3328
#define XB_TOPGEN   3392
#define XCD_BAR_WORDS 3456
#define XB_SPIN_CAP (1u << 24)
DI unsigned xb_ld(unsigned* p)              { return __hip_atomic_load(p, __ATOMIC_RELAXED, __HIP_MEMORY_SCOPE_AGENT); }
DI unsigned xb_add(unsigned* p, unsigned v) { return __hip_atomic_fetch_add(p, v, __ATOMIC_RELAXED, __HIP_MEMORY_SCOPE_AGENT); }
DI unsigned xb_xcc_id() { return (unsigned)__builtin_amdgcn_s_getreg((3 << 11) | 20) & 0xFu; }
#define XB_SPIN(cond, bar) do { unsigned _sp = 0; while (cond) { __builtin_amdgcn_s_sleep(1); \
    if ((++_sp & 255u) == 0u) { if (xb_ld(&(bar)[XB_TMO])) break; if (_sp > XB_SPIN_CAP) { atomicAdd(&(bar)[XB_TMO], 1u); break; } } } } while (0)
struct XcdBarrier { unsigned* bar; unsigned x; volatile LAS unsigned* st; };
DI XcdBarrier xcd_barrier_post(unsigned* bar, volatile LAS unsigned* st) {
    XcdBarrier b; b.bar = bar; b.x = xb_xcc_id(); b.st = st;
    if (threadIdx.x == 0) (void)xb_add(&bar[XB_XCNT(b.x)], 1u);
    return b;
}
DI void xcd_barrier_complete(unsigned* bar, unsigned x, unsigned& nloc, unsigned& nx) {
    const unsigned G = gridDim.x * gridDim.y * gridDim.z;
    unsigned sum, cnt, mine, sp = 0u;
    for (;;) {
        sum = 0u; cnt = 0u; mine = 0u;
#pragma unroll
        for (unsigned j = 0; j < 16; ++j) { const unsigned c = xb_ld(&bar[XB_XCNT(j)]); sum += c; cnt += (c > 0u) ? 1u : 0u; mine = (j == x) ? c : mine; }
        if (sum == G) break;
        __builtin_amdgcn_s_sleep(1);
        if ((++sp & 255u) == 0u) { if (xb_ld(&bar[XB_TMO])) break; if (sp > XB_SPIN_CAP) { atomicAdd(&bar[XB_TMO], 1u); break; } }
    }
    nloc = mine > 0u ? mine : 1u; nx = cnt > 0u ? cnt : 1u;
}
DI void xcd_barrier(const XcdBarrier& b) {
    asm volatile("s_waitcnt vmcnt(0)" ::: "memory");
    __syncthreads();
    if (threadIdx.x == 0) {
        unsigned* bar = b.bar;
        __builtin_amdgcn_s_waitcnt(0);
        unsigned nloc = b.st[0], nx = b.st[1];
        if (nloc == 0u) { xcd_barrier_complete(bar, b.x, nloc, nx); b.st[0] = nloc; b.st[1] = nx; }
        const unsigned old = xb_add(&bar[XB_XSUB(b.x)], 1u);
        const unsigned gen = old / nloc;
        if (old + 1u == (gen + 1u) * nloc) {
            __builtin_amdgcn_fence(__ATOMIC_RELEASE, "agent");
            asm volatile("s_waitcnt vmcnt(0)" ::: "memory");
            const unsigned og = xb_add(&bar[XB_TOP], 1u);
            const unsigned tg = og / nx;
            if (og + 1u == (tg + 1u) * nx) xb_add(&bar[XB_TOPGEN], 1u);
            else XB_SPIN(xb_ld(&bar[XB_TOPGEN]) == tg, bar);
            __builtin_amdgcn_fence(__ATOMIC_ACQUIRE, "agent");
            xb_add(&bar[XB_XGEN(b.x)], 1u);
            asm volatile("s_waitcnt vmcnt(0)" ::: "memory");
        } else {
            XB_SPIN(xb_ld(&bar[XB_XGEN(b.x)]) == gen, bar);
            __builtin_amdgcn_fence(__ATOMIC_ACQUIRE, "agent");
            asm volatile("s_waitcnt vmcnt(0)" ::: "memory");
        }
    }
    __syncthreads();
}

struct Args { const float* in[26]; float* out; unsigned char* ws; int ph_lo, ph_hi; };
struct Ctx {
    LAS unsigned char* lds;
    GAS unsigned char* ws;
    int tid, lane, wave, G, bid, gw, NGW;
    const struct Args* A;
    GAS float* out;
};
constexpr int RING_BYTES = 131072, MISC_OFF = RING_BYTES + 320, LDS_BYTES = 147456;

DI void tr_item(const float* __restrict__ W, int ldw, int k0, int src, const float* kscale, bf16_t* WT, int ldt, int orow0, LAS float* scr, int lane) {
    float tv[32];
#pragma unroll
    for (int i = 0; i < 32; ++i) { const int kk = 2 * i + (lane >> 5); tv[i] = (src >= 0) ? W[(size_t)(k0 + kk) * ldw + src] : 0.f; }
#pragma unroll
    for (int i = 0; i < 32; ++i) { const int kk = 2 * i + (lane >> 5); float v = tv[i]; if (kscale) v *= kscale[k0 + kk]; scr[kk * 33 + (lane & 31)] = v; }
    LDS_WAIT();
    const int c = lane & 7;
#pragma unroll
    for (int j = 0; j < 4; ++j) { const int n = (lane >> 3) + 8 * j; const LAS float* s = scr + (8 * c) * 33 + n;
        u32x4 o; o.x = pk2(s[0 * 33], s[1 * 33]); o.y = pk2(s[2 * 33], s[3 * 33]); o.z = pk2(s[4 * 33], s[5 * 33]); o.w = pk2(s[6 * 33], s[7 * 33]);
        *(u32x4*)(WT + (size_t)(orow0 + n) * ldt + k0 + 8 * c) = o; }
    LDS_WAIT();
}
DI void tr_item8(const float* __restrict__ W, int ldw, int k0, int src, float scale, unsigned char* WT, int ldt, int orow0, LAS float* scr, int lane) {
    float tv[32];
#pragma unroll
    for (int i = 0; i < 32; ++i) { const int kk = 2 * i + (lane >> 5); tv[i] = W[(size_t)(k0 + kk) * ldw + src]; }
#pragma unroll
    for (int i = 0; i < 32; ++i) { const int kk = 2 * i + (lane >> 5); scr[kk * 33 + (lane & 31)] = tv[i] * scale; }
    LDS_WAIT();
    const int c = lane & 7;
#pragma unroll
    for (int j = 0; j < 4; ++j) { const int n = (lane >> 3) + 8 * j; const LAS float* s = scr + (8 * c) * 33 + n;
        u32x2 o; o.x = pg8::pk4_fp8(s[0 * 33], s[1 * 33], s[2 * 33], s[3 * 33]); o.y = pg8::pk4_fp8(s[4 * 33], s[5 * 33], s[6 * 33], s[7 * 33]);
        *(u32x2*)(WT + (size_t)(orow0 + n) * ldt + k0 + 8 * c) = o; }
    LDS_WAIT();
}
constexpr int SW_ITEMS[8] = {16 * 24, 16 * 40, 16 * 32, 16 * 128, 4 * 4 * 32, 16 * 32, 3 * 6, 2 * 12};
constexpr int SW_TOTAL = 16 * 24 + 16 * 40 + 16 * 32 + 16 * 128 + 4 * 4 * 32 + 16 * 32 + 3 * 6 + 2 * 12;
DI void small_weight_item(const Ctx& C, int l, int it, LAS float* scr) {
    unsigned char* wl = (unsigned char*)(C.ws + WS_WSMALL + (size_t)l * WSMALL_LAYER); unsigned char* wc = (unsigned char*)(C.ws + WS_WC + (size_t)l * WC_LAYER);
    const float* win = C.A->in[2] + (size_t)l * DM * IN_W; const int ln = C.lane & 31;
    if (it < 384) { const int kb = it / 24, nb = it % 24; tr_item(win, IN_W, kb * 64, nb * 32 + ln, nullptr, (bf16_t*)(wl + OFF_WA), 1024, nb * 32, scr, C.lane); return; } it -= 384;
    if (it < 640) { const int kb = it / 40, nb = it % 40; tr_item(win, IN_W, kb * 64, COL_B + nb * 32 + ln, nullptr, (bf16_t*)(wl + OFF_WB), 1024, nb * 32, scr, C.lane); return; } it -= 640;
    if (it < 512) { const int kb = it / 32, nb = it % 32; const int n = nb * 32 + ln; tr_item(win, IN_W, kb * 64, n < 848 ? COL_CD + n : -1, nullptr, (bf16_t*)(wl + OFF_WCD), 1024, nb * 32, scr, C.lane); return; } it -= 512;
    if (it < 2048) { const int kb = it / 128, nb = it % 128; const int n = nb * 32 + ln, pn = n >> 8, c = n & 255;
        const int bj = c >> 7, wcc = (c >> 5) & 3, nn = (c >> 4) & 1, fq = (c >> 2) & 3, j = c & 3;
        const int src = COL_GATE + (2 * bj + nn) * 1024 + 64 * pn + 16 * wcc + 4 * fq + j;
        tr_item8(win, IN_W, kb * 64, src, pg8::FP8_W1_SCALE, wl + OFF_WG, 1024, nb * 32, scr, C.lane); return; } it -= 2048;
    if (it < 512) { const int b = it / 128, r = it % 128, kb = r / 32, nb = r % 32;
        tr_item(C.A->in[18] + (size_t)(l * 4 + b) * 256 * 1024, 1024, kb * 64, nb * 32 + ln, nullptr, (bf16_t*)(wl + OFF_WBR), 256, b * 1024 + nb * 32, scr, C.lane); return; } it -= 512;
    if (it < 512) { const int kb = it / 32, nb = it % 32; tr_item(C.A->in[19] + (size_t)l * DM * DM, 1024, kb * 64, nb * 32 + ln, nullptr, (bf16_t*)(wl + OFF_WOUT), 1024, nb * 32, scr, C.lane); return; } it -= 512;
    if (it < 18) { const int kb = it / 6, nb = it % 6; tr_item(C.A->in[8] + (size_t)l * 192 * 192, 192, kb * 64, nb * 32 + ln, C.A->in[7] + l * 192, (bf16_t*)(wc + OFF_WQ), 192, nb * 32, scr, C.lane); return; } it -= 18;
    { const int kb = it / 12, nb = it % 12; tr_item(C.A->in[10] + (size_t)l * 128 * 384, 384, kb * 64, nb * 32 + ln, C.A->in[9] + l * 128, (bf16_t*)(wc + OFF_WKV), 128, nb * 32, scr, C.lane); }
}
DI void ph_prologue(const Ctx& C) {
    LAS float* scr = (LAS float*)(C.lds + C.wave * 16384);
    for (int it = C.gw; it < 2 * SW_TOTAL; it += C.NGW) small_weight_item(C, it / SW_TOTAL, it % SW_TOTAL, scr);
    for (int it = C.gw; it < 2 * 2 * 4 * 2 * 4 * 2; it += C.NGW) {
        const int ks = it & 1, nt = (it >> 1) & 3, gt = (it >> 3) & 1, n = (it >> 4) & 3, dir = (it >> 6) & 1, l = it >> 7;
        const float* wp = (gt == 0 ? C.A->in[13] : C.A->in[15]) + ((size_t)((l * 2 + dir) * 4 + n) * 64) * 64;
        const int l15 = C.lane & 15, g = C.lane >> 4; u32x4 wv;
#pragma unroll
        for (int p = 0; p < 4; ++p) { const int k = 32 * ks + 8 * g + 2 * p; wv[p] = cvt_pk_bf16(wp[(size_t)k * 64 + 16 * nt + l15], wp[(size_t)(k + 1) * 64 + 16 * nt + l15]); }
        ((u32x4*)(C.ws + WS_WRG))[(size_t)it * 64 + C.lane] = wv;
    }
    bf16_t* XB0 = (bf16_t*)(C.ws + WS_XB0);
    for (int row0 = C.gw; row0 < NTOK; row0 += 4 * C.NGW) {
        f32x4 v[4][4];
#pragma unroll
        for (int i = 0; i < 4; ++i) { const int row = min(row0 + i * C.NGW, NTOK - 1);
            const float* src = row < NTOKG ? C.A->in[0] + (size_t)row * DM : C.A->in[1] + (size_t)(row - NTOKG) * DM; const f32x4* xr = (const f32x4*)src + C.lane;
#pragma unroll
            for (int j = 0; j < 4; ++j) v[i][j] = xr[64 * j]; }
#pragma unroll
        for (int i = 0; i < 4; ++i) { const int row = row0 + i * C.NGW; if (row < NTOK) { u32x2* o = (u32x2*)(XB0 + (size_t)row * DM) + C.lane;
#pragma unroll
            for (int j = 0; j < 4; ++j) { u32x2 w; w.x = cvt_pk_bf16(v[i][j][0], v[i][j][1]); w.y = cvt_pk_bf16(v[i][j][2], v[i][j][3]); o[64 * j] = w; } } }
    }
}
DI void expert_weight_items(const Ctx& C, int l) {
    __syncthreads();
    LAS float* scr = (LAS float*)(C.lds + C.wave * 16384);
    unsigned char* WGU = (unsigned char*)(C.ws + WS_EW + OFF_WGU8); unsigned char* WD = (unsigned char*)(C.ws + WS_EW + OFF_WD8);
    const int ln = C.lane & 31;
    const int gw0 = (C.G > 64) ? C.gw - 32 * 8 : C.gw, ngw = (C.G > 64) ? C.NGW - 32 * 8 : C.NGW;
    for (int it = gw0; it < 32768 + 16384; it += ngw) {
        if (it < 32768) { const int e = it >> 11, r = it & 2047, kb = r >> 7, nb = r & 127; const int n = nb * 32 + ln, pn = n >> 8, c = n & 255;
            const float* W = (c < 128 ? C.A->in[23] : C.A->in[24]) + (size_t)(l * NEXP + e) * DM * DEXP;
            tr_item8(W, DEXP, kb * 64, 128 * pn + (c & 127), pg8::FP8_W1_SCALE, WGU + (size_t)e * 4096 * 1024, 1024, nb * 32, scr, C.lane);
        } else { const int i2 = it - 32768, e = i2 >> 10, r = i2 & 1023, kb = r >> 5, nb = r & 31;
            tr_item8(C.A->in[25] + (size_t)(l * NEXP + e) * DEXP * DM, DM, kb * 64, nb * 32 + ln, pg8::FP8_W2_SCALE, WD + (size_t)e * 1024 * 2048, 2048, nb * 32, scr, C.lane); }
    }
}

template <bool ROUTER>
DI void ph_ln(const Ctx& C, int l, int which, bf16_t* XB) {
    LAS float* wr = (LAS float*)C.lds;
    if (ROUTER) { const float* src = C.A->in[22] + (size_t)l * DM * NEXP;
        for (int t = C.tid; t < DM * NEXP / 4; t += 512) { const int k = t >> 2, q = t & 3, ln = (k & 255) >> 2, ii = k & 3, jj = k >> 8;
            ((LAS f32x4*)wr)[((jj * 4 + ii) * 4 + q) * 64 + ln] = ((const f32x4*)src)[t]; }
        __syncthreads(); }
    const float* gp = C.A->in[20] + (size_t)(l * 2 + which) * DM; const float* bp = C.A->in[21] + (size_t)(l * 2 + which) * DM;
    f32x4 gv[4], bv[4];
#pragma unroll
    for (int j = 0; j < 4; ++j) { gv[j] = ((const f32x4*)gp)[C.lane + 64 * j]; bv[j] = ((const f32x4*)bp)[C.lane + 64 * j]; }
    float* affT = (float*)(C.ws + WS_AFF);
    f32x4 nx[4], ny[4], nz[4], nw[4];
    { const f32x4* xr0 = (const f32x4*)(C.out + (size_t)C.gw * DM) + C.lane;
#pragma unroll
      for (int j = 0; j < 4; ++j) nx[j] = xr0[64 * j];
      { const f32x4* xr1 = (const f32x4*)(C.out + (size_t)min(C.gw + C.NGW, NTOK - 1) * DM) + C.lane;
#pragma unroll
          for (int j = 0; j < 4; ++j) ny[j] = xr1[64 * j]; }
      { const f32x4* xr2 = (const f32x4*)(C.out + (size_t)min(C.gw + 2 * C.NGW, NTOK - 1) * DM) + C.lane;
#pragma unroll
          for (int j = 0; j < 4; ++j) nz[j] = xr2[64 * j]; }
      { const f32x4* xr3 = (const f32x4*)(C.out + (size_t)min(C.gw + 3 * C.NGW, NTOK - 1) * DM) + C.lane;
#pragma unroll
          for (int j = 0; j < 4; ++j) nw[j] = xr3[64 * j]; } }
    u32x4 sm0 = {0u, 0u, 0u, 0u}, sm1 = {0u, 0u, 0u, 0u};
    if (!ROUTER) { const u32x4* smr = (const u32x4*)(C.ws + WS_SM + (size_t)C.gw * 32); sm0 = smr[0]; sm1 = smr[1]; }
    for (int row = C.gw; row < NTOK; row += C.NGW) {
        f32x4* xr = (f32x4*)(C.out + (size_t)row * DM) + C.lane;
        f32x4 v[4]; float s = 0.f;
#pragma unroll
        for (int j = 0; j < 4; ++j) v[j] = nx[j] * ALPHA;
        if (!ROUTER) {
            const unsigned sw[8] = {sm0.x, sm0.y, sm0.z, sm0.w, sm1.x, sm1.y, sm1.z, sm1.w};
            { const u32x4* smr = (const u32x4*)(C.ws + WS_SM + (size_t)min(row + C.NGW, NTOK - 1) * 32); sm0 = smr[0]; sm1 = smr[1]; }
            const bf16_t* YE = (const bf16_t*)(C.ws + WS_Y); const int gofs = (row >> 16) * CAP;
            unsigned msk = 0u;
#pragma unroll
            for (int e = 0; e < 16; ++e) { const int slot = (int)(short)((e & 1) ? (sw[e >> 1] >> 16) : (sw[e >> 1] & 0xffffu)); if (slot >= 0) msk |= 1u << e; }
            msk = (unsigned)__builtin_amdgcn_readfirstlane((int)msk);
            while (msk) {
                const int e1 = __builtin_ctz(msk); msk &= msk - 1u; const bool two = msk != 0u; const int e2 = two ? __builtin_ctz(msk) : e1; if (two) msk &= msk - 1u;
                unsigned w1 = sw[0], w2 = sw[0];
#pragma unroll
                for (int q = 1; q < 8; ++q) { w1 = ((e1 >> 1) == q) ? sw[q] : w1; w2 = ((e2 >> 1) == q) ? sw[q] : w2; }
                const int s1 = (int)((e1 & 1) ? (w1 >> 16) : (w1 & 0xffffu)), s2 = (int)((e2 & 1) ? (w2 >> 16) : (w2 & 0xffffu));
                const u32x2* y1 = (const u32x2*)(YE + ((size_t)e1 * 16384 + gofs + s1) * DM) + C.lane; const u32x2* y2 = (const u32x2*)(YE + ((size_t)e2 * 16384 + gofs + s2) * DM) + C.lane;
                u32x2 a[4], b[4];
#pragma unroll
                for (int j = 0; j < 4; ++j) { a[j] = y1[64 * j]; b[j] = y2[64 * j]; }
                const float f2 = two ? 1.f : 0.f;
#pragma unroll
                for (int j = 0; j < 4; ++j) { v[j][0] += bflo(a[j].x) + f2 * bflo(b[j].x); v[j][1] += bfhi(a[j].x) + f2 * bfhi(b[j].x); v[j][2] += bflo(a[j].y) + f2 * bflo(b[j].y); v[j][3] += bfhi(a[j].y) + f2 * bfhi(b[j].y); }
            }
        }
#pragma unroll
        for (int j = 0; j < 4; ++j) s += (v[j][0] + v[j][1]) + (v[j][2] + v[j][3]);
#pragma unroll
        for (int j = 0; j < 4; ++j) { nx[j] = ny[j]; ny[j] = nz[j]; nz[j] = nw[j]; }
        { const int rn = row + 4 * C.NGW < NTOK ? row + 4 * C.NGW : row; const f32x4* xn = (const f32x4*)(C.out + (size_t)rn * DM) + C.lane;
#pragma unroll
            for (int j = 0; j < 4; ++j) nw[j] = xn[64 * j]; }
        const float mean = wave_sum(s) * (1.f / DM); float s2 = 0.f;
#pragma unroll
        for (int j = 0; j < 4; ++j) { v[j] = v[j] - mean; s2 += (v[j][0] * v[j][0] + v[j][1] * v[j][1]) + (v[j][2] * v[j][2] + v[j][3] * v[j][3]); }
        const float rstd = 1.0f / sqrtf(wave_sum(s2) * (1.f / DM) + LN_EPS);
        u32x2* o8 = (u32x2*)(XB + (size_t)row * DM) + C.lane; unsigned* o4 = (unsigned*)((unsigned char*)XB + (size_t)row * DM) + C.lane;
#pragma unroll
        for (int j = 0; j < 4; ++j) { v[j] = v[j] * rstd * gv[j] + bv[j]; xr[64 * j] = v[j];
            if constexpr (ROUTER) { o4[64 * j] = pg8::pk4_fp8(v[j][0], v[j][1], v[j][2], v[j][3]); asm volatile("" ::: "memory"); }
            else if (XB) { u32x2 w; w.x = cvt_pk_bf16(v[j][0], v[j][1]); w.y = cvt_pk_bf16(v[j][2], v[j][3]); o8[64 * j] = w; } }
        if (ROUTER) {
            float p[16];
#pragma unroll
            for (int e = 0; e < 16; ++e) p[e] = 0.f;
#pragma unroll
            for (int j = 0; j < 4; ++j)
#pragma unroll
                for (int i = 0; i < 4; ++i) { const float xv = v[j][i];
#pragma unroll
                    for (int q = 0; q < 4; ++q) { const f32x4 w4 = ((const LAS f32x4*)wr)[((j * 4 + i) * 4 + q) * 64 + C.lane]; p[4 * q] += xv * w4[0]; p[4 * q + 1] += xv * w4[1]; p[4 * q + 2] += xv * w4[2]; p[4 * q + 3] += xv * w4[3]; } }
            const bool b5 = (C.lane & 32) != 0, b4 = (C.lane & 16) != 0, b3 = (C.lane & 8) != 0, b2 = (C.lane & 4) != 0;
            float r8[8], r4[4], r2[2], lg;
#pragma unroll
            for (int i = 0; i < 8; ++i) { const float keep = b5 ? p[8 + i] : p[i], send = b5 ? p[i] : p[8 + i]; r8[i] = keep + __shfl_xor(send, 32); }
#pragma unroll
            for (int i = 0; i < 4; ++i) { const float keep = b4 ? r8[4 + i] : r8[i], send = b4 ? r8[i] : r8[4 + i]; r4[i] = keep + __shfl_xor(send, 16); }
#pragma unroll
            for (int i = 0; i < 2; ++i) { const float keep = b3 ? r4[2 + i] : r4[i], send = b3 ? r4[i] : r4[2 + i]; r2[i] = keep + __shfl_xor(send, 8); }
            { const float keep = b2 ? r2[1] : r2[0], send = b2 ? r2[0] : r2[1]; lg = keep + __shfl_xor(send, 4); }
            lg += __shfl_xor(lg, 2); lg += __shfl_xor(lg, 1);
            float mx = lg;
            mx = fmaxf(mx, __shfl_xor(mx, 4)); mx = fmaxf(mx, __shfl_xor(mx, 8)); mx = fmaxf(mx, __shfl_xor(mx, 16)); mx = fmaxf(mx, __shfl_xor(mx, 32));
            const float ex = __expf(lg - mx); float den = ex;
            den += __shfl_xor(den, 4); den += __shfl_xor(den, 8); den += __shfl_xor(den, 16); den += __shfl_xor(den, 32);
            const int eL = (b5 ? 8 : 0) + (b4 ? 4 : 0) + (b3 ? 2 : 0) + (b2 ? 1 : 0);
            if ((C.lane & 3) == 0) affT[((size_t)(row >> 16) * 16 + eL) * NTOKG + (row & 65535)] = ex / den;
            if (C.lane < 8) ((unsigned*)(C.ws + WS_SM))[(size_t)row * 8 + C.lane] = 0xFFFFFFFFu;
        }
    }
}

namespace att {
DI int crow(int r, int hi) { return (r & 3) + 8 * (r >> 2) + 4 * hi; }
DI int v_st(int k, int c) { const int kk = (k & ~0xC) | ((k & 4) << 1) | ((k & 8) >> 1); return ((kk >> 3) * 2 + (c >> 5)) * 512 + ((kk & 7) * 32 + (c & 31)) * 2; }
DI int v_rd_base(int lane) { return ((lane & 3) << 3) | (((lane >> 2) & 3) << 6) | (((lane >> 4) & 1) << 5) | (((lane >> 5) & 1) << 8); }
constexpr int v_rd_off(int d0, int ks, int half) { return d0 * 512 + ks * 2048 + half * 1024; }
template <int OFF> DI s16x4 tr_read(int vb) { s16x4 r; asm volatile("ds_read_b64_tr_b16 %0, %1 offset:%2" : "=&v"(r) : "v"(vb), "i"(OFF) : "memory"); return r; }
template <int D0> DI void pv_one(f32x16& od, int vb, bf16x8 pa0, bf16x8 pa1, bf16x8 pa2, bf16x8 pa3) {
    const s16x4 l0 = tr_read<v_rd_off(D0, 0, 0)>(vb), h0 = tr_read<v_rd_off(D0, 0, 1)>(vb), l1 = tr_read<v_rd_off(D0, 1, 0)>(vb), h1 = tr_read<v_rd_off(D0, 1, 1)>(vb);
    const s16x4 l2 = tr_read<v_rd_off(D0, 2, 0)>(vb), h2 = tr_read<v_rd_off(D0, 2, 1)>(vb), l3 = tr_read<v_rd_off(D0, 3, 0)>(vb), h3 = tr_read<v_rd_off(D0, 3, 1)>(vb);
    asm volatile("s_waitcnt lgkmcnt(0)" ::: "memory"); __builtin_amdgcn_sched_barrier(0);
#define PKV(L, H) (bf16x8){L[0], L[1], L[2], L[3], H[0], H[1], H[2], H[3]}
    od = __builtin_amdgcn_mfma_f32_32x32x16_bf16(pa0, PKV(l0, h0), od, 0, 0, 0);
    od = __builtin_amdgcn_mfma_f32_32x32x16_bf16(pa1, PKV(l1, h1), od, 0, 0, 0);
    od = __builtin_amdgcn_mfma_f32_32x32x16_bf16(pa2, PKV(l2, h2), od, 0, 0, 0);
    od = __builtin_amdgcn_mfma_f32_32x32x16_bf16(pa3, PKV(l3, h3), od, 0, 0, 0);
#undef PKV
}
DI void pv_ones(f32x16& o2, bf16x8 pa0, bf16x8 pa1, bf16x8 pa2, bf16x8 pa3) {
    const u32x4 onesw = {0x3F803F80u, 0x3F803F80u, 0x3F803F80u, 0x3F803F80u}; const bf16x8 ones = __builtin_bit_cast(bf16x8, onesw);
    o2 = __builtin_amdgcn_mfma_f32_32x32x16_bf16(pa0, ones, o2, 0, 0, 0); o2 = __builtin_amdgcn_mfma_f32_32x32x16_bf16(pa1, ones, o2, 0, 0, 0);
    o2 = __builtin_amdgcn_mfma_f32_32x32x16_bf16(pa2, ones, o2, 0, 0, 0); o2 = __builtin_amdgcn_mfma_f32_32x32x16_bf16(pa3, ones, o2, 0, 0, 0);
}
constexpr int KROW(int KS) { return KS * 32 + 16; }
constexpr int KTILE = 64 * 112, VTILE = 8192, LDS_ATT = 2 * KTILE + 2 * VTILE + 8 * 256;

DI void split3(float x, unsigned& w_hm, unsigned& w_l0) {
    const unsigned h = f2bf(x); const float r1 = x - __builtin_bit_cast(float, h << 16);
    const unsigned m = f2bf(r1); const float r2 = r1 - __builtin_bit_cast(float, m << 16);
    const unsigned l = f2bf(r2);
    w_hm = h | (m << 16); w_l0 = l;
}
template <int KS, bool ALIBI>
DI void attn_unit(const bf16_t* __restrict__ Qb, int ldq, const bf16_t* __restrict__ Kb, int ldk, const bf16_t* __restrict__ Vb, int ldv,
                  bf16_t* __restrict__ Ob, int ldo, int seq_len, int q0, float slope2, const unsigned* __restrict__ kn2, LAS unsigned char* lds) {
    int tid = threadIdx.x; asm volatile("" : "+v"(tid));
    const int wid = tid >> 6, lane = tid & 63, r32 = lane & 31, hi = lane >> 5;
    LAS unsigned char* K_lds = lds; LAS unsigned char* V_lds = lds + 2 * KTILE;
    LAS float* wsl = (LAS float*)(lds + 2 * KTILE + 2 * VTILE) + wid * 64; LAS float* li_l = wsl; LAS float* al_l = wsl + 32;
    LAS float* blk = (LAS float*)(lds + LDS_ATT);
    LAS int* tl = (LAS int*)(lds + LDS_ATT + 128);
    constexpr int KR = KROW(KS), KP = 2 * KS;
    constexpr float THR = 8.f, SKIP = -40.f;
    float mt = 0.f; f32x16 o[3];
#pragma unroll
    for (int d = 0; d < 3; ++d)
#pragma unroll
        for (int r = 0; r < 16; ++r) o[d][r] = 0.f;
    bf16x8 qr[KS];
    const bf16_t* Qw = Qb + (size_t)(wid * 32 + r32) * ldq + hi * 8;
#pragma unroll
    for (int d0 = 0; d0 < KS; ++d0) qr[d0] = *(const bf16x8*)(Qw + d0 * 16);
    if (ALIBI) { float qn = 0.f;
#pragma unroll
        for (int d0 = 0; d0 < KS; ++d0)
#pragma unroll
            for (int j = 0; j < 8; ++j) { const float f = bf2f((unsigned short)qr[d0][j]); qn += f * f; }
        qn += __shfl_xor(qn, 32); qn = wave_max(qn); if (lane == 0) blk[wid] = qn; }
    const int vkey = tid >> 3, vcol = (tid & 7) * 8, vst = v_st(vkey, vcol);
    const bool kact = tid < 64 * KP; const int kkey = kact ? tid / KP : 0, kpc = kact ? tid % KP : 0;
    const int vb0 = (int)(uintptr_t)V_lds + v_rd_base(lane);
    const int w0 = q0 + wid * 32; const float qpos = (float)(w0 + r32);
    const int NT = seq_len / 64, jd0 = q0 >> 6;
    bf16x8 kx0, kx1;
    { u32x4 a = {0u, 0u, 0u, 0u}, b = {0u, 0u, 0u, 0u};
        if (hi == 0) {
            a.z = 0x3F803F80u; a.w = 0x00003F80u; b.z = 0x3F803F80u; b.w = 0x00003F80u;
            if (ALIBI) { const float c0 = slope2 * (float)r32, c1 = slope2 * (float)(32 + r32);
                const unsigned h0 = f2bf(c0), l0 = f2bf(c0 - __builtin_bit_cast(float, h0 << 16)), h1 = f2bf(c1), l1 = f2bf(c1 - __builtin_bit_cast(float, h1 << 16));
                a.x = h0 | (l0 << 16); a.y = (h0 | (l0 << 16)) ^ 0x80008000u; b.x = h1 | (l1 << 16); b.y = (h1 | (l1 << 16)) ^ 0x80008000u; } }
        kx0 = __builtin_bit_cast(bf16x8, a); kx1 = __builtin_bit_cast(bf16x8, b); }
    bf16x8 vs, ks_;
    bool first = true;
#define SLOAD(k0) do { vs = *(const bf16x8*)(Vb + (size_t)((k0) + vkey) * ldv + vcol); ks_ = *(const bf16x8*)(Kb + (size_t)((k0) + kkey) * ldk + kpc * 8); } while (0)
#define SWRITE(b) do { *(LAS bf16x8*)(V_lds + (b) * VTILE + vst) = vs; if (kact) *(LAS bf16x8*)(K_lds + (b) * KTILE + kkey * KR + kpc * 16) = ks_; } while (0)
#define PK4(P, BASE, OUT) do { unsigned a0 = cvt_pk_bf16_b(P[BASE + 0], P[BASE + 1]), a1 = cvt_pk_bf16_b(P[BASE + 2], P[BASE + 3]); \
        unsigned b0_ = cvt_pk_bf16_b(P[BASE + 4], P[BASE + 5]), b1_ = cvt_pk_bf16_b(P[BASE + 6], P[BASE + 7]); \
        auto r0 = __builtin_amdgcn_permlane32_swap(a0, b0_, false, false); auto r1 = __builtin_amdgcn_permlane32_swap(a1, b1_, false, false); \
        u32x4 w = {r0[0], r1[0], r0[1], r1[1]}; OUT = __builtin_bit_cast(bf16x8, w); } while (0)
#define PKV2(L, H) (bf16x8){L[0], L[1], L[2], L[3], H[0], H[1], H[2], H[3]}
#define ATT_GRP(P, BASE, VA, VC, VD, VE) do { \
        _Pragma("unroll") for (int r_ = 0; r_ < 8; ++r_) P[BASE + r_] = __builtin_amdgcn_exp2f(P[BASE + r_]); \
        bf16x8 pa_; PK4(P, BASE, pa_); \
        o[0] = __builtin_amdgcn_mfma_f32_32x32x16_bf16(pa_, PKV2(VA, VC), o[0], 0, 0, 0); o[1] = __builtin_amdgcn_mfma_f32_32x32x16_bf16(pa_, PKV2(VD, VE), o[1], 0, 0, 0); \
        o[2] = __builtin_amdgcn_mfma_f32_32x32x16_bf16(pa_, ones, o[2], 0, 0, 0); __builtin_amdgcn_sched_barrier(0); } while (0)
#define ATT_TILE(j, cur) do { \
        f32x16 p0, p1; \
        _Pragma("unroll") for (int r = 0; r < 16; ++r) { p0[r] = 0.f; p1[r] = 0.f; } \
        const LAS unsigned char* Kc = K_lds + (cur) * KTILE; \
        _Pragma("unroll") for (int d0 = 0; d0 < KS; ++d0) { const int cb = (d0 * 16 + hi * 8) * 2;     \
            const bf16x8 b0 = *(const LAS bf16x8*)(Kc + r32 * KR + cb); const bf16x8 b1 = *(const LAS bf16x8*)(Kc + (32 + r32) * KR + cb); \
            p0 = __builtin_amdgcn_mfma_f32_32x32x16_bf16(b0, qr[d0], p0, 0, 0, 0); p1 = __builtin_amdgcn_mfma_f32_32x32x16_bf16(b1, qr[d0], p1, 0, 0, 0); } \
        int cls = 0; float Bq = 0.f; \
        if (ALIBI) { if (64 * (j) + 64 <= w0) { cls = 1; Bq = slope2 * ((float)(64 * (j)) - qpos); } else if (64 * (j) >= w0 + 32) { cls = 2; Bq = slope2 * (qpos - (float)(64 * (j))); } } \
        bf16x8 qx; { u32x4 w = {0u, 0u, 0u, 0u}; if (hi == 0) { unsigned whm, wl0; split3(Bq - mt, whm, wl0); w.z = whm; w.w = wl0; w.x = (cls == 1) ? 0x3F803F80u : 0u; w.y = (cls == 2) ? 0x3F803F80u : 0u; } qx = __builtin_bit_cast(bf16x8, w); } \
        p0 = __builtin_amdgcn_mfma_f32_32x32x16_bf16(kx0, qx, p0, 0, 0, 0); p1 = __builtin_amdgcn_mfma_f32_32x32x16_bf16(kx1, qx, p1, 0, 0, 0); \
        if (ALIBI && cls == 0) { const float dq = qpos - (float)((j) * 64 + 4 * hi); \
            _Pragma("unroll") for (int r = 0; r < 16; ++r) { const float kc = (float)((r & 3) + 8 * (r >> 2)); p0[r] = fmaf(fabsf(dq - kc), -slope2, p0[r]); p1[r] = fmaf(fabsf(dq - (kc + 32.f)), -slope2, p1[r]); } } \
        float tmax = p0[0]; \
        _Pragma("unroll") for (int r = 1; r < 16; ++r) tmax = fmaxf(tmax, p0[r]); \
        _Pragma("unroll") for (int r = 0; r < 16; ++r) tmax = fmaxf(tmax, p1[r]); \
        { auto rr = __builtin_amdgcn_permlane32_swap(__float_as_uint(tmax), __float_as_uint(tmax), false, false); tmax = fmaxf(__uint_as_float(rr[0]), __uint_as_float(rr[1])); } \
        const bool skip = !first && __all(tmax < SKIP); \
        if (!skip) { \
            if (first || !__all(tmax <= THR)) { \
                const float delta = first ? tmax : fmaxf(tmax, 0.f); const float alpha = first ? 1.f : __builtin_amdgcn_exp2f(-delta); \
                mt += delta; \
                _Pragma("unroll") for (int r = 0; r < 16; ++r) { p0[r] -= delta; p1[r] -= delta; } \
                if (!first) { if (hi == 0) al_l[r32] = alpha; LDS_WAIT(); \
                    _Pragma("unroll") for (int r = 0; r < 16; ++r) { const float a = al_l[crow(r, hi)]; o[0][r] *= a; o[1][r] *= a; o[2][r] *= a; } } \
            } \
              \
            const int vb = vb0 + (cur) * VTILE; \
            const s16x4 va0 = tr_read<v_rd_off(0, 0, 0)>(vb), vc0 = tr_read<v_rd_off(0, 0, 1)>(vb), vd0 = tr_read<v_rd_off(1, 0, 0)>(vb), ve0 = tr_read<v_rd_off(1, 0, 1)>(vb); \
            const s16x4 va1 = tr_read<v_rd_off(0, 1, 0)>(vb), vc1 = tr_read<v_rd_off(0, 1, 1)>(vb), vd1 = tr_read<v_rd_off(1, 1, 0)>(vb), ve1 = tr_read<v_rd_off(1, 1, 1)>(vb); \
            const s16x4 va2 = tr_read<v_rd_off(0, 2, 0)>(vb), vc2 = tr_read<v_rd_off(0, 2, 1)>(vb), vd2 = tr_read<v_rd_off(1, 2, 0)>(vb), ve2 = tr_read<v_rd_off(1, 2, 1)>(vb); \
            const s16x4 va3 = tr_read<v_rd_off(0, 3, 0)>(vb), vc3 = tr_read<v_rd_off(0, 3, 1)>(vb), vd3 = tr_read<v_rd_off(1, 3, 0)>(vb), ve3 = tr_read<v_rd_off(1, 3, 1)>(vb); \
            const u32x4 onesw = {0x3F803F80u, 0x3F803F80u, 0x3F803F80u, 0x3F803F80u}; const bf16x8 ones = __builtin_bit_cast(bf16x8, onesw); \
            asm volatile("s_waitcnt lgkmcnt(0)" ::: "memory"); __builtin_amdgcn_sched_barrier(0); \
            ATT_GRP(p0, 0, va0, vc0, vd0, ve0); ATT_GRP(p0, 8, va1, vc1, vd1, ve1); ATT_GRP(p1, 0, va2, vc2, vd2, ve2); ATT_GRP(p1, 8, va3, vc3, vd3, ve3); \
            first = false; \
        } } while (0)
#define ATT_RUN(COUNT, TILE_EXPR) do { const int cnt_ = (COUNT); if (cnt_ > 0) { \
        { const int jj = 0; SLOAD((TILE_EXPR) * 64); } SWRITE(0); __syncthreads(); \
        if (cnt_ > 1) { const int jj = 1; SLOAD((TILE_EXPR) * 64); } \
        for (int jj0 = 0; jj0 < cnt_; ++jj0) { const int cur_ = jj0 & 1; int j_; { const int jj = jj0; j_ = (TILE_EXPR); } \
            ATT_TILE(j_, cur_); \
            if (jj0 + 1 < cnt_) SWRITE(cur_ ^ 1); \
            __syncthreads(); \
            if (jj0 + 2 < cnt_) { const int jj = jj0 + 2; SLOAD((TILE_EXPR) * 64); } } } } while (0)
    if (wid >= 4) __builtin_amdgcn_s_setprio(1);
    ATT_RUN(4, jd0 + jj);
    if (ALIBI) {
        { const float mm = -wave_max(-mt); if (lane == 0) blk[8 + wid] = mm; }
        __syncthreads();
        if (wid == 0) {
            float qn2 = blk[0], mmin = blk[8];
#pragma unroll
            for (int i = 1; i < 8; ++i) { qn2 = fmaxf(qn2, blk[i]); mmin = fminf(mmin, blk[8 + i]); }
            int base = 0;
            for (int c0 = 0; c0 < NT - 4; c0 += 64) { const int c = c0 + lane; bool act = false; int t = 0;
                if (c < NT - 4) { t = (c < jd0) ? jd0 - 1 - c : c + 4;
                    const float dist = (t < jd0) ? (float)(q0 - (64 * t + 63)) : (float)(64 * t - (q0 + 255));
                    const float kn = __builtin_bit_cast(float, kn2[t]);
                    act = (sqrtf(qn2 * kn) * 1.02f - slope2 * dist - mmin >= SKIP); }
                const unsigned long long bm = __ballot(act);
                if (act) tl[base + __builtin_popcountll(bm & ((1ull << lane) - 1ull))] = t;
                base += __builtin_popcountll(bm); }
            if (lane == 0) blk[16] = __builtin_bit_cast(float, base);
        }
        __syncthreads();
        const int nact = __builtin_bit_cast(int, blk[16]);
        ATT_RUN(nact, tl[jj]);
    } else {
        ATT_RUN(NT - 4, (jj < jd0 ? jd0 - 1 - jj : jj + 4));
    }
#undef ATT_RUN
#undef ATT_TILE
#undef ATT_GRP
#undef PKV2
#undef PK4
#undef SLOAD
#undef SWRITE
    __builtin_amdgcn_s_setprio(0);
    bf16_t* Ow = Ob + (size_t)(wid * 32) * ldo;
#pragma unroll
    for (int r = 0; r < 16; ++r) { const int orow = crow(r, hi); const float rl = __builtin_amdgcn_rcpf(o[2][r]);
#pragma unroll
        for (int d0 = 0; d0 < 2; ++d0) Ow[(size_t)orow * ldo + d0 * 32 + r32] = (bf16_t)f2bf(o[d0][r] * rl); }
    __syncthreads();
}
}

DI void ph_attn_a(const Ctx& C, int l) {
    const bf16_t* UA = (const bf16_t*)(C.ws + WS_U); bf16_t* OA = (bf16_t*)(C.ws + WS_XB1);
    for (int u = C.bid; u < 4096; u += C.G) {
        int qb, vh, seq, len;
        if (u < 2048) { const int i = u >> 8, c = u & 255; seq = c >> 5; qb = c & 31; vh = (i + seq) & 7; len = 8192; }
        else { const int v = u - 2048, i = v >> 8, c = v & 255; seq = 8 + (c >> 3); qb = c & 7; vh = (i + (c >> 3)) & 7; len = 2048; }
        const int r0 = seq_start_row(seq); const int h = vh >> 1;
        const float slope2 = exp2f(-2.0f * (float)(h + 1)) * LOG2E;
        att::attn_unit<2, true>(UA + (size_t)(r0 + qb * 256) * 768 + vh * 32, 768, UA + (size_t)r0 * 768 + 256 + vh * 32, 768, UA + (size_t)r0 * 768 + 512 + h * 64, 768,
                                OA + (size_t)(r0 + qb * 256) * 512 + vh * 64, 512, len, qb * 256, slope2, (const unsigned*)(C.ws + WS_KN2) + ((size_t)l * 8 + vh) * 2048 + (r0 >> 6), C.lds);
    }
}
DI void ph_attn_c(const Ctx& C) {
    const bf16_t* Qc = (const bf16_t*)(C.ws + WS_XB1 + OFF_QC); const bf16_t* Kc = (const bf16_t*)(C.ws + WS_XB1 + OFF_KC); const bf16_t* Vc = (const bf16_t*)(C.ws + WS_XB1 + OFF_VC);
    bf16_t* Y = (bf16_t*)(C.ws + WS_Y);
    for (int u = C.bid; u < 2048; u += C.G) {
        int qb, h, seq, len;
        if (u < 1024) { qb = u & 31; h = (u >> 5) & 3; seq = u >> 7; len = 8192; } else { const int v = u - 1024; qb = v & 7; h = (v >> 3) & 3; seq = 8 + (v >> 5); len = 2048; }
        const int r0 = seq_start_row(seq);
        att::attn_unit<3, false>(Qc + (size_t)(r0 + qb * 256) * 192 + h * 48, 192, Kc + (size_t)r0 * 192 + h * 48, 192, Vc + (size_t)r0 * 256 + h * 64, 256,
                                 Y + (size_t)(r0 + qb * 256) * DM + 512 + h * 64, DM, len, qb * 256, 0.f, nullptr, C.lds);
    }
}
DI void ph_a_post(const Ctx& C, int l) {
    const bf16_t* OA = (const bf16_t*)(C.ws + WS_XB1); bf16_t* Y = (bf16_t*)(C.ws + WS_Y);
    const float linit = 0.8f - 0.6f * expf(-0.3f * (float)l);
    const float* lp = C.A->in[3] + l * 128;
    float sa = 0.f, sb = 0.f; if (C.lane < 32) { sa = lp[C.lane] * lp[32 + C.lane]; sb = lp[64 + C.lane] * lp[96 + C.lane]; }
    const float lam = expf(wave_sum(sa)) - expf(wave_sum(sb)) + linit;
    const int h = C.lane >> 4, d4 = (C.lane & 15) * 4;
    const f32x4 gg = *(const f32x4*)(C.A->in[4] + l * 64 + d4);
    for (int row0 = C.gw; row0 < NTOK; row0 += 4 * C.NGW) {
        u32x2 a[4], b[4];
#pragma unroll
        for (int i = 0; i < 4; ++i) { const size_t row = (size_t)row0 + (size_t)i * C.NGW; a[i] = *(const u32x2*)(OA + row * 512 + (2 * h) * 64 + d4); b[i] = *(const u32x2*)(OA + row * 512 + (2 * h + 1) * 64 + d4); }
#pragma unroll
        for (int i = 0; i < 4; ++i) { const size_t row = (size_t)row0 + (size_t)i * C.NGW;
            float o0 = bflo(a[i].x) - lam * bflo(b[i].x), o1 = bfhi(a[i].x) - lam * bfhi(b[i].x), o2 = bflo(a[i].y) - lam * bflo(b[i].y), o3 = bfhi(a[i].y) - lam * bfhi(b[i].y);
            float ss = o0 * o0 + o1 * o1 + o2 * o2 + o3 * o3;
            ss += __shfl_xor(ss, 1); ss += __shfl_xor(ss, 2); ss += __shfl_xor(ss, 4); ss += __shfl_xor(ss, 8);
            const float r = (1.0f / sqrtf(ss * (1.f / 64.f) + RMS_EPS)) * (1.0f - linit);
            u32x2 w; w.x = cvt_pk_bf16(o0 * r * gg[0], o1 * r * gg[1]); w.y = cvt_pk_bf16(o2 * r * gg[2], o3 * r * gg[3]);
            *(u32x2*)(Y + row * DM + h * 64 + d4) = w; }
    }
}

DI float hgrn_lb(const Ctx& C, int l, int dir, int ch) {
    if (l == 0) return 0.f;
    const float a = C.A->in[5][(0 * 2 + dir) * 256 + ch], b = C.A->in[5][(1 * 2 + dir) * 256 + ch];
    const float m = fmaxf(a, b), ea = expf(a - m), eb = expf(b - m); return eb / (ea + eb);
}
DI float dpp_shr_add(float x, int k) {
    float y;
    if (k == 1) y = __builtin_bit_cast(float, __builtin_amdgcn_update_dpp(0, __builtin_bit_cast(int, x), 0x111, 0xF, 0xF, true));
    else if (k == 2) y = __builtin_bit_cast(float, __builtin_amdgcn_update_dpp(0, __builtin_bit_cast(int, x), 0x112, 0xF, 0xF, true));
    else if (k == 4) y = __builtin_bit_cast(float, __builtin_amdgcn_update_dpp(0, __builtin_bit_cast(int, x), 0x114, 0xF, 0xF, true));
    else y = __builtin_bit_cast(float, __builtin_amdgcn_update_dpp(0, __builtin_bit_cast(int, x), 0x118, 0xF, 0xF, true));
    return x + y;
}
DI s16x4 tr16(unsigned addr) { s16x4 r; asm volatile("ds_read_b64_tr_b16 %0, %1\n\ts_waitcnt lgkmcnt(0)" : "=&v"(r) : "v"(addr) : "memory"); return r; }
constexpr int HG_ROW = 144, HG_ARR = 16 * HG_ROW;
template <int MODE>
DI void hgrn_pass(const Ctx& C, int l, int chunk, int h, int dir, LAS unsigned char* wl, float* ofs) {
    const bf16_t* UB = (const bf16_t*)(C.ws + WS_U); float* ST = (float*)(C.ws + WS_XB1); float* GAM = (float*)(C.ws + WS_GAM); bf16_t* Y = (bf16_t*)(C.ws + WS_Y);
    const int lane = C.lane, l15 = lane & 15, g = lane >> 4, r0 = chunk * 128; const size_t sbase = (size_t)((chunk * 4 + h) * 2 + dir);
    const unsigned QLa = (unsigned)(uintptr_t)wl, FLa = QLa + HG_ARR, VLa = QLa + 2 * HG_ARR, GLa = QLa + 3 * HG_ARR;
    LAS float* lbT = (LAS float*)(wl + 4 * HG_ARR);
    lbT[lane] = hgrn_lb(C, l, dir, h * 64 + lane);
    LDS_WAIT();
    f32x4 S[4][4];
#pragma unroll
    for (int dt = 0; dt < 4; ++dt)
#pragma unroll
        for (int et = 0; et < 4; ++et)
#pragma unroll
            for (int r = 0; r < 4; ++r) S[dt][et][r] = (MODE == 0) ? 0.f : ST[sbase * 4096 + (size_t)(16 * dt + 4 * g + r) * 64 + 16 * et + l15];
    float gsum[4] = {0.f, 0.f, 0.f, 0.f};
    const float* ngp = C.A->in[6] + l * 256 + h * 64 + l15;
    const int srow = lane >> 2, spc = lane & 3;
    u32x4 pq[2], pf[2], pv[2];
#define HG_LOAD(sc) do { const int t_ = (sc) * 16 + srow; const bf16_t* rp_ = UB + (size_t)(r0 + (dir ? 127 - t_ : t_)) * 1280 + h * 64 + spc * 16; \
        pf[0] = *(const u32x4*)(rp_ + (dir ? 512 : 256)); pf[1] = *(const u32x4*)(rp_ + (dir ? 512 : 256) + 8); pv[0] = *(const u32x4*)(rp_ + 768); pv[1] = *(const u32x4*)(rp_ + 768 + 8); \
        if (MODE != 0) { pq[0] = *(const u32x4*)(rp_); pq[1] = *(const u32x4*)(rp_ + 8); } } while (0)
#define HG_STORE() do { const int o_ = srow * HG_ROW + spc * 32; \
        *(LAS u32x4*)(wl + HG_ARR + o_) = pf[0]; *(LAS u32x4*)(wl + HG_ARR + o_ + 16) = pf[1]; *(LAS u32x4*)(wl + 2 * HG_ARR + o_) = pv[0]; *(LAS u32x4*)(wl + 2 * HG_ARR + o_ + 16) = pv[1]; \
        if (MODE != 0) { *(LAS u32x4*)(wl + o_) = pq[0]; *(LAS u32x4*)(wl + o_ + 16) = pq[1]; } } while (0)
    HG_LOAD(0);
    const unsigned tr_off = (unsigned)((4 * g + (l15 >> 2)) * HG_ROW + (l15 & 3) * 8);
    for (int sc = 0; sc < 8; ++sc) {
        LDS_WAIT();
        HG_STORE();
        if (MODE == 2) {
#pragma unroll
            for (int k = 0; k < 2; ++k) { const int t_ = sc * 16 + 8 * k + (lane >> 3);
                __builtin_amdgcn_global_load_lds((const unsigned*)(UB + (size_t)(r0 + 127 - t_) * 1280 + 1024 + h * 64 + (lane & 7) * 8), (LAS unsigned*)(wl + 3 * HG_ARR + k * 1024), 16, 0, 0); } }
        if (sc + 1 < 8) HG_LOAD(sc + 1);
        LDS_WAIT();
        bf16x8 vf[4];
#pragma unroll
        for (int et = 0; et < 4; ++et) { const s16x4 t4 = tr16(VLa + tr_off + et * 32); vf[et] = (bf16x8){t4[0], t4[1], t4[2], t4[3], 0, 0, 0, 0}; }
        __builtin_amdgcn_sched_barrier(0);
        bf16x8 khf[4]; float tot[4];
#pragma unroll
        for (int dt = 0; dt < 4; ++dt) { const s16x4 t4 = tr16(FLa + tr_off + dt * 32);
            float fv[4], lf[4];
            const float lbv = lbT[16 * dt + l15];
#pragma unroll
            for (int j = 0; j < 4; ++j) { fv[j] = lbv + (1.f - lbv) * sigmoidf_(bf2f((unsigned short)t4[j])); lf[j] = __builtin_amdgcn_logf(fv[j]); }
            const float Tg = (lf[0] + lf[1]) + (lf[2] + lf[3]);
            const float T1 = __shfl_down(Tg, 16), T2 = __shfl_down(Tg, 32), T3 = __shfl_down(Tg, 48);
            const float after = (g < 3 ? T1 : 0.f) + (g < 2 ? T2 : 0.f) + (g < 1 ? T3 : 0.f);
            float tt_ = Tg; tt_ += __shfl_xor(tt_, 16); tt_ += __shfl_xor(tt_, 32); tot[dt] = tt_; gsum[dt] += tt_;
            const float c3 = after, c2 = c3 + lf[3], c1 = c2 + lf[2], c0 = c1 + lf[1];
            const unsigned w0 = cvt_pk_bf16((1.f - fv[0]) * __builtin_amdgcn_exp2f(c0), (1.f - fv[1]) * __builtin_amdgcn_exp2f(c1));
            const unsigned w1 = cvt_pk_bf16((1.f - fv[2]) * __builtin_amdgcn_exp2f(c2), (1.f - fv[3]) * __builtin_amdgcn_exp2f(c3));
            const u32x4 w = {w0, w1, 0u, 0u}; khf[dt] = __builtin_bit_cast(bf16x8, w); }
        __builtin_amdgcn_sched_barrier(0);
        f32x4 O[4];
        if (MODE != 0) {
            bf16x8 qhf[2], ktf[2];
#pragma unroll
            for (int ks = 0; ks < 2; ++ks) { float b2[8], qv[8], kv[8];
#pragma unroll
                for (int dd = 0; dd < 2; ++dd) { const int dt = 2 * ks + dd;
                    const u32x2 fw = *(const LAS u32x2*)(wl + HG_ARR + l15 * HG_ROW + (16 * dt + 4 * g) * 2); const u32x2 qw = *(const LAS u32x2*)(wl + l15 * HG_ROW + (16 * dt + 4 * g) * 2);
                    const f32x4 lb4 = *(const LAS f32x4*)(lbT + 16 * dt + 4 * g);
                    const float fl4[4] = {bflo(fw.x), bfhi(fw.x), bflo(fw.y), bfhi(fw.y)}, ql4[4] = {bflo(qw.x), bfhi(qw.x), bflo(qw.y), bfhi(qw.y)};
#pragma unroll
                    for (int r = 0; r < 4; ++r) { const int i = 4 * dd + r; const float f = lb4[r] + (1.f - lb4[r]) * sigmoidf_(fl4[r]); b2[i] = __builtin_amdgcn_logf(f); kv[i] = 1.f - f; qv[i] = siluf_(ql4[r]); } }
#pragma unroll
                for (int i = 0; i < 8; ++i) { float x = b2[i]; x = dpp_shr_add(x, 1); x = dpp_shr_add(x, 2); x = dpp_shr_add(x, 4); x = dpp_shr_add(x, 8); b2[i] = x; }
                u32x4 wq, wk;
#pragma unroll
                for (int p = 0; p < 4; ++p) { const int i = 2 * p; const float e0 = __builtin_amdgcn_exp2f(b2[i]), e1 = __builtin_amdgcn_exp2f(b2[i + 1]);
                    wq[p] = cvt_pk_bf16(qv[i] * e0, qv[i + 1] * e1); wk[p] = cvt_pk_bf16(kv[i] * __builtin_amdgcn_exp2f(fminf(-b2[i], 120.f)), kv[i + 1] * __builtin_amdgcn_exp2f(fminf(-b2[i + 1], 120.f))); }
                qhf[ks] = __builtin_bit_cast(bf16x8, wq); ktf[ks] = __builtin_bit_cast(bf16x8, wk); }
            __builtin_amdgcn_sched_barrier(0);
            f32x4 aT = (f32x4){0.f, 0.f, 0.f, 0.f};
            aT = __builtin_amdgcn_mfma_f32_16x16x32_bf16(ktf[0], qhf[0], aT, 0, 0, 0);
            aT = __builtin_amdgcn_mfma_f32_16x16x32_bf16(ktf[1], qhf[1], aT, 0, 0, 0);
#pragma unroll
            for (int r = 0; r < 4; ++r) aT[r] = (4 * g + r > l15) ? 0.f : aT[r];
            const u32x4 aw = {cvt_pk_bf16(aT[0], aT[1]), cvt_pk_bf16(aT[2], aT[3]), 0u, 0u}; const bf16x8 atf = __builtin_bit_cast(bf16x8, aw);
#pragma unroll
            for (int et = 0; et < 4; ++et) { f32x4 o = (f32x4){0.f, 0.f, 0.f, 0.f};
                o = __builtin_amdgcn_mfma_f32_16x16x32_bf16(atf, vf[et], o, 0, 0, 0);
#pragma unroll
                for (int ks = 0; ks < 2; ++ks) { const u32x4 sw = {cvt_pk_bf16(S[2 * ks][et][0], S[2 * ks][et][1]), cvt_pk_bf16(S[2 * ks][et][2], S[2 * ks][et][3]), cvt_pk_bf16(S[2 * ks + 1][et][0], S[2 * ks + 1][et][1]), cvt_pk_bf16(S[2 * ks + 1][et][2], S[2 * ks + 1][et][3])};
                    o = __builtin_amdgcn_mfma_f32_16x16x32_bf16(qhf[ks], __builtin_bit_cast(bf16x8, sw), o, 0, 0, 0); }
                O[et] = o; }
        }
        __builtin_amdgcn_sched_barrier(0);
#pragma unroll
        for (int dt = 0; dt < 4; ++dt) { float dec[4];
#pragma unroll
            for (int r = 0; r < 4; ++r) dec[r] = __builtin_amdgcn_exp2f(__shfl(tot[dt], 4 * g + r));
#pragma unroll
            for (int et = 0; et < 4; ++et) { f32x4 s = S[dt][et];
#pragma unroll
                for (int r = 0; r < 4; ++r) s[r] *= dec[r];
                S[dt][et] = __builtin_amdgcn_mfma_f32_16x16x32_bf16(khf[dt], vf[et], s, 0, 0, 0); } }
        __builtin_amdgcn_sched_barrier(0);
        if (MODE == 1) {
#pragma unroll
            for (int et = 0; et < 4; ++et)
#pragma unroll
                for (int r = 0; r < 4; ++r) ofs[(sc * 16 + 4 * g + r) * 64 + 16 * et + l15] = O[et][r];
        }
        if (MODE == 2) {
            float rr[4];
#pragma unroll
            for (int r = 0; r < 4; ++r) { const int at = 127 - (sc * 16 + 4 * g + r); float ss = 0.f;
#pragma unroll
                for (int et = 0; et < 4; ++et) { const float of = ofs[at * 64 + 16 * et + l15]; O[et][r] += of; ss += O[et][r] * O[et][r]; }
                ss += __shfl_xor(ss, 1); ss += __shfl_xor(ss, 2); ss += __shfl_xor(ss, 4); ss += __shfl_xor(ss, 8);
                rr[r] = 1.0f / sqrtf(ss * (1.f / 64.f) + RMS_EPS); }
            VM_WAIT();
#pragma unroll
            for (int et = 0; et < 4; ++et) { const s16x4 t4 = tr16(GLa + (unsigned)((4 * g + (l15 >> 2)) * 128 + (l15 & 3) * 8) + et * 32); const float ngv = ngp[16 * et];
#pragma unroll
                for (int r = 0; r < 4; ++r) { const int at = 127 - (sc * 16 + 4 * g + r);
                    Y[(size_t)(r0 + at) * DM + 256 + h * 64 + 16 * et + l15] = (bf16_t)f2bf(O[et][r] * rr[r] * ngv * siluf_(bf2f((unsigned short)t4[r]))); } }
        }
    }
#undef HG_LOAD
#undef HG_STORE
    if (MODE == 0) {
#pragma unroll
        for (int dt = 0; dt < 4; ++dt)
#pragma unroll
            for (int et = 0; et < 4; ++et)
#pragma unroll
                for (int r = 0; r < 4; ++r) ST[sbase * 4096 + (size_t)(16 * dt + 4 * g + r) * 64 + 16 * et + l15] = S[dt][et][r];
        if (g == 0) {
#pragma unroll
            for (int dt = 0; dt < 4; ++dt) GAM[sbase * 64 + 16 * dt + l15] = __builtin_amdgcn_exp2f(gsum[dt]);
        }
    }
}
DI void ph_hgrn_local(const Ctx& C, int l) {
    LAS unsigned char* wl = C.lds + C.wave * 16384;
    for (int w = C.gw; w < NCHUNK * 8; w += C.NGW) hgrn_pass<0>(C, l, w >> 3, (w >> 1) & 3, w & 1, wl, nullptr);
}
DI void ph_hgrn_scan(const Ctx& C) {
    float* ST = (float*)(C.ws + WS_XB1); const float* GAM = (const float*)(C.ws + WS_GAM);
    for (int idx = C.bid * 512 + C.tid; idx < NSEQ * 8 * 4096; idx += C.G * 512) {
        const int e = idx & 4095, hd = (idx >> 12) & 7, seq = idx >> 15, h = hd >> 1, dir = hd & 1, d = e >> 6;
        const int c0 = seq < 8 ? seq * 64 : 512 + (seq - 8) * 16, nc = seq < 8 ? 64 : 16;
        float s = 0.f;
        for (int i0 = 0; i0 < nc; i0 += 16) {
            float tmp[16], gg[16];
#pragma unroll
            for (int i = 0; i < 16; ++i) { const int c = dir ? c0 + nc - 1 - (i0 + i) : c0 + i0 + i; const size_t base = (size_t)((c * 4 + h) * 2 + dir); tmp[i] = ST[base * 4096 + e]; gg[i] = GAM[base * 64 + d]; }
#pragma unroll
            for (int i = 0; i < 16; ++i) { const float t = tmp[i]; tmp[i] = s; s = fmaf(gg[i], s, t); }
#pragma unroll
            for (int i = 0; i < 16; ++i) { const int c = dir ? c0 + nc - 1 - (i0 + i) : c0 + i0 + i; const size_t base = (size_t)((c * 4 + h) * 2 + dir); ST[base * 4096 + e] = tmp[i]; }
        }
    }
}
template <int MODE>
DI void ph_hgrn_out(const Ctx& C, int l) {
    LAS unsigned char* wl = C.lds + C.wave * 16384;
    for (int w = C.gw; w < NCHUNK * 4; w += C.NGW) hgrn_pass<MODE>(C, l, w >> 2, w & 3, MODE == 2 ? 1 : 0, wl, (float*)(C.ws + WS_EW) + (size_t)w * 8192);
}

DI void ph_c_prep(const Ctx& C, int l) {
    const bf16_t* UCD = (const bf16_t*)(C.ws + WS_U);
    const bf16_t* WQ = (const bf16_t*)(C.ws + WS_WC + (size_t)l * WC_LAYER + OFF_WQ); const bf16_t* WKV = (const bf16_t*)(C.ws + WS_WC + (size_t)l * WC_LAYER + OFF_WKV);
    bf16_t* Qc = (bf16_t*)(C.ws + WS_XB1 + OFF_QC); bf16_t* Kc = (bf16_t*)(C.ws + WS_XB1 + OFF_KC); bf16_t* Vc = (bf16_t*)(C.ws + WS_XB1 + OFF_VC);
    const int lane = C.lane, r32 = lane & 31, hi = lane >> 5;
    const float C2c = 0.14433756729740643f * LOG2E;
    constexpr int PQ = 400, PKV = 272;
    for (int i = C.tid; i < 192 * 24; i += 512) { const int r = i / 24, p = i % 24; *(LAS u32x4*)(C.lds + r * PQ + p * 16) = *(const u32x4*)(WQ + (size_t)r * 192 + p * 8); }
    __syncthreads();
    for (int w = C.gw; w < NTOK / 32; w += C.NGW) {
        const int row = w * 32 + r32; const bf16_t* xr = UCD + (size_t)row * 1024;
        float cs[4], sn[4];
        { const float pos = (float)row_pos(row); const float inv[8] = {1.0f, 0.316227766016837933f, 0.1f, 0.0316227766016837933f, 0.01f, 0.00316227766016837933f, 0.001f, 0.000316227766016837933f};
#pragma unroll
            for (int ii = 0; ii < 4; ++ii) { const float invv = hi ? inv[4 + ii] : inv[ii]; const float ang = pos * invv;
                const double ad = (double)ang; const double k = __builtin_rint(ad * 0.15915494309189535); const float red = (float)(ad - k * 6.283185307179586);
                cs[ii] = __cosf(red); sn[ii] = __sinf(red); } }
        bf16x8 xq[12]; float ssq = 0.f;
#pragma unroll
        for (int ks = 0; ks < 12; ++ks) { xq[ks] = *(const bf16x8*)(xr + ks * 16 + hi * 8);
#pragma unroll
            for (int j = 0; j < 8; ++j) { const float f = bf2f((unsigned short)xq[ks][j]); ssq += f * f; } }
        ssq += __shfl_xor(ssq, 32);
        const float rq = (1.0f / sqrtf(ssq * (1.f / 192.f) + RMS_EPS)) * C2c;
#pragma unroll 1
        for (int nt = 0; nt < 6; ++nt) {
            f32x16 acc;
#pragma unroll
            for (int r = 0; r < 16; ++r) acc[r] = 0.f;
#pragma unroll
            for (int ks = 0; ks < 12; ++ks) { const bf16x8 a = *(const LAS bf16x8*)(C.lds + (32 * nt + r32) * PQ + (ks * 16 + hi * 8) * 2); acc = __builtin_amdgcn_mfma_f32_32x32x16_bf16(a, xq[ks], acc, 0, 0, 0); }
#pragma unroll
            for (int r = 0; r < 16; ++r) acc[r] *= rq;
            if (nt == 1 || nt == 4) {
#pragma unroll
                for (int ii = 0; ii < 4; ++ii) { const float x1 = acc[ii], x2 = acc[4 + ii]; acc[ii] = x1 * cs[ii] - x2 * sn[ii]; acc[4 + ii] = x1 * sn[ii] + x2 * cs[ii]; } }
            if (nt == 2 || nt == 5) {
#pragma unroll
                for (int ii = 0; ii < 4; ++ii) { const float x1 = acc[8 + ii], x2 = acc[12 + ii]; acc[8 + ii] = x1 * cs[ii] - x2 * sn[ii]; acc[12 + ii] = x1 * sn[ii] + x2 * cs[ii]; } }
#pragma unroll
            for (int g = 0; g < 4; ++g) { u32x2 wv; wv.x = cvt_pk_bf16(acc[4 * g], acc[4 * g + 1]); wv.y = cvt_pk_bf16(acc[4 * g + 2], acc[4 * g + 3]);
                *(u32x2*)(Qc + (size_t)row * 192 + 32 * nt + 8 * g + 4 * hi) = wv; }
        }
        { const u32x2 a = *(const u32x2*)(xr + 320 + 4 * hi), b = *(const u32x2*)(xr + 328 + 4 * hi);
            const float x1[4] = {bflo(a.x), bfhi(a.x), bflo(a.y), bfhi(a.y)}, x2[4] = {bflo(b.x), bfhi(b.x), bflo(b.y), bfhi(b.y)};
            float o1[4], o2[4];
#pragma unroll
            for (int ii = 0; ii < 4; ++ii) { o1[ii] = x1[ii] * cs[ii] - x2[ii] * sn[ii]; o2[ii] = x1[ii] * sn[ii] + x2[ii] * cs[ii]; }
            u32x2 w1, w2; w1.x = cvt_pk_bf16(o1[0], o1[1]); w1.y = cvt_pk_bf16(o1[2], o1[3]); w2.x = cvt_pk_bf16(o2[0], o2[1]); w2.y = cvt_pk_bf16(o2[2], o2[3]);
#pragma unroll
            for (int h = 0; h < 4; ++h) { *(u32x2*)(Kc + (size_t)row * 192 + h * 48 + 32 + 4 * hi) = w1; *(u32x2*)(Kc + (size_t)row * 192 + h * 48 + 40 + 4 * hi) = w2; } }
    }
    __syncthreads();
    for (int i = C.tid; i < 384 * 16; i += 512) { const int r = i / 16, p = i % 16; *(LAS u32x4*)(C.lds + r * PKV + p * 16) = *(const u32x4*)(WKV + (size_t)r * 128 + p * 8); }
    __syncthreads();
    for (int w = C.gw; w < NTOK / 32; w += C.NGW) {
        const int row = w * 32 + r32; const bf16_t* xr = UCD + (size_t)row * 1024;
        bf16x8 xk[8]; float ssk = 0.f;
#pragma unroll
        for (int ks = 0; ks < 8; ++ks) { xk[ks] = *(const bf16x8*)(xr + 192 + ks * 16 + hi * 8);
#pragma unroll
            for (int j = 0; j < 8; ++j) { const float f = bf2f((unsigned short)xk[ks][j]); ssk += f * f; } }
        ssk += __shfl_xor(ssk, 32);
        const float rk = 1.0f / sqrtf(ssk * (1.f / 128.f) + RMS_EPS);
#pragma unroll 1
        for (int nt = 0; nt < 12; ++nt) {
            f32x16 acc;
#pragma unroll
            for (int r = 0; r < 16; ++r) acc[r] = 0.f;
#pragma unroll
            for (int ks = 0; ks < 8; ++ks) { const bf16x8 a = *(const LAS bf16x8*)(C.lds + (32 * nt + r32) * PKV + (ks * 16 + hi * 8) * 2); acc = __builtin_amdgcn_mfma_f32_32x32x16_bf16(a, xk[ks], acc, 0, 0, 0); }
            const int h = nt / 3, part = nt % 3;
            bf16_t* dst = (part == 0) ? Kc + (size_t)row * 192 + h * 48 : Vc + (size_t)row * 256 + h * 64 + (part - 1) * 32;
#pragma unroll
            for (int g = 0; g < 4; ++g) { u32x2 wv; wv.x = cvt_pk_bf16(acc[4 * g] * rk, acc[4 * g + 1] * rk); wv.y = cvt_pk_bf16(acc[4 * g + 2] * rk, acc[4 * g + 3] * rk);
                *(u32x2*)(dst + 8 * g + 4 * hi) = wv; }
        }
    }
}

DI float one_minus_a2(float y, float a) {
    const float p = -y * (1.0f + y * (0.5f + y * (0.16666667f + y * (0.041666668f + y * (0.0083333338f + y * 0.0013888889f)))));
    return (y > -0.25f) ? p : (1.0f - a * a);
}
template <bool FINAL, int DIR>
DI void rglru_units(const Ctx& C, int l) {
    const bf16_t* UCD = (const bf16_t*)(C.ws + WS_U); f32x2* DC = (f32x2*)(C.ws + WS_DC);
    bf16_t* HFB = (bf16_t*)(C.ws + WS_EW);
    const int lane = C.lane, l15 = lane & 15, g = lane >> 4;
    LAS unsigned char* wl = C.lds + C.wave * 16384;
    LAS unsigned char* xcb = wl;
    LAS float* gs = (LAS float*)(wl + 2304);
    const int n = C.gw & 3, ch = n * 64 + lane;
    bf16x8 Wf[2][4][2];
    { const bf16x8* fp = (const bf16x8*)(C.ws + WS_WRG) + (size_t)((((l * 2 + DIR) * 4 + n) * 2) * 8) * 64 + lane;
#pragma unroll
      for (int gt = 0; gt < 2; ++gt)
#pragma unroll
        for (int nt = 0; nt < 4; ++nt)
#pragma unroll
            for (int ks = 0; ks < 2; ++ks) Wf[gt][nt][ks] = fp[(size_t)((gt * 4 + nt) * 2 + ks) * 64]; }
    const float ba = C.A->in[14][(l * 2 + DIR) * 256 + ch], bx = C.A->in[16][(l * 2 + DIR) * 256 + ch];
    const float lam = C.A->in[17][(l * 2 + DIR) * 256 + ch];
    const float c8sp = -8.0f * log1pf(expf(-lam));
    float cw[4];
#pragma unroll
    for (int j = 0; j < 4; ++j) cw[j] = C.A->in[11][(l * 4 + j) * 256 + ch];
    const float cb = C.A->in[12][l * 256 + ch];
    for (int w = C.gw; w < NCHUNK * 4; w += C.NGW) {
        const int chunk = w >> 2;
        const int r0 = chunk * 128; const int sb = row_seq_begin(r0), se = sb + row_seq_len(r0);
        float h = FINAL ? DC[(size_t)(chunk * 2 + DIR) * 256 + ch][1] : 0.f, P = 1.f;
        float xr[19];
#define RG_LOADX(dst, sc_) do { const int tb_ = r0 + 16 * (DIR ? 7 - (sc_) : (sc_)) - 2; \
            _Pragma("unroll") for (int i_ = 0; i_ < 19; ++i_) { const int rr_ = tb_ + i_; dst[i_] = (rr_ >= sb && rr_ < se) ? bf2f(UCD[(size_t)rr_ * 1024 + 336 + ch]) : 0.f; } } while (0)
        RG_LOADX(xr, 0);
        for (int sc = 0; sc < 8; ++sc) {
            const int t0 = r0 + 16 * (DIR ? 7 - sc : sc);
            float xcr[16];
#pragma unroll
            for (int a = 0; a < 16; ++a) { const int tt = DIR ? 15 - a : a;
                xcr[tt] = cb + cw[0] * xr[a] + cw[1] * xr[a + 1] + cw[2] * xr[a + 2] + cw[3] * xr[a + 3];
                *(LAS bf16_t*)(xcb + tt * 144 + lane * 2) = (bf16_t)f2bf(xcr[tt]); }
            if (sc + 1 < 8) RG_LOADX(xr, sc + 1);
            LDS_WAIT();
            const bf16x8 A0 = *(const LAS bf16x8*)(xcb + l15 * 144 + (8 * g) * 2), A1 = *(const LAS bf16x8*)(xcb + l15 * 144 + (32 + 8 * g) * 2);
#pragma unroll
            for (int gt = 0; gt < 2; ++gt)
#pragma unroll
                for (int nt = 0; nt < 4; ++nt) { f32x4 acc = (f32x4){0.f, 0.f, 0.f, 0.f};
                    acc = __builtin_amdgcn_mfma_f32_16x16x32_bf16(A0, Wf[gt][nt][0], acc, 0, 0, 0);
                    acc = __builtin_amdgcn_mfma_f32_16x16x32_bf16(A1, Wf[gt][nt][1], acc, 0, 0, 0);
#pragma unroll
                    for (int r = 0; r < 4; ++r) gs[(gt * 16 + 4 * g + r) * 68 + 16 * nt + l15] = acc[r]; }
            LDS_WAIT();
#pragma unroll
            for (int tt = 0; tt < 16; ++tt) {
                const float ra = gs[tt * 68 + lane] + ba, ia = gs[(16 + tt) * 68 + lane] + bx;
                const float r = sigmoidf_(ra), ig = sigmoidf_(ia);
                const float la = c8sp * r, a = __expf(la), u = __builtin_amdgcn_sqrtf(one_minus_a2(2.0f * la, a)) * (ig * xcr[tt]);
                h = fmaf(a, h, u); P *= a;
                if (FINAL) { const int tok = DIR ? t0 + 15 - tt : t0 + tt; HFB[((size_t)DIR * NTOK + tok) * 256 + ch] = (bf16_t)f2bf(h); } }
            LDS_WAIT();
        }
        if (!FINAL) DC[(size_t)(chunk * 2 + DIR) * 256 + ch] = (f32x2){P, h};
#undef RG_LOADX
    }
}
template <bool FINAL>
DI void ph_rglru(const Ctx& C, int l) { rglru_units<FINAL, 0>(C, l); rglru_units<FINAL, 1>(C, l); }
DI void ph_rglru_scan(const Ctx& C) {
    f32x2* DC = (f32x2*)(C.ws + WS_DC);
    for (int idx = C.bid * 512 + C.tid; idx < NSEQ * 512; idx += C.G * 512) {
        const int ch = idx & 255, dir = (idx >> 8) & 1, seq = idx >> 9;
        const int c0 = seq < 8 ? seq * 64 : 512 + (seq - 8) * 16, nc = seq < 8 ? 64 : 16;
        float hin = 0.f;
        for (int i0 = 0; i0 < nc; i0 += 16) {
            f32x2 vv[16];
#pragma unroll
            for (int i = 0; i < 16; ++i) { const int c = dir ? c0 + nc - 1 - (i0 + i) : c0 + i0 + i; vv[i] = DC[(size_t)(c * 2 + dir) * 256 + ch]; }
#pragma unroll
            for (int i = 0; i < 16; ++i) { const float P = vv[i][0], H = vv[i][1]; vv[i][1] = hin; hin = fmaf(P, hin, H); }
#pragma unroll
            for (int i = 0; i < 16; ++i) { const int c = dir ? c0 + nc - 1 - (i0 + i) : c0 + i0 + i; DC[(size_t)(c * 2 + dir) * 256 + ch] = vv[i]; }
        }
    }
}
DI float gelu_tanh(float x) { const float u = 0.7978845608028654f * (x + 0.044715f * x * x * x); const float e = __expf(2.0f * u); const float th = 1.0f - 2.0f / (e + 1.0f); return 0.5f * x * (1.0f + th); }
DI void ph_d_post(const Ctx& C) {
    const bf16_t* UCD = (const bf16_t*)(C.ws + WS_U); const bf16_t* HF = (const bf16_t*)(C.ws + WS_EW); const bf16_t* HB = HF + (size_t)NTOK * 256; bf16_t* Y = (bf16_t*)(C.ws + WS_Y);
    const int c4 = C.lane * 4;
    for (int row0 = C.gw; row0 < NTOK; row0 += 4 * C.NGW) {
        u32x2 a[4], b[4], g[4];
#pragma unroll
        for (int i = 0; i < 4; ++i) { const size_t row = (size_t)row0 + (size_t)i * C.NGW; a[i] = *(const u32x2*)(HF + row * 256 + c4); b[i] = *(const u32x2*)(HB + row * 256 + c4); g[i] = *(const u32x2*)(UCD + row * 1024 + 592 + c4); }
#pragma unroll
        for (int i = 0; i < 4; ++i) { const size_t row = (size_t)row0 + (size_t)i * C.NGW;
            const float y0 = (bflo(a[i].x) + bflo(b[i].x)) * gelu_tanh(bflo(g[i].x)), y1 = (bfhi(a[i].x) + bfhi(b[i].x)) * gelu_tanh(bfhi(g[i].x));
            const float y2 = (bflo(a[i].y) + bflo(b[i].y)) * gelu_tanh(bflo(g[i].y)), y3 = (bfhi(a[i].y) + bfhi(b[i].y)) * gelu_tanh(bfhi(g[i].y));
            u32x2 w; w.x = cvt_pk_bf16(y0, y1); w.y = cvt_pk_bf16(y2, y3);
            *(u32x2*)(Y + row * DM + 768 + c4) = w; }
    }
}

DI void ph_topk(const Ctx& C) {
    const float* affT = (const float*)(C.ws + WS_AFF); int* idx2 = (int*)(C.ws + WS_IDX); float* gsel2 = (float*)(C.ws + WS_GSEL);
    LAS unsigned* hist = (LAS unsigned*)C.lds;
    LAS unsigned* misc = hist + 4096;
    LAS unsigned* cg = misc + 8;
    LAS unsigned* ce = cg + 512;
    for (int u = C.bid; u < 32; u += C.G) {
        const int g = u >> 4, e = u & 15; const unsigned* a = (const unsigned*)(affT + (size_t)(g * 16 + e) * NTOKG);
        const int i0 = C.tid * 128; unsigned v[128];
        { const u32x4* p = (const u32x4*)(a + i0);
#pragma unroll
          for (int j = 0; j < 32; ++j) { const u32x4 q = p[j]; v[4 * j] = q.x; v[4 * j + 1] = q.y; v[4 * j + 2] = q.z; v[4 * j + 3] = q.w; } }
        unsigned prefix = 0u, mask = 0u, krem = CAP;
#pragma unroll 1
        for (int pass = 0; pass < 3; ++pass) {
            const int shift = pass == 0 ? 19 : (pass == 1 ? 7 : 0); const unsigned dm = pass == 2 ? 127u : 4095u; const int per = pass == 2 ? 2 : 64;
            for (int i = C.tid; i < 4096; i += 512) hist[i] = 0u;
            __syncthreads();
#pragma unroll
            for (int i = 0; i < 128; ++i) {
                const unsigned bin = ((v[i] & mask) == prefix) ? ((v[i] >> shift) & dm) : (5120u + (unsigned)C.lane);
                atomicAdd((unsigned*)&hist[bin], 1u); if ((i & 7) == 7) asm volatile("" : "+v"(prefix) :: "memory"); }
            __syncthreads();
            if (C.tid < 64) {
                unsigned t = 0; for (int b = 0; b < per; ++b) t += hist[per * C.tid + b];
                unsigned S = t;
#pragma unroll
                for (int off = 1; off < 64; off <<= 1) { const unsigned y = __shfl_down(S, off); if (C.tid + off < 64) S += y; }
                const unsigned above = S - t;
                if (above < krem && krem <= above + t) { unsigned cum = above; int D = per * C.tid + per - 1;
                    for (; D > per * C.tid; --D) { const unsigned c = hist[D]; if (cum + c >= krem) break; cum += c; }
                    misc[0] = (unsigned)D; misc[1] = cum; }
            }
            __syncthreads();
            prefix |= misc[0] << shift; mask |= dm << shift; krem -= misc[1];
            __syncthreads();
        }
        unsigned ngt = 0, neq = 0;
#pragma unroll
        for (int i = 0; i < 128; ++i) { ngt += (v[i] > prefix); neq += (v[i] == prefix); if ((i & 15) == 15) asm volatile("" : "+v"(prefix)); }
        unsigned ig = ngt, ie = neq;
#pragma unroll
        for (int off = 1; off < 64; off <<= 1) { const unsigned yg = __shfl_up(ig, off), ye = __shfl_up(ie, off); if (C.lane >= off) { ig += yg; ie += ye; } }
        if (C.lane == 63) { cg[C.wave] = ig; ce[C.wave] = ie; }
        __syncthreads();
        unsigned bg = 0, be = 0, allg = 0;
#pragma unroll
        for (int w = 0; w < 8; ++w) { const unsigned x = cg[w], y = ce[w]; if (w < C.wave) { bg += x; be += y; } allg += x; }
        unsigned pg = bg + ig - ngt, pe = be + ie - neq; const unsigned ngt_all = allg;
        int* io = idx2 + (size_t)e * 16384 + g * CAP; float* go = gsel2 + (size_t)e * 16384 + g * CAP; short* sm = (short*)(C.ws + WS_SM) + (size_t)(g * NTOKG + i0) * 16 + e;
#pragma unroll
        for (int i = 0; i < 128; ++i) {
            if (v[i] > prefix) { io[pg] = g * NTOKG + i0 + i; go[pg] = __builtin_bit_cast(float, v[i]); sm[i * 16] = (short)pg; ++pg; }
            else if (v[i] == prefix) { if (pe < krem) { io[ngt_all + pe] = g * NTOKG + i0 + i; go[ngt_all + pe] = __builtin_bit_cast(float, v[i]); sm[i * 16] = (short)(ngt_all + pe); } ++pe; }
            if ((i & 3) == 3) asm volatile("" : "+v"(prefix) :: "memory"); }
        __syncthreads();
    }
}

constexpr int MERGE_CHUNKS = 8, MERGE_ROWS = NTOK / MERGE_CHUNKS;
constexpr int EPB = 2;
constexpr int NPH_LAYER = 12 + 2 * MERGE_CHUNKS + 3 + (NEXP / EPB + 1) + 1, NPH = 1 + 2 * NPH_LAYER;
__global__ void __launch_bounds__(512, 2) mk_fwd(Args args) {
    extern __shared__ __attribute__((aligned(16))) unsigned char lds_raw[];
    Ctx C;
    C.lds = (LAS unsigned char*)lds_raw; C.ws = (GAS unsigned char*)args.ws; C.out = (GAS float*)args.out;
    C.tid = threadIdx.x; C.lane = C.tid & 63; C.wave = __builtin_amdgcn_readfirstlane(C.tid >> 6); C.G = gridDim.x; C.bid = blockIdx.x;
    C.gw = C.bid * 8 + C.wave; C.NGW = C.G * 8;
    C.A = &args;
    volatile LAS unsigned* MISC = (volatile LAS unsigned*)(C.lds + MISC_OFF);
    for (int u = C.tid; u < (LDS_BYTES - RING_BYTES) / 4; u += 512) ((LAS unsigned*)(C.lds + RING_BYTES))[u] = 0u;
    __syncthreads();
    const int lo = args.ph_lo, hi = args.ph_hi;
    unsigned* barw = (unsigned*)(C.ws + WS_CTL) + 4096;
    XcdBarrier bar; bar.bar = barw; bar.x = 0; bar.st = nullptr;
    if (hi - lo > 1) bar = xcd_barrier_post(barw, MISC + 8);
    int ph = 0;
#ifndef PHASE_MASK
#define PHASE_MASK 0xFFFFFFFFu
#endif
#ifndef REPEAT_MASK
#define REPEAT_MASK 0u
#endif
#define SITE(id) if constexpr (((PHASE_MASK) >> (id)) & 1u) for (int rep_ = 0; rep_ < ((((REPEAT_MASK) >> (id)) & 1u) ? 2 : 1); ++rep_)
#define PH_BEGIN if (ph >= lo && ph < hi) { { int tz_ = threadIdx.x; asm volatile("" : "+v"(tz_)); C.tid = tz_; C.lane = tz_ & 63; C.wave = __builtin_amdgcn_readfirstlane(tz_ >> 6); C.gw = C.bid * 8 + C.wave; unsigned char* wz_ = args.ws; asm volatile("" : "+s"(wz_)); C.ws = (GAS unsigned char*)wz_; float* oz_ = args.out; asm volatile("" : "+s"(oz_)); C.out = (GAS float*)oz_; }
#define PH_END } if (ph >= lo && ph + 1 < hi) xcd_barrier(bar); ++ph;

#define XB0 ((bf16_t*)(C.ws + WS_XB0))
#define XB1 ((bf16_t*)(C.ws + WS_XB1))
#define Yb ((bf16_t*)(C.ws + WS_Y))
#define Ub ((bf16_t*)(C.ws + WS_U))
    const int big = 30;

    PH_BEGIN SITE(1) ph_prologue(C); PH_END

    for (int l = 0; l < 2; ++l) {
#define wl (C.ws + WS_WSMALL + (size_t)l * WSMALL_LAYER)
        PH_BEGIN SITE(2) { pg8::Gemm g{XB0, (const bf16_t*)(wl + OFF_WA), NTOK, 768, 1024, 1024, 1024, big, 0}; pg8::StaticOrder S; S.init(NTOK, 768, C.G, C.bid);
            pg8::EpiProj E{Ub, 768, 256, 0.17677669529663689f * LOG2E, (unsigned*)(C.ws + WS_KN2) + (size_t)l * 8 * 2048}; pg8::gemm_phase(C.lds, g, S, E); } PH_END
        PH_BEGIN SITE(3) ph_attn_a(C, l); PH_END
        PH_BEGIN SITE(4) { ph_a_post(C, l); __syncthreads();
            pg8::Gemm g{XB0, (const bf16_t*)(wl + OFF_WB), NTOK, 1280, 1024, 1024, 1024, big, 0}; pg8::StaticOrder S; S.init(NTOK, 1280, C.G, C.bid);
            pg8::EpiProj E{Ub, 1280, 0, 1.f, nullptr}; pg8::gemm_phase(C.lds, g, S, E); } PH_END
        PH_BEGIN SITE(5) ph_hgrn_local(C, l); PH_END
        PH_BEGIN SITE(6) ph_hgrn_scan(C); PH_END
        PH_BEGIN SITE(7) ph_hgrn_out<1>(C, l); PH_END
        PH_BEGIN SITE(20) ph_hgrn_out<2>(C, l); PH_END
        PH_BEGIN SITE(8) { pg8::Gemm g{XB0, (const bf16_t*)(wl + OFF_WCD), NTOK, 1024, 1024, 1024, 1024, big, 0}; pg8::StaticOrder S; S.init(NTOK, 1024, C.G, C.bid);
            pg8::EpiProj E{Ub, 1024, 0, 1.f, nullptr}; pg8::gemm_phase(C.lds, g, S, E); } PH_END
        PH_BEGIN SITE(9) { ph_c_prep(C, l); __syncthreads(); ph_rglru<false>(C, l); } PH_END
        PH_BEGIN SITE(10) { if (rep_ == 0) { ph_rglru_scan(C); __syncthreads(); } ph_attn_c(C); } PH_END
        PH_BEGIN SITE(11) ph_rglru<true>(C, l); PH_END
        PH_BEGIN SITE(12) ph_d_post(C); PH_END
        for (int q = 0; q < MERGE_CHUNKS; ++q) {
            const size_t r0 = (size_t)q * MERGE_ROWS;
            PH_BEGIN SITE(13) {
                { unsigned char* X8 = (unsigned char*)(C.ws + WS_U) + (size_t)MERGE_ROWS * 8192;
                  for (int rb = C.gw; rb < MERGE_ROWS; rb += 8 * C.NGW) {
                      u32x4 a[8], b[8];
#pragma unroll
                      for (int i = 0; i < 8; ++i) { const int r = min(rb + i * C.NGW, MERGE_ROWS - 1); const u32x4* s = (const u32x4*)(XB0 + (r0 + r) * DM) + 2 * C.lane; a[i] = s[0]; b[i] = s[1]; }
#pragma unroll
                      for (int i = 0; i < 8; ++i) { const int r = rb + i * C.NGW; if (r < MERGE_ROWS) {
                          u32x4 o; o.x = pg8::pk4_fp8(bflo(a[i].x), bfhi(a[i].x), bflo(a[i].y), bfhi(a[i].y)); o.y = pg8::pk4_fp8(bflo(a[i].z), bfhi(a[i].z), bflo(a[i].w), bfhi(a[i].w));
                          o.z = pg8::pk4_fp8(bflo(b[i].x), bfhi(b[i].x), bflo(b[i].y), bfhi(b[i].y)); o.w = pg8::pk4_fp8(bflo(b[i].z), bfhi(b[i].z), bflo(b[i].w), bfhi(b[i].w));
                          ((u32x4*)(X8 + (size_t)r * DM))[C.lane] = o; } } }
                  __syncthreads(); }
                pg8::Gemm g{Yb + r0 * DM, (const bf16_t*)(wl + OFF_WBR), MERGE_ROWS, 4096, 256, 1024, 256, 2, 512}; pg8::StaticOrder S; S.init(MERGE_ROWS, 4096, C.G, C.bid);
                pg8::EpiProj E{Ub, 4096, 0, 1.f, nullptr}; pg8::gemm_phase(C.lds, g, S, E); } PH_END
            PH_BEGIN SITE(14) { pg8::Gemm g{(const bf16_t*)(C.ws + WS_U + (size_t)MERGE_ROWS * 8192), (const bf16_t*)(wl + OFF_WG), MERGE_ROWS, 4096, 1024, 1024, 1024, big, 0}; pg8::StaticOrder S; S.init(MERGE_ROWS, 4096, C.G, C.bid);
                pg8::EpiGateMix E{Ub, XB1 + r0 * DM, 1.f / pg8::FP8_W1_SCALE}; pg8::gemm_phase<pg8::EpiGateMix, pg8::StaticOrder, true>(C.lds, g, S, E); } PH_END
        }
        PH_BEGIN SITE(15) { pg8::Gemm g{XB1, (const bf16_t*)(wl + OFF_WOUT), NTOK, 1024, 1024, 1024, 1024, big, 0}; pg8::StaticOrder S; S.init(NTOK, 1024, C.G, C.bid);
            pg8::EpiResid E{l == 0 ? C.A->in[0] : (const float*)C.out, l == 0 ? C.A->in[1] : (const float*)(C.out + (size_t)NTOKG * DM), (float*)C.out}; pg8::gemm_phase(C.lds, g, S, E); } PH_END
        PH_BEGIN SITE(16) { ph_ln<true>(C, l, 0, XB1); } PH_END
        PH_BEGIN SITE(17) { if (C.bid < 32 && C.G > 64) ph_topk(C); else expert_weight_items(C, l); if (C.G <= 64) { __syncthreads(); if (C.bid < 32) ph_topk(C); } } PH_END
        for (int k = 0; k < NEXP / EPB + 1; ++k) {
            PH_BEGIN SITE(18) {
                constexpr size_t H_B = (size_t)EPB * 16384 * 2048;
                unsigned char* Hb = (unsigned char*)(C.ws + WS_XB0);
                if (k < NEXP / EPB) { const int e0 = k * EPB;
                    pg8::Gemm g{(const bf16_t*)(C.ws + WS_XB1), (const bf16_t*)(C.ws + WS_EW + OFF_WGU8 + (size_t)e0 * 4096 * 1024), EPB * 16384, 4096, 1024, 1024, 1024, big, 0, 6, (size_t)4096 * 1024, (const int*)(C.ws + WS_IDX) + (size_t)e0 * 16384}; pg8::StaticOrder S; S.init(EPB * 16384, 4096, C.G, C.bid);
                    pg8::EpiSiluMul8 E{Hb + (size_t)(k & 1) * H_B, 2048}; pg8::gemm_phase<pg8::EpiSiluMul8, pg8::StaticOrder, true, true>(C.lds, g, S, E); }
                if (k >= 1) { const int e0 = (k - 1) * EPB; __syncthreads();
                    pg8::Gemm g{(const bf16_t*)(Hb + (size_t)((k - 1) & 1) * H_B), (const bf16_t*)(C.ws + WS_EW + OFF_WD8 + (size_t)e0 * 1024 * 2048), EPB * 16384, 1024, 2048, 2048, 2048, big, 0, 6, (size_t)1024 * 2048}; pg8::StaticOrder S; S.init(EPB * 16384, 1024, C.G, C.bid);
                    pg8::EpiYe E{(bf16_t*)(C.ws + WS_Y) + (size_t)e0 * 16384 * DM, (const float*)(C.ws + WS_GSEL) + (size_t)e0 * 16384, 1.f / (pg8::FP8_H_SCALE * pg8::FP8_W2_SCALE)}; pg8::gemm_phase<pg8::EpiYe, pg8::StaticOrder, true>(C.lds, g, S, E); }
            } PH_END
        }
        PH_BEGIN SITE(19) ph_ln<false>(C, l, 1, l + 1 < 2 ? XB0 : nullptr); PH_END
    }
#undef PH_BEGIN
#undef PH_END
#undef XB0
#undef XB1
#undef Yb
#undef Ub
#undef wl
}

extern "C" void kernel_launch(void* const* d_in, const int* in_sizes, int n_in, void* d_out, int out_size, void* d_ws, size_t ws_size, hipStream_t stream) {
    static int grid = 0;
    if (grid == 0) {
        if (n_in != 26 || out_size != NTOK * DM || ws_size < WS_END) { fprintf(stderr, "kernel_launch: unexpected shapes: n_in %d out %d ws %zu (need %zu)\n", n_in, out_size, ws_size, (size_t)WS_END); grid = -1; return; }
        int dev = 0, cus = 0, per_cu = 0;
        if (hipGetDevice(&dev) != hipSuccess || hipDeviceGetAttribute(&cus, hipDeviceAttributeMultiprocessorCount, dev) != hipSuccess) { grid = -1; return; }
        if (hipFuncSetAttribute((const void*)mk_fwd, hipFuncAttributeMaxDynamicSharedMemorySize, LDS_BYTES) != hipSuccess) { fprintf(stderr, "kernel_launch: hipFuncSetAttribute failed\n"); grid = -1; return; }
        if (hipOccupancyMaxActiveBlocksPerMultiprocessor(&per_cu, (const void*)mk_fwd, 512, LDS_BYTES) != hipSuccess || per_cu < 1) { fprintf(stderr, "kernel_launch: occupancy query says %d\n", per_cu); }
        (void)hipGetLastError();
        grid = cus;
    }
    if (grid < 0) return;
    if (hipMemsetAsync((char*)d_ws + WS_CTL, 0, CTL_ZERO_BYTES, stream) != hipSuccess) return;
    Args a{};
    for (int i = 0; i < 26; ++i) a.in[i] = (const float*)d_in[i];
    a.out = (float*)d_out; a.ws = (unsigned char*)d_ws;
#if MK_PER_PHASE_LAUNCH
    for (int p = 0; p < NPH; ++p) { a.ph_lo = p; a.ph_hi = p + 1; hipLaunchKernelGGL(mk_fwd, dim3(grid), dim3(512), LDS_BYTES, stream, a); }
#else
    a.ph_lo = 0; a.ph_hi = NPH; hipLaunchKernelGGL(mk_fwd, dim3(grid), dim3(512), LDS_BYTES, stream, a);
#endif
    const hipError_t le = hipPeekAtLastError();
    if (le != hipSuccess) fprintf(stderr, "kernel_launch: launch failed: %s\n", hipGetErrorName(le));
}
```

```cpp
#include <hip/hip_runtime.h>
#include <cstdio>
#include <cstdint>

#ifndef MK_PER_PHASE_LAUNCH
#define MK_PER_PHASE_LAUNCH 0
#endif

#define LAS __attribute__((address_space(3)))
#define GAS __attribute__((address_space(1)))
typedef unsigned short bf16_t;
typedef short bf16x8 __attribute__((ext_vector_type(8)));
typedef short s16x4 __attribute__((ext_vector_type(4)));
typedef float f32x2 __attribute__((ext_vector_type(2)));
typedef float f32x4 __attribute__((ext_vector_type(4)));
typedef float f32x16 __attribute__((ext_vector_type(16)));
typedef unsigned u32x2 __attribute__((ext_vector_type(2)));
typedef unsigned u32x4 __attribute__((ext_vector_type(4)));
#define DI __device__ __forceinline__
#define LDS_WAIT() asm volatile("s_waitcnt lgkmcnt(0)" ::: "memory")
#define VM_WAIT() asm volatile("s_waitcnt vmcnt(0)" ::: "memory")

constexpr int DM = 1024, NTOK = 131072, NTOKG = 65536, NSEQ = 40, NCHUNK = 1024  ;
constexpr int IN_W = 6992, COL_B = 768, COL_CD = 2048, COL_GATE = 2896;
constexpr int NEXP = 16, DEXP = 2048, CAP = 8192;
constexpr float ALPHA = 1.41421356237309515f, INV_ALPHA = 0.70710678118654752f;
constexpr float LOG2E = 1.4426950408889634f;
constexpr float LN_EPS = 1e-5f, RMS_EPS = 1e-6f;

constexpr size_t MiB = (size_t)1 << 20;
constexpr size_t WS_CTL = 0, CTL_ZERO_BYTES = 1 * MiB;
constexpr size_t WS_KN2 = 256 * 1024;
constexpr size_t WS_WSMALL = 2 * MiB, WSMALL_LAYER = 18 * MiB;
constexpr size_t OFF_WA = 0, OFF_WB = (size_t)768 * 1024 * 2, OFF_WCD = OFF_WB + (size_t)1280 * 1024 * 2, OFF_WG = OFF_WCD + (size_t)1024 * 1024 * 2,
                 OFF_WBR = OFF_WG + (size_t)4096 * 1024 * 2, OFF_WOUT = OFF_WBR + (size_t)4096 * 256 * 2;
static_assert(OFF_WOUT + (size_t)1024 * 1024 * 2 <= WSMALL_LAYER, "small weights");
constexpr size_t WS_WC = 38 * MiB, WC_LAYER = 256 * 1024;
constexpr size_t OFF_WQ = 0, OFF_WKV = 96 * 1024;
constexpr size_t WS_WRG = 39 * MiB;
constexpr size_t WS_AFF = 40 * MiB;
constexpr size_t WS_IDX = 48 * MiB, WS_GSEL = 49 * MiB;
constexpr size_t WS_GAM = 50 * MiB;
constexpr size_t WS_DC = 52 * MiB;
constexpr size_t WS_SM = 56 * MiB;
constexpr size_t WS_XB0 = 64 * MiB, WS_XB1 = 320 * MiB, WS_Y = 576 * MiB, WS_U = 832 * MiB, WS_EW = 1152 * MiB, WS_END = 1344 * MiB;
constexpr size_t OFF_QC = 0, OFF_KC = 48 * MiB, OFF_VC = 96 * MiB;
constexpr size_t OFF_WGU8 = 0, OFF_WD8 = (size_t)16 * 4096 * 1024;

DI unsigned f2bf(float f) { unsigned u = __builtin_bit_cast(unsigned, f); return (u + 0x7fffu + ((u >> 16) & 1u)) >> 16; }
DI unsigned pk2(float lo, float hi) { return f2bf(lo) | (f2bf(hi) << 16); }
DI float bf2f(unsigned short b) { return __builtin_bit_cast(float, ((unsigned)b) << 16); }
DI float bflo(unsigned w) { return __builtin_bit_cast(float, w << 16); }
DI float bfhi(unsigned w) { return __builtin_bit_cast(float, w & 0xffff0000u); }
DI unsigned cvt_pk_bf16(float lo, float hi) { unsigned r; asm volatile("v_cvt_pk_bf16_f32 %0, %1, %2" : "=v"(r) : "v"(lo), "v"(hi)); return r; }
typedef __bf16 bf16x2_t __attribute__((ext_vector_type(2)));
DI unsigned cvt_pk_bf16_b(float lo, float hi) { const f32x2 v = {lo, hi}; const bf16x2_t b = __builtin_convertvector(v, bf16x2_t); return __builtin_bit_cast(unsigned, b); }
DI float sigmoidf_(float x) { return __builtin_amdgcn_rcpf(1.0f + __builtin_amdgcn_exp2f(-x * LOG2E)); }
DI float siluf_(float x) { return x * sigmoidf_(x); }
DI float wave_sum(float v) {
#pragma unroll
    for (int o = 1; o < 64; o <<= 1) v += __shfl_xor(v, o);
    return v;
}
DI float wave_max(float v) {
#pragma unroll
    for (int o = 1; o < 64; o <<= 1) v = fmaxf(v, __shfl_xor(v, o));
    return v;
}
DI int seq_start_row(int s) { return s < 8 ? s * 8192 : 65536 + (s - 8) * 2048; }
DI int row_pos(int row) { return row < 65536 ? (row & 8191) : (row & 2047); }
DI int row_seq_begin(int row) { return row < 65536 ? (row & ~8191) : (row & ~2047); }
DI int row_seq_len(int row) { return row < 65536 ? 8192 : 2048; }

namespace pg8 {
constexpr int BM = 256, BK = 64, HALF = 128, HTB = HALF * BK * 2, STAGE_BYTES = 8 * HTB, NXCD = 8, WGM = 8;
DI int lds_byte(int r, int c) { const int st = (r >> 4) * 2 + (c >> 5), rr = r & 15, cc = c & 31, ob = rr * 64 + cc * 2; return st * 1024 + (ob ^ (((ob >> 9) & 1) << 5)); }
DI void stage_rc(int b, int& R, int& C) { const int st = b / 1024, sb = b % 1024, swz = sb ^ (((sb >> 9) & 1) << 5); R = (st >> 1) * 16 + swz / 64; C = (st & 1) * 32 + (swz % 64) / 2; }
DI int perm32(int rho) { const int n = rho >> 4, i = rho & 15; return 8 * (i >> 2) + 4 * n + (i & 3); }

struct Unit { int pm, pn; };
struct Gemm { const bf16_t* A; const bf16_t* Bt; int M, N, K, lda, ldb, an_shift; size_t an_off; int bm_shift = 30; size_t bm_off = 0; const int* gidx = nullptr; };

struct StaticOrder {
    int nM, nN, nwg, G, c;
    DI void init(int M, int N, int G_, int c_) { nM = M / BM; nN = N / BM; nwg = nM * nN; G = G_; c = c_; }
    DI bool next(int i, Unit& u) const {
        const long L = (long)i * G + c; if (L >= nwg) return false;
        int wgid = (int)L; { const int q = nwg / NXCD, r = nwg % NXCD, xcd = wgid % NXCD, off = wgid / NXCD; wgid = (xcd < r ? xcd * (q + 1) : r * (q + 1) + (xcd - r) * q) + off; }
        const int nig = WGM * nN, gid = wgid / nig, fm = gid * WGM, gsz = (nM - fm) < WGM ? (nM - fm) : WGM;
        u.pm = fm + ((wgid % nig) % gsz); u.pn = (wgid % nig) / gsz; return true;
    }
};

typedef f32x4 Acc[2][2][4][2];

typedef int v8i_t __attribute__((ext_vector_type(8)));
DI void mfma8_tied(f32x4& c, const v8i_t& a, const v8i_t& b) { asm volatile("v_mfma_f32_16x16x128_f8f6f4 %0, %1, %2, %0" : "+v"(c) : "v"(a), "v"(b)); }
DI void glds_sv(const void* sbase, unsigned voff, unsigned lds_dst) { unsigned keep;
    asm volatile("s_mov_b32 %0, m0\n\ts_mov_b32 m0, %3\n\ts_nop 0\n\tglobal_load_lds_dwordx4 %1, %2\n\ts_mov_b32 m0, %0" : "=&s"(keep) : "v"(voff), "s"(sbase), "s"(lds_dst) : "memory"); }
constexpr int GIDX_OFF = 131072 + 1024, GIDX_TILES = 14;
template <class Epi, class Sched, bool FP8 = false, bool GATHER = false>
DI void gemm_phase(LAS unsigned char* lds, const Gemm g, const Sched& S, const Epi& E) {
    int tid = threadIdx.x; asm volatile("" : "+v"(tid));
    const int wid = __builtin_amdgcn_readfirstlane(tid >> 6), lane = tid & 63, wr = wid >> 2, wc = wid & 3, fr = lane & 15, fq = lane >> 4;
    const int K = g.K, nt = FP8 ? K / 128 : K / BK;
    const int pitchA = FP8 ? g.lda : g.lda * 2, pitchB = FP8 ? g.ldb : g.ldb * 2;
    unsigned voffA[2], voffB[2];
#pragma unroll
    for (int i = 0; i < 2; ++i) { int R, C; stage_rc(tid * 16 + i * 8192, R, C); const int Rb = Epi::PERM ? ((R & ~31) + perm32(R & 31)) : R;
        voffA[i] = (unsigned)(R * pitchA + C * 2); voffB[i] = (unsigned)(Rb * pitchB + C * 2); }
    const size_t kstep = (size_t)(BK * 2);
    const size_t hstepA = (size_t)HALF * pitchA, hstepB = (size_t)HALF * pitchB;
    const size_t tstepA = 2 * hstepA, tstepB = 2 * hstepB;
    const unsigned ldsw = (unsigned)wid * 1024u;
    const int aoff = lds_byte(wr * 64 + fr, fq * 8), boff = lds_byte(wc * 32 + fr, fq * 8);
#define PG8_SA(b, h) (((b) * 2 + (h)) * HTB)
#define PG8_SB(b, h) ((4 + (b) * 2 + (h)) * HTB)
#define PG8_STAGE(bufoff, gbase, voff) do { _Pragma("unroll") for (int _i = 0; _i < 2; ++_i) \
        glds_sv((const void*)(gbase), (voff)[_i], (unsigned)(uintptr_t)(lds + (bufoff) + ldsw + _i * 8192)); } while (0)
#define PG8_LD1(p) ([&]() { if constexpr (FP8) { const u32x4 lo_ = *(const LAS u32x4*)(p), hi_ = *(const LAS u32x4*)((p) + 1024); return Frag{__builtin_bit_cast(v8i_t, __builtin_shufflevector(lo_, hi_, 0, 1, 2, 3, 4, 5, 6, 7))}; } \
        else { Frag f_; f_.h[0] = *(const LAS bf16x8*)(p); f_.h[1] = *(const LAS bf16x8*)((p) + 1024); return f_; } }())
#define PG8_LDA(dst, b, h) do { _Pragma("unroll") for (int m = 0; m < 4; ++m) dst[m] = PG8_LD1(lds + PG8_SA(b, h) + aoff + m * 2048); } while (0)
#define PG8_LDB(dst, b, h) do { _Pragma("unroll") for (int n = 0; n < 2; ++n) dst[n] = PG8_LD1(lds + PG8_SB(b, h) + boff + n * 2048); } while (0)
#define PG8_MMA(ai, bj, At, Bt) do { __builtin_amdgcn_s_setprio(1); _Pragma("unroll") for (int m = 0; m < 4; ++m) _Pragma("unroll") for (int n = 0; n < 2; ++n) { \
        if constexpr (FP8) mfma8_tied(acc[ai][bj][m][n], Bt[n].w, At[m].w); \
        else { _Pragma("unroll") for (int k = 0; k < 2; ++k) acc[ai][bj][m][n] = __builtin_amdgcn_mfma_f32_16x16x32_bf16(Bt[n].h[k], At[m].h[k], acc[ai][bj][m][n], 0, 0, 0); } } \
        __builtin_amdgcn_s_setprio(0); } while (0)
#define PG8_WAIT_V(n) asm volatile("s_waitcnt vmcnt(" #n ")" ::: "memory")
#define PG8_WAIT_L(n) asm volatile("s_waitcnt lgkmcnt(" #n ")" ::: "memory")
#define PG8_BAR __builtin_amdgcn_s_barrier()
#define PG8_SCHED __builtin_amdgcn_sched_barrier(0)
    Unit cur, nxt; int ui = 0;
    unsigned vg[2][2] = {{0u, 0u}, {0u, 0u}};
    if constexpr (GATHER) { LAS unsigned* tab = (LAS unsigned*)(lds + GIDX_OFF); Unit u_;
        for (int i = 0; i < GIDX_TILES && S.next(i, u_); ++i) { if (tid < 256) tab[i * 256 + tid] = (unsigned)g.gidx[u_.pm * BM + tid]; }
        __syncthreads(); }
#define PG8_GOFF(ord) do { int tq_ = tid; asm volatile("" : "+v"(tq_)); int R_, C_; stage_rc(tq_ * 16, R_, C_); const LAS unsigned* tb_ = (const LAS unsigned*)(lds + GIDX_OFF) + (ord) * 256 + R_; \
        _Pragma("unroll") for (int h_ = 0; h_ < 2; ++h_) _Pragma("unroll") for (int i_ = 0; i_ < 2; ++i_) vg[h_][i_] = tb_[h_ * 128 + i_ * 64] * (unsigned)pitchA + (unsigned)(C_ * 2); } while (0)
#define PG8_STAGE_A(bufoff, base, h) do { if constexpr (GATHER) PG8_STAGE(bufoff, base, vg[h]); else PG8_STAGE(bufoff, (base) + (h) * hstepA, voffA); } while (0)
    if (!S.next(0, cur)) return;
    if constexpr (GATHER) PG8_GOFF(0);
    float zf = 0.f; asm volatile("" : "+v"(zf));
    Acc acc;
#pragma unroll
    for (int a = 0; a < 2; ++a)
#pragma unroll
        for (int b = 0; b < 2; ++b)
#pragma unroll
            for (int m = 0; m < 4; ++m)
#pragma unroll
                for (int n = 0; n < 2; ++n) acc[a][b][m][n] = (f32x4){zf, zf, zf, zf};
    union Frag { v8i_t w; bf16x8 h[2]; };
    Frag At[4], B0[2], B1[2];
    const char* cA = GATHER ? (const char*)g.A : (const char*)g.A + (size_t)cur.pm * tstepA + (size_t)(cur.pn >> g.an_shift) * g.an_off; const char* cB = (const char*)g.Bt + (size_t)cur.pn * tstepB + (size_t)(cur.pm >> g.bm_shift) * g.bm_off;
    PG8_STAGE(PG8_SB(0, 0), cB, voffB); PG8_STAGE(PG8_SB(0, 1), cB + hstepB, voffB); PG8_STAGE_A(PG8_SA(0, 0), cA, 0); PG8_STAGE_A(PG8_SA(0, 1), cA, 1);
    if (wr == 1) PG8_BAR;
    PG8_WAIT_V(2); PG8_BAR;
    PG8_STAGE(PG8_SB(1, 0), cB + kstep, voffB); PG8_STAGE_A(PG8_SA(1, 0), cA + kstep, 0); PG8_STAGE(PG8_SB(1, 1), cB + hstepB + kstep, voffB);
    PG8_WAIT_V(6); PG8_BAR;
    for (;;) {
        const bool has_next = S.next(ui + 1, nxt);
        const char* nA = (has_next && !GATHER) ? (const char*)g.A + (size_t)nxt.pm * tstepA + (size_t)(nxt.pn >> g.an_shift) * g.an_off : cA;
        const char* nB = has_next ? (const char*)g.Bt + (size_t)nxt.pn * tstepB + (size_t)(nxt.pm >> g.bm_shift) * g.bm_off : cB;
#pragma unroll 1
        for (int t = 0; t < nt; t += 2) {
            const bool last = (t == nt - 2);
            const char* a1 = cA + (size_t)(t + 1) * kstep;
            const char* a2 = last ? nA : cA + (size_t)(t + 2) * kstep; const char* b2 = last ? nB : cB + (size_t)(t + 2) * kstep;
            const char* a3 = a2 + kstep; const char* b3 = b2 + kstep;
            PG8_LDB(B0, 0, 0); PG8_LDB(B1, 0, 1); PG8_SCHED; PG8_LDA(At, 0, 0); PG8_STAGE_A(PG8_SA(1, 1), a1, 1);
            if constexpr (GATHER) { if (last && has_next) PG8_GOFF(ui + 1); }
            PG8_WAIT_V(8); PG8_WAIT_L(0); PG8_BAR; PG8_MMA(0, 0, At, B0); PG8_MMA(0, 1, At, B1); PG8_BAR; PG8_SCHED;
            PG8_LDA(At, 0, 1); PG8_STAGE(PG8_SB(0, 0), b2, voffB); PG8_STAGE(PG8_SB(0, 1), b2 + hstepB, voffB); PG8_STAGE_A(PG8_SA(0, 0), a2, 0);
            PG8_WAIT_V(8); PG8_WAIT_L(0); PG8_BAR; PG8_MMA(1, 0, At, B0); PG8_MMA(1, 1, At, B1); PG8_BAR; PG8_SCHED;
            PG8_LDB(B0, 1, 0); PG8_LDB(B1, 1, 1); PG8_SCHED; PG8_LDA(At, 1, 0); PG8_STAGE_A(PG8_SA(0, 1), a2, 1);
            PG8_WAIT_V(8); PG8_WAIT_L(0); PG8_BAR; PG8_MMA(0, 0, At, B0); PG8_MMA(0, 1, At, B1); PG8_BAR; PG8_SCHED;
            PG8_LDA(At, 1, 1); PG8_STAGE(PG8_SB(1, 0), b3, voffB); PG8_STAGE(PG8_SB(1, 1), b3 + hstepB, voffB); PG8_STAGE_A(PG8_SA(1, 0), a3, 0);
            PG8_WAIT_V(8); PG8_WAIT_L(0); PG8_BAR; PG8_MMA(1, 0, At, B0); PG8_MMA(1, 1, At, B1); PG8_BAR; PG8_SCHED;
        }
        if (wr == 0) PG8_BAR;
        if constexpr (FP8) asm volatile("s_nop 15\n\ts_nop 15" ::: "memory");
        { int tz = tid; asm volatile("" : "+v"(tz));
          const int lz = tz & 63; E(acc, cur, wr, wc, lz & 15, lz >> 4); }
        if (!has_next) break;
#pragma unroll
        for (int a = 0; a < 2; ++a)
#pragma unroll
            for (int b = 0; b < 2; ++b)
#pragma unroll
                for (int m = 0; m < 4; ++m)
#pragma unroll
                    for (int n = 0; n < 2; ++n) acc[a][b][m][n] = (f32x4){0.f, 0.f, 0.f, 0.f};
        cur = nxt; cA = nA; cB = nB; ++ui;
        if (wr == 1) PG8_BAR;
    }
    PG8_WAIT_V(0);
    PG8_BAR;
#undef PG8_SA
#undef PG8_SB
#undef PG8_STAGE
#undef PG8_STAGE_A
#undef PG8_GOFF
#undef PG8_LDA
#undef PG8_LDB
#undef PG8_MMA
#undef PG8_LD1
#undef PG8_WAIT_V
#undef PG8_WAIT_L
#undef PG8_BAR
#undef PG8_SCHED
}

struct EpiProj {
    static constexpr bool PERM = true;
    bf16_t* O; int ldc; int scale_cols; float scale; unsigned* kn2;
    DI void operator()(const Acc& acc, const Unit& u, int wr, int wc, int fr, int fq) const {
        const int row0 = u.pm * BM + wr * 64 + fr, colt = u.pn * BM, col0 = colt + wc * 32 + 8 * fq;
        const float sc = (colt < scale_cols) ? scale : 1.f;
        const bool donorm = (kn2 != nullptr) && (colt == 256);
#pragma unroll
        for (int ai = 0; ai < 2; ++ai) { float mx0 = 0.f, mx1 = 0.f;
#pragma unroll
            for (int m = 0; m < 4; ++m) { bf16_t* rowp = O + (size_t)(row0 + ai * HALF + m * 16) * ldc + col0;
#pragma unroll
                for (int bj = 0; bj < 2; ++bj) { const f32x4 v0 = acc[ai][bj][m][0] * sc, v1 = acc[ai][bj][m][1] * sc;
                    u32x4 w; w.x = cvt_pk_bf16(v0[0], v0[1]); w.y = cvt_pk_bf16(v0[2], v0[3]); w.z = cvt_pk_bf16(v1[0], v1[1]); w.w = cvt_pk_bf16(v1[2], v1[3]);
                    *(u32x4*)(rowp + bj * HALF) = w;
                    if (donorm) { float ss = bflo(w.x) * bflo(w.x) + bfhi(w.x) * bfhi(w.x) + bflo(w.y) * bflo(w.y) + bfhi(w.y) * bfhi(w.y) + bflo(w.z) * bflo(w.z) + bfhi(w.z) * bfhi(w.z) + bflo(w.w) * bflo(w.w) + bfhi(w.w) * bfhi(w.w);
                        ss += __shfl_xor(ss, 16); ss += __shfl_xor(ss, 32); if (bj == 0) mx0 = fmaxf(mx0, ss); else mx1 = fmaxf(mx1, ss); } } }
            if (donorm) {
#pragma unroll
                for (int o = 1; o < 16; o <<= 1) { mx0 = fmaxf(mx0, __shfl_xor(mx0, o)); mx1 = fmaxf(mx1, __shfl_xor(mx1, o)); }
                if (fr == 0 && fq == 0) { const int tile = 4 * u.pm + 2 * ai + wr;
                    atomicMax(kn2 + (size_t)(wc) * 2048 + tile, __builtin_bit_cast(unsigned, mx0)); atomicMax(kn2 + (size_t)(4 + wc) * 2048 + tile, __builtin_bit_cast(unsigned, mx1)); } } }
    }
};
struct EpiSiluMul {
    static constexpr bool PERM = true;
    bf16_t* H; int ldh;
    DI void operator()(const Acc& acc, const Unit& u, int wr, int wc, int fr, int fq) const {
        const int row0 = u.pm * BM + wr * 64 + fr, col0 = u.pn * HALF + wc * 32 + 8 * fq;
#pragma unroll
        for (int ai = 0; ai < 2; ++ai)
#pragma unroll
            for (int m = 0; m < 4; ++m) { bf16_t* rowp = H + (size_t)(row0 + ai * HALF + m * 16) * ldh + col0;
                float h[8];
#pragma unroll
                for (int n = 0; n < 2; ++n)
#pragma unroll
                    for (int j = 0; j < 4; ++j) h[n * 4 + j] = siluf_(acc[ai][0][m][n][j]) * acc[ai][1][m][n][j];
                u32x4 w; w.x = cvt_pk_bf16(h[0], h[1]); w.y = cvt_pk_bf16(h[2], h[3]); w.z = cvt_pk_bf16(h[4], h[5]); w.w = cvt_pk_bf16(h[6], h[7]);
                *(u32x4*)rowp = w; }
    }
};
DI unsigned pk4_fp8(float a, float b, float c, float d) { int w = 0; a = __builtin_amdgcn_fmed3f(a, -448.f, 448.f); b = __builtin_amdgcn_fmed3f(b, -448.f, 448.f); c = __builtin_amdgcn_fmed3f(c, -448.f, 448.f); d = __builtin_amdgcn_fmed3f(d, -448.f, 448.f);     w = __builtin_amdgcn_cvt_pk_fp8_f32(a, b, w, false); w = __builtin_amdgcn_cvt_pk_fp8_f32(c, d, w, true); return (unsigned)w; }
constexpr float FP8_W1_SCALE = 32.f, FP8_W2_SCALE = 64.f, FP8_H_SCALE = 4.f;
struct EpiSiluMul8 {
    static constexpr bool PERM = true;
    unsigned char* H; int ldh;
    DI void operator()(const Acc& acc, const Unit& u, int wr, int wc, int fr, int fq) const {
        const int row0 = u.pm * BM + wr * 64 + fr, col0 = u.pn * HALF + wc * 32 + 8 * fq;
        constexpr float k1 = -LOG2E / FP8_W1_SCALE; static_assert(FP8_W1_SCALE * FP8_W1_SCALE / FP8_H_SCALE == 256.f, "scale folding");
#pragma unroll
        for (int ai = 0; ai < 2; ++ai)
#pragma unroll
            for (int m = 0; m < 4; ++m) { unsigned char* rowp = H + (size_t)(row0 + ai * HALF + m * 16) * ldh + col0;
                float t[8], h[8];
#pragma unroll
                for (int q = 0; q < 8; ++q) t[q] = __builtin_fmaf(acc[ai][0][m][q >> 2][q & 3], k1, 8.f);
#pragma unroll
                for (int q = 0; q < 8; ++q) t[q] = __builtin_amdgcn_exp2f(t[q]);
#pragma unroll
                for (int q = 0; q < 8; ++q) { t[q] += 256.f; h[q] = acc[ai][0][m][q >> 2][q & 3] * acc[ai][1][m][q >> 2][q & 3]; }
#pragma unroll
                for (int q = 0; q < 8; ++q) t[q] = __builtin_amdgcn_rcpf(t[q]);
#pragma unroll
                for (int q = 0; q < 8; ++q) h[q] *= t[q];
                u32x2 w; w.x = pk4_fp8(h[0], h[1], h[2], h[3]); w.y = pk4_fp8(h[4], h[5], h[6], h[7]);
                *(u32x2*)rowp = w; }
    }
};
struct EpiMoeDown {
    static constexpr bool PERM = false;
    float* out; const int* idx; const float* gs; float sc;
    DI void operator()(const Acc& acc, const Unit& u, int wr, int wc, int fr, int fq) const {
        const int row0 = u.pm * BM + wr * 64 + fr, col0 = u.pn * BM + wc * 32 + 4 * fq;
#pragma unroll
        for (int ai = 0; ai < 2; ++ai)
#pragma unroll
            for (int m = 0; m < 4; ++m) { const int rl = row0 + ai * HALF + m * 16; const int tok = idx[rl]; const float g = gs[rl] * sc;
                float* rowp = out + (size_t)tok * DM + col0;
#pragma unroll
                for (int bj = 0; bj < 2; ++bj)
#pragma unroll
                    for (int n = 0; n < 2; ++n) { f32x4* p = (f32x4*)(rowp + bj * HALF + n * 16); f32x4 v = *p; v += acc[ai][bj][m][n] * g; *p = v; }
                asm volatile("" ::: "memory"); }
    }
};
struct EpiYe {
    static constexpr bool PERM = true;
    bf16_t* O; const float* gs; float sc;
    DI void operator()(const Acc& acc, const Unit& u, int wr, int wc, int fr, int fq) const {
        const int row0 = u.pm * BM + wr * 64 + fr, col0 = u.pn * BM + wc * 32 + 8 * fq;
        float gv[8];
#pragma unroll
        for (int c = 0; c < 8; ++c) gv[c] = gs[row0 + (c >> 2) * HALF + (c & 3) * 16];
#pragma unroll
        for (int ai = 0; ai < 2; ++ai)
#pragma unroll
            for (int m = 0; m < 4; ++m) { const int rl = row0 + ai * HALF + m * 16; const float g = gv[ai * 4 + m] * sc; bf16_t* rowp = O + (size_t)rl * DM + col0;
#pragma unroll
                for (int bj = 0; bj < 2; ++bj) { const f32x4 v0 = acc[ai][bj][m][0] * g, v1 = acc[ai][bj][m][1] * g;
                    u32x4 w; w.x = cvt_pk_bf16(v0[0], v0[1]); w.y = cvt_pk_bf16(v0[2], v0[3]); w.z = cvt_pk_bf16(v1[0], v1[1]); w.w = cvt_pk_bf16(v1[2], v1[3]);
                    *(u32x4*)(rowp + bj * HALF) = w; } }
    }
};
struct EpiResid {
    static constexpr bool PERM = false;
    const float* xa; const float* xb; float* out;
    DI void operator()(const Acc& acc, const Unit& u, int wr, int wc, int fr, int fq) const {
        const int row0 = u.pm * BM + wr * 64 + fr, col0 = u.pn * BM + wc * 32 + 4 * fq;
#pragma unroll
        for (int ai = 0; ai < 2; ++ai) {
            f32x4 sv[4][4];
#pragma unroll
            for (int m = 0; m < 4; ++m) { const int r = row0 + ai * HALF + m * 16;
                const float* srow = (r < NTOKG ? xa + (size_t)r * DM : xb + (size_t)(r - NTOKG) * DM) + col0;
#pragma unroll
                for (int q = 0; q < 4; ++q) sv[m][q] = *(const f32x4*)(srow + (q >> 1) * HALF + (q & 1) * 16); }
#pragma unroll
            for (int m = 0; m < 4; ++m) { const int r = row0 + ai * HALF + m * 16; float* orow = out + (size_t)r * DM + col0;
#pragma unroll
                for (int q = 0; q < 4; ++q) *(f32x4*)(orow + (q >> 1) * HALF + (q & 1) * 16) = sv[m][q] + acc[ai][q >> 1][m][q & 1] * INV_ALPHA; } }
    }
};
struct EpiGateMix {
    static constexpr bool PERM = false;
    const bf16_t* Z; bf16_t* mix; float si;
    DI void operator()(const Acc& acc, const Unit& u, int wr, int wc, int fr, int fq) const {
        const int row0 = u.pm * BM + wr * 64 + fr, J0 = u.pn * 64 + wc * 16 + fq * 4;
        u32x2 zall[8][4];
#pragma unroll
        for (int c = 0; c < 8; ++c) { const bf16_t* zrow = Z + (size_t)(row0 + (c >> 2) * HALF + (c & 3) * 16) * 4096 + J0;
#pragma unroll
            for (int b = 0; b < 4; ++b) zall[c][b] = *(const u32x2*)(zrow + b * 1024); }
#pragma unroll
        for (int ai = 0; ai < 2; ++ai)
#pragma unroll
            for (int m = 0; m < 4; ++m) { const int r = row0 + ai * HALF + m * 16;
                u32x2 zw[4];
#pragma unroll
                for (int b = 0; b < 4; ++b) zw[b] = zall[ai * 4 + m][b];
                const float kq = -si * LOG2E; float t[16];
#pragma unroll
                for (int q = 0; q < 16; ++q) t[q] = acc[ai][q >> 3][m][(q >> 2) & 1][q & 3] * kq;
#pragma unroll
                for (int q = 0; q < 16; ++q) t[q] = __builtin_amdgcn_exp2f(t[q]);
#pragma unroll
                for (int q = 0; q < 16; ++q) t[q] += 1.f;
#pragma unroll
                for (int q = 0; q < 16; ++q) t[q] = __builtin_amdgcn_rcpf(t[q]);
                f32x4 s = (f32x4){0.f, 0.f, 0.f, 0.f};
#pragma unroll
                for (int b = 0; b < 4; ++b) { s[0] += t[4 * b] * bflo(zw[b].x); s[1] += t[4 * b + 1] * bfhi(zw[b].x); s[2] += t[4 * b + 2] * bflo(zw[b].y); s[3] += t[4 * b + 3] * bfhi(zw[b].y); }
                u32x2 w; w.x = cvt_pk_bf16(s[0], s[1]); w.y = cvt_pk_bf16(s[2], s[3]);
                *(u32x2*)(mix + (size_t)r * DM + J0) = w; }
    }
};
}

#define XB_TMO      128
#define XB_XCNT(j)  (256  + 64 * (j))
#define XB_XSUB(j)  (1280 + 64 * (j))
#define XB_XGEN(j)  (2304 + 64 * (j))
#define XB_TOP      3328
#define XB_TOPGEN   3392
#define XCD_BAR_WORDS 3456
#define XB_SPIN_CAP (1u << 24)
DI unsigned xb_ld(unsigned* p)              { return __hip_atomic_load(p, __ATOMIC_RELAXED, __HIP_MEMORY_SCOPE_AGENT); }
DI unsigned xb_add(unsigned* p, unsigned v) { return __hip_atomic_fetch_add(p, v, __ATOMIC_RELAXED, __HIP_MEMORY_SCOPE_AGENT); }
DI unsigned xb_xcc_id() { return (unsigned)__builtin_amdgcn_s_getreg((3 << 11) | 20) & 0xFu; }
#define XB_SPIN(cond, bar) do { unsigned _sp = 0; while (cond) { __builtin_amdgcn_s_sleep(1); \
    if ((++_sp & 255u) == 0u) { if (xb_ld(&(bar)[XB_TMO])) break; if (_sp > XB_SPIN_CAP) { atomicAdd(&(bar)[XB_TMO], 1u); break; } } } } while (0)
struct XcdBarrier { unsigned* bar; unsigned x; volatile LAS unsigned* st; };
DI XcdBarrier xcd_barrier_post(unsigned* bar, volatile LAS unsigned* st) {
    XcdBarrier b; b.bar = bar; b.x = xb_xcc_id(); b.st = st;
    if (threadIdx.x == 0) (void)xb_add(&bar[XB_XCNT(b.x)], 1u);
    return b;
}
DI void xcd_barrier_complete(unsigned* bar, unsigned x, unsigned& nloc, unsigned& nx) {
    const unsigned G = gridDim.x * gridDim.y * gridDim.z;
    unsigned sum, cnt, mine, sp = 0u;
    for (;;) {
        sum = 0u; cnt = 0u; mine = 0u;
#pragma unroll
        for (unsigned j = 0; j < 16; ++j) { const unsigned c = xb_ld(&bar[XB_XCNT(j)]); sum += c; cnt += (c > 0u) ? 1u : 0u; mine = (j == x) ? c : mine; }
        if (sum == G) break;
        __builtin_amdgcn_s_sleep(1);
        if ((++sp & 255u) == 0u) { if (xb_ld(&bar[XB_TMO])) break; if (sp > XB_SPIN_CAP) { atomicAdd(&bar[XB_TMO], 1u); break; } }
    }
    nloc = mine > 0u ? mine : 1u; nx = cnt > 0u ? cnt : 1u;
}
DI void xcd_barrier(const XcdBarrier& b) {
    asm volatile("s_waitcnt vmcnt(0)" ::: "memory");
    __syncthreads();
    if (threadIdx.x == 0) {
        unsigned* bar = b.bar;
        __builtin_amdgcn_s_waitcnt(0);
        unsigned nloc = b.st[0], nx = b.st[1];
        if (nloc == 0u) { xcd_barrier_complete(bar, b.x, nloc, nx); b.st[0] = nloc; b.st[1] = nx; }
        const unsigned old = xb_add(&bar[XB_XSUB(b.x)], 1u);
        const unsigned gen = old / nloc;
        if (old + 1u == (gen + 1u) * nloc) {
            __builtin_amdgcn_fence(__ATOMIC_RELEASE, "agent");
            asm volatile("s_waitcnt vmcnt(0)" ::: "memory");
            const unsigned og = xb_add(&bar[XB_TOP], 1u);
            const unsigned tg = og / nx;
            if (og + 1u == (tg + 1u) * nx) xb_add(&bar[XB_TOPGEN], 1u);
            else XB_SPIN(xb_ld(&bar[XB_TOPGEN]) == tg, bar);
            __builtin_amdgcn_fence(__ATOMIC_ACQUIRE, "agent");
            xb_add(&bar[XB_XGEN(b.x)], 1u);
            asm volatile("s_waitcnt vmcnt(0)" ::: "memory");
        } else {
            XB_SPIN(xb_ld(&bar[XB_XGEN(b.x)]) == gen, bar);
            __builtin_amdgcn_fence(__ATOMIC_ACQUIRE, "agent");
            asm volatile("s_waitcnt vmcnt(0)" ::: "memory");
        }
    }
    __syncthreads();
}

struct Args { const float* in[26]; float* out; unsigned char* ws; int ph_lo, ph_hi; };
struct Ctx {
    LAS unsigned char* lds;
    GAS unsigned char* ws;
    int tid, lane, wave, G, bid, gw, NGW;
    const struct Args* A;
    GAS float* out;
};
constexpr int RING_BYTES = 131072, MISC_OFF = RING_BYTES + 320, LDS_BYTES = 147456;

DI void tr_item(const float* __restrict__ W, int ldw, int k0, int src, const float* kscale, bf16_t* WT, int ldt, int orow0, LAS float* scr, int lane) {
    float tv[32];
#pragma unroll
    for (int i = 0; i < 32; ++i) { const int kk = 2 * i + (lane >> 5); tv[i] = (src >= 0) ? W[(size_t)(k0 + kk) * ldw + src] : 0.f; }
#pragma unroll
    for (int i = 0; i < 32; ++i) { const int kk = 2 * i + (lane >> 5); float v = tv[i]; if (kscale) v *= kscale[k0 + kk]; scr[kk * 33 + (lane & 31)] = v; }
    LDS_WAIT();
    const int c = lane & 7;
#pragma unroll
    for (int j = 0; j < 4; ++j) { const int n = (lane >> 3) + 8 * j; const LAS float* s = scr + (8 * c) * 33 + n;
        u32x4 o; o.x = pk2(s[0 * 33], s[1 * 33]); o.y = pk2(s[2 * 33], s[3 * 33]); o.z = pk2(s[4 * 33], s[5 * 33]); o.w = pk2(s[6 * 33], s[7 * 33]);
        *(u32x4*)(WT + (size_t)(orow0 + n) * ldt + k0 + 8 * c) = o; }
    LDS_WAIT();
}
DI void tr_item8(const float* __restrict__ W, int ldw, int k0, int src, float scale, unsigned char* WT, int ldt, int orow0, LAS float* scr, int lane) {
    float tv[32];
#pragma unroll
    for (int i = 0; i < 32; ++i) { const int kk = 2 * i + (lane >> 5); tv[i] = W[(size_t)(k0 + kk) * ldw + src]; }
#pragma unroll
    for (int i = 0; i < 32; ++i) { const int kk = 2 * i + (lane >> 5); scr[kk * 33 + (lane & 31)] = tv[i] * scale; }
    LDS_WAIT();
    const int c = lane & 7;
#pragma unroll
    for (int j = 0; j < 4; ++j) { const int n = (lane >> 3) + 8 * j; const LAS float* s = scr + (8 * c) * 33 + n;
        u32x2 o; o.x = pg8::pk4_fp8(s[0 * 33], s[1 * 33], s[2 * 33], s[3 * 33]); o.y = pg8::pk4_fp8(s[4 * 33], s[5 * 33], s[6 * 33], s[7 * 33]);
        *(u32x2*)(WT + (size_t)(orow0 + n) * ldt + k0 + 8 * c) = o; }
    LDS_WAIT();
}
constexpr int SW_ITEMS[8] = {16 * 24, 16 * 40, 16 * 32, 16 * 128, 4 * 4 * 32, 16 * 32, 3 * 6, 2 * 12};
constexpr int SW_TOTAL = 16 * 24 + 16 * 40 + 16 * 32 + 16 * 128 + 4 * 4 * 32 + 16 * 32 + 3 * 6 + 2 * 12;
DI void small_weight_item(const Ctx& C, int l, int it, LAS float* scr) {
    unsigned char* wl = (unsigned char*)(C.ws + WS_WSMALL + (size_t)l * WSMALL_LAYER); unsigned char* wc = (unsigned char*)(C.ws + WS_WC + (size_t)l * WC_LAYER);
    const float* win = C.A->in[2] + (size_t)l * DM * IN_W; const int ln = C.lane & 31;
    if (it < 384) { const int kb = it / 24, nb = it % 24; tr_item(win, IN_W, kb * 64, nb * 32 + ln, nullptr, (bf16_t*)(wl + OFF_WA), 1024, nb * 32, scr, C.lane); return; } it -= 384;
    if (it < 640) { const int kb = it / 40, nb = it % 40; tr_item(win, IN_W, kb * 64, COL_B + nb * 32 + ln, nullptr, (bf16_t*)(wl + OFF_WB), 1024, nb * 32, scr, C.lane); return; } it -= 640;
    if (it < 512) { const int kb = it / 32, nb = it % 32; const int n = nb * 32 + ln; tr_item(win, IN_W, kb * 64, n < 848 ? COL_CD + n : -1, nullptr, (bf16_t*)(wl + OFF_WCD), 1024, nb * 32, scr, C.lane); return; } it -= 512;
    if (it < 2048) { const int kb = it / 128, nb = it % 128; const int n = nb * 32 + ln, pn = n >> 8, c = n & 255;
        const int bj = c >> 7, wcc = (c >> 5) & 3, nn = (c >> 4) & 1, fq = (c >> 2) & 3, j = c & 3;
        const int src = COL_GATE + (2 * bj + nn) * 1024 + 64 * pn + 16 * wcc + 4 * fq + j;
        tr_item8(win, IN_W, kb * 64, src, pg8::FP8_W1_SCALE, wl + OFF_WG, 1024, nb * 32, scr, C.lane); return; } it -= 2048;
    if (it < 512) { const int b = it / 128, r = it % 128, kb = r / 32, nb = r % 32;
        tr_item(C.A->in[18] + (size_t)(l * 4 + b) * 256 * 1024, 1024, kb * 64, nb * 32 + ln, nullptr, (bf16_t*)(wl + OFF_WBR), 256, b * 1024 + nb * 32, scr, C.lane); return; } it -= 512;
    if (it < 512) { const int kb = it / 32, nb = it % 32; tr_item(C.A->in[19] + (size_t)l * DM * DM, 1024, kb * 64, nb * 32 + ln, nullptr, (bf16_t*)(wl + OFF_WOUT), 1024, nb * 32, scr, C.lane); return; } it -= 512;
    if (it < 18) { const int kb = it / 6, nb = it % 6; tr_item(C.A->in[8] + (size_t)l * 192 * 192, 192, kb * 64, nb * 32 + ln, C.A->in[7] + l * 192, (bf16_t*)(wc + OFF_WQ), 192, nb * 32, scr, C.lane); return; } it -= 18;
    { const int kb = it / 12, nb = it % 12; tr_item(C.A->in[10] + (size_t)l * 128 * 384, 384, kb * 64, nb * 32 + ln, C.A->in[9] + l * 128, (bf16_t*)(wc + OFF_WKV), 128, nb * 32, scr, C.lane); }
}
DI void ph_prologue(const Ctx& C) {
    LAS float* scr = (LAS float*)(C.lds + C.wave * 16384);
    for (int it = C.gw; it < 2 * SW_TOTAL; it += C.NGW) small_weight_item(C, it / SW_TOTAL, it % SW_TOTAL, scr);
    for (int it = C.gw; it < 2 * 2 * 4 * 2 * 4 * 2; it += C.NGW) {
        const int ks = it & 1, nt = (it >> 1) & 3, gt = (it >> 3) & 1, n = (it >> 4) & 3, dir = (it >> 6) & 1, l = it >> 7;
        const float* wp = (gt == 0 ? C.A->in[13] : C.A->in[15]) + ((size_t)((l * 2 + dir) * 4 + n) * 64) * 64;
        const int l15 = C.lane & 15, g = C.lane >> 4; u32x4 wv;
#pragma unroll
        for (int p = 0; p < 4; ++p) { const int k = 32 * ks + 8 * g + 2 * p; wv[p] = cvt_pk_bf16(wp[(size_t)k * 64 + 16 * nt + l15], wp[(size_t)(k + 1) * 64 + 16 * nt + l15]); }
        ((u32x4*)(C.ws + WS_WRG))[(size_t)it * 64 + C.lane] = wv;
    }
    bf16_t* XB0 = (bf16_t*)(C.ws + WS_XB0);
    for (int row0 = C.gw; row0 < NTOK; row0 += 4 * C.NGW) {
        f32x4 v[4][4];
#pragma unroll
        for (int i = 0; i < 4; ++i) { const int row = min(row0 + i * C.NGW, NTOK - 1);
            const float* src = row < NTOKG ? C.A->in[0] + (size_t)row * DM : C.A->in[1] + (size_t)(row - NTOKG) * DM; const f32x4* xr = (const f32x4*)src + C.lane;
#pragma unroll
            for (int j = 0; j < 4; ++j) v[i][j] = xr[64 * j]; }
#pragma unroll
        for (int i = 0; i < 4; ++i) { const int row = row0 + i * C.NGW; if (row < NTOK) { u32x2* o = (u32x2*)(XB0 + (size_t)row * DM) + C.lane;
#pragma unroll
            for (int j = 0; j < 4; ++j) { u32x2 w; w.x = cvt_pk_bf16(v[i][j][0], v[i][j][1]); w.y = cvt_pk_bf16(v[i][j][2], v[i][j][3]); o[64 * j] = w; } } }
    }
}
DI void expert_weight_items(const Ctx& C, int l) {
    __syncthreads();
    LAS float* scr = (LAS float*)(C.lds + C.wave * 16384);
    unsigned char* WGU = (unsigned char*)(C.ws + WS_EW + OFF_WGU8); unsigned char* WD = (unsigned char*)(C.ws + WS_EW + OFF_WD8);
    const int ln = C.lane & 31;
    const int gw0 = (C.G > 64) ? C.gw - 32 * 8 : C.gw, ngw = (C.G > 64) ? C.NGW - 32 * 8 : C.NGW;
    for (int it = gw0; it < 32768 + 16384; it += ngw) {
        if (it < 32768) { const int e = it >> 11, r = it & 2047, kb = r >> 7, nb = r & 127; const int n = nb * 32 + ln, pn = n >> 8, c = n & 255;
            const float* W = (c < 128 ? C.A->in[23] : C.A->in[24]) + (size_t)(l * NEXP + e) * DM * DEXP;
            tr_item8(W, DEXP, kb * 64, 128 * pn + (c & 127), pg8::FP8_W1_SCALE, WGU + (size_t)e * 4096 * 1024, 1024, nb * 32, scr, C.lane);
        } else { const int i2 = it - 32768, e = i2 >> 10, r = i2 & 1023, kb = r >> 5, nb = r & 31;
            tr_item8(C.A->in[25] + (size_t)(l * NEXP + e) * DEXP * DM, DM, kb * 64, nb * 32 + ln, pg8::FP8_W2_SCALE, WD + (size_t)e * 1024 * 2048, 2048, nb * 32, scr, C.lane); }
    }
}

template <bool ROUTER>
DI void ph_ln(const Ctx& C, int l, int which, bf16_t* XB) {
    LAS float* wr = (LAS float*)C.lds;
    if (ROUTER) { const float* src = C.A->in[22] + (size_t)l * DM * NEXP;
        for (int t = C.tid; t < DM * NEXP / 4; t += 512) { const int k = t >> 2, q = t & 3, ln = (k & 255) >> 2, ii = k & 3, jj = k >> 8;
            ((LAS f32x4*)wr)[((jj * 4 + ii) * 4 + q) * 64 + ln] = ((const f32x4*)src)[t]; }
        __syncthreads(); }
    const float* gp = C.A->in[20] + (size_t)(l * 2 + which) * DM; const float* bp = C.A->in[21] + (size_t)(l * 2 + which) * DM;
    f32x4 gv[4], bv[4];
#pragma unroll
    for (int j = 0; j < 4; ++j) { gv[j] = ((const f32x4*)gp)[C.lane + 64 * j]; bv[j] = ((const f32x4*)bp)[C.lane + 64 * j]; }
    float* affT = (float*)(C.ws + WS_AFF);
    f32x4 nx[4], ny[4], nz[4], nw[4];
    { const f32x4* xr0 = (const f32x4*)(C.out + (size_t)C.gw * DM) + C.lane;
#pragma unroll
      for (int j = 0; j < 4; ++j) nx[j] = xr0[64 * j];
      { const f32x4* xr1 = (const f32x4*)(C.out + (size_t)min(C.gw + C.NGW, NTOK - 1) * DM) + C.lane;
#pragma unroll
          for (int j = 0; j < 4; ++j) ny[j] = xr1[64 * j]; }
      { const f32x4* xr2 = (const f32x4*)(C.out + (size_t)min(C.gw + 2 * C.NGW, NTOK - 1) * DM) + C.lane;
#pragma unroll
          for (int j = 0; j < 4; ++j) nz[j] = xr2[64 * j]; }
      { const f32x4* xr3 = (const f32x4*)(C.out + (size_t)min(C.gw + 3 * C.NGW, NTOK - 1) * DM) + C.lane;
#pragma unroll
          for (int j = 0; j < 4; ++j) nw[j] = xr3[64 * j]; } }
    u32x4 sm0 = {0u, 0u, 0u, 0u}, sm1 = {0u, 0u, 0u, 0u};
    if (!ROUTER) { const u32x4* smr = (const u32x4*)(C.ws + WS_SM + (size_t)C.gw * 32); sm0 = smr[0]; sm1 = smr[1]; }
    for (int row = C.gw; row < NTOK; row += C.NGW) {
        f32x4* xr = (f32x4*)(C.out + (size_t)row * DM) + C.lane;
        f32x4 v[4]; float s = 0.f;
#pragma unroll
        for (int j = 0; j < 4; ++j) v[j] = nx[j] * ALPHA;
        if (!ROUTER) {
            const unsigned sw[8] = {sm0.x, sm0.y, sm0.z, sm0.w, sm1.x, sm1.y, sm1.z, sm1.w};
            { const u32x4* smr = (const u32x4*)(C.ws + WS_SM + (size_t)min(row + C.NGW, NTOK - 1) * 32); sm0 = smr[0]; sm1 = smr[1]; }
            const bf16_t* YE = (const bf16_t*)(C.ws + WS_Y); const int gofs = (row >> 16) * CAP;
            unsigned msk = 0u;
#pragma unroll
            for (int e = 0; e < 16; ++e) { const int slot = (int)(short)((e & 1) ? (sw[e >> 1] >> 16) : (sw[e >> 1] & 0xffffu)); if (slot >= 0) msk |= 1u << e; }
            msk = (unsigned)__builtin_amdgcn_readfirstlane((int)msk);
            while (msk) {
                const int e1 = __builtin_ctz(msk); msk &= msk - 1u; const bool two = msk != 0u; const int e2 = two ? __builtin_ctz(msk) : e1; if (two) msk &= msk - 1u;
                unsigned w1 = sw[0], w2 = sw[0];
#pragma unroll
                for (int q = 1; q < 8; ++q) { w1 = ((e1 >> 1) == q) ? sw[q] : w1; w2 = ((e2 >> 1) == q) ? sw[q] : w2; }
                const int s1 = (int)((e1 & 1) ? (w1 >> 16) : (w1 & 0xffffu)), s2 = (int)((e2 & 1) ? (w2 >> 16) : (w2 & 0xffffu));
                const u32x2* y1 = (const u32x2*)(YE + ((size_t)e1 * 16384 + gofs + s1) * DM) + C.lane; const u32x2* y2 = (const u32x2*)(YE + ((size_t)e2 * 16384 + gofs + s2) * DM) + C.lane;
                u32x2 a[4], b[4];
#pragma unroll
                for (int j = 0; j < 4; ++j) { a[j] = y1[64 * j]; b[j] = y2[64 * j]; }
                const float f2 = two ? 1.f : 0.f;
#pragma unroll
                for (int j = 0; j < 4; ++j) { v[j][0] += bflo(a[j].x) + f2 * bflo(b[j].x); v[j][1] += bfhi(a[j].x) + f2 * bfhi(b[j].x); v[j][2] += bflo(a[j].y) + f2 * bflo(b[j].y); v[j][3] += bfhi(a[j].y) + f2 * bfhi(b[j].y); }
            }
        }
#pragma unroll
        for (int j = 0; j < 4; ++j) s += (v[j][0] + v[j][1]) + (v[j][2] + v[j][3]);
#pragma unroll
        for (int j = 0; j < 4; ++j) { nx[j] = ny[j]; ny[j] = nz[j]; nz[j] = nw[j]; }
        { const int rn = row + 4 * C.NGW < NTOK ? row + 4 * C.NGW : row; const f32x4* xn = (const f32x4*)(C.out + (size_t)rn * DM) + C.lane;
#pragma unroll
            for (int j = 0; j < 4; ++j) nw[j] = xn[64 * j]; }
        const float mean = wave_sum(s) * (1.f / DM); float s2 = 0.f;
#pragma unroll
        for (int j = 0; j < 4; ++j) { v[j] = v[j] - mean; s2 += (v[j][0] * v[j][0] + v[j][1] * v[j][1]) + (v[j][2] * v[j][2] + v[j][3] * v[j][3]); }
        const float rstd = 1.0f / sqrtf(wave_sum(s2) * (1.f / DM) + LN_EPS);
        u32x2* o8 = (u32x2*)(XB + (size_t)row * DM) + C.lane; unsigned* o4 = (unsigned*)((unsigned char*)XB + (size_t)row * DM) + C.lane;
#pragma unroll
        for (int j = 0; j < 4; ++j) { v[j] = v[j] * rstd * gv[j] + bv[j]; xr[64 * j] = v[j];
            if constexpr (ROUTER) { o4[64 * j] = pg8::pk4_fp8(v[j][0], v[j][1], v[j][2], v[j][3]); asm volatile("" ::: "memory"); }
            else if (XB) { u32x2 w; w.x = cvt_pk_bf16(v[j][0], v[j][1]); w.y = cvt_pk_bf16(v[j][2], v[j][3]); o8[64 * j] = w; } }
        if (ROUTER) {
            float p[16];
#pragma unroll
            for (int e = 0; e < 16; ++e) p[e] = 0.f;
#pragma unroll
            for (int j = 0; j < 4; ++j)
#pragma unroll
                for (int i = 0; i < 4; ++i) { const float xv = v[j][i];
#pragma unroll
                    for (int q = 0; q < 4; ++q) { const f32x4 w4 = ((const LAS f32x4*)wr)[((j * 4 + i) * 4 + q) * 64 + C.lane]; p[4 * q] += xv * w4[0]; p[4 * q + 1] += xv * w4[1]; p[4 * q + 2] += xv * w4[2]; p[4 * q + 3] += xv * w4[3]; } }
            const bool b5 = (C.lane & 32) != 0, b4 = (C.lane & 16) != 0, b3 = (C.lane & 8) != 0, b2 = (C.lane & 4) != 0;
            float r8[8], r4[4], r2[2], lg;
#pragma unroll
            for (int i = 0; i < 8; ++i) { const float keep = b5 ? p[8 + i] : p[i], send = b5 ? p[i] : p[8 + i]; r8[i] = keep + __shfl_xor(send, 32); }
#pragma unroll
            for (int i = 0; i < 4; ++i) { const float keep = b4 ? r8[4 + i] : r8[i], send = b4 ? r8[i] : r8[4 + i]; r4[i] = keep + __shfl_xor(send, 16); }
#pragma unroll
            for (int i = 0; i < 2; ++i) { const float keep = b3 ? r4[2 + i] : r4[i], send = b3 ? r4[i] : r4[2 + i]; r2[i] = keep + __shfl_xor(send, 8); }
            { const float keep = b2 ? r2[1] : r2[0], send = b2 ? r2[0] : r2[1]; lg = keep + __shfl_xor(send, 4); }
            lg += __shfl_xor(lg, 2); lg += __shfl_xor(lg, 1);
            float mx = lg;
            mx = fmaxf(mx, __shfl_xor(mx, 4)); mx = fmaxf(mx, __shfl_xor(mx, 8)); mx = fmaxf(mx, __shfl_xor(mx, 16)); mx = fmaxf(mx, __shfl_xor(mx, 32));
            const float ex = __expf(lg - mx); float den = ex;
            den += __shfl_xor(den, 4); den += __shfl_xor(den, 8); den += __shfl_xor(den, 16); den += __shfl_xor(den, 32);
            const int eL = (b5 ? 8 : 0) + (b4 ? 4 : 0) + (b3 ? 2 : 0) + (b2 ? 1 : 0);
            if ((C.lane & 3) == 0) affT[((size_t)(row >> 16) * 16 + eL) * NTOKG + (row & 65535)] = ex / den;
            if (C.lane < 8) ((unsigned*)(C.ws + WS_SM))[(size_t)row * 8 + C.lane] = 0xFFFFFFFFu;
        }
    }
}

namespace att {
DI int crow(int r, int hi) { return (r & 3) + 8 * (r >> 2) + 4 * hi; }
DI int v_st(int k, int c) { const int kk = (k & ~0xC) | ((k & 4) << 1) | ((k & 8) >> 1); return ((kk >> 3) * 2 + (c >> 5)) * 512 + ((kk & 7) * 32 + (c & 31)) * 2; }
DI int v_rd_base(int lane) { return ((lane & 3) << 3) | (((lane >> 2) & 3) << 6) | (((lane >> 4) & 1) << 5) | (((lane >> 5) & 1) << 8); }
constexpr int v_rd_off(int d0, int ks, int half) { return d0 * 512 + ks * 2048 + half * 1024; }
template <int OFF> DI s16x4 tr_read(int vb) { s16x4 r; asm volatile("ds_read_b64_tr_b16 %0, %1 offset:%2" : "=&v"(r) : "v"(vb), "i"(OFF) : "memory"); return r; }
template <int D0> DI void pv_one(f32x16& od, int vb, bf16x8 pa0, bf16x8 pa1, bf16x8 pa2, bf16x8 pa3) {
    const s16x4 l0 = tr_read<v_rd_off(D0, 0, 0)>(vb), h0 = tr_read<v_rd_off(D0, 0, 1)>(vb), l1 = tr_read<v_rd_off(D0, 1, 0)>(vb), h1 = tr_read<v_rd_off(D0, 1, 1)>(vb);
    const s16x4 l2 = tr_read<v_rd_off(D0, 2, 0)>(vb), h2 = tr_read<v_rd_off(D0, 2, 1)>(vb), l3 = tr_read<v_rd_off(D0, 3, 0)>(vb), h3 = tr_read<v_rd_off(D0, 3, 1)>(vb);
    asm volatile("s_waitcnt lgkmcnt(0)" ::: "memory"); __builtin_amdgcn_sched_barrier(0);
#define PKV(L, H) (bf16x8){L[0], L[1], L[2], L[3], H[0], H[1], H[2], H[3]}
    od = __builtin_amdgcn_mfma_f32_32x32x16_bf16(pa0, PKV(l0, h0), od, 0, 0, 0);
    od = __builtin_amdgcn_mfma_f32_32x32x16_bf16(pa1, PKV(l1, h1), od, 0, 0, 0);
    od = __builtin_amdgcn_mfma_f32_32x32x16_bf16(pa2, PKV(l2, h2), od, 0, 0, 0);
    od = __builtin_amdgcn_mfma_f32_32x32x16_bf16(pa3, PKV(l3, h3), od, 0, 0, 0);
#undef PKV
}
DI void pv_ones(f32x16& o2, bf16x8 pa0, bf16x8 pa1, bf16x8 pa2, bf16x8 pa3) {
    const u32x4 onesw = {0x3F803F80u, 0x3F803F80u, 0x3F803F80u, 0x3F803F80u}; const bf16x8 ones = __builtin_bit_cast(bf16x8, onesw);
    o2 = __builtin_amdgcn_mfma_f32_32x32x16_bf16(pa0, ones, o2, 0, 0, 0); o2 = __builtin_amdgcn_mfma_f32_32x32x16_bf16(pa1, ones, o2, 0, 0, 0);
    o2 = __builtin_amdgcn_mfma_f32_32x32x16_bf16(pa2, ones, o2, 0, 0, 0); o2 = __builtin_amdgcn_mfma_f32_32x32x16_bf16(pa3, ones, o2, 0, 0, 0);
}
constexpr int KROW(int KS) { return KS * 32 + 16; }
constexpr int KTILE = 64 * 112, VTILE = 8192, LDS_ATT = 2 * KTILE + 2 * VTILE + 8 * 256;

DI void split3(float x, unsigned& w_hm, unsigned& w_l0) {
    const unsigned h = f2bf(x); const float r1 = x - __builtin_bit_cast(float, h << 16);
    const unsigned m = f2bf(r1); const float r2 = r1 - __builtin_bit_cast(float, m << 16);
    const unsigned l = f2bf(r2);
    w_hm = h | (m << 16); w_l0 = l;
}
template <int KS, bool ALIBI>
DI void attn_unit(const bf16_t* __restrict__ Qb, int ldq, const bf16_t* __restrict__ Kb, int ldk, const bf16_t* __restrict__ Vb, int ldv,
                  bf16_t* __restrict__ Ob, int ldo, int seq_len, int q0, float slope2, const unsigned* __restrict__ kn2, LAS unsigned char* lds) {
    int tid = threadIdx.x; asm volatile("" : "+v"(tid));
    const int wid = tid >> 6, lane = tid & 63, r32 = lane & 31, hi = lane >> 5;
    LAS unsigned char* K_lds = lds; LAS unsigned char* V_lds = lds + 2 * KTILE;
    LAS float* wsl = (LAS float*)(lds + 2 * KTILE + 2 * VTILE) + wid * 64; LAS float* li_l = wsl; LAS float* al_l = wsl + 32;
    LAS float* blk = (LAS float*)(lds + LDS_ATT);
    LAS int* tl = (LAS int*)(lds + LDS_ATT + 128);
    constexpr int KR = KROW(KS), KP = 2 * KS;
    constexpr float THR = 8.f, SKIP = -40.f;
    float mt = 0.f; f32x16 o[3];
#pragma unroll
    for (int d = 0; d < 3; ++d)
#pragma unroll
        for (int r = 0; r < 16; ++r) o[d][r] = 0.f;
    bf16x8 qr[KS];
    const bf16_t* Qw = Qb + (size_t)(wid * 32 + r32) * ldq + hi * 8;
#pragma unroll
    for (int d0 = 0; d0 < KS; ++d0) qr[d0] = *(const bf16x8*)(Qw + d0 * 16);
    if (ALIBI) { float qn = 0.f;
#pragma unroll
        for (int d0 = 0; d0 < KS; ++d0)
#pragma unroll
            for (int j = 0; j < 8; ++j) { const float f = bf2f((unsigned short)qr[d0][j]); qn += f * f; }
        qn += __shfl_xor(qn, 32); qn = wave_max(qn); if (lane == 0) blk[wid] = qn; }
    const int vkey = tid >> 3, vcol = (tid & 7) * 8, vst = v_st(vkey, vcol);
    const bool kact = tid < 64 * KP; const int kkey = kact ? tid / KP : 0, kpc = kact ? tid % KP : 0;
    const int vb0 = (int)(uintptr_t)V_lds + v_rd_base(lane);
    const int w0 = q0 + wid * 32; const float qpos = (float)(w0 + r32);
    const int NT = seq_len / 64, jd0 = q0 >> 6;
    bf16x8 kx0, kx1;
    { u32x4 a = {0u, 0u, 0u, 0u}, b = {0u, 0u, 0u, 0u};
        if (hi == 0) {
            a.z = 0x3F803F80u; a.w = 0x00003F80u; b.z = 0x3F803F80u; b.w = 0x00003F80u;
            if (ALIBI) { const float c0 = slope2 * (float)r32, c1 = slope2 * (float)(32 + r32);
                const unsigned h0 = f2bf(c0), l0 = f2bf(c0 - __builtin_bit_cast(float, h0 << 16)), h1 = f2bf(c1), l1 = f2bf(c1 - __builtin_bit_cast(float, h1 << 16));
                a.x = h0 | (l0 << 16); a.y = (h0 | (l0 << 16)) ^ 0x80008000u; b.x = h1 | (l1 << 16); b.y = (h1 | (l1 << 16)) ^ 0x80008000u; } }
        kx0 = __builtin_bit_cast(bf16x8, a); kx1 = __builtin_bit_cast(bf16x8, b); }
    bf16x8 vs, ks_;
    bool first = true;
#define SLOAD(k0) do { vs = *(const bf16x8*)(Vb + (size_t)((k0) + vkey) * ldv + vcol); ks_ = *(const bf16x8*)(Kb + (size_t)((k0) + kkey) * ldk + kpc * 8); } while (0)
#define SWRITE(b) do { *(LAS bf16x8*)(V_lds + (b) * VTILE + vst) = vs; if (kact) *(LAS bf16x8*)(K_lds + (b) * KTILE + kkey * KR + kpc * 16) = ks_; } while (0)
#define PK4(P, BASE, OUT) do { unsigned a0 = cvt_pk_bf16_b(P[BASE + 0], P[BASE + 1]), a1 = cvt_pk_bf16_b(P[BASE + 2], P[BASE + 3]); \
        unsigned b0_ = cvt_pk_bf16_b(P[BASE + 4], P[BASE + 5]), b1_ = cvt_pk_bf16_b(P[BASE + 6], P[BASE + 7]); \
        auto r0 = __builtin_amdgcn_permlane32_swap(a0, b0_, false, false); auto r1 = __builtin_amdgcn_permlane32_swap(a1, b1_, false, false); \
        u32x4 w = {r0[0], r1[0], r0[1], r1[1]}; OUT = __builtin_bit_cast(bf16x8, w); } while (0)
#define PKV2(L, H) (bf16x8){L[0], L[1], L[2], L[3], H[0], H[1], H[2], H[3]}
#define ATT_GRP(P, BASE, VA, VC, VD, VE) do { \
        _Pragma("unroll") for (int r_ = 0; r_ < 8; ++r_) P[BASE + r_] = __builtin_amdgcn_exp2f(P[BASE + r_]); \
        bf16x8 pa_; PK4(P, BASE, pa_); \
        o[0] = __builtin_amdgcn_mfma_f32_32x32x16_bf16(pa_, PKV2(VA, VC), o[0], 0, 0, 0); o[1] = __builtin_amdgcn_mfma_f32_32x32x16_bf16(pa_, PKV2(VD, VE), o[1], 0, 0, 0); \
        o[2] = __builtin_amdgcn_mfma_f32_32x32x16_bf16(pa_, ones, o[2], 0, 0, 0); __builtin_amdgcn_sched_barrier(0); } while (0)
#define ATT_TILE(j, cur) do { \
        f32x16 p0, p1; \
        _Pragma("unroll") for (int r = 0; r < 16; ++r) { p0[r] = 0.f; p1[r] = 0.f; } \
        const LAS unsigned char* Kc = K_lds + (cur) * KTILE; \
        _Pragma("unroll") for (int d0 = 0; d0 < KS; ++d0) { const int cb = (d0 * 16 + hi * 8) * 2;     \
            const bf16x8 b0 = *(const LAS bf16x8*)(Kc + r32 * KR + cb); const bf16x8 b1 = *(const LAS bf16x8*)(Kc + (32 + r32) * KR + cb); \
            p0 = __builtin_amdgcn_mfma_f32_32x32x16_bf16(b0, qr[d0], p0, 0, 0, 0); p1 = __builtin_amdgcn_mfma_f32_32x32x16_bf16(b1, qr[d0], p1, 0, 0, 0); } \
        int cls = 0; float Bq = 0.f; \
        if (ALIBI) { if (64 * (j) + 64 <= w0) { cls = 1; Bq = slope2 * ((float)(64 * (j)) - qpos); } else if (64 * (j) >= w0 + 32) { cls = 2; Bq = slope2 * (qpos - (float)(64 * (j))); } } \
        bf16x8 qx; { u32x4 w = {0u, 0u, 0u, 0u}; if (hi == 0) { unsigned whm, wl0; split3(Bq - mt, whm, wl0); w.z = whm; w.w = wl0; w.x = (cls == 1) ? 0x3F803F80u : 0u; w.y = (cls == 2) ? 0x3F803F80u : 0u; } qx = __builtin_bit_cast(bf16x8, w); } \
        p0 = __builtin_amdgcn_mfma_f32_32x32x16_bf16(kx0, qx, p0, 0, 0, 0); p1 = __builtin_amdgcn_mfma_f32_32x32x16_bf16(kx1, qx, p1, 0, 0, 0); \
        if (ALIBI && cls == 0) { const float dq = qpos - (float)((j) * 64 + 4 * hi); \
            _Pragma("unroll") for (int r = 0; r < 16; ++r) { const float kc = (float)((r & 3) + 8 * (r >> 2)); p0[r] = fmaf(fabsf(dq - kc), -slope2, p0[r]); p1[r] = fmaf(fabsf(dq - (kc + 32.f)), -slope2, p1[r]); } } \
        float tmax = p0[0]; \
        _Pragma("unroll") for (int r = 1; r < 16; ++r) tmax = fmaxf(tmax, p0[r]); \
        _Pragma("unroll") for (int r = 0; r < 16; ++r) tmax = fmaxf(tmax, p1[r]); \
        { auto rr = __builtin_amdgcn_permlane32_swap(__float_as_uint(tmax), __float_as_uint(tmax), false, false); tmax = fmaxf(__uint_as_float(rr[0]), __uint_as_float(rr[1])); } \
        const bool skip = !first && __all(tmax < SKIP); \
        if (!skip) { \
            if (first || !__all(tmax <= THR)) { \
                const float delta = first ? tmax : fmaxf(tmax, 0.f); const float alpha = first ? 1.f : __builtin_amdgcn_exp2f(-delta); \
                mt += delta; \
                _Pragma("unroll") for (int r = 0; r < 16; ++r) { p0[r] -= delta; p1[r] -= delta; } \
                if (!first) { if (hi == 0) al_l[r32] = alpha; LDS_WAIT(); \
                    _Pragma("unroll") for (int r = 0; r < 16; ++r) { const float a = al_l[crow(r, hi)]; o[0][r] *= a; o[1][r] *= a; o[2][r] *= a; } } \
            } \
              \
            const int vb = vb0 + (cur) * VTILE; \
            const s16x4 va0 = tr_read<v_rd_off(0, 0, 0)>(vb), vc0 = tr_read<v_rd_off(0, 0, 1)>(vb), vd0 = tr_read<v_rd_off(1, 0, 0)>(vb), ve0 = tr_read<v_rd_off(1, 0, 1)>(vb); \
            const s16x4 va1 = tr_read<v_rd_off(0, 1, 0)>(vb), vc1 = tr_read<v_rd_off(0, 1, 1)>(vb), vd1 = tr_read<v_rd_off(1, 1, 0)>(vb), ve1 = tr_read<v_rd_off(1, 1, 1)>(vb); \
            const s16x4 va2 = tr_read<v_rd_off(0, 2, 0)>(vb), vc2 = tr_read<v_rd_off(0, 2, 1)>(vb), vd2 = tr_read<v_rd_off(1, 2, 0)>(vb), ve2 = tr_read<v_rd_off(1, 2, 1)>(vb); \
            const s16x4 va3 = tr_read<v_rd_off(0, 3, 0)>(vb), vc3 = tr_read<v_rd_off(0, 3, 1)>(vb), vd3 = tr_read<v_rd_off(1, 3, 0)>(vb), ve3 = tr_read<v_rd_off(1, 3, 1)>(vb); \
            const u32x4 onesw = {0x3F803F80u, 0x3F803F80u, 0x3F803F80u, 0x3F803F80u}; const bf16x8 ones = __builtin_bit_cast(bf16x8, onesw); \
            asm volatile("s_waitcnt lgkmcnt(0)" ::: "memory"); __builtin_amdgcn_sched_barrier(0); \
            ATT_GRP(p0, 0, va0, vc0, vd0, ve0); ATT_GRP(p0, 8, va1, vc1, vd1, ve1); ATT_GRP(p1, 0, va2, vc2, vd2, ve2); ATT_GRP(p1, 8, va3, vc3, vd3, ve3); \
            first = false; \
        } } while (0)
#define ATT_RUN(COUNT, TILE_EXPR) do { const int cnt_ = (COUNT); if (cnt_ > 0) { \
        { const int jj = 0; SLOAD((TILE_EXPR) * 64); } SWRITE(0); __syncthreads(); \
        if (cnt_ > 1) { const int jj = 1; SLOAD((TILE_EXPR) * 64); } \
        for (int jj0 = 0; jj0 < cnt_; ++jj0) { const int cur_ = jj0 & 1; int j_; { const int jj = jj0; j_ = (TILE_EXPR); } \
            ATT_TILE(j_, cur_); \
            if (jj0 + 1 < cnt_) SWRITE(cur_ ^ 1); \
            __syncthreads(); \
            if (jj0 + 2 < cnt_) { const int jj = jj0 + 2; SLOAD((TILE_EXPR) * 64); } } } } while (0)
    if (wid >= 4) __builtin_amdgcn_s_setprio(1);
    ATT_RUN(4, jd0 + jj);
    if (ALIBI) {
        { const float mm = -wave_max(-mt); if (lane == 0) blk[8 + wid] = mm; }
        __syncthreads();
        if (wid == 0) {
            float qn2 = blk[0], mmin = blk[8];
#pragma unroll
            for (int i = 1; i < 8; ++i) { qn2 = fmaxf(qn2, blk[i]); mmin = fminf(mmin, blk[8 + i]); }
            int base = 0;
            for (int c0 = 0; c0 < NT - 4; c0 += 64) { const int c = c0 + lane; bool act = false; int t = 0;
                if (c < NT - 4) { t = (c < jd0) ? jd0 - 1 - c : c + 4;
                    const float dist = (t < jd0) ? (float)(q0 - (64 * t + 63)) : (float)(64 * t - (q0 + 255));
                    const float kn = __builtin_bit_cast(float, kn2[t]);
                    act = (sqrtf(qn2 * kn) * 1.02f - slope2 * dist - mmin >= SKIP); }
                const unsigned long long bm = __ballot(act);
                if (act) tl[base + __builtin_popcountll(bm & ((1ull << lane) - 1ull))] = t;
                base += __builtin_popcountll(bm); }
            if (lane == 0) blk[16] = __builtin_bit_cast(float, base);
        }
        __syncthreads();
        const int nact = __builtin_bit_cast(int, blk[16]);
        ATT_RUN(nact, tl[jj]);
    } else {
        ATT_RUN(NT - 4, (jj < jd0 ? jd0 - 1 - jj : jj + 4));
    }
#undef ATT_RUN
#undef ATT_TILE
#undef ATT_GRP
#undef PKV2
#undef PK4
#undef SLOAD
#undef SWRITE
    __builtin_amdgcn_s_setprio(0);
    bf16_t* Ow = Ob + (size_t)(wid * 32) * ldo;
#pragma unroll
    for (int r = 0; r < 16; ++r) { const int orow = crow(r, hi); const float rl = __builtin_amdgcn_rcpf(o[2][r]);
#pragma unroll
        for (int d0 = 0; d0 < 2; ++d0) Ow[(size_t)orow * ldo + d0 * 32 + r32] = (bf16_t)f2bf(o[d0][r] * rl); }
    __syncthreads();
}
}

DI void ph_attn_a(const Ctx& C, int l) {
    const bf16_t* UA = (const bf16_t*)(C.ws + WS_U); bf16_t* OA = (bf16_t*)(C.ws + WS_XB1);
    GAS unsigned* head = (GAS unsigned*)(C.ws + WS_CTL) + 16384 + 64 * l;
    LAS volatile int* qslot = (LAS volatile int*)(C.lds + MISC_OFF + 64);
    if (C.tid == 0) qslot[0] = (int)__hip_atomic_fetch_add(head, 1u, __ATOMIC_RELAXED, __HIP_MEMORY_SCOPE_AGENT);
    __syncthreads();
    int u = qslot[0];
    while (u < 4096) {
        int nxt = 0;
        if (C.tid == 0) nxt = (int)__hip_atomic_fetch_add(head, 1u, __ATOMIC_RELAXED, __HIP_MEMORY_SCOPE_AGENT);
        const int k = u >> 9, j = u & 511, vhb = j >> 8;
        const bool prompt = (k == 0) || (k == 1) || (k == 4) || (k == 6);
        const int h = (k == 0 || k == 2) ? 3 : (k == 1 || k == 3) ? 2 : (k == 4 || k == 5) ? 1 : 0;
        const int vh = 2 * h + vhb;
        const int seq = prompt ? ((j >> 5) & 7) : 8 + ((j >> 3) & 31), qb = prompt ? (j & 31) : (j & 7), len = prompt ? 8192 : 2048;
        const int r0 = seq_start_row(seq);
        const float slope2 = exp2f(-2.0f * (float)(h + 1)) * LOG2E;
        att::attn_unit<2, true>(UA + (size_t)(r0 + qb * 256) * 768 + vh * 32, 768, UA + (size_t)r0 * 768 + 256 + vh * 32, 768, UA + (size_t)r0 * 768 + 512 + h * 64, 768,
                                OA + (size_t)(r0 + qb * 256) * 512 + vh * 64, 512, len, qb * 256, slope2, (const unsigned*)(C.ws + WS_KN2) + ((size_t)l * 8 + vh) * 2048 + (r0 >> 6), C.lds);
        if (C.tid == 0) qslot[0] = nxt;
        __syncthreads();
        u = qslot[0];
    }
}
DI void ph_attn_c(const Ctx& C) {
    const bf16_t* Qc = (const bf16_t*)(C.ws + WS_XB1 + OFF_QC); const bf16_t* Kc = (const bf16_t*)(C.ws + WS_XB1 + OFF_KC); const bf16_t* Vc = (const bf16_t*)(C.ws + WS_XB1 + OFF_VC);
    bf16_t* Y = (bf16_t*)(C.ws + WS_Y);
    for (int u = C.bid; u < 2048; u += C.G) {
        int qb, h, seq, len;
        if (u < 1024) { qb = u & 31; h = (u >> 5) & 3; seq = u >> 7; len = 8192; } else { const int v = u - 1024; qb = v & 7; h = (v >> 3) & 3; seq = 8 + (v >> 5); len = 2048; }
        const int r0 = seq_start_row(seq);
        att::attn_unit<3, false>(Qc + (size_t)(r0 + qb * 256) * 192 + h * 48, 192, Kc + (size_t)r0 * 192 + h * 48, 192, Vc + (size_t)r0 * 256 + h * 64, 256,
                                 Y + (size_t)(r0 + qb * 256) * DM + 512 + h * 64, DM, len, qb * 256, 0.f, nullptr, C.lds);
    }
}
DI void ph_a_post(const Ctx& C, int l) {
    const bf16_t* OA = (const bf16_t*)(C.ws + WS_XB1); bf16_t* Y = (bf16_t*)(C.ws + WS_Y);
    const float linit = 0.8f - 0.6f * expf(-0.3f * (float)l);
    const float* lp = C.A->in[3] + l * 128;
    float sa = 0.f, sb = 0.f; if (C.lane < 32) { sa = lp[C.lane] * lp[32 + C.lane]; sb = lp[64 + C.lane] * lp[96 + C.lane]; }
    const float lam = expf(wave_sum(sa)) - expf(wave_sum(sb)) + linit;
    const int h = C.lane >> 4, d4 = (C.lane & 15) * 4;
    const f32x4 gg = *(const f32x4*)(C.A->in[4] + l * 64 + d4);
    for (int row0 = C.gw; row0 < NTOK; row0 += 4 * C.NGW) {
        u32x2 a[4], b[4];
#pragma unroll
        for (int i = 0; i < 4; ++i) { const size_t row = (size_t)row0 + (size_t)i * C.NGW; a[i] = *(const u32x2*)(OA + row * 512 + (2 * h) * 64 + d4); b[i] = *(const u32x2*)(OA + row * 512 + (2 * h + 1) * 64 + d4); }
#pragma unroll
        for (int i = 0; i < 4; ++i) { const size_t row = (size_t)row0 + (size_t)i * C.NGW;
            float o0 = bflo(a[i].x) - lam * bflo(b[i].x), o1 = bfhi(a[i].x) - lam * bfhi(b[i].x), o2 = bflo(a[i].y) - lam * bflo(b[i].y), o3 = bfhi(a[i].y) - lam * bfhi(b[i].y);
            float ss = o0 * o0 + o1 * o1 + o2 * o2 + o3 * o3;
            ss += __shfl_xor(ss, 1); ss += __shfl_xor(ss, 2); ss += __shfl_xor(ss, 4); ss += __shfl_xor(ss, 8);
            const float r = (1.0f / sqrtf(ss * (1.f / 64.f) + RMS_EPS)) * (1.0f - linit);
            u32x2 w; w.x = cvt_pk_bf16(o0 * r * gg[0], o1 * r * gg[1]); w.y = cvt_pk_bf16(o2 * r * gg[2], o3 * r * gg[3]);
            *(u32x2*)(Y + row * DM + h * 64 + d4) = w; }
    }
}

DI float hgrn_lb(const Ctx& C, int l, int dir, int ch) {
    if (l == 0) return 0.f;
    const float a = C.A->in[5][(0 * 2 + dir) * 256 + ch], b = C.A->in[5][(1 * 2 + dir) * 256 + ch];
    const float m = fmaxf(a, b), ea = expf(a - m), eb = expf(b - m); return eb / (ea + eb);
}
DI float dpp_shr_add(float x, int k) {
    float y;
    if (k == 1) y = __builtin_bit_cast(float, __builtin_amdgcn_update_dpp(0, __builtin_bit_cast(int, x), 0x111, 0xF, 0xF, true));
    else if (k == 2) y = __builtin_bit_cast(float, __builtin_amdgcn_update_dpp(0, __builtin_bit_cast(int, x), 0x112, 0xF, 0xF, true));
    else if (k == 4) y = __builtin_bit_cast(float, __builtin_amdgcn_update_dpp(0, __builtin_bit_cast(int, x), 0x114, 0xF, 0xF, true));
    else y = __builtin_bit_cast(float, __builtin_amdgcn_update_dpp(0, __builtin_bit_cast(int, x), 0x118, 0xF, 0xF, true));
    return x + y;
}
DI s16x4 tr16(unsigned addr) { s16x4 r; asm volatile("ds_read_b64_tr_b16 %0, %1\n\ts_waitcnt lgkmcnt(0)" : "=&v"(r) : "v"(addr) : "memory"); return r; }
constexpr int HG_ROW = 144, HG_ARR = 16 * HG_ROW;
template <int MODE>
DI void hgrn_pass(const Ctx& C, int l, int chunk, int h, int dir, LAS unsigned char* wl, float* ofs) {
    const bf16_t* UB = (const bf16_t*)(C.ws + WS_U); float* ST = (float*)(C.ws + WS_XB1); float* GAM = (float*)(C.ws + WS_GAM); bf16_t* Y = (bf16_t*)(C.ws + WS_Y);
    const int lane = C.lane, l15 = lane & 15, g = lane >> 4, r0 = chunk * 128; const size_t sbase = (size_t)((chunk * 4 + h) * 2 + dir);
    const unsigned QLa = (unsigned)(uintptr_t)wl, FLa = QLa + HG_ARR, VLa = QLa + 2 * HG_ARR, GLa = QLa + 3 * HG_ARR;
    LAS float* lbT = (LAS float*)(wl + 4 * HG_ARR);
    lbT[lane] = hgrn_lb(C, l, dir, h * 64 + lane);
    LDS_WAIT();
    f32x4 S[4][4];
#pragma unroll
    for (int dt = 0; dt < 4; ++dt)
#pragma unroll
        for (int et = 0; et < 4; ++et)
#pragma unroll
            for (int r = 0; r < 4; ++r) S[dt][et][r] = (MODE == 0) ? 0.f : ST[sbase * 4096 + (size_t)(16 * dt + 4 * g + r) * 64 + 16 * et + l15];
    float gsum[4] = {0.f, 0.f, 0.f, 0.f};
    const float* ngp = C.A->in[6] + l * 256 + h * 64 + l15;
    const int srow = lane >> 2, spc = lane & 3;
    u32x4 pq[2], pf[2], pv[2];
#define HG_LOAD(sc) do { const int t_ = (sc) * 16 + srow; const bf16_t* rp_ = UB + (size_t)(r0 + (dir ? 127 - t_ : t_)) * 1280 + h * 64 + spc * 16; \
        pf[0] = *(const u32x4*)(rp_ + (dir ? 512 : 256)); pf[1] = *(const u32x4*)(rp_ + (dir ? 512 : 256) + 8); pv[0] = *(const u32x4*)(rp_ + 768); pv[1] = *(const u32x4*)(rp_ + 768 + 8); \
        if (MODE != 0) { pq[0] = *(const u32x4*)(rp_); pq[1] = *(const u32x4*)(rp_ + 8); } } while (0)
#define HG_STORE() do { const int o_ = srow * HG_ROW + spc * 32; \
        *(LAS u32x4*)(wl + HG_ARR + o_) = pf[0]; *(LAS u32x4*)(wl + HG_ARR + o_ + 16) = pf[1]; *(LAS u32x4*)(wl + 2 * HG_ARR + o_) = pv[0]; *(LAS u32x4*)(wl + 2 * HG_ARR + o_ + 16) = pv[1]; \
        if (MODE != 0) { *(LAS u32x4*)(wl + o_) = pq[0]; *(LAS u32x4*)(wl + o_ + 16) = pq[1]; } } while (0)
    HG_LOAD(0);
    const unsigned tr_off = (unsigned)((4 * g + (l15 >> 2)) * HG_ROW + (l15 & 3) * 8);
    for (int sc = 0; sc < 8; ++sc) {
        LDS_WAIT();
        HG_STORE();
        if (MODE == 2) {
#pragma unroll
            for (int k = 0; k < 2; ++k) { const int t_ = sc * 16 + 8 * k + (lane >> 3);
                __builtin_amdgcn_global_load_lds((const unsigned*)(UB + (size_t)(r0 + 127 - t_) * 1280 + 1024 + h * 64 + (lane & 7) * 8), (LAS unsigned*)(wl + 3 * HG_ARR + k * 1024), 16, 0, 0); } }
        if (sc + 1 < 8) HG_LOAD(sc + 1);
        LDS_WAIT();
        bf16x8 vf[4];
#pragma unroll
        for (int et = 0; et < 4; ++et) { const s16x4 t4 = tr16(VLa + tr_off + et * 32); vf[et] = (bf16x8){t4[0], t4[1], t4[2], t4[3], 0, 0, 0, 0}; }
        __builtin_amdgcn_sched_barrier(0);
        bf16x8 khf[4]; float tot[4];
#pragma unroll
        for (int dt = 0; dt < 4; ++dt) { const s16x4 t4 = tr16(FLa + tr_off + dt * 32);
            float fv[4], lf[4];
            const float lbv = lbT[16 * dt + l15];
#pragma unroll
            for (int j = 0; j < 4; ++j) { fv[j] = lbv + (1.f - lbv) * sigmoidf_(bf2f((unsigned short)t4[j])); lf[j] = __builtin_amdgcn_logf(fv[j]); }
            const float Tg = (lf[0] + lf[1]) + (lf[2] + lf[3]);
            const float T1 = __shfl_down(Tg, 16), T2 = __shfl_down(Tg, 32), T3 = __shfl_down(Tg, 48);
            const float after = (g < 3 ? T1 : 0.f) + (g < 2 ? T2 : 0.f) + (g < 1 ? T3 : 0.f);
            float tt_ = Tg; tt_ += __shfl_xor(tt_, 16); tt_ += __shfl_xor(tt_, 32); tot[dt] = tt_; gsum[dt] += tt_;
            const float c3 = after, c2 = c3 + lf[3], c1 = c2 + lf[2], c0 = c1 + lf[1];
            const unsigned w0 = cvt_pk_bf16((1.f - fv[0]) * __builtin_amdgcn_exp2f(c0), (1.f - fv[1]) * __builtin_amdgcn_exp2f(c1));
            const unsigned w1 = cvt_pk_bf16((1.f - fv[2]) * __builtin_amdgcn_exp2f(c2), (1.f - fv[3]) * __builtin_amdgcn_exp2f(c3));
            const u32x4 w = {w0, w1, 0u, 0u}; khf[dt] = __builtin_bit_cast(bf16x8, w); }
        __builtin_amdgcn_sched_barrier(0);
        f32x4 O[4];
        if (MODE != 0) {
            bf16x8 qhf[2], ktf[2];
#pragma unroll
            for (int ks = 0; ks < 2; ++ks) { float b2[8], qv[8], kv[8];
#pragma unroll
                for (int dd = 0; dd < 2; ++dd) { const int dt = 2 * ks + dd;
                    const u32x2 fw = *(const LAS u32x2*)(wl + HG_ARR + l15 * HG_ROW + (16 * dt + 4 * g) * 2); const u32x2 qw = *(const LAS u32x2*)(wl + l15 * HG_ROW + (16 * dt + 4 * g) * 2);
                    const f32x4 lb4 = *(const LAS f32x4*)(lbT + 16 * dt + 4 * g);
                    const float fl4[4] = {bflo(fw.x), bfhi(fw.x), bflo(fw.y), bfhi(fw.y)}, ql4[4] = {bflo(qw.x), bfhi(qw.x), bflo(qw.y), bfhi(qw.y)};
#pragma unroll
                    for (int r = 0; r < 4; ++r) { const int i = 4 * dd + r; const float f = lb4[r] + (1.f - lb4[r]) * sigmoidf_(fl4[r]); b2[i] = __builtin_amdgcn_logf(f); kv[i] = 1.f - f; qv[i] = siluf_(ql4[r]); } }
#pragma unroll
                for (int i = 0; i < 8; ++i) { float x = b2[i]; x = dpp_shr_add(x, 1); x = dpp_shr_add(x, 2); x = dpp_shr_add(x, 4); x = dpp_shr_add(x, 8); b2[i] = x; }
                u32x4 wq, wk;
#pragma unroll
                for (int p = 0; p < 4; ++p) { const int i = 2 * p; const float e0 = __builtin_amdgcn_exp2f(b2[i]), e1 = __builtin_amdgcn_exp2f(b2[i + 1]);
                    wq[p] = cvt_pk_bf16(qv[i] * e0, qv[i + 1] * e1); wk[p] = cvt_pk_bf16(kv[i] * __builtin_amdgcn_exp2f(fminf(-b2[i], 120.f)), kv[i + 1] * __builtin_amdgcn_exp2f(fminf(-b2[i + 1], 120.f))); }
                qhf[ks] = __builtin_bit_cast(bf16x8, wq); ktf[ks] = __builtin_bit_cast(bf16x8, wk); }
            __builtin_amdgcn_sched_barrier(0);
            f32x4 aT = (f32x4){0.f, 0.f, 0.f, 0.f};
            aT = __builtin_amdgcn_mfma_f32_16x16x32_bf16(ktf[0], qhf[0], aT, 0, 0, 0);
            aT = __builtin_amdgcn_mfma_f32_16x16x32_bf16(ktf[1], qhf[1], aT, 0, 0, 0);
#pragma unroll
            for (int r = 0; r < 4; ++r) aT[r] = (4 * g + r > l15) ? 0.f : aT[r];
            const u32x4 aw = {cvt_pk_bf16(aT[0], aT[1]), cvt_pk_bf16(aT[2], aT[3]), 0u, 0u}; const bf16x8 atf = __builtin_bit_cast(bf16x8, aw);
#pragma unroll
            for (int et = 0; et < 4; ++et) { f32x4 o = (f32x4){0.f, 0.f, 0.f, 0.f};
                o = __builtin_amdgcn_mfma_f32_16x16x32_bf16(atf, vf[et], o, 0, 0, 0);
#pragma unroll
                for (int ks = 0; ks < 2; ++ks) { const u32x4 sw = {cvt_pk_bf16(S[2 * ks][et][0], S[2 * ks][et][1]), cvt_pk_bf16(S[2 * ks][et][2], S[2 * ks][et][3]), cvt_pk_bf16(S[2 * ks + 1][et][0], S[2 * ks + 1][et][1]), cvt_pk_bf16(S[2 * ks + 1][et][2], S[2 * ks + 1][et][3])};
                    o = __builtin_amdgcn_mfma_f32_16x16x32_bf16(qhf[ks], __builtin_bit_cast(bf16x8, sw), o, 0, 0, 0); }
                O[et] = o; }
        }
        __builtin_amdgcn_sched_barrier(0);
#pragma unroll
        for (int dt = 0; dt < 4; ++dt) { float dec[4];
#pragma unroll
            for (int r = 0; r < 4; ++r) dec[r] = __builtin_amdgcn_exp2f(__shfl(tot[dt], 4 * g + r));
#pragma unroll
            for (int et = 0; et < 4; ++et) { f32x4 s = S[dt][et];
#pragma unroll
                for (int r = 0; r < 4; ++r) s[r] *= dec[r];
                S[dt][et] = __builtin_amdgcn_mfma_f32_16x16x32_bf16(khf[dt], vf[et], s, 0, 0, 0); } }
        __builtin_amdgcn_sched_barrier(0);
        if (MODE == 1) {
#pragma unroll
            for (int et = 0; et < 4; ++et)
#pragma unroll
                for (int r = 0; r < 4; ++r) ofs[(sc * 16 + 4 * g + r) * 64 + 16 * et + l15] = O[et][r];
        }
        if (MODE == 2) {
            float rr[4];
#pragma unroll
            for (int r = 0; r < 4; ++r) { const int at = 127 - (sc * 16 + 4 * g + r); float ss = 0.f;
#pragma unroll
                for (int et = 0; et < 4; ++et) { const float of = ofs[at * 64 + 16 * et + l15]; O[et][r] += of; ss += O[et][r] * O[et][r]; }
                ss += __shfl_xor(ss, 1); ss += __shfl_xor(ss, 2); ss += __shfl_xor(ss, 4); ss += __shfl_xor(ss, 8);
                rr[r] = 1.0f / sqrtf(ss * (1.f / 64.f) + RMS_EPS); }
            VM_WAIT();
#pragma unroll
            for (int et = 0; et < 4; ++et) { const s16x4 t4 = tr16(GLa + (unsigned)((4 * g + (l15 >> 2)) * 128 + (l15 & 3) * 8) + et * 32); const float ngv = ngp[16 * et];
#pragma unroll
                for (int r = 0; r < 4; ++r) { const int at = 127 - (sc * 16 + 4 * g + r);
                    Y[(size_t)(r0 + at) * DM + 256 + h * 64 + 16 * et + l15] = (bf16_t)f2bf(O[et][r] * rr[r] * ngv * siluf_(bf2f((unsigned short)t4[r]))); } }
        }
    }
#undef HG_LOAD
#undef HG_STORE
    if (MODE == 0) {
#pragma unroll
        for (int dt = 0; dt < 4; ++dt)
#pragma unroll
            for (int et = 0; et < 4; ++et)
#pragma unroll
                for (int r = 0; r < 4; ++r) ST[sbase * 4096 + (size_t)(16 * dt + 4 * g + r) * 64 + 16 * et + l15] = S[dt][et][r];
        if (g == 0) {
#pragma unroll
            for (int dt = 0; dt < 4; ++dt) GAM[sbase * 64 + 16 * dt + l15] = __builtin_amdgcn_exp2f(gsum[dt]);
        }
    }
}
DI void ph_hgrn_local(const Ctx& C, int l) {
    LAS unsigned char* wl = C.lds + C.wave * 16384;
    for (int w = C.gw; w < NCHUNK * 8; w += C.NGW) hgrn_pass<0>(C, l, w >> 3, (w >> 1) & 3, w & 1, wl, nullptr);
}
DI void ph_hgrn_scan(const Ctx& C) {
    float* ST = (float*)(C.ws + WS_XB1); const float* GAM = (const float*)(C.ws + WS_GAM);
    for (int idx = C.bid * 512 + C.tid; idx < NSEQ * 8 * 4096; idx += C.G * 512) {
        const int e = idx & 4095, hd = (idx >> 12) & 7, seq = idx >> 15, h = hd >> 1, dir = hd & 1, d = e >> 6;
        const int c0 = seq < 8 ? seq * 64 : 512 + (seq - 8) * 16, nc = seq < 8 ? 64 : 16;
        float s = 0.f;
        for (int i0 = 0; i0 < nc; i0 += 16) {
            float tmp[16], gg[16];
#pragma unroll
            for (int i = 0; i < 16; ++i) { const int c = dir ? c0 + nc - 1 - (i0 + i) : c0 + i0 + i; const size_t base = (size_t)((c * 4 + h) * 2 + dir); tmp[i] = ST[base * 4096 + e]; gg[i] = GAM[base * 64 + d]; }
#pragma unroll
            for (int i = 0; i < 16; ++i) { const float t = tmp[i]; tmp[i] = s; s = fmaf(gg[i], s, t); }
#pragma unroll
            for (int i = 0; i < 16; ++i) { const int c = dir ? c0 + nc - 1 - (i0 + i) : c0 + i0 + i; const size_t base = (size_t)((c * 4 + h) * 2 + dir); ST[base * 4096 + e] = tmp[i]; }
        }
    }
}
template <int MODE>
DI void ph_hgrn_out(const Ctx& C, int l) {
    LAS unsigned char* wl = C.lds + C.wave * 16384;
    for (int w = C.gw; w < NCHUNK * 4; w += C.NGW) hgrn_pass<MODE>(C, l, w >> 2, w & 3, MODE == 2 ? 1 : 0, wl, (float*)(C.ws + WS_EW) + (size_t)w * 8192);
}

DI void ph_c_prep(const Ctx& C, int l) {
    const bf16_t* UCD = (const bf16_t*)(C.ws + WS_U);
    const bf16_t* WQ = (const bf16_t*)(C.ws + WS_WC + (size_t)l * WC_LAYER + OFF_WQ); const bf16_t* WKV = (const bf16_t*)(C.ws + WS_WC + (size_t)l * WC_LAYER + OFF_WKV);
    bf16_t* Qc = (bf16_t*)(C.ws + WS_XB1 + OFF_QC); bf16_t* Kc = (bf16_t*)(C.ws + WS_XB1 + OFF_KC); bf16_t* Vc = (bf16_t*)(C.ws + WS_XB1 + OFF_VC);
    const int lane = C.lane, r32 = lane & 31, hi = lane >> 5;
    const float C2c = 0.14433756729740643f * LOG2E;
    constexpr int PQ = 400, PKV = 272;
    for (int i = C.tid; i < 192 * 24; i += 512) { const int r = i / 24, p = i % 24; *(LAS u32x4*)(C.lds + r * PQ + p * 16) = *(const u32x4*)(WQ + (size_t)r * 192 + p * 8); }
    __syncthreads();
    for (int w = C.gw; w < NTOK / 32; w += C.NGW) {
        const int row = w * 32 + r32; const bf16_t* xr = UCD + (size_t)row * 1024;
        float cs[4], sn[4];
        { const float pos = (float)row_pos(row); const float inv[8] = {1.0f, 0.316227766016837933f, 0.1f, 0.0316227766016837933f, 0.01f, 0.00316227766016837933f, 0.001f, 0.000316227766016837933f};
#pragma unroll
            for (int ii = 0; ii < 4; ++ii) { const float invv = hi ? inv[4 + ii] : inv[ii]; const float ang = pos * invv;
                const double ad = (double)ang; const double k = __builtin_rint(ad * 0.15915494309189535); const float red = (float)(ad - k * 6.283185307179586);
                cs[ii] = __cosf(red); sn[ii] = __sinf(red); } }
        bf16x8 xq[12]; float ssq = 0.f;
#pragma unroll
        for (int ks = 0; ks < 12; ++ks) { xq[ks] = *(const bf16x8*)(xr + ks * 16 + hi * 8);
#pragma unroll
            for (int j = 0; j < 8; ++j) { const float f = bf2f((unsigned short)xq[ks][j]); ssq += f * f; } }
        ssq += __shfl_xor(ssq, 32);
        const float rq = (1.0f / sqrtf(ssq * (1.f / 192.f) + RMS_EPS)) * C2c;
#pragma unroll 1
        for (int nt = 0; nt < 6; ++nt) {
            f32x16 acc;
#pragma unroll
            for (int r = 0; r < 16; ++r) acc[r] = 0.f;
#pragma unroll
            for (int ks = 0; ks < 12; ++ks) { const bf16x8 a = *(const LAS bf16x8*)(C.lds + (32 * nt + r32) * PQ + (ks * 16 + hi * 8) * 2); acc = __builtin_amdgcn_mfma_f32_32x32x16_bf16(a, xq[ks], acc, 0, 0, 0); }
#pragma unroll
            for (int r = 0; r < 16; ++r) acc[r] *= rq;
            if (nt == 1 || nt == 4) {
#pragma unroll
                for (int ii = 0; ii < 4; ++ii) { const float x1 = acc[ii], x2 = acc[4 + ii]; acc[ii] = x1 * cs[ii] - x2 * sn[ii]; acc[4 + ii] = x1 * sn[ii] + x2 * cs[ii]; } }
            if (nt == 2 || nt == 5) {
#pragma unroll
                for (int ii = 0; ii < 4; ++ii) { const float x1 = acc[8 + ii], x2 = acc[12 + ii]; acc[8 + ii] = x1 * cs[ii] - x2 * sn[ii]; acc[12 + ii] = x1 * sn[ii] + x2 * cs[ii]; } }
#pragma unroll
            for (int g = 0; g < 4; ++g) { u32x2 wv; wv.x = cvt_pk_bf16(acc[4 * g], acc[4 * g + 1]); wv.y = cvt_pk_bf16(acc[4 * g + 2], acc[4 * g + 3]);
                *(u32x2*)(Qc + (size_t)row * 192 + 32 * nt + 8 * g + 4 * hi) = wv; }
        }
        { const u32x2 a = *(const u32x2*)(xr + 320 + 4 * hi), b = *(const u32x2*)(xr + 328 + 4 * hi);
            const float x1[4] = {bflo(a.x), bfhi(a.x), bflo(a.y), bfhi(a.y)}, x2[4] = {bflo(b.x), bfhi(b.x), bflo(b.y), bfhi(b.y)};
            float o1[4], o2[4];
#pragma unroll
            for (int ii = 0; ii < 4; ++ii) { o1[ii] = x1[ii] * cs[ii] - x2[ii] * sn[ii]; o2[ii] = x1[ii] * sn[ii] + x2[ii] * cs[ii]; }
            u32x2 w1, w2; w1.x = cvt_pk_bf16(o1[0], o1[1]); w1.y = cvt_pk_bf16(o1[2], o1[3]); w2.x = cvt_pk_bf16(o2[0], o2[1]); w2.y = cvt_pk_bf16(o2[2], o2[3]);
#pragma unroll
            for (int h = 0; h < 4; ++h) { *(u32x2*)(Kc + (size_t)row * 192 + h * 48 + 32 + 4 * hi) = w1; *(u32x2*)(Kc + (size_t)row * 192 + h * 48 + 40 + 4 * hi) = w2; } }
    }
    __syncthreads();
    for (int i = C.tid; i < 384 * 16; i += 512) { const int r = i / 16, p = i % 16; *(LAS u32x4*)(C.lds + r * PKV + p * 16) = *(const u32x4*)(WKV + (size_t)r * 128 + p * 8); }
    __syncthreads();
    for (int w = C.gw; w < NTOK / 32; w += C.NGW) {
        const int row = w * 32 + r32; const bf16_t* xr = UCD + (size_t)row * 1024;
        bf16x8 xk[8]; float ssk = 0.f;
#pragma unroll
        for (int ks = 0; ks < 8; ++ks) { xk[ks] = *(const bf16x8*)(xr + 192 + ks * 16 + hi * 8);
#pragma unroll
            for (int j = 0; j < 8; ++j) { const float f = bf2f((unsigned short)xk[ks][j]); ssk += f * f; } }
        ssk += __shfl_xor(ssk, 32);
        const float rk = 1.0f / sqrtf(ssk * (1.f / 128.f) + RMS_EPS);
#pragma unroll 1
        for (int nt = 0; nt < 12; ++nt) {
            f32x16 acc;
#pragma unroll
            for (int r = 0; r < 16; ++r) acc[r] = 0.f;
#pragma unroll
            for (int ks = 0; ks < 8; ++ks) { const bf16x8 a = *(const LAS bf16x8*)(C.lds + (32 * nt + r32) * PKV + (ks * 16 + hi * 8) * 2); acc = __builtin_amdgcn_mfma_f32_32x32x16_bf16(a, xk[ks], acc, 0, 0, 0); }
            const int h = nt / 3, part = nt % 3;
            bf16_t* dst = (part == 0) ? Kc + (size_t)row * 192 + h * 48 : Vc + (size_t)row * 256 + h * 64 + (part - 1) * 32;
#pragma unroll
            for (int g = 0; g < 4; ++g) { u32x2 wv; wv.x = cvt_pk_bf16(acc[4 * g] * rk, acc[4 * g + 1] * rk); wv.y = cvt_pk_bf16(acc[4 * g + 2] * rk, acc[4 * g + 3] * rk);
                *(u32x2*)(dst + 8 * g + 4 * hi) = wv; }
        }
    }
}

DI float one_minus_a2(float y, float a) {
    const float p = -y * (1.0f + y * (0.5f + y * (0.16666667f + y * (0.041666668f + y * (0.0083333338f + y * 0.0013888889f)))));
    return (y > -0.25f) ? p : (1.0f - a * a);
}
template <bool FINAL, int DIR>
DI void rglru_units(const Ctx& C, int l) {
    const bf16_t* UCD = (const bf16_t*)(C.ws + WS_U); f32x2* DC = (f32x2*)(C.ws + WS_DC);
    bf16_t* HFB = (bf16_t*)(C.ws + WS_EW);
    const int lane = C.lane, l15 = lane & 15, g = lane >> 4;
    LAS unsigned char* wl = C.lds + C.wave * 16384;
    LAS unsigned char* xcb = wl;
    LAS float* gs = (LAS float*)(wl + 2304);
    const int n = C.gw & 3, ch = n * 64 + lane;
    bf16x8 Wf[2][4][2];
    { const bf16x8* fp = (const bf16x8*)(C.ws + WS_WRG) + (size_t)((((l * 2 + DIR) * 4 + n) * 2) * 8) * 64 + lane;
#pragma unroll
      for (int gt = 0; gt < 2; ++gt)
#pragma unroll
        for (int nt = 0; nt < 4; ++nt)
#pragma unroll
            for (int ks = 0; ks < 2; ++ks) Wf[gt][nt][ks] = fp[(size_t)((gt * 4 + nt) * 2 + ks) * 64]; }
    const float ba = C.A->in[14][(l * 2 + DIR) * 256 + ch], bx = C.A->in[16][(l * 2 + DIR) * 256 + ch];
    const float lam = C.A->in[17][(l * 2 + DIR) * 256 + ch];
    const float c8sp = -8.0f * log1pf(expf(-lam));
    float cw[4];
#pragma unroll
    for (int j = 0; j < 4; ++j) cw[j] = C.A->in[11][(l * 4 + j) * 256 + ch];
    const float cb = C.A->in[12][l * 256 + ch];
    for (int w = C.gw; w < NCHUNK * 4; w += C.NGW) {
        const int chunk = w >> 2;
        const int r0 = chunk * 128; const int sb = row_seq_begin(r0), se = sb + row_seq_len(r0);
        float h = FINAL ? DC[(size_t)(chunk * 2 + DIR) * 256 + ch][1] : 0.f, P = 1.f;
        float xr[19];
#define RG_LOADX(dst, sc_) do { const int tb_ = r0 + 16 * (DIR ? 7 - (sc_) : (sc_)) - 2; \
            _Pragma("unroll") for (int i_ = 0; i_ < 19; ++i_) { const int rr_ = tb_ + i_; dst[i_] = (rr_ >= sb && rr_ < se) ? bf2f(UCD[(size_t)rr_ * 1024 + 336 + ch]) : 0.f; } } while (0)
        RG_LOADX(xr, 0);
        for (int sc = 0; sc < 8; ++sc) {
            const int t0 = r0 + 16 * (DIR ? 7 - sc : sc);
            float xcr[16];
#pragma unroll
            for (int a = 0; a < 16; ++a) { const int tt = DIR ? 15 - a : a;
                xcr[tt] = cb + cw[0] * xr[a] + cw[1] * xr[a + 1] + cw[2] * xr[a + 2] + cw[3] * xr[a + 3];
                *(LAS bf16_t*)(xcb + tt * 144 + lane * 2) = (bf16_t)f2bf(xcr[tt]); }
            if (sc + 1 < 8) RG_LOADX(xr, sc + 1);
            LDS_WAIT();
            const bf16x8 A0 = *(const LAS bf16x8*)(xcb + l15 * 144 + (8 * g) * 2), A1 = *(const LAS bf16x8*)(xcb + l15 * 144 + (32 + 8 * g) * 2);
#pragma unroll
            for (int gt = 0; gt < 2; ++gt)
#pragma unroll
                for (int nt = 0; nt < 4; ++nt) { f32x4 acc = (f32x4){0.f, 0.f, 0.f, 0.f};
                    acc = __builtin_amdgcn_mfma_f32_16x16x32_bf16(A0, Wf[gt][nt][0], acc, 0, 0, 0);
                    acc = __builtin_amdgcn_mfma_f32_16x16x32_bf16(A1, Wf[gt][nt][1], acc, 0, 0, 0);
#pragma unroll
                    for (int r = 0; r < 4; ++r) gs[(gt * 16 + 4 * g + r) * 68 + 16 * nt + l15] = acc[r]; }
            LDS_WAIT();
#pragma unroll
            for (int tt = 0; tt < 16; ++tt) {
                const float ra = gs[tt * 68 + lane] + ba, ia = gs[(16 + tt) * 68 + lane] + bx;
                const float r = sigmoidf_(ra), ig = sigmoidf_(ia);
                const float la = c8sp * r, a = __expf(la), u = __builtin_amdgcn_sqrtf(one_minus_a2(2.0f * la, a)) * (ig * xcr[tt]);
                h = fmaf(a, h, u); P *= a;
                if (FINAL) { const int tok = DIR ? t0 + 15 - tt : t0 + tt; HFB[((size_t)DIR * NTOK + tok) * 256 + ch] = (bf16_t)f2bf(h); } }
            LDS_WAIT();
        }
        if (!FINAL) DC[(size_t)(chunk * 2 + DIR) * 256 + ch] = (f32x2){P, h};
#undef RG_LOADX
    }
}
template <bool FINAL>
DI void ph_rglru(const Ctx& C, int l) { rglru_units<FINAL, 0>(C, l); rglru_units<FINAL, 1>(C, l); }
DI void ph_rglru_scan(const Ctx& C) {
    f32x2* DC = (f32x2*)(C.ws + WS_DC);
    for (int idx = C.bid * 512 + C.tid; idx < NSEQ * 512; idx += C.G * 512) {
        const int ch = idx & 255, dir = (idx >> 8) & 1, seq = idx >> 9;
        const int c0 = seq < 8 ? seq * 64 : 512 + (seq - 8) * 16, nc = seq < 8 ? 64 : 16;
        float hin = 0.f;
        for (int i0 = 0; i0 < nc; i0 += 16) {
            f32x2 vv[16];
#pragma unroll
            for (int i = 0; i < 16; ++i) { const int c = dir ? c0 + nc - 1 - (i0 + i) : c0 + i0 + i; vv[i] = DC[(size_t)(c * 2 + dir) * 256 + ch]; }
#pragma unroll
            for (int i = 0; i < 16; ++i) { const float P = vv[i][0], H = vv[i][1]; vv[i][1] = hin; hin = fmaf(P, hin, H); }
#pragma unroll
            for (int i = 0; i < 16; ++i) { const int c = dir ? c0 + nc - 1 - (i0 + i) : c0 + i0 + i; DC[(size_t)(c * 2 + dir) * 256 + ch] = vv[i]; }
        }
    }
}
DI float gelu_tanh(float x) { const float u = 0.7978845608028654f * (x + 0.044715f * x * x * x); const float e = __expf(2.0f * u); const float th = 1.0f - 2.0f / (e + 1.0f); return 0.5f * x * (1.0f + th); }
DI void ph_d_post(const Ctx& C) {
    const bf16_t* UCD = (const bf16_t*)(C.ws + WS_U); const bf16_t* HF = (const bf16_t*)(C.ws + WS_EW); const bf16_t* HB = HF + (size_t)NTOK * 256; bf16_t* Y = (bf16_t*)(C.ws + WS_Y);
    const int c4 = C.lane * 4;
    for (int row0 = C.gw; row0 < NTOK; row0 += 4 * C.NGW) {
        u32x2 a[4], b[4], g[4];
#pragma unroll
        for (int i = 0; i < 4; ++i) { const size_t row = (size_t)row0 + (size_t)i * C.NGW; a[i] = *(const u32x2*)(HF + row * 256 + c4); b[i] = *(const u32x2*)(HB + row * 256 + c4); g[i] = *(const u32x2*)(UCD + row * 1024 + 592 + c4); }
#pragma unroll
        for (int i = 0; i < 4; ++i) { const size_t row = (size_t)row0 + (size_t)i * C.NGW;
            const float y0 = (bflo(a[i].x) + bflo(b[i].x)) * gelu_tanh(bflo(g[i].x)), y1 = (bfhi(a[i].x) + bfhi(b[i].x)) * gelu_tanh(bfhi(g[i].x));
            const float y2 = (bflo(a[i].y) + bflo(b[i].y)) * gelu_tanh(bflo(g[i].y)), y3 = (bfhi(a[i].y) + bfhi(b[i].y)) * gelu_tanh(bfhi(g[i].y));
            u32x2 w; w.x = cvt_pk_bf16(y0, y1); w.y = cvt_pk_bf16(y2, y3);
            *(u32x2*)(Y + row * DM + 768 + c4) = w; }
    }
}

DI void ph_topk(const Ctx& C) {
    const float* affT = (const float*)(C.ws + WS_AFF); int* idx2 = (int*)(C.ws + WS_IDX); float* gsel2 = (float*)(C.ws + WS_GSEL);
    LAS unsigned* hist = (LAS unsigned*)C.lds;
    LAS unsigned* misc = hist + 4096;
    LAS unsigned* cg = misc + 8;
    LAS unsigned* ce = cg + 512;
    for (int u = C.bid; u < 32; u += C.G) {
        const int g = u >> 4, e = u & 15; const unsigned* a = (const unsigned*)(affT + (size_t)(g * 16 + e) * NTOKG);
        const int i0 = C.tid * 128; unsigned v[128];
        { const u32x4* p = (const u32x4*)(a + i0);
#pragma unroll
          for (int j = 0; j < 32; ++j) { const u32x4 q = p[j]; v[4 * j] = q.x; v[4 * j + 1] = q.y; v[4 * j + 2] = q.z; v[4 * j + 3] = q.w; } }
        unsigned prefix = 0u, mask = 0u, krem = CAP;
#pragma unroll 1
        for (int pass = 0; pass < 3; ++pass) {
            const int shift = pass == 0 ? 19 : (pass == 1 ? 7 : 0); const unsigned dm = pass == 2 ? 127u : 4095u; const int per = pass == 2 ? 2 : 64;
            for (int i = C.tid; i < 4096; i += 512) hist[i] = 0u;
            __syncthreads();
#pragma unroll
            for (int i = 0; i < 128; ++i) {
                const unsigned bin = ((v[i] & mask) == prefix) ? ((v[i] >> shift) & dm) : (5120u + (unsigned)C.lane);
                atomicAdd((unsigned*)&hist[bin], 1u); if ((i & 7) == 7) asm volatile("" : "+v"(prefix) :: "memory"); }
            __syncthreads();
            if (C.tid < 64) {
                unsigned t = 0; for (int b = 0; b < per; ++b) t += hist[per * C.tid + b];
                unsigned S = t;
#pragma unroll
                for (int off = 1; off < 64; off <<= 1) { const unsigned y = __shfl_down(S, off); if (C.tid + off < 64) S += y; }
                const unsigned above = S - t;
                if (above < krem && krem <= above + t) { unsigned cum = above; int D = per * C.tid + per - 1;
                    for (; D > per * C.tid; --D) { const unsigned c = hist[D]; if (cum + c >= krem) break; cum += c; }
                    misc[0] = (unsigned)D; misc[1] = cum; }
            }
            __syncthreads();
            prefix |= misc[0] << shift; mask |= dm << shift; krem -= misc[1];
            __syncthreads();
        }
        unsigned ngt = 0, neq = 0;
#pragma unroll
        for (int i = 0; i < 128; ++i) { ngt += (v[i] > prefix); neq += (v[i] == prefix); if ((i & 15) == 15) asm volatile("" : "+v"(prefix)); }
        unsigned ig = ngt, ie = neq;
#pragma unroll
        for (int off = 1; off < 64; off <<= 1) { const unsigned yg = __shfl_up(ig, off), ye = __shfl_up(ie, off); if (C.lane >= off) { ig += yg; ie += ye; } }
        if (C.lane == 63) { cg[C.wave] = ig; ce[C.wave] = ie; }
        __syncthreads();
        unsigned bg = 0, be = 0, allg = 0;
#pragma unroll
        for (int w = 0; w < 8; ++w) { const unsigned x = cg[w], y = ce[w]; if (w < C.wave) { bg += x; be += y; } allg += x; }
        unsigned pg = bg + ig - ngt, pe = be + ie - neq; const unsigned ngt_all = allg;
        int* io = idx2 + (size_t)e * 16384 + g * CAP; float* go = gsel2 + (size_t)e * 16384 + g * CAP; short* sm = (short*)(C.ws + WS_SM) + (size_t)(g * NTOKG + i0) * 16 + e;
#pragma unroll
        for (int i = 0; i < 128; ++i) {
            if (v[i] > prefix) { io[pg] = g * NTOKG + i0 + i; go[pg] = __builtin_bit_cast(float, v[i]); sm[i * 16] = (short)pg; ++pg; }
            else if (v[i] == prefix) { if (pe < krem) { io[ngt_all + pe] = g * NTOKG + i0 + i; go[ngt_all + pe] = __builtin_bit_cast(float, v[i]); sm[i * 16] = (short)(ngt_all + pe); } ++pe; }
            if ((i & 3) == 3) asm volatile("" : "+v"(prefix) :: "memory"); }
        __syncthreads();
    }
}

constexpr int MERGE_CHUNKS = 8, MERGE_ROWS = NTOK / MERGE_CHUNKS;
constexpr int EPB = 2;
constexpr int NPH_LAYER = 12 + 2 * MERGE_CHUNKS + 3 + (NEXP / EPB + 1) + 1, NPH = 1 + 2 * NPH_LAYER;
__global__ void __launch_bounds__(512, 2) mk_fwd(Args args) {
    extern __shared__ __attribute__((aligned(16))) unsigned char lds_raw[];
    Ctx C;
    C.lds = (LAS unsigned char*)lds_raw; C.ws = (GAS unsigned char*)args.ws; C.out = (GAS float*)args.out;
    C.tid = threadIdx.x; C.lane = C.tid & 63; C.wave = __builtin_amdgcn_readfirstlane(C.tid >> 6); C.G = gridDim.x; C.bid = blockIdx.x;
    C.gw = C.bid * 8 + C.wave; C.NGW = C.G * 8;
    C.A = &args;
    volatile LAS unsigned* MISC = (volatile LAS unsigned*)(C.lds + MISC_OFF);
    for (int u = C.tid; u < (LDS_BYTES - RING_BYTES) / 4; u += 512) ((LAS unsigned*)(C.lds + RING_BYTES))[u] = 0u;
    __syncthreads();
    const int lo = args.ph_lo, hi = args.ph_hi;
    unsigned* barw = (unsigned*)(C.ws + WS_CTL) + 4096;
    XcdBarrier bar; bar.bar = barw; bar.x = 0; bar.st = nullptr;
    if (hi - lo > 1) bar = xcd_barrier_post(barw, MISC + 8);
    int ph = 0;
#ifndef PHASE_MASK
#define PHASE_MASK 0xFFFFFFFFu
#endif
#ifndef REPEAT_MASK
#define REPEAT_MASK 0u
#endif
#define SITE(id) if constexpr (((PHASE_MASK) >> (id)) & 1u) for (int rep_ = 0; rep_ < ((((REPEAT_MASK) >> (id)) & 1u) ? 2 : 1); ++rep_)
#define PH_BEGIN if (ph >= lo && ph < hi) { { int tz_ = threadIdx.x; asm volatile("" : "+v"(tz_)); C.tid = tz_; C.lane = tz_ & 63; C.wave = __builtin_amdgcn_readfirstlane(tz_ >> 6); C.gw = C.bid * 8 + C.wave; unsigned char* wz_ = args.ws; asm volatile("" : "+s"(wz_)); C.ws = (GAS unsigned char*)wz_; float* oz_ = args.out; asm volatile("" : "+s"(oz_)); C.out = (GAS float*)oz_; }
#define PH_END } if (ph >= lo && ph + 1 < hi) xcd_barrier(bar); ++ph;

#define XB0 ((bf16_t*)(C.ws + WS_XB0))
#define XB1 ((bf16_t*)(C.ws + WS_XB1))
#define Yb ((bf16_t*)(C.ws + WS_Y))
#define Ub ((bf16_t*)(C.ws + WS_U))
    const int big = 30;

    PH_BEGIN SITE(1) ph_prologue(C); PH_END

    for (int l = 0; l < 2; ++l) {
#define wl (C.ws + WS_WSMALL + (size_t)l * WSMALL_LAYER)
        PH_BEGIN SITE(2) { pg8::Gemm g{XB0, (const bf16_t*)(wl + OFF_WA), NTOK, 768, 1024, 1024, 1024, big, 0}; pg8::StaticOrder S; S.init(NTOK, 768, C.G, C.bid);
            pg8::EpiProj E{Ub, 768, 256, 0.17677669529663689f * LOG2E, (unsigned*)(C.ws + WS_KN2) + (size_t)l * 8 * 2048}; pg8::gemm_phase(C.lds, g, S, E); } PH_END
        PH_BEGIN SITE(3) ph_attn_a(C, l); PH_END
        PH_BEGIN SITE(4) { ph_a_post(C, l); __syncthreads();
            pg8::Gemm g{XB0, (const bf16_t*)(wl + OFF_WB), NTOK, 1280, 1024, 1024, 1024, big, 0}; pg8::StaticOrder S; S.init(NTOK, 1280, C.G, C.bid);
            pg8::EpiProj E{Ub, 1280, 0, 1.f, nullptr}; pg8::gemm_phase(C.lds, g, S, E); } PH_END
        PH_BEGIN SITE(5) ph_hgrn_local(C, l); PH_END
        PH_BEGIN SITE(6) ph_hgrn_scan(C); PH_END
        PH_BEGIN SITE(7) ph_hgrn_out<1>(C, l); PH_END
        PH_BEGIN SITE(20) ph_hgrn_out<2>(C, l); PH_END
        PH_BEGIN SITE(8) { pg8::Gemm g{XB0, (const bf16_t*)(wl + OFF_WCD), NTOK, 1024, 1024, 1024, 1024, big, 0}; pg8::StaticOrder S; S.init(NTOK, 1024, C.G, C.bid);
            pg8::EpiProj E{Ub, 1024, 0, 1.f, nullptr}; pg8::gemm_phase(C.lds, g, S, E); } PH_END
        PH_BEGIN SITE(9) { ph_c_prep(C, l); __syncthreads(); ph_rglru<false>(C, l); } PH_END
        PH_BEGIN SITE(10) { if (rep_ == 0) { ph_rglru_scan(C); __syncthreads(); } ph_attn_c(C); } PH_END
        PH_BEGIN SITE(11) ph_rglru<true>(C, l); PH_END
        PH_BEGIN SITE(12) ph_d_post(C); PH_END
        for (int q = 0; q < MERGE_CHUNKS; ++q) {
            const size_t r0 = (size_t)q * MERGE_ROWS;
            PH_BEGIN SITE(13) {
                { unsigned char* X8 = (unsigned char*)(C.ws + WS_U) + (size_t)MERGE_ROWS * 8192;
                  for (int rb = C.gw; rb < MERGE_ROWS; rb += 8 * C.NGW) {
                      u32x4 a[8], b[8];
#pragma unroll
                      for (int i = 0; i < 8; ++i) { const int r = min(rb + i * C.NGW, MERGE_ROWS - 1); const u32x4* s = (const u32x4*)(XB0 + (r0 + r) * DM) + 2 * C.lane; a[i] = s[0]; b[i] = s[1]; }
#pragma unroll
                      for (int i = 0; i < 8; ++i) { const int r = rb + i * C.NGW; if (r < MERGE_ROWS) {
                          u32x4 o; o.x = pg8::pk4_fp8(bflo(a[i].x), bfhi(a[i].x), bflo(a[i].y), bfhi(a[i].y)); o.y = pg8::pk4_fp8(bflo(a[i].z), bfhi(a[i].z), bflo(a[i].w), bfhi(a[i].w));
                          o.z = pg8::pk4_fp8(bflo(b[i].x), bfhi(b[i].x), bflo(b[i].y), bfhi(b[i].y)); o.w = pg8::pk4_fp8(bflo(b[i].z), bfhi(b[i].z), bflo(b[i].w), bfhi(b[i].w));
                          ((u32x4*)(X8 + (size_t)r * DM))[C.lane] = o; } } }
                  __syncthreads(); }
                pg8::Gemm g{Yb + r0 * DM, (const bf16_t*)(wl + OFF_WBR), MERGE_ROWS, 4096, 256, 1024, 256, 2, 512}; pg8::StaticOrder S; S.init(MERGE_ROWS, 4096, C.G, C.bid);
                pg8::EpiProj E{Ub, 4096, 0, 1.f, nullptr}; pg8::gemm_phase(C.lds, g, S, E); } PH_END
            PH_BEGIN SITE(14) { pg8::Gemm g{(const bf16_t*)(C.ws + WS_U + (size_t)MERGE_ROWS * 8192), (const bf16_t*)(wl + OFF_WG), MERGE_ROWS, 4096, 1024, 1024, 1024, big, 0}; pg8::StaticOrder S; S.init(MERGE_ROWS, 4096, C.G, C.bid);
                pg8::EpiGateMix E{Ub, XB1 + r0 * DM, 1.f / pg8::FP8_W1_SCALE}; pg8::gemm_phase<pg8::EpiGateMix, pg8::StaticOrder, true>(C.lds, g, S, E); } PH_END
        }
        PH_BEGIN SITE(15) { pg8::Gemm g{XB1, (const bf16_t*)(wl + OFF_WOUT), NTOK, 1024, 1024, 1024, 1024, big, 0}; pg8::StaticOrder S; S.init(NTOK, 1024, C.G, C.bid);
            pg8::EpiResid E{l == 0 ? C.A->in[0] : (const float*)C.out, l == 0 ? C.A->in[1] : (const float*)(C.out + (size_t)NTOKG * DM), (float*)C.out}; pg8::gemm_phase(C.lds, g, S, E); } PH_END
        PH_BEGIN SITE(16) { ph_ln<true>(C, l, 0, XB1); } PH_END
        PH_BEGIN SITE(17) { if (C.bid < 32 && C.G > 64) ph_topk(C); else expert_weight_items(C, l); if (C.G <= 64) { __syncthreads(); if (C.bid < 32) ph_topk(C); } } PH_END
        for (int k = 0; k < NEXP / EPB + 1; ++k) {
            PH_BEGIN SITE(18) {
                constexpr size_t H_B = (size_t)EPB * 16384 * 2048;
                unsigned char* Hb = (unsigned char*)(C.ws + WS_XB0);
                if (k < NEXP / EPB) { const int e0 = k * EPB;
                    pg8::Gemm g{(const bf16_t*)(C.ws + WS_XB1), (const bf16_t*)(C.ws + WS_EW + OFF_WGU8 + (size_t)e0 * 4096 * 1024), EPB * 16384, 4096, 1024, 1024, 1024, big, 0, 6, (size_t)4096 * 1024, (const int*)(C.ws + WS_IDX) + (size_t)e0 * 16384}; pg8::StaticOrder S; S.init(EPB * 16384, 4096, C.G, C.bid);
                    pg8::EpiSiluMul8 E{Hb + (size_t)(k & 1) * H_B, 2048}; pg8::gemm_phase<pg8::EpiSiluMul8, pg8::StaticOrder, true, true>(C.lds, g, S, E); }
                if (k >= 1) { const int e0 = (k - 1) * EPB; __syncthreads();
                    pg8::Gemm g{(const bf16_t*)(Hb + (size_t)((k - 1) & 1) * H_B), (const bf16_t*)(C.ws + WS_EW + OFF_WD8 + (size_t)e0 * 1024 * 2048), EPB * 16384, 1024, 2048, 2048, 2048, big, 0, 6, (size_t)1024 * 2048}; pg8::StaticOrder S; S.init(EPB * 16384, 1024, C.G, C.bid);
                    pg8::EpiYe E{(bf16_t*)(C.ws + WS_Y) + (size_t)e0 * 16384 * DM, (const float*)(C.ws + WS_GSEL) + (size_t)e0 * 16384, 1.f / (pg8::FP8_H_SCALE * pg8::FP8_W2_SCALE)}; pg8::gemm_phase<pg8::EpiYe, pg8::StaticOrder, true>(C.lds, g, S, E); }
            } PH_END
        }
        PH_BEGIN SITE(19) ph_ln<false>(C, l, 1, l + 1 < 2 ? XB0 : nullptr); PH_END
    }
#undef PH_BEGIN
#undef PH_END
#undef XB0
#undef XB1
#undef Yb
#undef Ub
#undef wl
}

extern "C" void kernel_launch(void* const* d_in, const int* in_sizes, int n_in, void* d_out, int out_size, void* d_ws, size_t ws_size, hipStream_t stream) {
    static int grid = 0;
    if (grid == 0) {
        if (n_in != 26 || out_size != NTOK * DM || ws_size < WS_END) { fprintf(stderr, "kernel_launch: unexpected shapes: n_in %d out %d ws %zu (need %zu)\n", n_in, out_size, ws_size, (size_t)WS_END); grid = -1; return; }
        int dev = 0, cus = 0, per_cu = 0;
        if (hipGetDevice(&dev) != hipSuccess || hipDeviceGetAttribute(&cus, hipDeviceAttributeMultiprocessorCount, dev) != hipSuccess) { grid = -1; return; }
        if (hipFuncSetAttribute((const void*)mk_fwd, hipFuncAttributeMaxDynamicSharedMemorySize, LDS_BYTES) != hipSuccess) { fprintf(stderr, "kernel_launch: hipFuncSetAttribute failed\n"); grid = -1; return; }
        if (hipOccupancyMaxActiveBlocksPerMultiprocessor(&per_cu, (const void*)mk_fwd, 512, LDS_BYTES) != hipSuccess || per_cu < 1) { fprintf(stderr, "kernel_launch: occupancy query says %d\n", per_cu); }
        (void)hipGetLastError();
        grid = cus;
    }
    if (grid < 0) return;
    if (hipMemsetAsync((char*)d_ws + WS_CTL, 0, CTL_ZERO_BYTES, stream) != hipSuccess) return;
    Args a{};
    for (int i = 0; i < 26; ++i) a.in[i] = (const float*)d_in[i];
    a.out = (float*)d_out; a.ws = (unsigned char*)d_ws;
#if MK_PER_PHASE_LAUNCH
    for (int p = 0; p < NPH; ++p) { a.ph_lo = p; a.ph_hi = p + 1; hipLaunchKernelGGL(mk_fwd, dim3(grid), dim3(512), LDS_BYTES, stream, a); }
#else
    a.ph_lo = 0; a.ph_hi = NPH; hipLaunchKernelGGL(mk_fwd, dim3(grid), dim3(512), LDS_BYTES, stream, a);
#endif
    const hipError_t le = hipPeekAtLastError();
    if (le != hipSuccess) fprintf(stderr, "kernel_launch: launch failed: %s\n", hipGetErrorName(le));
}
```

```cpp
#include <hip/hip_runtime.h>
#include <cstdio>
#include <cstdint>

#ifndef MK_PER_PHASE_LAUNCH
#define MK_PER_PHASE_LAUNCH 0
#endif

#define LAS __attribute__((address_space(3)))
#define GAS __attribute__((address_space(1)))
typedef unsigned short bf16_t;
typedef short bf16x8 __attribute__((ext_vector_type(8)));
typedef short s16x4 __attribute__((ext_vector_type(4)));
typedef float f32x2 __attribute__((ext_vector_type(2)));
typedef float f32x4 __attribute__((ext_vector_type(4)));
typedef float f32x16 __attribute__((ext_vector_type(16)));
typedef unsigned u32x2 __attribute__((ext_vector_type(2)));
typedef unsigned u32x4 __attribute__((ext_vector_type(4)));
#define DI __device__ __forceinline__
#define LDS_WAIT() asm volatile("s_waitcnt lgkmcnt(0)" ::: "memory")
#define VM_WAIT() asm volatile("s_waitcnt vmcnt(0)" ::: "memory")

constexpr int DM = 1024, NTOK = 131072, NTOKG = 65536, NSEQ = 40, NCHUNK = 1024  ;
constexpr int IN_W = 6992, COL_B = 768, COL_CD = 2048, COL_GATE = 2896;
constexpr int NEXP = 16, DEXP = 2048, CAP = 8192;
constexpr float ALPHA = 1.41421356237309515f, INV_ALPHA = 0.70710678118654752f;
constexpr float LOG2E = 1.4426950408889634f;
constexpr float LN_EPS = 1e-5f, RMS_EPS = 1e-6f;

constexpr size_t MiB = (size_t)1 << 20;
constexpr size_t WS_CTL = 0, CTL_ZERO_BYTES = 1 * MiB;
constexpr size_t WS_KN2 = 256 * 1024;
constexpr size_t WS_WSMALL = 2 * MiB, WSMALL_LAYER = 18 * MiB;
constexpr size_t OFF_WA = 0, OFF_WB = (size_t)768 * 1024 * 2, OFF_WCD = OFF_WB + (size_t)1280 * 1024 * 2, OFF_WG = OFF_WCD + (size_t)1024 * 1024 * 2,
                 OFF_WBR = OFF_WG + (size_t)4096 * 1024 * 2, OFF_WOUT = OFF_WBR + (size_t)4096 * 256 * 2;
static_assert(OFF_WOUT + (size_t)1024 * 1024 * 2 <= WSMALL_LAYER, "small weights");
constexpr size_t WS_WC = 38 * MiB, WC_LAYER = 256 * 1024;
constexpr size_t OFF_WQ = 0, OFF_WKV = 96 * 1024;
constexpr size_t WS_WRG = 39 * MiB;
constexpr size_t WS_AFF = 40 * MiB;
constexpr size_t WS_IDX = 48 * MiB, WS_GSEL = 49 * MiB;
constexpr size_t WS_GAM = 50 * MiB;
constexpr size_t WS_DC = 52 * MiB;
constexpr size_t WS_SM = 56 * MiB;
constexpr size_t WS_XB0 = 64 * MiB, WS_XB1 = 320 * MiB, WS_Y = 576 * MiB, WS_U = 832 * MiB, WS_EW = 1152 * MiB, WS_END = 1344 * MiB;
constexpr size_t OFF_QC = 0, OFF_KC = 48 * MiB, OFF_VC = 96 * MiB;
constexpr size_t OFF_WGU8 = 0, OFF_WD8 = (size_t)16 * 4096 * 1024;

DI unsigned f2bf(float f) { unsigned u = __builtin_bit_cast(unsigned, f); return (u + 0x7fffu + ((u >> 16) & 1u)) >> 16; }
DI unsigned pk2(float lo, float hi) { return f2bf(lo) | (f2bf(hi) << 16); }
DI float bf2f(unsigned short b) { return __builtin_bit_cast(float, ((unsigned)b) << 16); }
DI float bflo(unsigned w) { return __builtin_bit_cast(float, w << 16); }
DI float bfhi(unsigned w) { return __builtin_bit_cast(float, w & 0xffff0000u); }
DI unsigned cvt_pk_bf16(float lo, float hi) { unsigned r; asm volatile("v_cvt_pk_bf16_f32 %0, %1, %2" : "=v"(r) : "v"(lo), "v"(hi)); return r; }
typedef __bf16 bf16x2_t __attribute__((ext_vector_type(2)));
DI unsigned cvt_pk_bf16_b(float lo, float hi) { const f32x2 v = {lo, hi}; const bf16x2_t b = __builtin_convertvector(v, bf16x2_t); return __builtin_bit_cast(unsigned, b); }
DI float sigmoidf_(float x) { return __builtin_amdgcn_rcpf(1.0f + __builtin_amdgcn_exp2f(-x * LOG2E)); }
DI float siluf_(float x) { return x * sigmoidf_(x); }
DI float wave_sum(float v) {
#pragma unroll
    for (int o = 1; o < 64; o <<= 1) v += __shfl_xor(v, o);
    return v;
}
DI float wave_max(float v) {
#pragma unroll
    for (int o = 1; o < 64; o <<= 1) v = fmaxf(v, __shfl_xor(v, o));
    return v;
}
DI int seq_start_row(int s) { return s < 8 ? s * 8192 : 65536 + (s - 8) * 2048; }
DI int row_pos(int row) { return row < 65536 ? (row & 8191) : (row & 2047); }
DI int row_seq_begin(int row) { return row < 65536 ? (row & ~8191) : (row & ~2047); }
DI int row_seq_len(int row) { return row < 65536 ? 8192 : 2048; }

namespace pg8 {
constexpr int BM = 256, BK = 64, HALF = 128, HTB = HALF * BK * 2, STAGE_BYTES = 8 * HTB, NXCD = 8, WGM = 8;
DI int lds_byte(int r, int c) { const int st = (r >> 4) * 2 + (c >> 5), rr = r & 15, cc = c & 31, ob = rr * 64 + cc * 2; return st * 1024 + (ob ^ (((ob >> 9) & 1) << 5)); }
DI void stage_rc(int b, int& R, int& C) { const int st = b / 1024, sb = b % 1024, swz = sb ^ (((sb >> 9) & 1) << 5); R = (st >> 1) * 16 + swz / 64; C = (st & 1) * 32 + (swz % 64) / 2; }
DI int perm32(int rho) { const int n = rho >> 4, i = rho & 15; return 8 * (i >> 2) + 4 * n + (i & 3); }

struct Unit { int pm, pn; };
struct Gemm { const bf16_t* A; const bf16_t* Bt; int M, N, K, lda, ldb, an_shift; size_t an_off; int bm_shift = 30; size_t bm_off = 0; const int* gidx = nullptr; };

struct StaticOrder {
    int nM, nN, nwg, G, c;
    DI void init(int M, int N, int G_, int c_) { nM = M / BM; nN = N / BM; nwg = nM * nN; G = G_; c = c_; }
    DI bool next(int i, Unit& u) const {
        const long L = (long)i * G + c; if (L >= nwg) return false;
        int wgid = (int)L; { const int q = nwg / NXCD, r = nwg % NXCD, xcd = wgid % NXCD, off = wgid / NXCD; wgid = (xcd < r ? xcd * (q + 1) : r * (q + 1) + (xcd - r) * q) + off; }
        const int nig = WGM * nN, gid = wgid / nig, fm = gid * WGM, gsz = (nM - fm) < WGM ? (nM - fm) : WGM;
        u.pm = fm + ((wgid % nig) % gsz); u.pn = (wgid % nig) / gsz; return true;
    }
};

typedef f32x4 Acc[2][2][4][2];

typedef int v8i_t __attribute__((ext_vector_type(8)));
DI void mfma8_tied(f32x4& c, const v8i_t& a, const v8i_t& b) { asm volatile("v_mfma_f32_16x16x128_f8f6f4 %0, %1, %2, %0" : "+v"(c) : "v"(a), "v"(b)); }
DI void glds_sv(const void* sbase, unsigned voff, unsigned lds_dst) { unsigned keep;
    asm volatile("s_mov_b32 %0, m0\n\ts_mov_b32 m0, %3\n\ts_nop 0\n\tglobal_load_lds_dwordx4 %1, %2\n\ts_mov_b32 m0, %0" : "=&s"(keep) : "v"(voff), "s"(sbase), "s"(lds_dst) : "memory"); }
constexpr int GIDX_OFF = 131072 + 1024, GIDX_TILES = 14;
template <class Epi, class Sched, bool FP8 = false, bool GATHER = false>
DI void gemm_phase(LAS unsigned char* lds, const Gemm g, const Sched& S, const Epi& E) {
    int tid = threadIdx.x; asm volatile("" : "+v"(tid));
    const int wid = __builtin_amdgcn_readfirstlane(tid >> 6), lane = tid & 63, wr = wid >> 2, wc = wid & 3, fr = lane & 15, fq = lane >> 4;
    const int K = g.K, nt = FP8 ? K / 128 : K / BK;
    const int pitchA = FP8 ? g.lda : g.lda * 2, pitchB = FP8 ? g.ldb : g.ldb * 2;
    unsigned voffA[2], voffB[2];
#pragma unroll
    for (int i = 0; i < 2; ++i) { int R, C; stage_rc(tid * 16 + i * 8192, R, C); const int Rb = Epi::PERM ? ((R & ~31) + perm32(R & 31)) : R;
        voffA[i] = (unsigned)(R * pitchA + C * 2); voffB[i] = (unsigned)(Rb * pitchB + C * 2); }
    const size_t kstep = (size_t)(BK * 2);
    const size_t hstepA = (size_t)HALF * pitchA, hstepB = (size_t)HALF * pitchB;
    const size_t tstepA = 2 * hstepA, tstepB = 2 * hstepB;
    const unsigned ldsw = (unsigned)wid * 1024u;
    const int aoff = lds_byte(wr * 64 + fr, fq * 8), boff = lds_byte(wc * 32 + fr, fq * 8);
#define PG8_SA(b, h) (((b) * 2 + (h)) * HTB)
#define PG8_SB(b, h) ((4 + (b) * 2 + (h)) * HTB)
#define PG8_STAGE(bufoff, gbase, voff) do { _Pragma("unroll") for (int _i = 0; _i < 2; ++_i) \
        glds_sv((const void*)(gbase), (voff)[_i], (unsigned)(uintptr_t)(lds + (bufoff) + ldsw + _i * 8192)); } while (0)
#define PG8_LD1(p) ([&]() { if constexpr (FP8) { const u32x4 lo_ = *(const LAS u32x4*)(p), hi_ = *(const LAS u32x4*)((p) + 1024); return Frag{__builtin_bit_cast(v8i_t, __builtin_shufflevector(lo_, hi_, 0, 1, 2, 3, 4, 5, 6, 7))}; } \
        else { Frag f_; f_.h[0] = *(const LAS bf16x8*)(p); f_.h[1] = *(const LAS bf16x8*)((p) + 1024); return f_; } }())
#define PG8_LDA(dst, b, h) do { _Pragma("unroll") for (int m = 0; m < 4; ++m) dst[m] = PG8_LD1(lds + PG8_SA(b, h) + aoff + m * 2048); } while (0)
#define PG8_LDB(dst, b, h) do { _Pragma("unroll") for (int n = 0; n < 2; ++n) dst[n] = PG8_LD1(lds + PG8_SB(b, h) + boff + n * 2048); } while (0)
#define PG8_MMA(ai, bj, At, Bt) do { __builtin_amdgcn_s_setprio(1); _Pragma("unroll") for (int m = 0; m < 4; ++m) _Pragma("unroll") for (int n = 0; n < 2; ++n) { \
        if constexpr (FP8) mfma8_tied(acc[ai][bj][m][n], Bt[n].w, At[m].w); \
        else { _Pragma("unroll") for (int k = 0; k < 2; ++k) acc[ai][bj][m][n] = __builtin_amdgcn_mfma_f32_16x16x32_bf16(Bt[n].h[k], At[m].h[k], acc[ai][bj][m][n], 0, 0, 0); } } \
        __builtin_amdgcn_s_setprio(0); } while (0)
#define PG8_WAIT_V(n) asm volatile("s_waitcnt vmcnt(" #n ")" ::: "memory")
#define PG8_WAIT_L(n) asm volatile("s_waitcnt lgkmcnt(" #n ")" ::: "memory")
#define PG8_BAR __builtin_amdgcn_s_barrier()
#define PG8_SCHED __builtin_amdgcn_sched_barrier(0)
    Unit cur, nxt; int ui = 0;
    unsigned vg[2][2] = {{0u, 0u}, {0u, 0u}};
    if constexpr (GATHER) { LAS unsigned* tab = (LAS unsigned*)(lds + GIDX_OFF); Unit u_;
        for (int i = 0; i < GIDX_TILES && S.next(i, u_); ++i) { if (tid < 256) tab[i * 256 + tid] = (unsigned)g.gidx[u_.pm * BM + tid]; }
        __syncthreads(); }
#define PG8_GOFF(ord) do { int tq_ = tid; asm volatile("" : "+v"(tq_)); int R_, C_; stage_rc(tq_ * 16, R_, C_); const LAS unsigned* tb_ = (const LAS unsigned*)(lds + GIDX_OFF) + (ord) * 256 + R_; \
        _Pragma("unroll") for (int h_ = 0; h_ < 2; ++h_) _Pragma("unroll") for (int i_ = 0; i_ < 2; ++i_) vg[h_][i_] = tb_[h_ * 128 + i_ * 64] * (unsigned)pitchA + (unsigned)(C_ * 2); } while (0)
#define PG8_STAGE_A(bufoff, base, h) do { if constexpr (GATHER) PG8_STAGE(bufoff, base, vg[h]); else PG8_STAGE(bufoff, (base) + (h) * hstepA, voffA); } while (0)
    if (!S.next(0, cur)) return;
    if constexpr (GATHER) PG8_GOFF(0);
    float zf = 0.f; asm volatile("" : "+v"(zf));
    Acc acc;
#pragma unroll
    for (int a = 0; a < 2; ++a)
#pragma unroll
        for (int b = 0; b < 2; ++b)
#pragma unroll
            for (int m = 0; m < 4; ++m)
#pragma unroll
                for (int n = 0; n < 2; ++n) acc[a][b][m][n] = (f32x4){zf, zf, zf, zf};
    union Frag { v8i_t w; bf16x8 h[2]; };
    Frag At[4], B0[2], B1[2];
    const char* cA = GATHER ? (const char*)g.A : (const char*)g.A + (size_t)cur.pm * tstepA + (size_t)(cur.pn >> g.an_shift) * g.an_off; const char* cB = (const char*)g.Bt + (size_t)cur.pn * tstepB + (size_t)(cur.pm >> g.bm_shift) * g.bm_off;
    PG8_STAGE(PG8_SB(0, 0), cB, voffB); PG8_STAGE(PG8_SB(0, 1), cB + hstepB, voffB); PG8_STAGE_A(PG8_SA(0, 0), cA, 0); PG8_STAGE_A(PG8_SA(0, 1), cA, 1);
    if (wr == 1) PG8_BAR;
    PG8_WAIT_V(2); PG8_BAR;
    PG8_STAGE(PG8_SB(1, 0), cB + kstep, voffB); PG8_STAGE_A(PG8_SA(1, 0), cA + kstep, 0); PG8_STAGE(PG8_SB(1, 1), cB + hstepB + kstep, voffB);
    PG8_WAIT_V(6); PG8_BAR;
    for (;;) {
        const bool has_next = S.next(ui + 1, nxt);
        const char* nA = (has_next && !GATHER) ? (const char*)g.A + (size_t)nxt.pm * tstepA + (size_t)(nxt.pn >> g.an_shift) * g.an_off : cA;
        const char* nB = has_next ? (const char*)g.Bt + (size_t)nxt.pn * tstepB + (size_t)(nxt.pm >> g.bm_shift) * g.bm_off : cB;
#pragma unroll 1
        for (int t = 0; t < nt; t += 2) {
            const bool last = (t == nt - 2);
            const char* a1 = cA + (size_t)(t + 1) * kstep;
            const char* a2 = last ? nA : cA + (size_t)(t + 2) * kstep; const char* b2 = last ? nB : cB + (size_t)(t + 2) * kstep;
            const char* a3 = a2 + kstep; const char* b3 = b2 + kstep;
            PG8_LDB(B0, 0, 0); PG8_LDB(B1, 0, 1); PG8_SCHED; PG8_LDA(At, 0, 0); PG8_STAGE_A(PG8_SA(1, 1), a1, 1);
            if constexpr (GATHER) { if (last && has_next) PG8_GOFF(ui + 1); }
            PG8_WAIT_V(8); PG8_WAIT_L(0); PG8_BAR; PG8_MMA(0, 0, At, B0); PG8_MMA(0, 1, At, B1); PG8_BAR; PG8_SCHED;
            PG8_LDA(At, 0, 1); PG8_STAGE(PG8_SB(0, 0), b2, voffB); PG8_STAGE(PG8_SB(0, 1), b2 + hstepB, voffB); PG8_STAGE_A(PG8_SA(0, 0), a2, 0);
            PG8_WAIT_V(8); PG8_WAIT_L(0); PG8_BAR; PG8_MMA(1, 0, At, B0); PG8_MMA(1, 1, At, B1); PG8_BAR; PG8_SCHED;
            PG8_LDB(B0, 1, 0); PG8_LDB(B1, 1, 1); PG8_SCHED; PG8_LDA(At, 1, 0); PG8_STAGE_A(PG8_SA(0, 1), a2, 1);
            PG8_WAIT_V(8); PG8_WAIT_L(0); PG8_BAR; PG8_MMA(0, 0, At, B0); PG8_MMA(0, 1, At, B1); PG8_BAR; PG8_SCHED;
            PG8_LDA(At, 1, 1); PG8_STAGE(PG8_SB(1, 0), b3, voffB); PG8_STAGE(PG8_SB(1, 1), b3 + hstepB, voffB); PG8_STAGE_A(PG8_SA(1, 0), a3, 0);
            PG8_WAIT_V(8); PG8_WAIT_L(0); PG8_BAR; PG8_MMA(1, 0, At, B0); PG8_MMA(1, 1, At, B1); PG8_BAR; PG8_SCHED;
        }
        if (wr == 0) PG8_BAR;
        if constexpr (FP8) asm volatile("s_nop 15\n\ts_nop 15" ::: "memory");
        { int tz = tid; asm volatile("" : "+v"(tz));
          const int lz = tz & 63; E(acc, cur, wr, wc, lz & 15, lz >> 4); }
        if (!has_next) break;
#pragma unroll
        for (int a = 0; a < 2; ++a)
#pragma unroll
            for (int b = 0; b < 2; ++b)
#pragma unroll
                for (int m = 0; m < 4; ++m)
#pragma unroll
                    for (int n = 0; n < 2; ++n) acc[a][b][m][n] = (f32x4){0.f, 0.f, 0.f, 0.f};
        cur = nxt; cA = nA; cB = nB; ++ui;
        if (wr == 1) PG8_BAR;
    }
    PG8_WAIT_V(0);
    PG8_BAR;
#undef PG8_SA
#undef PG8_SB
#undef PG8_STAGE
#undef PG8_STAGE_A
#undef PG8_GOFF
#undef PG8_LDA
#undef PG8_LDB
#undef PG8_MMA
#undef PG8_LD1
#undef PG8_WAIT_V
#undef PG8_WAIT_L
#undef PG8_BAR
#undef PG8_SCHED
}

struct EpiProj {
    static constexpr bool PERM = true;
    bf16_t* O; int ldc; int scale_cols; float scale; unsigned* kn2;
    DI void operator()(const Acc& acc, const Unit& u, int wr, int wc, int fr, int fq) const {
        const int row0 = u.pm * BM + wr * 64 + fr, colt = u.pn * BM, col0 = colt + wc * 32 + 8 * fq;
        const float sc = (colt < scale_cols) ? scale : 1.f;
        const bool donorm = (kn2 != nullptr) && (colt == 256);
#pragma unroll
        for (int ai = 0; ai < 2; ++ai) { float mx0 = 0.f, mx1 = 0.f;
#pragma unroll
            for (int m = 0; m < 4; ++m) { bf16_t* rowp = O + (size_t)(row0 + ai * HALF + m * 16) * ldc + col0;
#pragma unroll
                for (int bj = 0; bj < 2; ++bj) { const f32x4 v0 = acc[ai][bj][m][0] * sc, v1 = acc[ai][bj][m][1] * sc;
                    u32x4 w; w.x = cvt_pk_bf16(v0[0], v0[1]); w.y = cvt_pk_bf16(v0[2], v0[3]); w.z = cvt_pk_bf16(v1[0], v1[1]); w.w = cvt_pk_bf16(v1[2], v1[3]);
                    *(u32x4*)(rowp + bj * HALF) = w;
                    if (donorm) { float ss = bflo(w.x) * bflo(w.x) + bfhi(w.x) * bfhi(w.x) + bflo(w.y) * bflo(w.y) + bfhi(w.y) * bfhi(w.y) + bflo(w.z) * bflo(w.z) + bfhi(w.z) * bfhi(w.z) + bflo(w.w) * bflo(w.w) + bfhi(w.w) * bfhi(w.w);
                        ss += __shfl_xor(ss, 16); ss += __shfl_xor(ss, 32); if (bj == 0) mx0 = fmaxf(mx0, ss); else mx1 = fmaxf(mx1, ss); } } }
            if (donorm) {
#pragma unroll
                for (int o = 1; o < 16; o <<= 1) { mx0 = fmaxf(mx0, __shfl_xor(mx0, o)); mx1 = fmaxf(mx1, __shfl_xor(mx1, o)); }
                if (fr == 0 && fq == 0) { const int tile = 4 * u.pm + 2 * ai + wr;
                    atomicMax(kn2 + (size_t)(wc) * 2048 + tile, __builtin_bit_cast(unsigned, mx0)); atomicMax(kn2 + (size_t)(4 + wc) * 2048 + tile, __builtin_bit_cast(unsigned, mx1)); } } }
    }
};
struct EpiSiluMul {
    static constexpr bool PERM = true;
    bf16_t* H; int ldh;
    DI void operator()(const Acc& acc, const Unit& u, int wr, int wc, int fr, int fq) const {
        const int row0 = u.pm * BM + wr * 64 + fr, col0 = u.pn * HALF + wc * 32 + 8 * fq;
#pragma unroll
        for (int ai = 0; ai < 2; ++ai)
#pragma unroll
            for (int m = 0; m < 4; ++m) { bf16_t* rowp = H + (size_t)(row0 + ai * HALF + m * 16) * ldh + col0;
                float h[8];
#pragma unroll
                for (int n = 0; n < 2; ++n)
#pragma unroll
                    for (int j = 0; j < 4; ++j) h[n * 4 + j] = siluf_(acc[ai][0][m][n][j]) * acc[ai][1][m][n][j];
                u32x4 w; w.x = cvt_pk_bf16(h[0], h[1]); w.y = cvt_pk_bf16(h[2], h[3]); w.z = cvt_pk_bf16(h[4], h[5]); w.w = cvt_pk_bf16(h[6], h[7]);
                *(u32x4*)rowp = w; }
    }
};
DI unsigned pk4_fp8(float a, float b, float c, float d) { int w = 0; a = __builtin_amdgcn_fmed3f(a, -448.f, 448.f); b = __builtin_amdgcn_fmed3f(b, -448.f, 448.f); c = __builtin_amdgcn_fmed3f(c, -448.f, 448.f); d = __builtin_amdgcn_fmed3f(d, -448.f, 448.f);     w = __builtin_amdgcn_cvt_pk_fp8_f32(a, b, w, false); w = __builtin_amdgcn_cvt_pk_fp8_f32(c, d, w, true); return (unsigned)w; }
constexpr float FP8_W1_SCALE = 32.f, FP8_W2_SCALE = 64.f, FP8_H_SCALE = 4.f;
struct EpiSiluMul8 {
    static constexpr bool PERM = true;
    unsigned char* H; int ldh;
    DI void operator()(const Acc& acc, const Unit& u, int wr, int wc, int fr, int fq) const {
        const int row0 = u.pm * BM + wr * 64 + fr, col0 = u.pn * HALF + wc * 32 + 8 * fq;
        constexpr float k1 = -LOG2E / FP8_W1_SCALE; static_assert(FP8_W1_SCALE * FP8_W1_SCALE / FP8_H_SCALE == 256.f, "scale folding");
#pragma unroll
        for (int ai = 0; ai < 2; ++ai)
#pragma unroll
            for (int m = 0; m < 4; ++m) { unsigned char* rowp = H + (size_t)(row0 + ai * HALF + m * 16) * ldh + col0;
                float t[8], h[8];
#pragma unroll
                for (int q = 0; q < 8; ++q) t[q] = __builtin_fmaf(acc[ai][0][m][q >> 2][q & 3], k1, 8.f);
#pragma unroll
                for (int q = 0; q < 8; ++q) t[q] = __builtin_amdgcn_exp2f(t[q]);
#pragma unroll
                for (int q = 0; q < 8; ++q) { t[q] += 256.f; h[q] = acc[ai][0][m][q >> 2][q & 3] * acc[ai][1][m][q >> 2][q & 3]; }
#pragma unroll
                for (int q = 0; q < 8; ++q) t[q] = __builtin_amdgcn_rcpf(t[q]);
#pragma unroll
                for (int q = 0; q < 8; ++q) h[q] *= t[q];
                u32x2 w; w.x = pk4_fp8(h[0], h[1], h[2], h[3]); w.y = pk4_fp8(h[4], h[5], h[6], h[7]);
                *(u32x2*)rowp = w; }
    }
};
struct EpiMoeDown {
    static constexpr bool PERM = false;
    float* out; const int* idx; const float* gs; float sc;
    DI void operator()(const Acc& acc, const Unit& u, int wr, int wc, int fr, int fq) const {
        const int row0 = u.pm * BM + wr * 64 + fr, col0 = u.pn * BM + wc * 32 + 4 * fq;
#pragma unroll
        for (int ai = 0; ai < 2; ++ai)
#pragma unroll
            for (int m = 0; m < 4; ++m) { const int rl = row0 + ai * HALF + m * 16; const int tok = idx[rl]; const float g = gs[rl] * sc;
                float* rowp = out + (size_t)tok * DM + col0;
#pragma unroll
                for (int bj = 0; bj < 2; ++bj)
#pragma unroll
                    for (int n = 0; n < 2; ++n) { f32x4* p = (f32x4*)(rowp + bj * HALF + n * 16); f32x4 v = *p; v += acc[ai][bj][m][n] * g; *p = v; }
                asm volatile("" ::: "memory"); }
    }
};
struct EpiYe {
    static constexpr bool PERM = true;
    bf16_t* O; const float* gs; float sc;
    DI void operator()(const Acc& acc, const Unit& u, int wr, int wc, int fr, int fq) const {
        const int row0 = u.pm * BM + wr * 64 + fr, col0 = u.pn * BM + wc * 32 + 8 * fq;
        float gv[8];
#pragma unroll
        for (int c = 0; c < 8; ++c) gv[c] = gs[row0 + (c >> 2) * HALF + (c & 3) * 16];
#pragma unroll
        for (int ai = 0; ai < 2; ++ai)
#pragma unroll
            for (int m = 0; m < 4; ++m) { const int rl = row0 + ai * HALF + m * 16; const float g = gv[ai * 4 + m] * sc; bf16_t* rowp = O + (size_t)rl * DM + col0;
#pragma unroll
                for (int bj = 0; bj < 2; ++bj) { const f32x4 v0 = acc[ai][bj][m][0] * g, v1 = acc[ai][bj][m][1] * g;
                    u32x4 w; w.x = cvt_pk_bf16(v0[0], v0[1]); w.y = cvt_pk_bf16(v0[2], v0[3]); w.z = cvt_pk_bf16(v1[0], v1[1]); w.w = cvt_pk_bf16(v1[2], v1[3]);
                    *(u32x4*)(rowp + bj * HALF) = w; } }
    }
};
struct EpiResid {
    static constexpr bool PERM = false;
    const float* xa; const float* xb; float* out;
    DI void operator()(const Acc& acc, const Unit& u, int wr, int wc, int fr, int fq) const {
        const int row0 = u.pm * BM + wr * 64 + fr, col0 = u.pn * BM + wc * 32 + 4 * fq;
#pragma unroll
        for (int ai = 0; ai < 2; ++ai) {
            f32x4 sv[4][4];
#pragma unroll
            for (int m = 0; m < 4; ++m) { const int r = row0 + ai * HALF + m * 16;
                const float* srow = (r < NTOKG ? xa + (size_t)r * DM : xb + (size_t)(r - NTOKG) * DM) + col0;
#pragma unroll
                for (int q = 0; q < 4; ++q) sv[m][q] = *(const f32x4*)(srow + (q >> 1) * HALF + (q & 1) * 16); }
#pragma unroll
            for (int m = 0; m < 4; ++m) { const int r = row0 + ai * HALF + m * 16; float* orow = out + (size_t)r * DM + col0;
#pragma unroll
                for (int q = 0; q < 4; ++q) *(f32x4*)(orow + (q >> 1) * HALF + (q & 1) * 16) = sv[m][q] + acc[ai][q >> 1][m][q & 1] * INV_ALPHA; } }
    }
};
struct EpiGateMix {
    static constexpr bool PERM = false;
    const bf16_t* Z; bf16_t* mix; float si;
    DI void operator()(const Acc& acc, const Unit& u, int wr, int wc, int fr, int fq) const {
        const int row0 = u.pm * BM + wr * 64 + fr, J0 = u.pn * 64 + wc * 16 + fq * 4;
        u32x2 zall[8][4];
#pragma unroll
        for (int c = 0; c < 8; ++c) { const bf16_t* zrow = Z + (size_t)(row0 + (c >> 2) * HALF + (c & 3) * 16) * 4096 + J0;
#pragma unroll
            for (int b = 0; b < 4; ++b) zall[c][b] = *(const u32x2*)(zrow + b * 1024); }
#pragma unroll
        for (int ai = 0; ai < 2; ++ai)
#pragma unroll
            for (int m = 0; m < 4; ++m) { const int r = row0 + ai * HALF + m * 16;
                u32x2 zw[4];
#pragma unroll
                for (int b = 0; b < 4; ++b) zw[b] = zall[ai * 4 + m][b];
                const float kq = -si * LOG2E; float t[16];
#pragma unroll
                for (int q = 0; q < 16; ++q) t[q] = acc[ai][q >> 3][m][(q >> 2) & 1][q & 3] * kq;
#pragma unroll
                for (int q = 0; q < 16; ++q) t[q] = __builtin_amdgcn_exp2f(t[q]);
#pragma unroll
                for (int q = 0; q < 16; ++q) t[q] += 1.f;
#pragma unroll
                for (int q = 0; q < 16; ++q) t[q] = __builtin_amdgcn_rcpf(t[q]);
                f32x4 s = (f32x4){0.f, 0.f, 0.f, 0.f};
#pragma unroll
                for (int b = 0; b < 4; ++b) { s[0] += t[4 * b] * bflo(zw[b].x); s[1] += t[4 * b + 1] * bfhi(zw[b].x); s[2] += t[4 * b + 2] * bflo(zw[b].y); s[3] += t[4 * b + 3] * bfhi(zw[b].y); }
                u32x2 w; w.x = cvt_pk_bf16(s[0], s[1]); w.y = cvt_pk_bf16(s[2], s[3]);
                *(u32x2*)(mix + (size_t)r * DM + J0) = w; }
    }
};
}

#define XB_TMO      128
#define XB_XCNT(j)  (256  + 64 * (j))
#define XB_XSUB(j)  (1280 + 64 * (j))
#define XB_XGEN(j)  (2304 + 64 * (j))
#define XB_TOP      3328
#define XB_TOPGEN   3392
#define XCD_BAR_WORDS 3456
#define XB_SPIN_CAP (1u << 24)
DI unsigned xb_ld(unsigned* p)              { return __hip_atomic_load(p, __ATOMIC_RELAXED, __HIP_MEMORY_SCOPE_AGENT); }
DI unsigned xb_add(unsigned* p, unsigned v) { return __hip_atomic_fetch_add(p, v, __ATOMIC_RELAXED, __HIP_MEMORY_SCOPE_AGENT); }
DI unsigned xb_xcc_id() { return (unsigned)__builtin_amdgcn_s_getreg((3 << 11) | 20) & 0xFu; }
#define XB_SPIN(cond, bar) do { unsigned _sp = 0; while (cond) { __builtin_amdgcn_s_sleep(1); \
    if ((++_sp & 255u) == 0u) { if (xb_ld(&(bar)[XB_TMO])) break; if (_sp > XB_SPIN_CAP) { atomicAdd(&(bar)[XB_TMO], 1u); break; } } } } while (0)
struct XcdBarrier { unsigned* bar; unsigned x; volatile LAS unsigned* st; };
DI XcdBarrier xcd_barrier_post(unsigned* bar, volatile LAS unsigned* st) {
    XcdBarrier b; b.bar = bar; b.x = xb_xcc_id(); b.st = st;
    if (threadIdx.x == 0) (void)xb_add(&bar[XB_XCNT(b.x)], 1u);
    return b;
}
DI void xcd_barrier_complete(unsigned* bar, unsigned x, unsigned& nloc, unsigned& nx) {
    const unsigned G = gridDim.x * gridDim.y * gridDim.z;
    unsigned sum, cnt, mine, sp = 0u;
    for (;;) {
        sum = 0u; cnt = 0u; mine = 0u;
#pragma unroll
        for (unsigned j = 0; j < 16; ++j) { const unsigned c = xb_ld(&bar[XB_XCNT(j)]); sum += c; cnt += (c > 0u) ? 1u : 0u; mine = (j == x) ? c : mine; }
        if (sum == G) break;
        __builtin_amdgcn_s_sleep(1);
        if ((++sp & 255u) == 0u) { if (xb_ld(&bar[XB_TMO])) break; if (sp > XB_SPIN_CAP) { atomicAdd(&bar[XB_TMO], 1u); break; } }
    }
    nloc = mine > 0u ? mine : 1u; nx = cnt > 0u ? cnt : 1u;
}
DI void xcd_barrier(const XcdBarrier& b) {
    asm volatile("s_waitcnt vmcnt(0)" ::: "memory");
    __syncthreads();
    if (threadIdx.x == 0) {
        unsigned* bar = b.bar;
        __builtin_amdgcn_s_waitcnt(0);
        unsigned nloc = b.st[0], nx = b.st[1];
        if (nloc == 0u) { xcd_barrier_complete(bar, b.x, nloc, nx); b.st[0] = nloc; b.st[1] = nx; }
        const unsigned old = xb_add(&bar[XB_XSUB(b.x)], 1u);
        const unsigned gen = old / nloc;
        if (old + 1u == (gen + 1u) * nloc) {
            __builtin_amdgcn_fence(__ATOMIC_RELEASE, "agent");
            asm volatile("s_waitcnt vmcnt(0)" ::: "memory");
            const unsigned og = xb_add(&bar[XB_TOP], 1u);
            const unsigned tg = og / nx;
            if (og + 1u == (tg + 1u) * nx) xb_add(&bar[XB_TOPGEN], 1u);
            else XB_SPIN(xb_ld(&bar[XB_TOPGEN]) == tg, bar);
            __builtin_amdgcn_fence(__ATOMIC_ACQUIRE, "agent");
            xb_add(&bar[XB_XGEN(b.x)], 1u);
            asm volatile("s_waitcnt vmcnt(0)" ::: "memory");
        } else {
            XB_SPIN(xb_ld(&bar[XB_XGEN(b.x)]) == gen, bar);
            __builtin_amdgcn_fence(__ATOMIC_ACQUIRE, "agent");
            asm volatile("s_waitcnt vmcnt(0)" ::: "memory");
        }
    }
    __syncthreads();
}

struct Args { const float* in[26]; float* out; unsigned char* ws; int ph_lo, ph_hi; };
struct Ctx {
    LAS unsigned char* lds;
    GAS unsigned char* ws;
    int tid, lane, wave, G, bid, gw, NGW;
    const struct Args* A;
    GAS float* out;
};
constexpr int RING_BYTES = 131072, MISC_OFF = RING_BYTES + 320, LDS_BYTES = 147456;

DI void tr_item(const float* __restrict__ W, int ldw, int k0, int src, const float* kscale, bf16_t* WT, int ldt, int orow0, LAS float* scr, int lane) {
    float tv[32];
#pragma unroll
    for (int i = 0; i < 32; ++i) { const int kk = 2 * i + (lane >> 5); tv[i] = (src >= 0) ? W[(size_t)(k0 + kk) * ldw + src] : 0.f; }
#pragma unroll
    for (int i = 0; i < 32; ++i) { const int kk = 2 * i + (lane >> 5); float v = tv[i]; if (kscale) v *= kscale[k0 + kk]; scr[kk * 33 + (lane & 31)] = v; }
    LDS_WAIT();
    const int c = lane & 7;
#pragma unroll
    for (int j = 0; j < 4; ++j) { const int n = (lane >> 3) + 8 * j; const LAS float* s = scr + (8 * c) * 33 + n;
        u32x4 o; o.x = pk2(s[0 * 33], s[1 * 33]); o.y = pk2(s[2 * 33], s[3 * 33]); o.z = pk2(s[4 * 33], s[5 * 33]); o.w = pk2(s[6 * 33], s[7 * 33]);
        *(u32x4*)(WT + (size_t)(orow0 + n) * ldt + k0 + 8 * c) = o; }
    LDS_WAIT();
}
DI void tr_item8(const float* __restrict__ W, int ldw, int k0, int src, float scale, unsigned char* WT, int ldt, int orow0, LAS float* scr, int lane) {
    float tv[32];
#pragma unroll
    for (int i = 0; i < 32; ++i) { const int kk = 2 * i + (lane >> 5); tv[i] = W[(size_t)(k0 + kk) * ldw + src]; }
#pragma unroll
    for (int i = 0; i < 32; ++i) { const int kk = 2 * i + (lane >> 5); scr[kk * 33 + (lane & 31)] = tv[i] * scale; }
    LDS_WAIT();
    const int c = lane & 7;
#pragma unroll
    for (int j = 0; j < 4; ++j) { const int n = (lane >> 3) + 8 * j; const LAS float* s = scr + (8 * c) * 33 + n;
        u32x2 o; o.x = pg8::pk4_fp8(s[0 * 33], s[1 * 33], s[2 * 33], s[3 * 33]); o.y = pg8::pk4_fp8(s[4 * 33], s[5 * 33], s[6 * 33], s[7 * 33]);
        *(u32x2*)(WT + (size_t)(orow0 + n) * ldt + k0 + 8 * c) = o; }
    LDS_WAIT();
}
constexpr int SW_ITEMS[8] = {16 * 24, 16 * 40, 16 * 32, 16 * 128, 4 * 4 * 32, 16 * 32, 3 * 6, 2 * 12};
constexpr int SW_TOTAL = 16 * 24 + 16 * 40 + 16 * 32 + 16 * 128 + 4 * 4 * 32 + 16 * 32 + 3 * 6 + 2 * 12;
DI void small_weight_item(const Ctx& C, int l, int it, LAS float* scr) {
    unsigned char* wl = (unsigned char*)(C.ws + WS_WSMALL + (size_t)l * WSMALL_LAYER); unsigned char* wc = (unsigned char*)(C.ws + WS_WC + (size_t)l * WC_LAYER);
    const float* win = C.A->in[2] + (size_t)l * DM * IN_W; const int ln = C.lane & 31;
    if (it < 384) { const int kb = it / 24, nb = it % 24; tr_item(win, IN_W, kb * 64, nb * 32 + ln, nullptr, (bf16_t*)(wl + OFF_WA), 1024, nb * 32, scr, C.lane); return; } it -= 384;
    if (it < 640) { const int kb = it / 40, nb = it % 40; tr_item(win, IN_W, kb * 64, COL_B + nb * 32 + ln, nullptr, (bf16_t*)(wl + OFF_WB), 1024, nb * 32, scr, C.lane); return; } it -= 640;
    if (it < 512) { const int kb = it / 32, nb = it % 32; const int n = nb * 32 + ln; tr_item(win, IN_W, kb * 64, n < 848 ? COL_CD + n : -1, nullptr, (bf16_t*)(wl + OFF_WCD), 1024, nb * 32, scr, C.lane); return; } it -= 512;
    if (it < 2048) { const int kb = it / 128, nb = it % 128; const int n = nb * 32 + ln, pn = n >> 8, c = n & 255;
        const int bj = c >> 7, wcc = (c >> 5) & 3, nn = (c >> 4) & 1, fq = (c >> 2) & 3, j = c & 3;
        const int src = COL_GATE + (2 * bj + nn) * 1024 + 64 * pn + 16 * wcc + 4 * fq + j;
        tr_item8(win, IN_W, kb * 64, src, pg8::FP8_W1_SCALE, wl + OFF_WG, 1024, nb * 32, scr, C.lane); return; } it -= 2048;
    if (it < 512) { const int b = it / 128, r = it % 128, kb = r / 32, nb = r % 32;
        tr_item(C.A->in[18] + (size_t)(l * 4 + b) * 256 * 1024, 1024, kb * 64, nb * 32 + ln, nullptr, (bf16_t*)(wl + OFF_WBR), 256, b * 1024 + nb * 32, scr, C.lane); return; } it -= 512;
    if (it < 512) { const int kb = it / 32, nb = it % 32; tr_item(C.A->in[19] + (size_t)l * DM * DM, 1024, kb * 64, nb * 32 + ln, nullptr, (bf16_t*)(wl + OFF_WOUT), 1024, nb * 32, scr, C.lane); return; } it -= 512;
    if (it < 18) { const int kb = it / 6, nb = it % 6; tr_item(C.A->in[8] + (size_t)l * 192 * 192, 192, kb * 64, nb * 32 + ln, C.A->in[7] + l * 192, (bf16_t*)(wc + OFF_WQ), 192, nb * 32, scr, C.lane); return; } it -= 18;
    { const int kb = it / 12, nb = it % 12; tr_item(C.A->in[10] + (size_t)l * 128 * 384, 384, kb * 64, nb * 32 + ln, C.A->in[9] + l * 128, (bf16_t*)(wc + OFF_WKV), 128, nb * 32, scr, C.lane); }
}
DI void ph_prologue(const Ctx& C) {
    LAS float* scr = (LAS float*)(C.lds + C.wave * 16384);
    for (int it = C.gw; it < 2 * SW_TOTAL; it += C.NGW) small_weight_item(C, it / SW_TOTAL, it % SW_TOTAL, scr);
    for (int it = C.gw; it < 2 * 2 * 4 * 2 * 4 * 2; it += C.NGW) {
        const int ks = it & 1, nt = (it >> 1) & 3, gt = (it >> 3) & 1, n = (it >> 4) & 3, dir = (it >> 6) & 1, l = it >> 7;
        const float* wp = (gt == 0 ? C.A->in[13] : C.A->in[15]) + ((size_t)((l * 2 + dir) * 4 + n) * 64) * 64;
        const int l15 = C.lane & 15, g = C.lane >> 4; u32x4 wv;
#pragma unroll
        for (int p = 0; p < 4; ++p) { const int k = 32 * ks + 8 * g + 2 * p; wv[p] = cvt_pk_bf16(wp[(size_t)k * 64 + 16 * nt + l15], wp[(size_t)(k + 1) * 64 + 16 * nt + l15]); }
        ((u32x4*)(C.ws + WS_WRG))[(size_t)it * 64 + C.lane] = wv;
    }
    bf16_t* XB0 = (bf16_t*)(C.ws + WS_XB0);
    for (int row0 = C.gw; row0 < NTOK; row0 += 4 * C.NGW) {
        f32x4 v[4][4];
#pragma unroll
        for (int i = 0; i < 4; ++i) { const int row = min(row0 + i * C.NGW, NTOK - 1);
            const float* src = row < NTOKG ? C.A->in[0] + (size_t)row * DM : C.A->in[1] + (size_t)(row - NTOKG) * DM; const f32x4* xr = (const f32x4*)src + C.lane;
#pragma unroll
            for (int j = 0; j < 4; ++j) v[i][j] = xr[64 * j]; }
#pragma unroll
        for (int i = 0; i < 4; ++i) { const int row = row0 + i * C.NGW; if (row < NTOK) { u32x2* o = (u32x2*)(XB0 + (size_t)row * DM) + C.lane;
#pragma unroll
            for (int j = 0; j < 4; ++j) { u32x2 w; w.x = cvt_pk_bf16(v[i][j][0], v[i][j][1]); w.y = cvt_pk_bf16(v[i][j][2], v[i][j][3]); o[64 * j] = w; } } }
    }
}
DI void expert_weight_items(const Ctx& C, int l) {
    __syncthreads();
    LAS float* scr = (LAS float*)(C.lds + C.wave * 16384);
    unsigned char* WGU = (unsigned char*)(C.ws + WS_EW + OFF_WGU8); unsigned char* WD = (unsigned char*)(C.ws + WS_EW + OFF_WD8);
    const int ln = C.lane & 31;
    const int gw0 = (C.G > 64) ? C.gw - 32 * 8 : C.gw, ngw = (C.G > 64) ? C.NGW - 32 * 8 : C.NGW;
    for (int it = gw0; it < 32768 + 16384; it += ngw) {
        if (it < 32768) { const int e = it >> 11, r = it & 2047, kb = r >> 7, nb = r & 127; const int n = nb * 32 + ln, pn = n >> 8, c = n & 255;
            const float* W = (c < 128 ? C.A->in[23] : C.A->in[24]) + (size_t)(l * NEXP + e) * DM * DEXP;
            tr_item8(W, DEXP, kb * 64, 128 * pn + (c & 127), pg8::FP8_W1_SCALE, WGU + (size_t)e * 4096 * 1024, 1024, nb * 32, scr, C.lane);
        } else { const int i2 = it - 32768, e = i2 >> 10, r = i2 & 1023, kb = r >> 5, nb = r & 31;
            tr_item8(C.A->in[25] + (size_t)(l * NEXP + e) * DEXP * DM, DM, kb * 64, nb * 32 + ln, pg8::FP8_W2_SCALE, WD + (size_t)e * 1024 * 2048, 2048, nb * 32, scr, C.lane); }
    }
}

template <bool ROUTER>
DI void ph_ln(const Ctx& C, int l, int which, bf16_t* XB) {
    LAS float* wr = (LAS float*)C.lds;
    if (ROUTER) { const float* src = C.A->in[22] + (size_t)l * DM * NEXP;
        for (int t = C.tid; t < DM * NEXP / 4; t += 512) { const int k = t >> 2, q = t & 3, ln = (k & 255) >> 2, ii = k & 3, jj = k >> 8;
            ((LAS f32x4*)wr)[((jj * 4 + ii) * 4 + q) * 64 + ln] = ((const f32x4*)src)[t]; }
        __syncthreads(); }
    const float* gp = C.A->in[20] + (size_t)(l * 2 + which) * DM; const float* bp = C.A->in[21] + (size_t)(l * 2 + which) * DM;
    f32x4 gv[4], bv[4];
#pragma unroll
    for (int j = 0; j < 4; ++j) { gv[j] = ((const f32x4*)gp)[C.lane + 64 * j]; bv[j] = ((const f32x4*)bp)[C.lane + 64 * j]; }
    float* affT = (float*)(C.ws + WS_AFF);
    f32x4 nx[4], ny[4], nz[4], nw[4];
    { const f32x4* xr0 = (const f32x4*)(C.out + (size_t)C.gw * DM) + C.lane;
#pragma unroll
      for (int j = 0; j < 4; ++j) nx[j] = __builtin_nontemporal_load(&xr0[64 * j]);
      { const f32x4* xr1 = (const f32x4*)(C.out + (size_t)min(C.gw + C.NGW, NTOK - 1) * DM) + C.lane;
#pragma unroll
          for (int j = 0; j < 4; ++j) ny[j] = __builtin_nontemporal_load(&xr1[64 * j]); }
      { const f32x4* xr2 = (const f32x4*)(C.out + (size_t)min(C.gw + 2 * C.NGW, NTOK - 1) * DM) + C.lane;
#pragma unroll
          for (int j = 0; j < 4; ++j) nz[j] = __builtin_nontemporal_load(&xr2[64 * j]); }
      { const f32x4* xr3 = (const f32x4*)(C.out + (size_t)min(C.gw + 3 * C.NGW, NTOK - 1) * DM) + C.lane;
#pragma unroll
          for (int j = 0; j < 4; ++j) nw[j] = __builtin_nontemporal_load(&xr3[64 * j]); } }
    u32x4 sm0 = {0u, 0u, 0u, 0u}, sm1 = {0u, 0u, 0u, 0u};
    if (!ROUTER) { const u32x4* smr = (const u32x4*)(C.ws + WS_SM + (size_t)C.gw * 32); sm0 = smr[0]; sm1 = smr[1]; }
    for (int row = C.gw; row < NTOK; row += C.NGW) {
        f32x4* xr = (f32x4*)(C.out + (size_t)row * DM) + C.lane;
        f32x4 v[4]; float s = 0.f;
#pragma unroll
        for (int j = 0; j < 4; ++j) v[j] = nx[j] * ALPHA;
        if (!ROUTER) {
            const unsigned sw[8] = {sm0.x, sm0.y, sm0.z, sm0.w, sm1.x, sm1.y, sm1.z, sm1.w};
            { const u32x4* smr = (const u32x4*)(C.ws + WS_SM + (size_t)min(row + C.NGW, NTOK - 1) * 32); sm0 = smr[0]; sm1 = smr[1]; }
            const bf16_t* YE = (const bf16_t*)(C.ws + WS_Y); const int gofs = (row >> 16) * CAP;
            unsigned msk = 0u;
#pragma unroll
            for (int e = 0; e < 16; ++e) { const int slot = (int)(short)((e & 1) ? (sw[e >> 1] >> 16) : (sw[e >> 1] & 0xffffu)); if (slot >= 0) msk |= 1u << e; }
            msk = (unsigned)__builtin_amdgcn_readfirstlane((int)msk);
            while (msk) {
                const int e1 = __builtin_ctz(msk); msk &= msk - 1u; const bool two = msk != 0u; const int e2 = two ? __builtin_ctz(msk) : e1; if (two) msk &= msk - 1u;
                unsigned w1 = sw[0], w2 = sw[0];
#pragma unroll
                for (int q = 1; q < 8; ++q) { w1 = ((e1 >> 1) == q) ? sw[q] : w1; w2 = ((e2 >> 1) == q) ? sw[q] : w2; }
                const int s1 = (int)((e1 & 1) ? (w1 >> 16) : (w1 & 0xffffu)), s2 = (int)((e2 & 1) ? (w2 >> 16) : (w2 & 0xffffu));
                const u32x2* y1 = (const u32x2*)(YE + ((size_t)e1 * 16384 + gofs + s1) * DM) + C.lane; const u32x2* y2 = (const u32x2*)(YE + ((size_t)e2 * 16384 + gofs + s2) * DM) + C.lane;
                u32x2 a[4], b[4];
#pragma unroll
                for (int j = 0; j < 4; ++j) { a[j] = y1[64 * j]; b[j] = y2[64 * j]; }
                const float f2 = two ? 1.f : 0.f;
#pragma unroll
                for (int j = 0; j < 4; ++j) { v[j][0] += bflo(a[j].x) + f2 * bflo(b[j].x); v[j][1] += bfhi(a[j].x) + f2 * bfhi(b[j].x); v[j][2] += bflo(a[j].y) + f2 * bflo(b[j].y); v[j][3] += bfhi(a[j].y) + f2 * bfhi(b[j].y); }
            }
        }
#pragma unroll
        for (int j = 0; j < 4; ++j) s += (v[j][0] + v[j][1]) + (v[j][2] + v[j][3]);
#pragma unroll
        for (int j = 0; j < 4; ++j) { nx[j] = ny[j]; ny[j] = nz[j]; nz[j] = nw[j]; }
        { const int rn = row + 4 * C.NGW < NTOK ? row + 4 * C.NGW : row; const f32x4* xn = (const f32x4*)(C.out + (size_t)rn * DM) + C.lane;
#pragma unroll
            for (int j = 0; j < 4; ++j) nw[j] = __builtin_nontemporal_load(&xn[64 * j]); }
        const float mean = wave_sum(s) * (1.f / DM); float s2 = 0.f;
#pragma unroll
        for (int j = 0; j < 4; ++j) { v[j] = v[j] - mean; s2 += (v[j][0] * v[j][0] + v[j][1] * v[j][1]) + (v[j][2] * v[j][2] + v[j][3] * v[j][3]); }
        const float rstd = 1.0f / sqrtf(wave_sum(s2) * (1.f / DM) + LN_EPS);
        u32x2* o8 = (u32x2*)(XB + (size_t)row * DM) + C.lane; unsigned* o4 = (unsigned*)((unsigned char*)XB + (size_t)row * DM) + C.lane;
#pragma unroll
        for (int j = 0; j < 4; ++j) { v[j] = v[j] * rstd * gv[j] + bv[j]; __builtin_nontemporal_store(v[j], &xr[64 * j]);
            if constexpr (ROUTER) { o4[64 * j] = pg8::pk4_fp8(v[j][0], v[j][1], v[j][2], v[j][3]); asm volatile("" ::: "memory"); }
            else if (XB) { u32x2 w; w.x = cvt_pk_bf16(v[j][0], v[j][1]); w.y = cvt_pk_bf16(v[j][2], v[j][3]); o8[64 * j] = w; } }
        if (ROUTER) {
            float p[16];
#pragma unroll
            for (int e = 0; e < 16; ++e) p[e] = 0.f;
#pragma unroll
            for (int j = 0; j < 4; ++j)
#pragma unroll
                for (int i = 0; i < 4; ++i) { const float xv = v[j][i];
#pragma unroll
                    for (int q = 0; q < 4; ++q) { const f32x4 w4 = ((const LAS f32x4*)wr)[((j * 4 + i) * 4 + q) * 64 + C.lane]; p[4 * q] += xv * w4[0]; p[4 * q + 1] += xv * w4[1]; p[4 * q + 2] += xv * w4[2]; p[4 * q + 3] += xv * w4[3]; } }
            const bool b5 = (C.lane & 32) != 0, b4 = (C.lane & 16) != 0, b3 = (C.lane & 8) != 0, b2 = (C.lane & 4) != 0;
            float r8[8], r4[4], r2[2], lg;
#pragma unroll
            for (int i = 0; i < 8; ++i) { const float keep = b5 ? p[8 + i] : p[i], send = b5 ? p[i] : p[8 + i]; r8[i] = keep + __shfl_xor(send, 32); }
#pragma unroll
            for (int i = 0; i < 4; ++i) { const float keep = b4 ? r8[4 + i] : r8[i], send = b4 ? r8[i] : r8[4 + i]; r4[i] = keep + __shfl_xor(send, 16); }
#pragma unroll
            for (int i = 0; i < 2; ++i) { const float keep = b3 ? r4[2 + i] : r4[i], send = b3 ? r4[i] : r4[2 + i]; r2[i] = keep + __shfl_xor(send, 8); }
            { const float keep = b2 ? r2[1] : r2[0], send = b2 ? r2[0] : r2[1]; lg = keep + __shfl_xor(send, 4); }
            lg += __shfl_xor(lg, 2); lg += __shfl_xor(lg, 1);
            float mx = lg;
            mx = fmaxf(mx, __shfl_xor(mx, 4)); mx = fmaxf(mx, __shfl_xor(mx, 8)); mx = fmaxf(mx, __shfl_xor(mx, 16)); mx = fmaxf(mx, __shfl_xor(mx, 32));
            const float ex = __expf(lg - mx); float den = ex;
            den += __shfl_xor(den, 4); den += __shfl_xor(den, 8); den += __shfl_xor(den, 16); den += __shfl_xor(den, 32);
            const int eL = (b5 ? 8 : 0) + (b4 ? 4 : 0) + (b3 ? 2 : 0) + (b2 ? 1 : 0);
            if ((C.lane & 3) == 0) affT[((size_t)(row >> 16) * 16 + eL) * NTOKG + (row & 65535)] = ex / den;
            if (C.lane < 8) ((unsigned*)(C.ws + WS_SM))[(size_t)row * 8 + C.lane] = 0xFFFFFFFFu;
        }
    }
}

namespace att {
DI int crow(int r, int hi) { return (r & 3) + 8 * (r >> 2) + 4 * hi; }
DI int v_st(int k, int c) { const int kk = (k & ~0xC) | ((k & 4) << 1) | ((k & 8) >> 1); return ((kk >> 3) * 2 + (c >> 5)) * 512 + ((kk & 7) * 32 + (c & 31)) * 2; }
DI int v_rd_base(int lane) { return ((lane & 3) << 3) | (((lane >> 2) & 3) << 6) | (((lane >> 4) & 1) << 5) | (((lane >> 5) & 1) << 8); }
constexpr int v_rd_off(int d0, int ks, int half) { return d0 * 512 + ks * 2048 + half * 1024; }
template <int OFF> DI s16x4 tr_read(int vb) { s16x4 r; asm volatile("ds_read_b64_tr_b16 %0, %1 offset:%2" : "=&v"(r) : "v"(vb), "i"(OFF) : "memory"); return r; }
template <int D0> DI void pv_one(f32x16& od, int vb, bf16x8 pa0, bf16x8 pa1, bf16x8 pa2, bf16x8 pa3) {
    const s16x4 l0 = tr_read<v_rd_off(D0, 0, 0)>(vb), h0 = tr_read<v_rd_off(D0, 0, 1)>(vb), l1 = tr_read<v_rd_off(D0, 1, 0)>(vb), h1 = tr_read<v_rd_off(D0, 1, 1)>(vb);
    const s16x4 l2 = tr_read<v_rd_off(D0, 2, 0)>(vb), h2 = tr_read<v_rd_off(D0, 2, 1)>(vb), l3 = tr_read<v_rd_off(D0, 3, 0)>(vb), h3 = tr_read<v_rd_off(D0, 3, 1)>(vb);
    asm volatile("s_waitcnt lgkmcnt(0)" ::: "memory"); __builtin_amdgcn_sched_barrier(0);
#define PKV(L, H) (bf16x8){L[0], L[1], L[2], L[3], H[0], H[1], H[2], H[3]}
    od = __builtin_amdgcn_mfma_f32_32x32x16_bf16(pa0, PKV(l0, h0), od, 0, 0, 0);
    od = __builtin_amdgcn_mfma_f32_32x32x16_bf16(pa1, PKV(l1, h1), od, 0, 0, 0);
    od = __builtin_amdgcn_mfma_f32_32x32x16_bf16(pa2, PKV(l2, h2), od, 0, 0, 0);
    od = __builtin_amdgcn_mfma_f32_32x32x16_bf16(pa3, PKV(l3, h3), od, 0, 0, 0);
#undef PKV
}
DI void pv_ones(f32x16& o2, bf16x8 pa0, bf16x8 pa1, bf16x8 pa2, bf16x8 pa3) {
    const u32x4 onesw = {0x3F803F80u, 0x3F803F80u, 0x3F803F80u, 0x3F803F80u}; const bf16x8 ones = __builtin_bit_cast(bf16x8, onesw);
    o2 = __builtin_amdgcn_mfma_f32_32x32x16_bf16(pa0, ones, o2, 0, 0, 0); o2 = __builtin_amdgcn_mfma_f32_32x32x16_bf16(pa1, ones, o2, 0, 0, 0);
    o2 = __builtin_amdgcn_mfma_f32_32x32x16_bf16(pa2, ones, o2, 0, 0, 0); o2 = __builtin_amdgcn_mfma_f32_32x32x16_bf16(pa3, ones, o2, 0, 0, 0);
}
constexpr int KROW(int KS) { return KS * 32 + 16; }
constexpr int KTILE = 64 * 112, VTILE = 8192, LDS_ATT = 2 * KTILE + 2 * VTILE + 8 * 256;

DI void split3(float x, unsigned& w_hm, unsigned& w_l0) {
    const unsigned h = f2bf(x); const float r1 = x - __builtin_bit_cast(float, h << 16);
    const unsigned m = f2bf(r1); const float r2 = r1 - __builtin_bit_cast(float, m << 16);
    const unsigned l = f2bf(r2);
    w_hm = h | (m << 16); w_l0 = l;
}
template <int KS, bool ALIBI>
DI void attn_unit(const bf16_t* __restrict__ Qb, int ldq, const bf16_t* __restrict__ Kb, int ldk, const bf16_t* __restrict__ Vb, int ldv,
                  bf16_t* __restrict__ Ob, int ldo, int seq_len, int q0, float slope2, const unsigned* __restrict__ kn2, LAS unsigned char* lds) {
    int tid = threadIdx.x; asm volatile("" : "+v"(tid));
    const int wid = tid >> 6, lane = tid & 63, r32 = lane & 31, hi = lane >> 5;
    LAS unsigned char* K_lds = lds; LAS unsigned char* V_lds = lds + 2 * KTILE;
    LAS float* wsl = (LAS float*)(lds + 2 * KTILE + 2 * VTILE) + wid * 64; LAS float* li_l = wsl; LAS float* al_l = wsl + 32;
    LAS float* blk = (LAS float*)(lds + LDS_ATT);
    LAS int* tl = (LAS int*)(lds + LDS_ATT + 128);
    constexpr int KR = KROW(KS), KP = 2 * KS;
    constexpr float THR = 8.f, SKIP = -40.f;
    float mt = 0.f; f32x16 o[3];
#pragma unroll
    for (int d = 0; d < 3; ++d)
#pragma unroll
        for (int r = 0; r < 16; ++r) o[d][r] = 0.f;
    bf16x8 qr[KS];
    const bf16_t* Qw = Qb + (size_t)(wid * 32 + r32) * ldq + hi * 8;
#pragma unroll
    for (int d0 = 0; d0 < KS; ++d0) qr[d0] = *(const bf16x8*)(Qw + d0 * 16);
    if (ALIBI) { float qn = 0.f;
#pragma unroll
        for (int d0 = 0; d0 < KS; ++d0)
#pragma unroll
            for (int j = 0; j < 8; ++j) { const float f = bf2f((unsigned short)qr[d0][j]); qn += f * f; }
        qn += __shfl_xor(qn, 32); qn = wave_max(qn); if (lane == 0) blk[wid] = qn; }
    const int vkey = tid >> 3, vcol = (tid & 7) * 8, vst = v_st(vkey, vcol);
    const bool kact = tid < 64 * KP; const int kkey = kact ? tid / KP : 0, kpc = kact ? tid % KP : 0;
    const int vb0 = (int)(uintptr_t)V_lds + v_rd_base(lane);
    const int w0 = q0 + wid * 32; const float qpos = (float)(w0 + r32);
    const int NT = seq_len / 64, jd0 = q0 >> 6;
    bf16x8 kx0, kx1;
    { u32x4 a = {0u, 0u, 0u, 0u}, b = {0u, 0u, 0u, 0u};
        if (hi == 0) {
            a.z = 0x3F803F80u; a.w = 0x00003F80u; b.z = 0x3F803F80u; b.w = 0x00003F80u;
            if (ALIBI) { const float c0 = slope2 * (float)r32, c1 = slope2 * (float)(32 + r32);
                const unsigned h0 = f2bf(c0), l0 = f2bf(c0 - __builtin_bit_cast(float, h0 << 16)), h1 = f2bf(c1), l1 = f2bf(c1 - __builtin_bit_cast(float, h1 << 16));
                a.x = h0 | (l0 << 16); a.y = (h0 | (l0 << 16)) ^ 0x80008000u; b.x = h1 | (l1 << 16); b.y = (h1 | (l1 << 16)) ^ 0x80008000u; } }
        kx0 = __builtin_bit_cast(bf16x8, a); kx1 = __builtin_bit_cast(bf16x8, b); }
    bf16x8 vs, ks_;
    bool first = true;
#define SLOAD(k0) do { vs = *(const bf16x8*)(Vb + (size_t)((k0) + vkey) * ldv + vcol); ks_ = *(const bf16x8*)(Kb + (size_t)((k0) + kkey) * ldk + kpc * 8); } while (0)
#define SWRITE(b) do { *(LAS bf16x8*)(V_lds + (b) * VTILE + vst) = vs; if (kact) *(LAS bf16x8*)(K_lds + (b) * KTILE + kkey * KR + kpc * 16) = ks_; } while (0)
#define PK4(P, BASE, OUT) do { unsigned a0 = cvt_pk_bf16_b(P[BASE + 0], P[BASE + 1]), a1 = cvt_pk_bf16_b(P[BASE + 2], P[BASE + 3]); \
        unsigned b0_ = cvt_pk_bf16_b(P[BASE + 4], P[BASE + 5]), b1_ = cvt_pk_bf16_b(P[BASE + 6], P[BASE + 7]); \
        auto r0 = __builtin_amdgcn_permlane32_swap(a0, b0_, false, false); auto r1 = __builtin_amdgcn_permlane32_swap(a1, b1_, false, false); \
        u32x4 w = {r0[0], r1[0], r0[1], r1[1]}; OUT = __builtin_bit_cast(bf16x8, w); } while (0)
#define PKV2(L, H) (bf16x8){L[0], L[1], L[2], L[3], H[0], H[1], H[2], H[3]}
#define ATT_GRP(P, BASE, VA, VC, VD, VE) do { \
        _Pragma("unroll") for (int r_ = 0; r_ < 8; ++r_) P[BASE + r_] = __builtin_amdgcn_exp2f(P[BASE + r_]); \
        bf16x8 pa_; PK4(P, BASE, pa_); \
        o[0] = __builtin_amdgcn_mfma_f32_32x32x16_bf16(pa_, PKV2(VA, VC), o[0], 0, 0, 0); o[1] = __builtin_amdgcn_mfma_f32_32x32x16_bf16(pa_, PKV2(VD, VE), o[1], 0, 0, 0); \
        o[2] = __builtin_amdgcn_mfma_f32_32x32x16_bf16(pa_, ones, o[2], 0, 0, 0); __builtin_amdgcn_sched_barrier(0); } while (0)
#define ATT_TILE(j, cur) do { \
        f32x16 p0, p1; \
        _Pragma("unroll") for (int r = 0; r < 16; ++r) { p0[r] = 0.f; p1[r] = 0.f; } \
        const LAS unsigned char* Kc = K_lds + (cur) * KTILE; \
        _Pragma("unroll") for (int d0 = 0; d0 < KS; ++d0) { const int cb = (d0 * 16 + hi * 8) * 2;     \
            const bf16x8 b0 = *(const LAS bf16x8*)(Kc + r32 * KR + cb); const bf16x8 b1 = *(const LAS bf16x8*)(Kc + (32 + r32) * KR + cb); \
            p0 = __builtin_amdgcn_mfma_f32_32x32x16_bf16(b0, qr[d0], p0, 0, 0, 0); p1 = __builtin_amdgcn_mfma_f32_32x32x16_bf16(b1, qr[d0], p1, 0, 0, 0); } \
        int cls = 0; float Bq = 0.f; \
        if (ALIBI) { if (64 * (j) + 64 <= w0) { cls = 1; Bq = slope2 * ((float)(64 * (j)) - qpos); } else if (64 * (j) >= w0 + 32) { cls = 2; Bq = slope2 * (qpos - (float)(64 * (j))); } } \
        bf16x8 qx; { u32x4 w = {0u, 0u, 0u, 0u}; if (hi == 0) { unsigned whm, wl0; split3(Bq - mt, whm, wl0); w.z = whm; w.w = wl0; w.x = (cls == 1) ? 0x3F803F80u : 0u; w.y = (cls == 2) ? 0x3F803F80u : 0u; } qx = __builtin_bit_cast(bf16x8, w); } \
        p0 = __builtin_amdgcn_mfma_f32_32x32x16_bf16(kx0, qx, p0, 0, 0, 0); p1 = __builtin_amdgcn_mfma_f32_32x32x16_bf16(kx1, qx, p1, 0, 0, 0); \
        if (ALIBI && cls == 0) { const float dq = qpos - (float)((j) * 64 + 4 * hi); \
            _Pragma("unroll") for (int r = 0; r < 16; ++r) { const float kc = (float)((r & 3) + 8 * (r >> 2)); p0[r] = fmaf(fabsf(dq - kc), -slope2, p0[r]); p1[r] = fmaf(fabsf(dq - (kc + 32.f)), -slope2, p1[r]); } } \
        float tmax = p0[0]; \
        _Pragma("unroll") for (int r = 1; r < 16; ++r) tmax = fmaxf(tmax, p0[r]); \
        _Pragma("unroll") for (int r = 0; r < 16; ++r) tmax = fmaxf(tmax, p1[r]); \
        { auto rr = __builtin_amdgcn_permlane32_swap(__float_as_uint(tmax), __float_as_uint(tmax), false, false); tmax = fmaxf(__uint_as_float(rr[0]), __uint_as_float(rr[1])); } \
        const bool skip = !first && __all(tmax < SKIP); \
        if (!skip) { \
            if (first || !__all(tmax <= THR)) { \
                const float delta = first ? tmax : fmaxf(tmax, 0.f); const float alpha = first ? 1.f : __builtin_amdgcn_exp2f(-delta); \
                mt += delta; \
                _Pragma("unroll") for (int r = 0; r < 16; ++r) { p0[r] -= delta; p1[r] -= delta; } \
                if (!first) { if (hi == 0) al_l[r32] = alpha; LDS_WAIT(); \
                    _Pragma("unroll") for (int r = 0; r < 16; ++r) { const float a = al_l[crow(r, hi)]; o[0][r] *= a; o[1][r] *= a; o[2][r] *= a; } } \
            } \
              \
            const int vb = vb0 + (cur) * VTILE; \
            const s16x4 va0 = tr_read<v_rd_off(0, 0, 0)>(vb), vc0 = tr_read<v_rd_off(0, 0, 1)>(vb), vd0 = tr_read<v_rd_off(1, 0, 0)>(vb), ve0 = tr_read<v_rd_off(1, 0, 1)>(vb); \
            const s16x4 va1 = tr_read<v_rd_off(0, 1, 0)>(vb), vc1 = tr_read<v_rd_off(0, 1, 1)>(vb), vd1 = tr_read<v_rd_off(1, 1, 0)>(vb), ve1 = tr_read<v_rd_off(1, 1, 1)>(vb); \
            const s16x4 va2 = tr_read<v_rd_off(0, 2, 0)>(vb), vc2 = tr_read<v_rd_off(0, 2, 1)>(vb), vd2 = tr_read<v_rd_off(1, 2, 0)>(vb), ve2 = tr_read<v_rd_off(1, 2, 1)>(vb); \
            const s16x4 va3 = tr_read<v_rd_off(0, 3, 0)>(vb), vc3 = tr_read<v_rd_off(0, 3, 1)>(vb), vd3 = tr_read<v_rd_off(1, 3, 0)>(vb), ve3 = tr_read<v_rd_off(1, 3, 1)>(vb); \
            const u32x4 onesw = {0x3F803F80u, 0x3F803F80u, 0x3F803F80u, 0x3F803F80u}; const bf16x8 ones = __builtin_bit_cast(bf16x8, onesw); \
            asm volatile("s_waitcnt lgkmcnt(0)" ::: "memory"); __builtin_amdgcn_sched_barrier(0); \
            ATT_GRP(p0, 0, va0, vc0, vd0, ve0); ATT_GRP(p0, 8, va1, vc1, vd1, ve1); ATT_GRP(p1, 0, va2, vc2, vd2, ve2); ATT_GRP(p1, 8, va3, vc3, vd3, ve3); \
            first = false; \
        } } while (0)
#define ATT_RUN(COUNT, TILE_EXPR) do { const int cnt_ = (COUNT); if (cnt_ > 0) { \
        { const int jj = 0; SLOAD((TILE_EXPR) * 64); } SWRITE(0); __syncthreads(); \
        if (cnt_ > 1) { const int jj = 1; SLOAD((TILE_EXPR) * 64); } \
        for (int jj0 = 0; jj0 < cnt_; ++jj0) { const int cur_ = jj0 & 1; int j_; { const int jj = jj0; j_ = (TILE_EXPR); } \
            ATT_TILE(j_, cur_); \
            if (jj0 + 1 < cnt_) SWRITE(cur_ ^ 1); \
            __syncthreads(); \
            if (jj0 + 2 < cnt_) { const int jj = jj0 + 2; SLOAD((TILE_EXPR) * 64); } } } } while (0)
    if (wid >= 4) __builtin_amdgcn_s_setprio(1);
    ATT_RUN(4, jd0 + jj);
    if (ALIBI) {
        { const float mm = -wave_max(-mt); if (lane == 0) blk[8 + wid] = mm; }
        __syncthreads();
        if (wid == 0) {
            float qn2 = blk[0], mmin = blk[8];
#pragma unroll
            for (int i = 1; i < 8; ++i) { qn2 = fmaxf(qn2, blk[i]); mmin = fminf(mmin, blk[8 + i]); }
            int base = 0;
            for (int c0 = 0; c0 < NT - 4; c0 += 64) { const int c = c0 + lane; bool act = false; int t = 0;
                if (c < NT - 4) { t = (c < jd0) ? jd0 - 1 - c : c + 4;
                    const float dist = (t < jd0) ? (float)(q0 - (64 * t + 63)) : (float)(64 * t - (q0 + 255));
                    const float kn = __builtin_bit_cast(float, kn2[t]);
                    act = (sqrtf(qn2 * kn) * 1.02f - slope2 * dist - mmin >= SKIP); }
                const unsigned long long bm = __ballot(act);
                if (act) tl[base + __builtin_popcountll(bm & ((1ull << lane) - 1ull))] = t;
                base += __builtin_popcountll(bm); }
            if (lane == 0) blk[16] = __builtin_bit_cast(float, base);
        }
        __syncthreads();
        const int nact = __builtin_bit_cast(int, blk[16]);
        ATT_RUN(nact, tl[jj]);
    } else {
        ATT_RUN(NT - 4, (jj < jd0 ? jd0 - 1 - jj : jj + 4));
    }
#undef ATT_RUN
#undef ATT_TILE
#undef ATT_GRP
#undef PKV2
#undef PK4
#undef SLOAD
#undef SWRITE
    __builtin_amdgcn_s_setprio(0);
    bf16_t* Ow = Ob + (size_t)(wid * 32) * ldo;
#pragma unroll
    for (int r = 0; r < 16; ++r) { const int orow = crow(r, hi); const float rl = __builtin_amdgcn_rcpf(o[2][r]);
#pragma unroll
        for (int d0 = 0; d0 < 2; ++d0) Ow[(size_t)orow * ldo + d0 * 32 + r32] = (bf16_t)f2bf(o[d0][r] * rl); }
    __syncthreads();
}
}

DI void ph_attn_a(const Ctx& C, int l) {
    const bf16_t* UA = (const bf16_t*)(C.ws + WS_U); bf16_t* OA = (bf16_t*)(C.ws + WS_XB1);
    GAS unsigned* head = (GAS unsigned*)(C.ws + WS_CTL) + 16384 + 64 * l;
    LAS volatile int* qslot = (LAS volatile int*)(C.lds + MISC_OFF + 64);
    if (C.tid == 0) qslot[0] = (int)__hip_atomic_fetch_add(head, 1u, __ATOMIC_RELAXED, __HIP_MEMORY_SCOPE_AGENT);
    __syncthreads();
    int u = qslot[0];
    while (u < 4096) {
        int nxt = 0;
        if (C.tid == 0) nxt = (int)__hip_atomic_fetch_add(head, 1u, __ATOMIC_RELAXED, __HIP_MEMORY_SCOPE_AGENT);
        const int k = u >> 9, j = u & 511, vhb = j >> 8;
        const bool prompt = (k == 0) || (k == 1) || (k == 4) || (k == 6);
        const int h = (k == 0 || k == 2) ? 3 : (k == 1 || k == 3) ? 2 : (k == 4 || k == 5) ? 1 : 0;
        const int vh = 2 * h + vhb;
        const int seq = prompt ? ((j >> 5) & 7) : 8 + ((j >> 3) & 31), qb = prompt ? (j & 31) : (j & 7), len = prompt ? 8192 : 2048;
        const int r0 = seq_start_row(seq);
        const float slope2 = exp2f(-2.0f * (float)(h + 1)) * LOG2E;
        att::attn_unit<2, true>(UA + (size_t)(r0 + qb * 256) * 768 + vh * 32, 768, UA + (size_t)r0 * 768 + 256 + vh * 32, 768, UA + (size_t)r0 * 768 + 512 + h * 64, 768,
                                OA + (size_t)(r0 + qb * 256) * 512 + vh * 64, 512, len, qb * 256, slope2, (const unsigned*)(C.ws + WS_KN2) + ((size_t)l * 8 + vh) * 2048 + (r0 >> 6), C.lds);
        if (C.tid == 0) qslot[0] = nxt;
        __syncthreads();
        u = qslot[0];
    }
}
DI void ph_attn_c(const Ctx& C) {
    const bf16_t* Qc = (const bf16_t*)(C.ws + WS_XB1 + OFF_QC); const bf16_t* Kc = (const bf16_t*)(C.ws + WS_XB1 + OFF_KC); const bf16_t* Vc = (const bf16_t*)(C.ws + WS_XB1 + OFF_VC);
    bf16_t* Y = (bf16_t*)(C.ws + WS_Y);
    for (int u = C.bid; u < 2048; u += C.G) {
        int qb, h, seq, len;
        if (u < 1024) { qb = u & 31; h = (u >> 5) & 3; seq = u >> 7; len = 8192; } else { const int v = u - 1024; qb = v & 7; h = (v >> 3) & 3; seq = 8 + (v >> 5); len = 2048; }
        const int r0 = seq_start_row(seq);
        att::attn_unit<3, false>(Qc + (size_t)(r0 + qb * 256) * 192 + h * 48, 192, Kc + (size_t)r0 * 192 + h * 48, 192, Vc + (size_t)r0 * 256 + h * 64, 256,
                                 Y + (size_t)(r0 + qb * 256) * DM + 512 + h * 64, DM, len, qb * 256, 0.f, nullptr, C.lds);
    }
}
DI void ph_a_post(const Ctx& C, int l) {
    const bf16_t* OA = (const bf16_t*)(C.ws + WS_XB1); bf16_t* Y = (bf16_t*)(C.ws + WS_Y);
    const float linit = 0.8f - 0.6f * expf(-0.3f * (float)l);
    const float* lp = C.A->in[3] + l * 128;
    float sa = 0.f, sb = 0.f; if (C.lane < 32) { sa = lp[C.lane] * lp[32 + C.lane]; sb = lp[64 + C.lane] * lp[96 + C.lane]; }
    const float lam = expf(wave_sum(sa)) - expf(wave_sum(sb)) + linit;
    const int h = C.lane >> 4, d4 = (C.lane & 15) * 4;
    const f32x4 gg = *(const f32x4*)(C.A->in[4] + l * 64 + d4);
    for (int row0 = C.gw; row0 < NTOK; row0 += 4 * C.NGW) {
        u32x2 a[4], b[4];
#pragma unroll
        for (int i = 0; i < 4; ++i) { const size_t row = (size_t)row0 + (size_t)i * C.NGW; a[i] = *(const u32x2*)(OA + row * 512 + (2 * h) * 64 + d4); b[i] = *(const u32x2*)(OA + row * 512 + (2 * h + 1) * 64 + d4); }
#pragma unroll
        for (int i = 0; i < 4; ++i) { const size_t row = (size_t)row0 + (size_t)i * C.NGW;
            float o0 = bflo(a[i].x) - lam * bflo(b[i].x), o1 = bfhi(a[i].x) - lam * bfhi(b[i].x), o2 = bflo(a[i].y) - lam * bflo(b[i].y), o3 = bfhi(a[i].y) - lam * bfhi(b[i].y);
            float ss = o0 * o0 + o1 * o1 + o2 * o2 + o3 * o3;
            ss += __shfl_xor(ss, 1); ss += __shfl_xor(ss, 2); ss += __shfl_xor(ss, 4); ss += __shfl_xor(ss, 8);
            const float r = (1.0f / sqrtf(ss * (1.f / 64.f) + RMS_EPS)) * (1.0f - linit);
            u32x2 w; w.x = cvt_pk_bf16(o0 * r * gg[0], o1 * r * gg[1]); w.y = cvt_pk_bf16(o2 * r * gg[2], o3 * r * gg[3]);
            *(u32x2*)(Y + row * DM + h * 64 + d4) = w; }
    }
}

DI float hgrn_lb(const Ctx& C, int l, int dir, int ch) {
    if (l == 0) return 0.f;
    const float a = C.A->in[5][(0 * 2 + dir) * 256 + ch], b = C.A->in[5][(1 * 2 + dir) * 256 + ch];
    const float m = fmaxf(a, b), ea = expf(a - m), eb = expf(b - m); return eb / (ea + eb);
}
DI float dpp_shr_add(float x, int k) {
    float y;
    if (k == 1) y = __builtin_bit_cast(float, __builtin_amdgcn_update_dpp(0, __builtin_bit_cast(int, x), 0x111, 0xF, 0xF, true));
    else if (k == 2) y = __builtin_bit_cast(float, __builtin_amdgcn_update_dpp(0, __builtin_bit_cast(int, x), 0x112, 0xF, 0xF, true));
    else if (k == 4) y = __builtin_bit_cast(float, __builtin_amdgcn_update_dpp(0, __builtin_bit_cast(int, x), 0x114, 0xF, 0xF, true));
    else y = __builtin_bit_cast(float, __builtin_amdgcn_update_dpp(0, __builtin_bit_cast(int, x), 0x118, 0xF, 0xF, true));
    return x + y;
}
DI s16x4 tr16(unsigned addr) { s16x4 r; asm volatile("ds_read_b64_tr_b16 %0, %1\n\ts_waitcnt lgkmcnt(0)" : "=&v"(r) : "v"(addr) : "memory"); return r; }
constexpr int HG_ROW = 144, HG_ARR = 16 * HG_ROW;
template <int MODE>
DI void hgrn_pass(const Ctx& C, int l, int chunk, int h, int dir, LAS unsigned char* wl, float* ofs) {
    const bf16_t* UB = (const bf16_t*)(C.ws + WS_U); float* ST = (float*)(C.ws + WS_XB1); float* GAM = (float*)(C.ws + WS_GAM); bf16_t* Y = (bf16_t*)(C.ws + WS_Y);
    const int lane = C.lane, l15 = lane & 15, g = lane >> 4, r0 = chunk * 128; const size_t sbase = (size_t)((chunk * 4 + h) * 2 + dir);
    const unsigned QLa = (unsigned)(uintptr_t)wl, FLa = QLa + HG_ARR, VLa = QLa + 2 * HG_ARR, GLa = QLa + 3 * HG_ARR;
    LAS float* lbT = (LAS float*)(wl + 4 * HG_ARR);
    lbT[lane] = hgrn_lb(C, l, dir, h * 64 + lane);
    LDS_WAIT();
    f32x4 S[4][4];
#pragma unroll
    for (int dt = 0; dt < 4; ++dt)
#pragma unroll
        for (int et = 0; et < 4; ++et)
#pragma unroll
            for (int r = 0; r < 4; ++r) S[dt][et][r] = (MODE == 0) ? 0.f : ST[sbase * 4096 + (size_t)(16 * dt + 4 * g + r) * 64 + 16 * et + l15];
    float gsum[4] = {0.f, 0.f, 0.f, 0.f};
    const float* ngp = C.A->in[6] + l * 256 + h * 64 + l15;
    const int srow = lane >> 2, spc = lane & 3;
    u32x4 pq[2], pf[2], pv[2];
#define HG_LOAD(sc) do { const int t_ = (sc) * 16 + srow; const bf16_t* rp_ = UB + (size_t)(r0 + (dir ? 127 - t_ : t_)) * 1280 + h * 64 + spc * 16; \
        pf[0] = *(const u32x4*)(rp_ + (dir ? 512 : 256)); pf[1] = *(const u32x4*)(rp_ + (dir ? 512 : 256) + 8); pv[0] = *(const u32x4*)(rp_ + 768); pv[1] = *(const u32x4*)(rp_ + 768 + 8); \
        if (MODE != 0) { pq[0] = *(const u32x4*)(rp_); pq[1] = *(const u32x4*)(rp_ + 8); } } while (0)
#define HG_STORE() do { const int o_ = srow * HG_ROW + spc * 32; \
        *(LAS u32x4*)(wl + HG_ARR + o_) = pf[0]; *(LAS u32x4*)(wl + HG_ARR + o_ + 16) = pf[1]; *(LAS u32x4*)(wl + 2 * HG_ARR + o_) = pv[0]; *(LAS u32x4*)(wl + 2 * HG_ARR + o_ + 16) = pv[1]; \
        if (MODE != 0) { *(LAS u32x4*)(wl + o_) = pq[0]; *(LAS u32x4*)(wl + o_ + 16) = pq[1]; } } while (0)
    HG_LOAD(0);
    const unsigned tr_off = (unsigned)((4 * g + (l15 >> 2)) * HG_ROW + (l15 & 3) * 8);
    for (int sc = 0; sc < 8; ++sc) {
        LDS_WAIT();
        HG_STORE();
        if (MODE == 2) {
#pragma unroll
            for (int k = 0; k < 2; ++k) { const int t_ = sc * 16 + 8 * k + (lane >> 3);
                __builtin_amdgcn_global_load_lds((const unsigned*)(UB + (size_t)(r0 + 127 - t_) * 1280 + 1024 + h * 64 + (lane & 7) * 8), (LAS unsigned*)(wl + 3 * HG_ARR + k * 1024), 16, 0, 0); } }
        if (sc + 1 < 8) HG_LOAD(sc + 1);
        LDS_WAIT();
        bf16x8 vf[4];
#pragma unroll
        for (int et = 0; et < 4; ++et) { const s16x4 t4 = tr16(VLa + tr_off + et * 32); vf[et] = (bf16x8){t4[0], t4[1], t4[2], t4[3], 0, 0, 0, 0}; }
        __builtin_amdgcn_sched_barrier(0);
        bf16x8 khf[4]; float tot[4];
#pragma unroll
        for (int dt = 0; dt < 4; ++dt) { const s16x4 t4 = tr16(FLa + tr_off + dt * 32);
            float fv[4], lf[4];
            const float lbv = lbT[16 * dt + l15];
#pragma unroll
            for (int j = 0; j < 4; ++j) { fv[j] = lbv + (1.f - lbv) * sigmoidf_(bf2f((unsigned short)t4[j])); lf[j] = __builtin_amdgcn_logf(fv[j]); }
            const float Tg = (lf[0] + lf[1]) + (lf[2] + lf[3]);
            const float T1 = __shfl_down(Tg, 16), T2 = __shfl_down(Tg, 32), T3 = __shfl_down(Tg, 48);
            const float after = (g < 3 ? T1 : 0.f) + (g < 2 ? T2 : 0.f) + (g < 1 ? T3 : 0.f);
            float tt_ = Tg; tt_ += __shfl_xor(tt_, 16); tt_ += __shfl_xor(tt_, 32); tot[dt] = tt_; gsum[dt] += tt_;
            const float c3 = after, c2 = c3 + lf[3], c1 = c2 + lf[2], c0 = c1 + lf[1];
            const unsigned w0 = cvt_pk_bf16((1.f - fv[0]) * __builtin_amdgcn_exp2f(c0), (1.f - fv[1]) * __builtin_amdgcn_exp2f(c1));
            const unsigned w1 = cvt_pk_bf16((1.f - fv[2]) * __builtin_amdgcn_exp2f(c2), (1.f - fv[3]) * __builtin_amdgcn_exp2f(c3));
            const u32x4 w = {w0, w1, 0u, 0u}; khf[dt] = __builtin_bit_cast(bf16x8, w); }
        __builtin_amdgcn_sched_barrier(0);
        f32x4 O[4];
        if (MODE != 0) {
            bf16x8 qhf[2], ktf[2];
#pragma unroll
            for (int ks = 0; ks < 2; ++ks) { float b2[8], qv[8], kv[8];
#pragma unroll
                for (int dd = 0; dd < 2; ++dd) { const int dt = 2 * ks + dd;
                    const u32x2 fw = *(const LAS u32x2*)(wl + HG_ARR + l15 * HG_ROW + (16 * dt + 4 * g) * 2); const u32x2 qw = *(const LAS u32x2*)(wl + l15 * HG_ROW + (16 * dt + 4 * g) * 2);
                    const f32x4 lb4 = *(const LAS f32x4*)(lbT + 16 * dt + 4 * g);
                    const float fl4[4] = {bflo(fw.x), bfhi(fw.x), bflo(fw.y), bfhi(fw.y)}, ql4[4] = {bflo(qw.x), bfhi(qw.x), bflo(qw.y), bfhi(qw.y)};
#pragma unroll
                    for (int r = 0; r < 4; ++r) { const int i = 4 * dd + r; const float f = lb4[r] + (1.f - lb4[r]) * sigmoidf_(fl4[r]); b2[i] = __builtin_amdgcn_logf(f); kv[i] = 1.f - f; qv[i] = siluf_(ql4[r]); } }
#pragma unroll
                for (int i = 0; i < 8; ++i) { float x = b2[i]; x = dpp_shr_add(x, 1); x = dpp_shr_add(x, 2); x = dpp_shr_add(x, 4); x = dpp_shr_add(x, 8); b2[i] = x; }
                u32x4 wq, wk;
#pragma unroll
                for (int p = 0; p < 4; ++p) { const int i = 2 * p; const float e0 = __builtin_amdgcn_exp2f(b2[i]), e1 = __builtin_amdgcn_exp2f(b2[i + 1]);
                    wq[p] = cvt_pk_bf16(qv[i] * e0, qv[i + 1] * e1); wk[p] = cvt_pk_bf16(kv[i] * __builtin_amdgcn_exp2f(fminf(-b2[i], 120.f)), kv[i + 1] * __builtin_amdgcn_exp2f(fminf(-b2[i + 1], 120.f))); }
                qhf[ks] = __builtin_bit_cast(bf16x8, wq); ktf[ks] = __builtin_bit_cast(bf16x8, wk); }
            __builtin_amdgcn_sched_barrier(0);
            f32x4 aT = (f32x4){0.f, 0.f, 0.f, 0.f};
            aT = __builtin_amdgcn_mfma_f32_16x16x32_bf16(ktf[0], qhf[0], aT, 0, 0, 0);
            aT = __builtin_amdgcn_mfma_f32_16x16x32_bf16(ktf[1], qhf[1], aT, 0, 0, 0);
#pragma unroll
            for (int r = 0; r < 4; ++r) aT[r] = (4 * g + r > l15) ? 0.f : aT[r];
            const u32x4 aw = {cvt_pk_bf16(aT[0], aT[1]), cvt_pk_bf16(aT[2], aT[3]), 0u, 0u}; const bf16x8 atf = __builtin_bit_cast(bf16x8, aw);
#pragma unroll
            for (int et = 0; et < 4; ++et) { f32x4 o = (f32x4){0.f, 0.f, 0.f, 0.f};
                o = __builtin_amdgcn_mfma_f32_16x16x32_bf16(atf, vf[et], o, 0, 0, 0);
#pragma unroll
                for (int ks = 0; ks < 2; ++ks) { const u32x4 sw = {cvt_pk_bf16(S[2 * ks][et][0], S[2 * ks][et][1]), cvt_pk_bf16(S[2 * ks][et][2], S[2 * ks][et][3]), cvt_pk_bf16(S[2 * ks + 1][et][0], S[2 * ks + 1][et][1]), cvt_pk_bf16(S[2 * ks + 1][et][2], S[2 * ks + 1][et][3])};
                    o = __builtin_amdgcn_mfma_f32_16x16x32_bf16(qhf[ks], __builtin_bit_cast(bf16x8, sw), o, 0, 0, 0); }
                O[et] = o; }
        }
        __builtin_amdgcn_sched_barrier(0);
#pragma unroll
        for (int dt = 0; dt < 4; ++dt) { float dec[4];
#pragma unroll
            for (int r = 0; r < 4; ++r) dec[r] = __builtin_amdgcn_exp2f(__shfl(tot[dt], 4 * g + r));
#pragma unroll
            for (int et = 0; et < 4; ++et) { f32x4 s = S[dt][et];
#pragma unroll
                for (int r = 0; r < 4; ++r) s[r] *= dec[r];
                S[dt][et] = __builtin_amdgcn_mfma_f32_16x16x32_bf16(khf[dt], vf[et], s, 0, 0, 0); } }
        __builtin_amdgcn_sched_barrier(0);
        if (MODE == 1) {
#pragma unroll
            for (int et = 0; et < 4; ++et)
#pragma unroll
                for (int r = 0; r < 4; ++r) ofs[(sc * 16 + 4 * g + r) * 64 + 16 * et + l15] = O[et][r];
        }
        if (MODE == 2) {
            float rr[4];
#pragma unroll
            for (int r = 0; r < 4; ++r) { const int at = 127 - (sc * 16 + 4 * g + r); float ss = 0.f;
#pragma unroll
                for (int et = 0; et < 4; ++et) { const float of = ofs[at * 64 + 16 * et + l15]; O[et][r] += of; ss += O[et][r] * O[et][r]; }
                ss += __shfl_xor(ss, 1); ss += __shfl_xor(ss, 2); ss += __shfl_xor(ss, 4); ss += __shfl_xor(ss, 8);
                rr[r] = 1.0f / sqrtf(ss * (1.f / 64.f) + RMS_EPS); }
            VM_WAIT();
#pragma unroll
            for (int et = 0; et < 4; ++et) { const s16x4 t4 = tr16(GLa + (unsigned)((4 * g + (l15 >> 2)) * 128 + (l15 & 3) * 8) + et * 32); const float ngv = ngp[16 * et];
#pragma unroll
                for (int r = 0; r < 4; ++r) { const int at = 127 - (sc * 16 + 4 * g + r);
                    Y[(size_t)(r0 + at) * DM + 256 + h * 64 + 16 * et + l15] = (bf16_t)f2bf(O[et][r] * rr[r] * ngv * siluf_(bf2f((unsigned short)t4[r]))); } }
        }
    }
#undef HG_LOAD
#undef HG_STORE
    if (MODE == 0) {
#pragma unroll
        for (int dt = 0; dt < 4; ++dt)
#pragma unroll
            for (int et = 0; et < 4; ++et)
#pragma unroll
                for (int r = 0; r < 4; ++r) ST[sbase * 4096 + (size_t)(16 * dt + 4 * g + r) * 64 + 16 * et + l15] = S[dt][et][r];
        if (g == 0) {
#pragma unroll
            for (int dt = 0; dt < 4; ++dt) GAM[sbase * 64 + 16 * dt + l15] = __builtin_amdgcn_exp2f(gsum[dt]);
        }
    }
}
DI void ph_hgrn_local(const Ctx& C, int l) {
    LAS unsigned char* wl = C.lds + C.wave * 16384;
    for (int w = C.gw; w < NCHUNK * 8; w += C.NGW) hgrn_pass<0>(C, l, w >> 3, (w >> 1) & 3, w & 1, wl, nullptr);
}
DI void ph_hgrn_scan(const Ctx& C) {
    float* ST = (float*)(C.ws + WS_XB1); const float* GAM = (const float*)(C.ws + WS_GAM);
    for (int idx = C.bid * 512 + C.tid; idx < NSEQ * 8 * 4096; idx += C.G * 512) {
        const int e = idx & 4095, hd = (idx >> 12) & 7, seq = idx >> 15, h = hd >> 1, dir = hd & 1, d = e >> 6;
        const int c0 = seq < 8 ? seq * 64 : 512 + (seq - 8) * 16, nc = seq < 8 ? 64 : 16;
        float s = 0.f;
        for (int i0 = 0; i0 < nc; i0 += 16) {
            float tmp[16], gg[16];
#pragma unroll
            for (int i = 0; i < 16; ++i) { const int c = dir ? c0 + nc - 1 - (i0 + i) : c0 + i0 + i; const size_t base = (size_t)((c * 4 + h) * 2 + dir); tmp[i] = ST[base * 4096 + e]; gg[i] = GAM[base * 64 + d]; }
#pragma unroll
            for (int i = 0; i < 16; ++i) { const float t = tmp[i]; tmp[i] = s; s = fmaf(gg[i], s, t); }
#pragma unroll
            for (int i = 0; i < 16; ++i) { const int c = dir ? c0 + nc - 1 - (i0 + i) : c0 + i0 + i; const size_t base = (size_t)((c * 4 + h) * 2 + dir); ST[base * 4096 + e] = tmp[i]; }
        }
    }
}
template <int MODE>
DI void ph_hgrn_out(const Ctx& C, int l) {
    LAS unsigned char* wl = C.lds + C.wave * 16384;
    for (int w = C.gw; w < NCHUNK * 4; w += C.NGW) hgrn_pass<MODE>(C, l, w >> 2, w & 3, MODE == 2 ? 1 : 0, wl, (float*)(C.ws + WS_EW) + (size_t)w * 8192);
}

DI void ph_c_prep(const Ctx& C, int l) {
    const bf16_t* UCD = (const bf16_t*)(C.ws + WS_U);
    const bf16_t* WQ = (const bf16_t*)(C.ws + WS_WC + (size_t)l * WC_LAYER + OFF_WQ); const bf16_t* WKV = (const bf16_t*)(C.ws + WS_WC + (size_t)l * WC_LAYER + OFF_WKV);
    bf16_t* Qc = (bf16_t*)(C.ws + WS_XB1 + OFF_QC); bf16_t* Kc = (bf16_t*)(C.ws + WS_XB1 + OFF_KC); bf16_t* Vc = (bf16_t*)(C.ws + WS_XB1 + OFF_VC);
    const int lane = C.lane, r32 = lane & 31, hi = lane >> 5;
    const float C2c = 0.14433756729740643f * LOG2E;
    constexpr int PQ = 400, PKV = 272;
    for (int i = C.tid; i < 192 * 24; i += 512) { const int r = i / 24, p = i % 24; *(LAS u32x4*)(C.lds + r * PQ + p * 16) = *(const u32x4*)(WQ + (size_t)r * 192 + p * 8); }
    __syncthreads();
    for (int w = C.gw; w < NTOK / 32; w += C.NGW) {
        const int row = w * 32 + r32; const bf16_t* xr = UCD + (size_t)row * 1024;
        float cs[4], sn[4];
        { const float pos = (float)row_pos(row); const float inv[8] = {1.0f, 0.316227766016837933f, 0.1f, 0.0316227766016837933f, 0.01f, 0.00316227766016837933f, 0.001f, 0.000316227766016837933f};
#pragma unroll
            for (int ii = 0; ii < 4; ++ii) { const float invv = hi ? inv[4 + ii] : inv[ii]; const float ang = pos * invv;
                const double ad = (double)ang; const double k = __builtin_rint(ad * 0.15915494309189535); const float red = (float)(ad - k * 6.283185307179586);
                cs[ii] = __cosf(red); sn[ii] = __sinf(red); } }
        bf16x8 xq[12]; float ssq = 0.f;
#pragma unroll
        for (int ks = 0; ks < 12; ++ks) { xq[ks] = *(const bf16x8*)(xr + ks * 16 + hi * 8);
#pragma unroll
            for (int j = 0; j < 8; ++j) { const float f = bf2f((unsigned short)xq[ks][j]); ssq += f * f; } }
        ssq += __shfl_xor(ssq, 32);
        const float rq = (1.0f / sqrtf(ssq * (1.f / 192.f) + RMS_EPS)) * C2c;
#pragma unroll 1
        for (int nt = 0; nt < 6; ++nt) {
            f32x16 acc;
#pragma unroll
            for (int r = 0; r < 16; ++r) acc[r] = 0.f;
#pragma unroll
            for (int ks = 0; ks < 12; ++ks) { const bf16x8 a = *(const LAS bf16x8*)(C.lds + (32 * nt + r32) * PQ + (ks * 16 + hi * 8) * 2); acc = __builtin_amdgcn_mfma_f32_32x32x16_bf16(a, xq[ks], acc, 0, 0, 0); }
#pragma unroll
            for (int r = 0; r < 16; ++r) acc[r] *= rq;
            if (nt == 1 || nt == 4) {
#pragma unroll
                for (int ii = 0; ii < 4; ++ii) { const float x1 = acc[ii], x2 = acc[4 + ii]; acc[ii] = x1 * cs[ii] - x2 * sn[ii]; acc[4 + ii] = x1 * sn[ii] + x2 * cs[ii]; } }
            if (nt == 2 || nt == 5) {
#pragma unroll
                for (int ii = 0; ii < 4; ++ii) { const float x1 = acc[8 + ii], x2 = acc[12 + ii]; acc[8 + ii] = x1 * cs[ii] - x2 * sn[ii]; acc[12 + ii] = x1 * sn[ii] + x2 * cs[ii]; } }
#pragma unroll
            for (int g = 0; g < 4; ++g) { u32x2 wv; wv.x = cvt_pk_bf16(acc[4 * g], acc[4 * g + 1]); wv.y = cvt_pk_bf16(acc[4 * g + 2], acc[4 * g + 3]);
                *(u32x2*)(Qc + (size_t)row * 192 + 32 * nt + 8 * g + 4 * hi) = wv; }
        }
        { const u32x2 a = *(const u32x2*)(xr + 320 + 4 * hi), b = *(const u32x2*)(xr + 328 + 4 * hi);
            const float x1[4] = {bflo(a.x), bfhi(a.x), bflo(a.y), bfhi(a.y)}, x2[4] = {bflo(b.x), bfhi(b.x), bflo(b.y), bfhi(b.y)};
            float o1[4], o2[4];
#pragma unroll
            for (int ii = 0; ii < 4; ++ii) { o1[ii] = x1[ii] * cs[ii] - x2[ii] * sn[ii]; o2[ii] = x1[ii] * sn[ii] + x2[ii] * cs[ii]; }
            u32x2 w1, w2; w1.x = cvt_pk_bf16(o1[0], o1[1]); w1.y = cvt_pk_bf16(o1[2], o1[3]); w2.x = cvt_pk_bf16(o2[0], o2[1]); w2.y = cvt_pk_bf16(o2[2], o2[3]);
#pragma unroll
            for (int h = 0; h < 4; ++h) { *(u32x2*)(Kc + (size_t)row * 192 + h * 48 + 32 + 4 * hi) = w1; *(u32x2*)(Kc + (size_t)row * 192 + h * 48 + 40 + 4 * hi) = w2; } }
    }
    __syncthreads();
    for (int i = C.tid; i < 384 * 16; i += 512) { const int r = i / 16, p = i % 16; *(LAS u32x4*)(C.lds + r * PKV + p * 16) = *(const u32x4*)(WKV + (size_t)r * 128 + p * 8); }
    __syncthreads();
    for (int w = C.gw; w < NTOK / 32; w += C.NGW) {
        const int row = w * 32 + r32; const bf16_t* xr = UCD + (size_t)row * 1024;
        bf16x8 xk[8]; float ssk = 0.f;
#pragma unroll
        for (int ks = 0; ks < 8; ++ks) { xk[ks] = *(const bf16x8*)(xr + 192 + ks * 16 + hi * 8);
#pragma unroll
            for (int j = 0; j < 8; ++j) { const float f = bf2f((unsigned short)xk[ks][j]); ssk += f * f; } }
        ssk += __shfl_xor(ssk, 32);
        const float rk = 1.0f / sqrtf(ssk * (1.f / 128.f) + RMS_EPS);
#pragma unroll 1
        for (int nt = 0; nt < 12; ++nt) {
            f32x16 acc;
#pragma unroll
            for (int r = 0; r < 16; ++r) acc[r] = 0.f;
#pragma unroll
            for (int ks = 0; ks < 8; ++ks) { const bf16x8 a = *(const LAS bf16x8*)(C.lds + (32 * nt + r32) * PKV + (ks * 16 + hi * 8) * 2); acc = __builtin_amdgcn_mfma_f32_32x32x16_bf16(a, xk[ks], acc, 0, 0, 0); }
            const int h = nt / 3, part = nt % 3;
            bf16_t* dst = (part == 0) ? Kc + (size_t)row * 192 + h * 48 : Vc + (size_t)row * 256 + h * 64 + (part - 1) * 32;
#pragma unroll
            for (int g = 0; g < 4; ++g) { u32x2 wv; wv.x = cvt_pk_bf16(acc[4 * g] * rk, acc[4 * g + 1] * rk); wv.y = cvt_pk_bf16(acc[4 * g + 2] * rk, acc[4 * g + 3] * rk);
                *(u32x2*)(dst + 8 * g + 4 * hi) = wv; }
        }
    }
}

DI float one_minus_a2(float y, float a) {
    const float p = -y * (1.0f + y * (0.5f + y * (0.16666667f + y * (0.041666668f + y * (0.0083333338f + y * 0.0013888889f)))));
    return (y > -0.25f) ? p : (1.0f - a * a);
}
template <bool FINAL, int DIR>
DI void rglru_units(const Ctx& C, int l) {
    const bf16_t* UCD = (const bf16_t*)(C.ws + WS_U); f32x2* DC = (f32x2*)(C.ws + WS_DC);
    bf16_t* HFB = (bf16_t*)(C.ws + WS_EW);
    const int lane = C.lane, l15 = lane & 15, g = lane >> 4;
    LAS unsigned char* wl = C.lds + C.wave * 16384;
    LAS unsigned char* xcb = wl;
    LAS float* gs = (LAS float*)(wl + 2304);
    const int n = C.gw & 3, ch = n * 64 + lane;
    bf16x8 Wf[2][4][2];
    { const bf16x8* fp = (const bf16x8*)(C.ws + WS_WRG) + (size_t)((((l * 2 + DIR) * 4 + n) * 2) * 8) * 64 + lane;
#pragma unroll
      for (int gt = 0; gt < 2; ++gt)
#pragma unroll
        for (int nt = 0; nt < 4; ++nt)
#pragma unroll
            for (int ks = 0; ks < 2; ++ks) Wf[gt][nt][ks] = fp[(size_t)((gt * 4 + nt) * 2 + ks) * 64]; }
    const float ba = C.A->in[14][(l * 2 + DIR) * 256 + ch], bx = C.A->in[16][(l * 2 + DIR) * 256 + ch];
    const float lam = C.A->in[17][(l * 2 + DIR) * 256 + ch];
    const float c8sp = -8.0f * log1pf(expf(-lam));
    float cw[4];
#pragma unroll
    for (int j = 0; j < 4; ++j) cw[j] = C.A->in[11][(l * 4 + j) * 256 + ch];
    const float cb = C.A->in[12][l * 256 + ch];
    for (int w = C.gw; w < NCHUNK * 4; w += C.NGW) {
        const int chunk = w >> 2;
        const int r0 = chunk * 128; const int sb = row_seq_begin(r0), se = sb + row_seq_len(r0);
        float h = FINAL ? DC[(size_t)(chunk * 2 + DIR) * 256 + ch][1] : 0.f, P = 1.f;
        float xr[19];
#define RG_LOADX(dst, sc_) do { const int tb_ = r0 + 16 * (DIR ? 7 - (sc_) : (sc_)) - 2; \
            _Pragma("unroll") for (int i_ = 0; i_ < 19; ++i_) { const int rr_ = tb_ + i_; dst[i_] = (rr_ >= sb && rr_ < se) ? bf2f(UCD[(size_t)rr_ * 1024 + 336 + ch]) : 0.f; } } while (0)
        RG_LOADX(xr, 0);
        for (int sc = 0; sc < 8; ++sc) {
            const int t0 = r0 + 16 * (DIR ? 7 - sc : sc);
            float xcr[16];
#pragma unroll
            for (int a = 0; a < 16; ++a) { const int tt = DIR ? 15 - a : a;
                xcr[tt] = cb + cw[0] * xr[a] + cw[1] * xr[a + 1] + cw[2] * xr[a + 2] + cw[3] * xr[a + 3];
                *(LAS bf16_t*)(xcb + tt * 144 + lane * 2) = (bf16_t)f2bf(xcr[tt]); }
            if (sc + 1 < 8) RG_LOADX(xr, sc + 1);
            LDS_WAIT();
            const bf16x8 A0 = *(const LAS bf16x8*)(xcb + l15 * 144 + (8 * g) * 2), A1 = *(const LAS bf16x8*)(xcb + l15 * 144 + (32 + 8 * g) * 2);
#pragma unroll
            for (int gt = 0; gt < 2; ++gt)
#pragma unroll
                for (int nt = 0; nt < 4; ++nt) { f32x4 acc = (f32x4){0.f, 0.f, 0.f, 0.f};
                    acc = __builtin_amdgcn_mfma_f32_16x16x32_bf16(A0, Wf[gt][nt][0], acc, 0, 0, 0);
                    acc = __builtin_amdgcn_mfma_f32_16x16x32_bf16(A1, Wf[gt][nt][1], acc, 0, 0, 0);
#pragma unroll
                    for (int r = 0; r < 4; ++r) gs[(gt * 16 + 4 * g + r) * 68 + 16 * nt + l15] = acc[r]; }
            LDS_WAIT();
#pragma unroll
            for (int tt = 0; tt < 16; ++tt) {
                const float ra = gs[tt * 68 + lane] + ba, ia = gs[(16 + tt) * 68 + lane] + bx;
                const float r = sigmoidf_(ra), ig = sigmoidf_(ia);
                const float la = c8sp * r, a = __expf(la), u = __builtin_amdgcn_sqrtf(one_minus_a2(2.0f * la, a)) * (ig * xcr[tt]);
                h = fmaf(a, h, u); P *= a;
                if (FINAL) { const int tok = DIR ? t0 + 15 - tt : t0 + tt; HFB[((size_t)DIR * NTOK + tok) * 256 + ch] = (bf16_t)f2bf(h); } }
            LDS_WAIT();
        }
        if (!FINAL) DC[(size_t)(chunk * 2 + DIR) * 256 + ch] = (f32x2){P, h};
#undef RG_LOADX
    }
}
template <bool FINAL>
DI void ph_rglru(const Ctx& C, int l) { rglru_units<FINAL, 0>(C, l); rglru_units<FINAL, 1>(C, l); }
DI void ph_rglru_scan(const Ctx& C) {
    f32x2* DC = (f32x2*)(C.ws + WS_DC);
    for (int idx = C.bid * 512 + C.tid; idx < NSEQ * 512; idx += C.G * 512) {
        const int ch = idx & 255, dir = (idx >> 8) & 1, seq = idx >> 9;
        const int c0 = seq < 8 ? seq * 64 : 512 + (seq - 8) * 16, nc = seq < 8 ? 64 : 16;
        float hin = 0.f;
        for (int i0 = 0; i0 < nc; i0 += 16) {
            f32x2 vv[16];
#pragma unroll
            for (int i = 0; i < 16; ++i) { const int c = dir ? c0 + nc - 1 - (i0 + i) : c0 + i0 + i; vv[i] = DC[(size_t)(c * 2 + dir) * 256 + ch]; }
#pragma unroll
            for (int i = 0; i < 16; ++i) { const float P = vv[i][0], H = vv[i][1]; vv[i][1] = hin; hin = fmaf(P, hin, H); }
#pragma unroll
            for (int i = 0; i < 16; ++i) { const int c = dir ? c0 + nc - 1 - (i0 + i) : c0 + i0 + i; DC[(size_t)(c * 2 + dir) * 256 + ch] = vv[i]; }
        }
    }
}
DI float gelu_tanh(float x) { const float u = 0.7978845608028654f * (x + 0.044715f * x * x * x); const float e = __expf(2.0f * u); const float th = 1.0f - 2.0f / (e + 1.0f); return 0.5f * x * (1.0f + th); }
DI void ph_d_post(const Ctx& C) {
    const bf16_t* UCD = (const bf16_t*)(C.ws + WS_U); const bf16_t* HF = (const bf16_t*)(C.ws + WS_EW); const bf16_t* HB = HF + (size_t)NTOK * 256; bf16_t* Y = (bf16_t*)(C.ws + WS_Y);
    const int c4 = C.lane * 4;
    for (int row0 = C.gw; row0 < NTOK; row0 += 4 * C.NGW) {
        u32x2 a[4], b[4], g[4];
#pragma unroll
        for (int i = 0; i < 4; ++i) { const size_t row = (size_t)row0 + (size_t)i * C.NGW; a[i] = *(const u32x2*)(HF + row * 256 + c4); b[i] = *(const u32x2*)(HB + row * 256 + c4); g[i] = *(const u32x2*)(UCD + row * 1024 + 592 + c4); }
#pragma unroll
        for (int i = 0; i < 4; ++i) { const size_t row = (size_t)row0 + (size_t)i * C.NGW;
            const float y0 = (bflo(a[i].x) + bflo(b[i].x)) * gelu_tanh(bflo(g[i].x)), y1 = (bfhi(a[i].x) + bfhi(b[i].x)) * gelu_tanh(bfhi(g[i].x));
            const float y2 = (bflo(a[i].y) + bflo(b[i].y)) * gelu_tanh(bflo(g[i].y)), y3 = (bfhi(a[i].y) + bfhi(b[i].y)) * gelu_tanh(bfhi(g[i].y));
            u32x2 w; w.x = cvt_pk_bf16(y0, y1); w.y = cvt_pk_bf16(y2, y3);
            *(u32x2*)(Y + row * DM + 768 + c4) = w; }
    }
}

DI void ph_topk(const Ctx& C) {
    const float* affT = (const float*)(C.ws + WS_AFF); int* idx2 = (int*)(C.ws + WS_IDX); float* gsel2 = (float*)(C.ws + WS_GSEL);
    LAS unsigned* hist = (LAS unsigned*)C.lds;
    LAS unsigned* misc = hist + 4096;
    LAS unsigned* cg = misc + 8;
    LAS unsigned* ce = cg + 512;
    for (int u = C.bid; u < 32; u += C.G) {
        const int g = u >> 4, e = u & 15; const unsigned* a = (const unsigned*)(affT + (size_t)(g * 16 + e) * NTOKG);
        const int i0 = C.tid * 128; unsigned v[128];
        { const u32x4* p = (const u32x4*)(a + i0);
#pragma unroll
          for (int j = 0; j < 32; ++j) { const u32x4 q = p[j]; v[4 * j] = q.x; v[4 * j + 1] = q.y; v[4 * j + 2] = q.z; v[4 * j + 3] = q.w; } }
        unsigned prefix = 0u, mask = 0u, krem = CAP;
#pragma unroll 1
        for (int pass = 0; pass < 3; ++pass) {
            const int shift = pass == 0 ? 19 : (pass == 1 ? 7 : 0); const unsigned dm = pass == 2 ? 127u : 4095u; const int per = pass == 2 ? 2 : 64;
            for (int i = C.tid; i < 4096; i += 512) hist[i] = 0u;
            __syncthreads();
#pragma unroll
            for (int i = 0; i < 128; ++i) {
                const unsigned bin = ((v[i] & mask) == prefix) ? ((v[i] >> shift) & dm) : (5120u + (unsigned)C.lane);
                atomicAdd((unsigned*)&hist[bin], 1u); if ((i & 7) == 7) asm volatile("" : "+v"(prefix) :: "memory"); }
            __syncthreads();
            if (C.tid < 64) {
                unsigned t = 0; for (int b = 0; b < per; ++b) t += hist[per * C.tid + b];
                unsigned S = t;
#pragma unroll
                for (int off = 1; off < 64; off <<= 1) { const unsigned y = __shfl_down(S, off); if (C.tid + off < 64) S += y; }
                const unsigned above = S - t;
                if (above < krem && krem <= above + t) { unsigned cum = above; int D = per * C.tid + per - 1;
                    for (; D > per * C.tid; --D) { const unsigned c = hist[D]; if (cum + c >= krem) break; cum += c; }
                    misc[0] = (unsigned)D; misc[1] = cum; }
            }
            __syncthreads();
            prefix |= misc[0] << shift; mask |= dm << shift; krem -= misc[1];
            __syncthreads();
        }
        unsigned ngt = 0, neq = 0;
#pragma unroll
        for (int i = 0; i < 128; ++i) { ngt += (v[i] > prefix); neq += (v[i] == prefix); if ((i & 15) == 15) asm volatile("" : "+v"(prefix)); }
        unsigned ig = ngt, ie = neq;
#pragma unroll
        for (int off = 1; off < 64; off <<= 1) { const unsigned yg = __shfl_up(ig, off), ye = __shfl_up(ie, off); if (C.lane >= off) { ig += yg; ie += ye; } }
        if (C.lane == 63) { cg[C.wave] = ig; ce[C.wave] = ie; }
        __syncthreads();
        unsigned bg = 0, be = 0, allg = 0;
#pragma unroll
        for (int w = 0; w < 8; ++w) { const unsigned x = cg[w], y = ce[w]; if (w < C.wave) { bg += x; be += y; } allg += x; }
        unsigned pg = bg + ig - ngt, pe = be + ie - neq; const unsigned ngt_all = allg;
        int* io = idx2 + (size_t)e * 16384 + g * CAP; float* go = gsel2 + (size_t)e * 16384 + g * CAP; short* sm = (short*)(C.ws + WS_SM) + (size_t)(g * NTOKG + i0) * 16 + e;
#pragma unroll
        for (int i = 0; i < 128; ++i) {
            if (v[i] > prefix) { io[pg] = g * NTOKG + i0 + i; go[pg] = __builtin_bit_cast(float, v[i]); sm[i * 16] = (short)pg; ++pg; }
            else if (v[i] == prefix) { if (pe < krem) { io[ngt_all + pe] = g * NTOKG + i0 + i; go[ngt_all + pe] = __builtin_bit_cast(float, v[i]); sm[i * 16] = (short)(ngt_all + pe); } ++pe; }
            if ((i & 3) == 3) asm volatile("" : "+v"(prefix) :: "memory"); }
        __syncthreads();
    }
}

constexpr int MERGE_CHUNKS = 8, MERGE_ROWS = NTOK / MERGE_CHUNKS;
constexpr int EPB = 2;
constexpr int NPH_LAYER = 12 + 2 * MERGE_CHUNKS + 3 + (NEXP / EPB + 1) + 1, NPH = 1 + 2 * NPH_LAYER;
__global__ void __launch_bounds__(512, 2) mk_fwd(Args args) {
    extern __shared__ __attribute__((aligned(16))) unsigned char lds_raw[];
    Ctx C;
    C.lds = (LAS unsigned char*)lds_raw; C.ws = (GAS unsigned char*)args.ws; C.out = (GAS float*)args.out;
    C.tid = threadIdx.x; C.lane = C.tid & 63; C.wave = __builtin_amdgcn_readfirstlane(C.tid >> 6); C.G = gridDim.x; C.bid = blockIdx.x;
    C.gw = C.bid * 8 + C.wave; C.NGW = C.G * 8;
    C.A = &args;
    volatile LAS unsigned* MISC = (volatile LAS unsigned*)(C.lds + MISC_OFF);
    for (int u = C.tid; u < (LDS_BYTES - RING_BYTES) / 4; u += 512) ((LAS unsigned*)(C.lds + RING_BYTES))[u] = 0u;
    __syncthreads();
    const int lo = args.ph_lo, hi = args.ph_hi;
    unsigned* barw = (unsigned*)(C.ws + WS_CTL) + 4096;
    XcdBarrier bar; bar.bar = barw; bar.x = 0; bar.st = nullptr;
    if (hi - lo > 1) bar = xcd_barrier_post(barw, MISC + 8);
    int ph = 0;
#ifndef PHASE_MASK
#define PHASE_MASK 0xFFFFFFFFu
#endif
#ifndef REPEAT_MASK
#define REPEAT_MASK 0u
#endif
#define SITE(id) if constexpr (((PHASE_MASK) >> (id)) & 1u) for (int rep_ = 0; rep_ < ((((REPEAT_MASK) >> (id)) & 1u) ? 2 : 1); ++rep_)
#define PH_BEGIN if (ph >= lo && ph < hi) { { int tz_ = threadIdx.x; asm volatile("" : "+v"(tz_)); C.tid = tz_; C.lane = tz_ & 63; C.wave = __builtin_amdgcn_readfirstlane(tz_ >> 6); C.gw = C.bid * 8 + C.wave; unsigned char* wz_ = args.ws; asm volatile("" : "+s"(wz_)); C.ws = (GAS unsigned char*)wz_; float* oz_ = args.out; asm volatile("" : "+s"(oz_)); C.out = (GAS float*)oz_; }
#define PH_END } if (ph >= lo && ph + 1 < hi) xcd_barrier(bar); ++ph;

#define XB0 ((bf16_t*)(C.ws + WS_XB0))
#define XB1 ((bf16_t*)(C.ws + WS_XB1))
#define Yb ((bf16_t*)(C.ws + WS_Y))
#define Ub ((bf16_t*)(C.ws + WS_U))
    const int big = 30;

    PH_BEGIN SITE(1) ph_prologue(C); PH_END

    for (int l = 0; l < 2; ++l) {
#define wl (C.ws + WS_WSMALL + (size_t)l * WSMALL_LAYER)
        PH_BEGIN SITE(2) { pg8::Gemm g{XB0, (const bf16_t*)(wl + OFF_WA), NTOK, 768, 1024, 1024, 1024, big, 0}; pg8::StaticOrder S; S.init(NTOK, 768, C.G, C.bid);
            pg8::EpiProj E{Ub, 768, 256, 0.17677669529663689f * LOG2E, (unsigned*)(C.ws + WS_KN2) + (size_t)l * 8 * 2048}; pg8::gemm_phase(C.lds, g, S, E); } PH_END
        PH_BEGIN SITE(3) ph_attn_a(C, l); PH_END
        PH_BEGIN SITE(4) { ph_a_post(C, l); __syncthreads();
            pg8::Gemm g{XB0, (const bf16_t*)(wl + OFF_WB), NTOK, 1280, 1024, 1024, 1024, big, 0}; pg8::StaticOrder S; S.init(NTOK, 1280, C.G, C.bid);
            pg8::EpiProj E{Ub, 1280, 0, 1.f, nullptr}; pg8::gemm_phase(C.lds, g, S, E); } PH_END
        PH_BEGIN SITE(5) ph_hgrn_local(C, l); PH_END
        PH_BEGIN SITE(6) ph_hgrn_scan(C); PH_END
        PH_BEGIN SITE(7) ph_hgrn_out<1>(C, l); PH_END
        PH_BEGIN SITE(20) ph_hgrn_out<2>(C, l); PH_END
        PH_BEGIN SITE(8) { pg8::Gemm g{XB0, (const bf16_t*)(wl + OFF_WCD), NTOK, 1024, 1024, 1024, 1024, big, 0}; pg8::StaticOrder S; S.init(NTOK, 1024, C.G, C.bid);
            pg8::EpiProj E{Ub, 1024, 0, 1.f, nullptr}; pg8::gemm_phase(C.lds, g, S, E); } PH_END
        PH_BEGIN SITE(9) { ph_c_prep(C, l); __syncthreads(); ph_rglru<false>(C, l); } PH_END
        PH_BEGIN SITE(10) { if (rep_ == 0) { ph_rglru_scan(C); __syncthreads(); } ph_attn_c(C); } PH_END
        PH_BEGIN SITE(11) ph_rglru<true>(C, l); PH_END
        PH_BEGIN SITE(12) ph_d_post(C); PH_END
        for (int q = 0; q < MERGE_CHUNKS; ++q) {
            const size_t r0 = (size_t)q * MERGE_ROWS;
            PH_BEGIN SITE(13) {
                { unsigned char* X8 = (unsigned char*)(C.ws + WS_U) + (size_t)MERGE_ROWS * 8192;
                  for (int rb = C.gw; rb < MERGE_ROWS; rb += 8 * C.NGW) {
                      u32x4 a[8], b[8];
#pragma unroll
                      for (int i = 0; i < 8; ++i) { const int r = min(rb + i * C.NGW, MERGE_ROWS - 1); const u32x4* s = (const u32x4*)(XB0 + (r0 + r) * DM) + 2 * C.lane; a[i] = s[0]; b[i] = s[1]; }
#pragma unroll
                      for (int i = 0; i < 8; ++i) { const int r = rb + i * C.NGW; if (r < MERGE_ROWS) {
                          u32x4 o; o.x = pg8::pk4_fp8(bflo(a[i].x), bfhi(a[i].x), bflo(a[i].y), bfhi(a[i].y)); o.y = pg8::pk4_fp8(bflo(a[i].z), bfhi(a[i].z), bflo(a[i].w), bfhi(a[i].w));
                          o.z = pg8::pk4_fp8(bflo(b[i].x), bfhi(b[i].x), bflo(b[i].y), bfhi(b[i].y)); o.w = pg8::pk4_fp8(bflo(b[i].z), bfhi(b[i].z), bflo(b[i].w), bfhi(b[i].w));
                          ((u32x4*)(X8 + (size_t)r * DM))[C.lane] = o; } } }
                  __syncthreads(); }
                pg8::Gemm g{Yb + r0 * DM, (const bf16_t*)(wl + OFF_WBR), MERGE_ROWS, 4096, 256, 1024, 256, 2, 512}; pg8::StaticOrder S; S.init(MERGE_ROWS, 4096, C.G, C.bid);
                pg8::EpiProj E{Ub, 4096, 0, 1.f, nullptr}; pg8::gemm_phase(C.lds, g, S, E); } PH_END
            PH_BEGIN SITE(14) { pg8::Gemm g{(const bf16_t*)(C.ws + WS_U + (size_t)MERGE_ROWS * 8192), (const bf16_t*)(wl + OFF_WG), MERGE_ROWS, 4096, 1024, 1024, 1024, big, 0}; pg8::StaticOrder S; S.init(MERGE_ROWS, 4096, C.G, C.bid);
                pg8::EpiGateMix E{Ub, XB1 + r0 * DM, 1.f / pg8::FP8_W1_SCALE}; pg8::gemm_phase<pg8::EpiGateMix, pg8::StaticOrder, true>(C.lds, g, S, E); } PH_END
        }
        PH_BEGIN SITE(15) { pg8::Gemm g{XB1, (const bf16_t*)(wl + OFF_WOUT), NTOK, 1024, 1024, 1024, 1024, big, 0}; pg8::StaticOrder S; S.init(NTOK, 1024, C.G, C.bid);
            pg8::EpiResid E{l == 0 ? C.A->in[0] : (const float*)C.out, l == 0 ? C.A->in[1] : (const float*)(C.out + (size_t)NTOKG * DM), (float*)C.out}; pg8::gemm_phase(C.lds, g, S, E); } PH_END
        PH_BEGIN SITE(16) { ph_ln<true>(C, l, 0, XB1); } PH_END
        PH_BEGIN SITE(17) { if (C.bid < 32 && C.G > 64) ph_topk(C); else expert_weight_items(C, l); if (C.G <= 64) { __syncthreads(); if (C.bid < 32) ph_topk(C); } } PH_END
        for (int k = 0; k < NEXP / EPB + 1; ++k) {
            PH_BEGIN SITE(18) {
                constexpr size_t H_B = (size_t)EPB * 16384 * 2048;
                unsigned char* Hb = (unsigned char*)(C.ws + WS_XB0);
                if (k < NEXP / EPB) { const int e0 = k * EPB;
                    pg8::Gemm g{(const bf16_t*)(C.ws + WS_XB1), (const bf16_t*)(C.ws + WS_EW + OFF_WGU8 + (size_t)e0 * 4096 * 1024), EPB * 16384, 4096, 1024, 1024, 1024, big, 0, 6, (size_t)4096 * 1024, (const int*)(C.ws + WS_IDX) + (size_t)e0 * 16384}; pg8::StaticOrder S; S.init(EPB * 16384, 4096, C.G, C.bid);
                    pg8::EpiSiluMul8 E{Hb + (size_t)(k & 1) * H_B, 2048}; pg8::gemm_phase<pg8::EpiSiluMul8, pg8::StaticOrder, true, true>(C.lds, g, S, E); }
                if (k >= 1) { const int e0 = (k - 1) * EPB; __syncthreads();
                    pg8::Gemm g{(const bf16_t*)(Hb + (size_t)((k - 1) & 1) * H_B), (const bf16_t*)(C.ws + WS_EW + OFF_WD8 + (size_t)e0 * 1024 * 2048), EPB * 16384, 1024, 2048, 2048, 2048, big, 0, 6, (size_t)1024 * 2048}; pg8::StaticOrder S; S.init(EPB * 16384, 1024, C.G, C.bid);
                    pg8::EpiYe E{(bf16_t*)(C.ws + WS_Y) + (size_t)e0 * 16384 * DM, (const float*)(C.ws + WS_GSEL) + (size_t)e0 * 16384, 1.f / (pg8::FP8_H_SCALE * pg8::FP8_W2_SCALE)}; pg8::gemm_phase<pg8::EpiYe, pg8::StaticOrder, true>(C.lds, g, S, E); }
            } PH_END
        }
        PH_BEGIN SITE(19) ph_ln<false>(C, l, 1, l + 1 < 2 ? XB0 : nullptr); PH_END
    }
#undef PH_BEGIN
#undef PH_END
#undef XB0
#undef XB1
#undef Yb
#undef Ub
#undef wl
}

extern "C" void kernel_launch(void* const* d_in, const int* in_sizes, int n_in, void* d_out, int out_size, void* d_ws, size_t ws_size, hipStream_t stream) {
    static int grid = 0;
    if (grid == 0) {
        if (n_in != 26 || out_size != NTOK * DM || ws_size < WS_END) { fprintf(stderr, "kernel_launch: unexpected shapes: n_in %d out %d ws %zu (need %zu)\n", n_in, out_size, ws_size, (size_t)WS_END); grid = -1; return; }
        int dev = 0, cus = 0, per_cu = 0;
        if (hipGetDevice(&dev) != hipSuccess || hipDeviceGetAttribute(&cus, hipDeviceAttributeMultiprocessorCount, dev) != hipSuccess) { grid = -1; return; }
        if (hipFuncSetAttribute((const void*)mk_fwd, hipFuncAttributeMaxDynamicSharedMemorySize, LDS_BYTES) != hipSuccess) { fprintf(stderr, "kernel_launch: hipFuncSetAttribute failed\n"); grid = -1; return; }
        if (hipOccupancyMaxActiveBlocksPerMultiprocessor(&per_cu, (const void*)mk_fwd, 512, LDS_BYTES) != hipSuccess || per_cu < 1) { fprintf(stderr, "kernel_launch: occupancy query says %d\n", per_cu); }
        (void)hipGetLastError();
        grid = cus;
    }
    if (grid < 0) return;
    if (hipMemsetAsync((char*)d_ws + WS_CTL, 0, CTL_ZERO_BYTES, stream) != hipSuccess) return;
    Args a{};
    for (int i = 0; i < 26; ++i) a.in[i] = (const float*)d_in[i];
    a.out = (float*)d_out; a.ws = (unsigned char*)d_ws;
#if MK_PER_PHASE_LAUNCH
    for (int p = 0; p < NPH; ++p) { a.ph_lo = p; a.ph_hi = p + 1; hipLaunchKernelGGL(mk_fwd, dim3(grid), dim3(512), LDS_BYTES, stream, a); }
#else
    a.ph_lo = 0; a.ph_hi = NPH; hipLaunchKernelGGL(mk_fwd, dim3(grid), dim3(512), LDS_BYTES, stream, a);
#endif
    const hipError_t le = hipPeekAtLastError();
    if (le != hipSuccess) fprintf(stderr, "kernel_launch: launch failed: %s\n", hipGetErrorName(le));
}
```

```cpp
#include <hip/hip_runtime.h>
#include <cstdio>
#include <cstdint>

#ifndef MK_PER_PHASE_LAUNCH
#define MK_PER_PHASE_LAUNCH 0
#endif

#define LAS __attribute__((address_space(3)))
#define GAS __attribute__((address_space(1)))
typedef unsigned short bf16_t;
typedef short bf16x8 __attribute__((ext_vector_type(8)));
typedef short s16x4 __attribute__((ext_vector_type(4)));
typedef float f32x2 __attribute__((ext_vector_type(2)));
typedef float f32x4 __attribute__((ext_vector_type(4)));
typedef float f32x16 __attribute__((ext_vector_type(16)));
typedef unsigned u32x2 __attribute__((ext_vector_type(2)));
typedef unsigned u32x4 __attribute__((ext_vector_type(4)));
#define DI __device__ __forceinline__
#define LDS_WAIT() asm volatile("s_waitcnt lgkmcnt(0)" ::: "memory")
#define VM_WAIT() asm volatile("s_waitcnt vmcnt(0)" ::: "memory")

constexpr int DM = 1024, NTOK = 131072, NTOKG = 65536, NSEQ = 40, NCHUNK = 1024  ;
constexpr int IN_W = 6992, COL_B = 768, COL_CD = 2048, COL_GATE = 2896;
constexpr int NEXP = 16, DEXP = 2048, CAP = 8192;
constexpr float ALPHA = 1.41421356237309515f, INV_ALPHA = 0.70710678118654752f;
constexpr float LOG2E = 1.4426950408889634f;
constexpr float LN_EPS = 1e-5f, RMS_EPS = 1e-6f;

constexpr size_t MiB = (size_t)1 << 20;
constexpr size_t WS_CTL = 0, CTL_ZERO_BYTES = 1 * MiB;
constexpr size_t WS_KN2 = 256 * 1024;
constexpr size_t WS_WSMALL = 2 * MiB, WSMALL_LAYER = 18 * MiB;
constexpr size_t OFF_WA = 0, OFF_WB = (size_t)768 * 1024 * 2, OFF_WCD = OFF_WB + (size_t)1280 * 1024 * 2, OFF_WG = OFF_WCD + (size_t)1024 * 1024 * 2,
                 OFF_WBR = OFF_WG + (size_t)4096 * 1024 * 2, OFF_WOUT = OFF_WBR + (size_t)4096 * 256 * 2;
static_assert(OFF_WOUT + (size_t)1024 * 1024 * 2 <= WSMALL_LAYER, "small weights");
constexpr size_t WS_WC = 38 * MiB, WC_LAYER = 256 * 1024;
constexpr size_t OFF_WQ = 0, OFF_WKV = 96 * 1024;
constexpr size_t WS_WRG = 39 * MiB;
constexpr size_t WS_AFF = 40 * MiB;
constexpr size_t WS_IDX = 48 * MiB, WS_GSEL = 49 * MiB;
constexpr size_t WS_GAM = 50 * MiB;
constexpr size_t WS_DC = 52 * MiB;
constexpr size_t WS_SM = 56 * MiB;
constexpr size_t WS_XB0 = 64 * MiB, WS_XB1 = 320 * MiB, WS_Y = 576 * MiB, WS_U = 832 * MiB, WS_EW = 1152 * MiB, WS_END = 1344 * MiB;
constexpr size_t OFF_QC = 0, OFF_KC = 48 * MiB, OFF_VC = 96 * MiB;
constexpr size_t OFF_WGU8 = 0, OFF_WD8 = (size_t)16 * 4096 * 1024;

DI unsigned f2bf(float f) { unsigned u = __builtin_bit_cast(unsigned, f); return (u + 0x7fffu + ((u >> 16) & 1u)) >> 16; }
DI unsigned pk2(float lo, float hi) { return f2bf(lo) | (f2bf(hi) << 16); }
DI float bf2f(unsigned short b) { return __builtin_bit_cast(float, ((unsigned)b) << 16); }
DI float bflo(unsigned w) { return __builtin_bit_cast(float, w << 16); }
DI float bfhi(unsigned w) { return __builtin_bit_cast(float, w & 0xffff0000u); }
DI unsigned cvt_pk_bf16(float lo, float hi) { unsigned r; asm volatile("v_cvt_pk_bf16_f32 %0, %1, %2" : "=v"(r) : "v"(lo), "v"(hi)); return r; }
typedef __bf16 bf16x2_t __attribute__((ext_vector_type(2)));
DI unsigned cvt_pk_bf16_b(float lo, float hi) { const f32x2 v = {lo, hi}; const bf16x2_t b = __builtin_convertvector(v, bf16x2_t); return __builtin_bit_cast(unsigned, b); }
DI float sigmoidf_(float x) { return __builtin_amdgcn_rcpf(1.0f + __builtin_amdgcn_exp2f(-x * LOG2E)); }
DI float siluf_(float x) { return x * sigmoidf_(x); }
DI float wave_sum(float v) {
#pragma unroll
    for (int o = 1; o < 64; o <<= 1) v += __shfl_xor(v, o);
    return v;
}
DI float wave_max(float v) {
#pragma unroll
    for (int o = 1; o < 64; o <<= 1) v = fmaxf(v, __shfl_xor(v, o));
    return v;
}
DI int seq_start_row(int s) { return s < 8 ? s * 8192 : 65536 + (s - 8) * 2048; }
DI int row_pos(int row) { return row < 65536 ? (row & 8191) : (row & 2047); }
DI int row_seq_begin(int row) { return row < 65536 ? (row & ~8191) : (row & ~2047); }
DI int row_seq_len(int row) { return row < 65536 ? 8192 : 2048; }

namespace pg8 {
constexpr int BM = 256, BK = 64, HALF = 128, HTB = HALF * BK * 2, STAGE_BYTES = 8 * HTB, NXCD = 8, WGM = 8;
DI int lds_byte(int r, int c) { const int st = (r >> 4) * 2 + (c >> 5), rr = r & 15, cc = c & 31, ob = rr * 64 + cc * 2; return st * 1024 + (ob ^ (((ob >> 9) & 1) << 5)); }
DI void stage_rc(int b, int& R, int& C) { const int st = b / 1024, sb = b % 1024, swz = sb ^ (((sb >> 9) & 1) << 5); R = (st >> 1) * 16 + swz / 64; C = (st & 1) * 32 + (swz % 64) / 2; }
DI int perm32(int rho) { const int n = rho >> 4, i = rho & 15; return 8 * (i >> 2) + 4 * n + (i & 3); }

struct Unit { int pm, pn; };
struct Gemm { const bf16_t* A; const bf16_t* Bt; int M, N, K, lda, ldb, an_shift; size_t an_off; int bm_shift = 30; size_t bm_off = 0; const int* gidx = nullptr; };

struct StaticOrder {
    int nM, nN, nwg, G, c;
    DI void init(int M, int N, int G_, int c_) { nM = M / BM; nN = N / BM; nwg = nM * nN; G = G_; c = c_; }
    DI bool next(int i, Unit& u) const {
        const long L = (long)i * G + c; if (L >= nwg) return false;
        int wgid = (int)L; { const int q = nwg / NXCD, r = nwg % NXCD, xcd = wgid % NXCD, off = wgid / NXCD; wgid = (xcd < r ? xcd * (q + 1) : r * (q + 1) + (xcd - r) * q) + off; }
        const int nig = WGM * nN, gid = wgid / nig, fm = gid * WGM, gsz = (nM - fm) < WGM ? (nM - fm) : WGM;
        u.pm = fm + ((wgid % nig) % gsz); u.pn = (wgid % nig) / gsz; return true;
    }
};

typedef f32x4 Acc[2][2][4][2];

typedef int v8i_t __attribute__((ext_vector_type(8)));
DI void mfma8_tied(f32x4& c, const v8i_t& a, const v8i_t& b) { asm volatile("v_mfma_f32_16x16x128_f8f6f4 %0, %1, %2, %0" : "+v"(c) : "v"(a), "v"(b)); }
DI void glds_sv(const void* sbase, unsigned voff, unsigned lds_dst) { unsigned keep;
    asm volatile("s_mov_b32 %0, m0\n\ts_mov_b32 m0, %3\n\ts_nop 0\n\tglobal_load_lds_dwordx4 %1, %2\n\ts_mov_b32 m0, %0" : "=&s"(keep) : "v"(voff), "s"(sbase), "s"(lds_dst) : "memory"); }
constexpr int GIDX_OFF = 131072 + 1024, GIDX_TILES = 14;
template <class Epi, class Sched, bool FP8 = false, bool GATHER = false>
DI void gemm_phase(LAS unsigned char* lds, const Gemm g, const Sched& S, const Epi& E) {
    int tid = threadIdx.x; asm volatile("" : "+v"(tid));
    const int wid = __builtin_amdgcn_readfirstlane(tid >> 6), lane = tid & 63, wr = wid >> 2, wc = wid & 3, fr = lane & 15, fq = lane >> 4;
    const int K = g.K, nt = FP8 ? K / 128 : K / BK;
    const int pitchA = FP8 ? g.lda : g.lda * 2, pitchB = FP8 ? g.ldb : g.ldb * 2;
    unsigned voffA[2], voffB[2];
#pragma unroll
    for (int i = 0; i < 2; ++i) { int R, C; stage_rc(tid * 16 + i * 8192, R, C); const int Rb = Epi::PERM ? ((R & ~31) + perm32(R & 31)) : R;
        voffA[i] = (unsigned)(R * pitchA + C * 2); voffB[i] = (unsigned)(Rb * pitchB + C * 2); }
    const size_t kstep = (size_t)(BK * 2);
    const size_t hstepA = (size_t)HALF * pitchA, hstepB = (size_t)HALF * pitchB;
    const size_t tstepA = 2 * hstepA, tstepB = 2 * hstepB;
    const unsigned ldsw = (unsigned)wid * 1024u;
    const int aoff = lds_byte(wr * 64 + fr, fq * 8), boff = lds_byte(wc * 32 + fr, fq * 8);
#define PG8_SA(b, h) (((b) * 2 + (h)) * HTB)
#define PG8_SB(b, h) ((4 + (b) * 2 + (h)) * HTB)
#define PG8_STAGE(bufoff, gbase, voff) do { _Pragma("unroll") for (int _i = 0; _i < 2; ++_i) \
        glds_sv((const void*)(gbase), (voff)[_i], (unsigned)(uintptr_t)(lds + (bufoff) + ldsw + _i * 8192)); } while (0)
#define PG8_LD1(p) ([&]() { if constexpr (FP8) { const u32x4 lo_ = *(const LAS u32x4*)(p), hi_ = *(const LAS u32x4*)((p) + 1024); return Frag{__builtin_bit_cast(v8i_t, __builtin_shufflevector(lo_, hi_, 0, 1, 2, 3, 4, 5, 6, 7))}; } \
        else { Frag f_; f_.h[0] = *(const LAS bf16x8*)(p); f_.h[1] = *(const LAS bf16x8*)((p) + 1024); return f_; } }())
#define PG8_LDA(dst, b, h) do { _Pragma("unroll") for (int m = 0; m < 4; ++m) dst[m] = PG8_LD1(lds + PG8_SA(b, h) + aoff + m * 2048); } while (0)
#define PG8_LDB(dst, b, h) do { _Pragma("unroll") for (int n = 0; n < 2; ++n) dst[n] = PG8_LD1(lds + PG8_SB(b, h) + boff + n * 2048); } while (0)
#define PG8_MMA(ai, bj, At, Bt) do { __builtin_amdgcn_s_setprio(1); _Pragma("unroll") for (int m = 0; m < 4; ++m) _Pragma("unroll") for (int n = 0; n < 2; ++n) { \
        if constexpr (FP8) mfma8_tied(acc[ai][bj][m][n], Bt[n].w, At[m].w); \
        else { _Pragma("unroll") for (int k = 0; k < 2; ++k) acc[ai][bj][m][n] = __builtin_amdgcn_mfma_f32_16x16x32_bf16(Bt[n].h[k], At[m].h[k], acc[ai][bj][m][n], 0, 0, 0); } } \
        __builtin_amdgcn_s_setprio(0); } while (0)
#define PG8_WAIT_V(n) asm volatile("s_waitcnt vmcnt(" #n ")" ::: "memory")
#define PG8_WAIT_L(n) asm volatile("s_waitcnt lgkmcnt(" #n ")" ::: "memory")
#define PG8_BAR __builtin_amdgcn_s_barrier()
#define PG8_SCHED __builtin_amdgcn_sched_barrier(0)
    Unit cur, nxt; int ui = 0;
    unsigned vg[2][2] = {{0u, 0u}, {0u, 0u}};
    if constexpr (GATHER) { LAS unsigned* tab = (LAS unsigned*)(lds + GIDX_OFF); Unit u_;
        for (int i = 0; i < GIDX_TILES && S.next(i, u_); ++i) { if (tid < 256) tab[i * 256 + tid] = (unsigned)g.gidx[u_.pm * BM + tid]; }
        __syncthreads(); }
#define PG8_GOFF(ord) do { int tq_ = tid; asm volatile("" : "+v"(tq_)); int R_, C_; stage_rc(tq_ * 16, R_, C_); const LAS unsigned* tb_ = (const LAS unsigned*)(lds + GIDX_OFF) + (ord) * 256 + R_; \
        _Pragma("unroll") for (int h_ = 0; h_ < 2; ++h_) _Pragma("unroll") for (int i_ = 0; i_ < 2; ++i_) vg[h_][i_] = tb_[h_ * 128 + i_ * 64] * (unsigned)pitchA + (unsigned)(C_ * 2); } while (0)
#define PG8_STAGE_A(bufoff, base, h) do { if constexpr (GATHER) PG8_STAGE(bufoff, base, vg[h]); else PG8_STAGE(bufoff, (base) + (h) * hstepA, voffA); } while (0)
    if (!S.next(0, cur)) return;
    if constexpr (GATHER) PG8_GOFF(0);
    float zf = 0.f; asm volatile("" : "+v"(zf));
    Acc acc;
#pragma unroll
    for (int a = 0; a < 2; ++a)
#pragma unroll
        for (int b = 0; b < 2; ++b)
#pragma unroll
            for (int m = 0; m < 4; ++m)
#pragma unroll
                for (int n = 0; n < 2; ++n) acc[a][b][m][n] = (f32x4){zf, zf, zf, zf};
    union Frag { v8i_t w; bf16x8 h[2]; };
    Frag At[4], B0[2], B1[2];
    const char* cA = GATHER ? (const char*)g.A : (const char*)g.A + (size_t)cur.pm * tstepA + (size_t)(cur.pn >> g.an_shift) * g.an_off; const char* cB = (const char*)g.Bt + (size_t)cur.pn * tstepB + (size_t)(cur.pm >> g.bm_shift) * g.bm_off;
    PG8_STAGE(PG8_SB(0, 0), cB, voffB); PG8_STAGE(PG8_SB(0, 1), cB + hstepB, voffB); PG8_STAGE_A(PG8_SA(0, 0), cA, 0); PG8_STAGE_A(PG8_SA(0, 1), cA, 1);
    if (wr == 1) PG8_BAR;
    PG8_WAIT_V(2); PG8_BAR;
    PG8_STAGE(PG8_SB(1, 0), cB + kstep, voffB); PG8_STAGE_A(PG8_SA(1, 0), cA + kstep, 0); PG8_STAGE(PG8_SB(1, 1), cB + hstepB + kstep, voffB);
    PG8_WAIT_V(6); PG8_BAR;
    for (;;) {
        const bool has_next = S.next(ui + 1, nxt);
        const char* nA = (has_next && !GATHER) ? (const char*)g.A + (size_t)nxt.pm * tstepA + (size_t)(nxt.pn >> g.an_shift) * g.an_off : cA;
        const char* nB = has_next ? (const char*)g.Bt + (size_t)nxt.pn * tstepB + (size_t)(nxt.pm >> g.bm_shift) * g.bm_off : cB;
#pragma unroll 1
        for (int t = 0; t < nt; t += 2) {
            const bool last = (t == nt - 2);
            const char* a1 = cA + (size_t)(t + 1) * kstep;
            const char* a2 = last ? nA : cA + (size_t)(t + 2) * kstep; const char* b2 = last ? nB : cB + (size_t)(t + 2) * kstep;
            const char* a3 = a2 + kstep; const char* b3 = b2 + kstep;
            PG8_LDB(B0, 0, 0); PG8_LDB(B1, 0, 1); PG8_SCHED; PG8_LDA(At, 0, 0); PG8_STAGE_A(PG8_SA(1, 1), a1, 1);
            if constexpr (GATHER) { if (last && has_next) PG8_GOFF(ui + 1); }
            PG8_WAIT_V(8); PG8_WAIT_L(0); PG8_BAR; PG8_MMA(0, 0, At, B0); PG8_MMA(0, 1, At, B1); PG8_BAR; PG8_SCHED;
            PG8_LDA(At, 0, 1); PG8_STAGE(PG8_SB(0, 0), b2, voffB); PG8_STAGE(PG8_SB(0, 1), b2 + hstepB, voffB); PG8_STAGE_A(PG8_SA(0, 0), a2, 0);
            PG8_WAIT_V(8); PG8_WAIT_L(0); PG8_BAR; PG8_MMA(1, 0, At, B0); PG8_MMA(1, 1, At, B1); PG8_BAR; PG8_SCHED;
            PG8_LDB(B0, 1, 0); PG8_LDB(B1, 1, 1); PG8_SCHED; PG8_LDA(At, 1, 0); PG8_STAGE_A(PG8_SA(0, 1), a2, 1);
            PG8_WAIT_V(8); PG8_WAIT_L(0); PG8_BAR; PG8_MMA(0, 0, At, B0); PG8_MMA(0, 1, At, B1); PG8_BAR; PG8_SCHED;
            PG8_LDA(At, 1, 1); PG8_STAGE(PG8_SB(1, 0), b3, voffB); PG8_STAGE(PG8_SB(1, 1), b3 + hstepB, voffB); PG8_STAGE_A(PG8_SA(1, 0), a3, 0);
            PG8_WAIT_V(8); PG8_WAIT_L(0); PG8_BAR; PG8_MMA(1, 0, At, B0); PG8_MMA(1, 1, At, B1); PG8_BAR; PG8_SCHED;
        }
        if (wr == 0) PG8_BAR;
        if constexpr (FP8) asm volatile("s_nop 15\n\ts_nop 15" ::: "memory");
        { int tz = tid; asm volatile("" : "+v"(tz));
          const int lz = tz & 63; E(acc, cur, wr, wc, lz & 15, lz >> 4); }
        if (!has_next) break;
#pragma unroll
        for (int a = 0; a < 2; ++a)
#pragma unroll
            for (int b = 0; b < 2; ++b)
#pragma unroll
                for (int m = 0; m < 4; ++m)
#pragma unroll
                    for (int n = 0; n < 2; ++n) acc[a][b][m][n] = (f32x4){0.f, 0.f, 0.f, 0.f};
        cur = nxt; cA = nA; cB = nB; ++ui;
        if (wr == 1) PG8_BAR;
    }
    PG8_WAIT_V(0);
    PG8_BAR;
#undef PG8_SA
#undef PG8_SB
#undef PG8_STAGE
#undef PG8_STAGE_A
#undef PG8_GOFF
#undef PG8_LDA
#undef PG8_LDB
#undef PG8_MMA
#undef PG8_LD1
#undef PG8_WAIT_V
#undef PG8_WAIT_L
#undef PG8_BAR
#undef PG8_SCHED
}

struct EpiProj {
    static constexpr bool PERM = true;
    bf16_t* O; int ldc; int scale_cols; float scale; unsigned* kn2;
    DI void operator()(const Acc& acc, const Unit& u, int wr, int wc, int fr, int fq) const {
        const int row0 = u.pm * BM + wr * 64 + fr, colt = u.pn * BM, col0 = colt + wc * 32 + 8 * fq;
        const float sc = (colt < scale_cols) ? scale : 1.f;
        const bool donorm = (kn2 != nullptr) && (colt == 256);
#pragma unroll
        for (int ai = 0; ai < 2; ++ai) { float mx0 = 0.f, mx1 = 0.f;
#pragma unroll
            for (int m = 0; m < 4; ++m) { bf16_t* rowp = O + (size_t)(row0 + ai * HALF + m * 16) * ldc + col0;
#pragma unroll
                for (int bj = 0; bj < 2; ++bj) { const f32x4 v0 = acc[ai][bj][m][0] * sc, v1 = acc[ai][bj][m][1] * sc;
                    u32x4 w; w.x = cvt_pk_bf16(v0[0], v0[1]); w.y = cvt_pk_bf16(v0[2], v0[3]); w.z = cvt_pk_bf16(v1[0], v1[1]); w.w = cvt_pk_bf16(v1[2], v1[3]);
                    *(u32x4*)(rowp + bj * HALF) = w;
                    if (donorm) { float ss = bflo(w.x) * bflo(w.x) + bfhi(w.x) * bfhi(w.x) + bflo(w.y) * bflo(w.y) + bfhi(w.y) * bfhi(w.y) + bflo(w.z) * bflo(w.z) + bfhi(w.z) * bfhi(w.z) + bflo(w.w) * bflo(w.w) + bfhi(w.w) * bfhi(w.w);
                        ss += __shfl_xor(ss, 16); ss += __shfl_xor(ss, 32); if (bj == 0) mx0 = fmaxf(mx0, ss); else mx1 = fmaxf(mx1, ss); } } }
            if (donorm) {
#pragma unroll
                for (int o = 1; o < 16; o <<= 1) { mx0 = fmaxf(mx0, __shfl_xor(mx0, o)); mx1 = fmaxf(mx1, __shfl_xor(mx1, o)); }
                if (fr == 0 && fq == 0) { const int tile = 4 * u.pm + 2 * ai + wr;
                    atomicMax(kn2 + (size_t)(wc) * 2048 + tile, __builtin_bit_cast(unsigned, mx0)); atomicMax(kn2 + (size_t)(4 + wc) * 2048 + tile, __builtin_bit_cast(unsigned, mx1)); } } }
    }
};
struct EpiSiluMul {
    static constexpr bool PERM = true;
    bf16_t* H; int ldh;
    DI void operator()(const Acc& acc, const Unit& u, int wr, int wc, int fr, int fq) const {
        const int row0 = u.pm * BM + wr * 64 + fr, col0 = u.pn * HALF + wc * 32 + 8 * fq;
#pragma unroll
        for (int ai = 0; ai < 2; ++ai)
#pragma unroll
            for (int m = 0; m < 4; ++m) { bf16_t* rowp = H + (size_t)(row0 + ai * HALF + m * 16) * ldh + col0;
                float h[8];
#pragma unroll
                for (int n = 0; n < 2; ++n)
#pragma unroll
                    for (int j = 0; j < 4; ++j) h[n * 4 + j] = siluf_(acc[ai][0][m][n][j]) * acc[ai][1][m][n][j];
                u32x4 w; w.x = cvt_pk_bf16(h[0], h[1]); w.y = cvt_pk_bf16(h[2], h[3]); w.z = cvt_pk_bf16(h[4], h[5]); w.w = cvt_pk_bf16(h[6], h[7]);
                *(u32x4*)rowp = w; }
    }
};
DI unsigned pk4_fp8(float a, float b, float c, float d) { int w = 0; a = __builtin_amdgcn_fmed3f(a, -448.f, 448.f); b = __builtin_amdgcn_fmed3f(b, -448.f, 448.f); c = __builtin_amdgcn_fmed3f(c, -448.f, 448.f); d = __builtin_amdgcn_fmed3f(d, -448.f, 448.f);     w = __builtin_amdgcn_cvt_pk_fp8_f32(a, b, w, false); w = __builtin_amdgcn_cvt_pk_fp8_f32(c, d, w, true); return (unsigned)w; }
constexpr float FP8_W1_SCALE = 32.f, FP8_W2_SCALE = 64.f, FP8_H_SCALE = 4.f;
struct EpiSiluMul8 {
    static constexpr bool PERM = true;
    unsigned char* H; int ldh;
    DI void operator()(const Acc& acc, const Unit& u, int wr, int wc, int fr, int fq) const {
        const int row0 = u.pm * BM + wr * 64 + fr, col0 = u.pn * HALF + wc * 32 + 8 * fq;
        constexpr float k1 = -LOG2E / FP8_W1_SCALE; static_assert(FP8_W1_SCALE * FP8_W1_SCALE / FP8_H_SCALE == 256.f, "scale folding");
#pragma unroll
        for (int ai = 0; ai < 2; ++ai)
#pragma unroll
            for (int m = 0; m < 4; ++m) { unsigned char* rowp = H + (size_t)(row0 + ai * HALF + m * 16) * ldh + col0;
                float t[8], h[8];
#pragma unroll
                for (int q = 0; q < 8; ++q) t[q] = __builtin_fmaf(acc[ai][0][m][q >> 2][q & 3], k1, 8.f);
#pragma unroll
                for (int q = 0; q < 8; ++q) t[q] = __builtin_amdgcn_exp2f(t[q]);
#pragma unroll
                for (int q = 0; q < 8; ++q) { t[q] += 256.f; h[q] = acc[ai][0][m][q >> 2][q & 3] * acc[ai][1][m][q >> 2][q & 3]; }
#pragma unroll
                for (int q = 0; q < 8; ++q) t[q] = __builtin_amdgcn_rcpf(t[q]);
#pragma unroll
                for (int q = 0; q < 8; ++q) h[q] *= t[q];
                u32x2 w; w.x = pk4_fp8(h[0], h[1], h[2], h[3]); w.y = pk4_fp8(h[4], h[5], h[6], h[7]);
                *(u32x2*)rowp = w; }
    }
};
struct EpiMoeDown {
    static constexpr bool PERM = false;
    float* out; const int* idx; const float* gs; float sc;
    DI void operator()(const Acc& acc, const Unit& u, int wr, int wc, int fr, int fq) const {
        const int row0 = u.pm * BM + wr * 64 + fr, col0 = u.pn * BM + wc * 32 + 4 * fq;
#pragma unroll
        for (int ai = 0; ai < 2; ++ai)
#pragma unroll
            for (int m = 0; m < 4; ++m) { const int rl = row0 + ai * HALF + m * 16; const int tok = idx[rl]; const float g = gs[rl] * sc;
                float* rowp = out + (size_t)tok * DM + col0;
#pragma unroll
                for (int bj = 0; bj < 2; ++bj)
#pragma unroll
                    for (int n = 0; n < 2; ++n) { f32x4* p = (f32x4*)(rowp + bj * HALF + n * 16); f32x4 v = *p; v += acc[ai][bj][m][n] * g; *p = v; }
                asm volatile("" ::: "memory"); }
    }
};
struct EpiYe {
    static constexpr bool PERM = true;
    bf16_t* O; const float* gs; float sc;
    DI void operator()(const Acc& acc, const Unit& u, int wr, int wc, int fr, int fq) const {
        const int row0 = u.pm * BM + wr * 64 + fr, col0 = u.pn * BM + wc * 32 + 8 * fq;
        float gv[8];
#pragma unroll
        for (int c = 0; c < 8; ++c) gv[c] = gs[row0 + (c >> 2) * HALF + (c & 3) * 16];
#pragma unroll
        for (int ai = 0; ai < 2; ++ai)
#pragma unroll
            for (int m = 0; m < 4; ++m) { const int rl = row0 + ai * HALF + m * 16; const float g = gv[ai * 4 + m] * sc; bf16_t* rowp = O + (size_t)rl * DM + col0;
#pragma unroll
                for (int bj = 0; bj < 2; ++bj) { const f32x4 v0 = acc[ai][bj][m][0] * g, v1 = acc[ai][bj][m][1] * g;
                    u32x4 w; w.x = cvt_pk_bf16(v0[0], v0[1]); w.y = cvt_pk_bf16(v0[2], v0[3]); w.z = cvt_pk_bf16(v1[0], v1[1]); w.w = cvt_pk_bf16(v1[2], v1[3]);
                    *(u32x4*)(rowp + bj * HALF) = w; } }
    }
};
struct EpiResid {
    static constexpr bool PERM = false;
    const float* xa; const float* xb; float* out;
    DI void operator()(const Acc& acc, const Unit& u, int wr, int wc, int fr, int fq) const {
        const int row0 = u.pm * BM + wr * 64 + fr, col0 = u.pn * BM + wc * 32 + 4 * fq;
#pragma unroll
        for (int ai = 0; ai < 2; ++ai) {
            f32x4 sv[4][4];
#pragma unroll
            for (int m = 0; m < 4; ++m) { const int r = row0 + ai * HALF + m * 16;
                const float* srow = (r < NTOKG ? xa + (size_t)r * DM : xb + (size_t)(r - NTOKG) * DM) + col0;
#pragma unroll
                for (int q = 0; q < 4; ++q) sv[m][q] = __builtin_nontemporal_load((const f32x4*)(srow + (q >> 1) * HALF + (q & 1) * 16)); }
#pragma unroll
            for (int m = 0; m < 4; ++m) { const int r = row0 + ai * HALF + m * 16; float* orow = out + (size_t)r * DM + col0;
#pragma unroll
                for (int q = 0; q < 4; ++q) __builtin_nontemporal_store(sv[m][q] + acc[ai][q >> 1][m][q & 1] * INV_ALPHA, (f32x4*)(orow + (q >> 1) * HALF + (q & 1) * 16)); } }
    }
};
struct EpiGateMix {
    static constexpr bool PERM = false;
    const bf16_t* Z; bf16_t* mix; float si;
    DI void operator()(const Acc& acc, const Unit& u, int wr, int wc, int fr, int fq) const {
        const int row0 = u.pm * BM + wr * 64 + fr, J0 = u.pn * 64 + wc * 16 + fq * 4;
        u32x2 zall[8][4];
#pragma unroll
        for (int c = 0; c < 8; ++c) { const bf16_t* zrow = Z + (size_t)(row0 + (c >> 2) * HALF + (c & 3) * 16) * 4096 + J0;
#pragma unroll
            for (int b = 0; b < 4; ++b) zall[c][b] = *(const u32x2*)(zrow + b * 1024); }
#pragma unroll
        for (int ai = 0; ai < 2; ++ai)
#pragma unroll
            for (int m = 0; m < 4; ++m) { const int r = row0 + ai * HALF + m * 16;
                u32x2 zw[4];
#pragma unroll
                for (int b = 0; b < 4; ++b) zw[b] = zall[ai * 4 + m][b];
                const float kq = -si * LOG2E; float t[16];
#pragma unroll
                for (int q = 0; q < 16; ++q) t[q] = acc[ai][q >> 3][m][(q >> 2) & 1][q & 3] * kq;
#pragma unroll
                for (int q = 0; q < 16; ++q) t[q] = __builtin_amdgcn_exp2f(t[q]);
#pragma unroll
                for (int q = 0; q < 16; ++q) t[q] += 1.f;
#pragma unroll
                for (int q = 0; q < 16; ++q) t[q] = __builtin_amdgcn_rcpf(t[q]);
                f32x4 s = (f32x4){0.f, 0.f, 0.f, 0.f};
#pragma unroll
                for (int b = 0; b < 4; ++b) { s[0] += t[4 * b] * bflo(zw[b].x); s[1] += t[4 * b + 1] * bfhi(zw[b].x); s[2] += t[4 * b + 2] * bflo(zw[b].y); s[3] += t[4 * b + 3] * bfhi(zw[b].y); }
                u32x2 w; w.x = cvt_pk_bf16(s[0], s[1]); w.y = cvt_pk_bf16(s[2], s[3]);
                *(u32x2*)(mix + (size_t)r * DM + J0) = w; }
    }
};
}

#define XB_TMO      128
#define XB_XCNT(j)  (256  + 64 * (j))
#define XB_XSUB(j)  (1280 + 64 * (j))
#define XB_XGEN(j)  (2304 + 64 * (j))
#define XB_TOP      3328
#define XB_TOPGEN   3392
#define XCD_BAR_WORDS 3456
#define XB_SPIN_CAP (1u << 24)
DI unsigned xb_ld(unsigned* p)              { return __hip_atomic_load(p, __ATOMIC_RELAXED, __HIP_MEMORY_SCOPE_AGENT); }
DI unsigned xb_add(unsigned* p, unsigned v) { return __hip_atomic_fetch_add(p, v, __ATOMIC_RELAXED, __HIP_MEMORY_SCOPE_AGENT); }
DI unsigned xb_xcc_id() { return (unsigned)__builtin_amdgcn_s_getreg((3 << 11) | 20) & 0xFu; }
#define XB_SPIN(cond, bar) do { unsigned _sp = 0; while (cond) { __builtin_amdgcn_s_sleep(1); \
    if ((++_sp & 255u) == 0u) { if (xb_ld(&(bar)[XB_TMO])) break; if (_sp > XB_SPIN_CAP) { atomicAdd(&(bar)[XB_TMO], 1u); break; } } } } while (0)
struct XcdBarrier { unsigned* bar; unsigned x; volatile LAS unsigned* st; };
DI XcdBarrier xcd_barrier_post(unsigned* bar, volatile LAS unsigned* st) {
    XcdBarrier b; b.bar = bar; b.x = xb_xcc_id(); b.st = st;
    if (threadIdx.x == 0) (void)xb_add(&bar[XB_XCNT(b.x)], 1u);
    return b;
}
DI void xcd_barrier_complete(unsigned* bar, unsigned x, unsigned& nloc, unsigned& nx) {
    const unsigned G = gridDim.x * gridDim.y * gridDim.z;
    unsigned sum, cnt, mine, sp = 0u;
    for (;;) {
        sum = 0u; cnt = 0u; mine = 0u;
#pragma unroll
        for (unsigned j = 0; j < 16; ++j) { const unsigned c = xb_ld(&bar[XB_XCNT(j)]); sum += c; cnt += (c > 0u) ? 1u : 0u; mine = (j == x) ? c : mine; }
        if (sum == G) break;
        __builtin_amdgcn_s_sleep(1);
        if ((++sp & 255u) == 0u) { if (xb_ld(&bar[XB_TMO])) break; if (sp > XB_SPIN_CAP) { atomicAdd(&bar[XB_TMO], 1u); break; } }
    }
    nloc = mine > 0u ? mine : 1u; nx = cnt > 0u ? cnt : 1u;
}
DI void xcd_barrier(const XcdBarrier& b) {
    asm volatile("s_waitcnt vmcnt(0)" ::: "memory");
    __syncthreads();
    if (threadIdx.x == 0) {
        unsigned* bar = b.bar;
        __builtin_amdgcn_s_waitcnt(0);
        unsigned nloc = b.st[0], nx = b.st[1];
        if (nloc == 0u) { xcd_barrier_complete(bar, b.x, nloc, nx); b.st[0] = nloc; b.st[1] = nx; }
        const unsigned old = xb_add(&bar[XB_XSUB(b.x)], 1u);
        const unsigned gen = old / nloc;
        if (old + 1u == (gen + 1u) * nloc) {
            __builtin_amdgcn_fence(__ATOMIC_RELEASE, "agent");
            asm volatile("s_waitcnt vmcnt(0)" ::: "memory");
            const unsigned og = xb_add(&bar[XB_TOP], 1u);
            const unsigned tg = og / nx;
            if (og + 1u == (tg + 1u) * nx) xb_add(&bar[XB_TOPGEN], 1u);
            else XB_SPIN(xb_ld(&bar[XB_TOPGEN]) == tg, bar);
            __builtin_amdgcn_fence(__ATOMIC_ACQUIRE, "agent");
            xb_add(&bar[XB_XGEN(b.x)], 1u);
            asm volatile("s_waitcnt vmcnt(0)" ::: "memory");
        } else {
            XB_SPIN(xb_ld(&bar[XB_XGEN(b.x)]) == gen, bar);
            __builtin_amdgcn_fence(__ATOMIC_ACQUIRE, "agent");
            asm volatile("s_waitcnt vmcnt(0)" ::: "memory");
        }
    }
    __syncthreads();
}

struct Args { const float* in[26]; float* out; unsigned char* ws; int ph_lo, ph_hi; };
struct Ctx {
    LAS unsigned char* lds;
    GAS unsigned char* ws;
    int tid, lane, wave, G, bid, gw, NGW;
    const struct Args* A;
    GAS float* out;
};
constexpr int RING_BYTES = 131072, MISC_OFF = RING_BYTES + 320, LDS_BYTES = 147456;

DI void tr_item(const float* __restrict__ W, int ldw, int k0, int src, const float* kscale, bf16_t* WT, int ldt, int orow0, LAS float* scr, int lane) {
    float tv[32];
#pragma unroll
    for (int i = 0; i < 32; ++i) { const int kk = 2 * i + (lane >> 5); tv[i] = (src >= 0) ? W[(size_t)(k0 + kk) * ldw + src] : 0.f; }
#pragma unroll
    for (int i = 0; i < 32; ++i) { const int kk = 2 * i + (lane >> 5); float v = tv[i]; if (kscale) v *= kscale[k0 + kk]; scr[kk * 33 + (lane & 31)] = v; }
    LDS_WAIT();
    const int c = lane & 7;
#pragma unroll
    for (int j = 0; j < 4; ++j) { const int n = (lane >> 3) + 8 * j; const LAS float* s = scr + (8 * c) * 33 + n;
        u32x4 o; o.x = pk2(s[0 * 33], s[1 * 33]); o.y = pk2(s[2 * 33], s[3 * 33]); o.z = pk2(s[4 * 33], s[5 * 33]); o.w = pk2(s[6 * 33], s[7 * 33]);
        *(u32x4*)(WT + (size_t)(orow0 + n) * ldt + k0 + 8 * c) = o; }
    LDS_WAIT();
}
DI void tr_item8(const float* __restrict__ W, int ldw, int k0, int src, float scale, unsigned char* WT, int ldt, int orow0, LAS float* scr, int lane) {
    float tv[32];
#pragma unroll
    for (int i = 0; i < 32; ++i) { const int kk = 2 * i + (lane >> 5); tv[i] = __builtin_nontemporal_load(&W[(size_t)(k0 + kk) * ldw + src]); }
#pragma unroll
    for (int i = 0; i < 32; ++i) { const int kk = 2 * i + (lane >> 5); scr[kk * 33 + (lane & 31)] = tv[i] * scale; }
    LDS_WAIT();
    const int c = lane & 7;
#pragma unroll
    for (int j = 0; j < 4; ++j) { const int n = (lane >> 3) + 8 * j; const LAS float* s = scr + (8 * c) * 33 + n;
        u32x2 o; o.x = pg8::pk4_fp8(s[0 * 33], s[1 * 33], s[2 * 33], s[3 * 33]); o.y = pg8::pk4_fp8(s[4 * 33], s[5 * 33], s[6 * 33], s[7 * 33]);
        *(u32x2*)(WT + (size_t)(orow0 + n) * ldt + k0 + 8 * c) = o; }
    LDS_WAIT();
}
constexpr int SW_ITEMS[8] = {16 * 24, 16 * 40, 16 * 32, 16 * 128, 4 * 4 * 32, 16 * 32, 3 * 6, 2 * 12};
constexpr int SW_TOTAL = 16 * 24 + 16 * 40 + 16 * 32 + 16 * 128 + 4 * 4 * 32 + 16 * 32 + 3 * 6 + 2 * 12;
DI void small_weight_item(const Ctx& C, int l, int it, LAS float* scr) {
    unsigned char* wl = (unsigned char*)(C.ws + WS_WSMALL + (size_t)l * WSMALL_LAYER); unsigned char* wc = (unsigned char*)(C.ws + WS_WC + (size_t)l * WC_LAYER);
    const float* win = C.A->in[2] + (size_t)l * DM * IN_W; const int ln = C.lane & 31;
    if (it < 384) { const int kb = it / 24, nb = it % 24; tr_item(win, IN_W, kb * 64, nb * 32 + ln, nullptr, (bf16_t*)(wl + OFF_WA), 1024, nb * 32, scr, C.lane); return; } it -= 384;
    if (it < 640) { const int kb = it / 40, nb = it % 40; tr_item(win, IN_W, kb * 64, COL_B + nb * 32 + ln, nullptr, (bf16_t*)(wl + OFF_WB), 1024, nb * 32, scr, C.lane); return; } it -= 640;
    if (it < 512) { const int kb = it / 32, nb = it % 32; const int n = nb * 32 + ln; tr_item(win, IN_W, kb * 64, n < 848 ? COL_CD + n : -1, nullptr, (bf16_t*)(wl + OFF_WCD), 1024, nb * 32, scr, C.lane); return; } it -= 512;
    if (it < 2048) { const int kb = it / 128, nb = it % 128; const int n = nb * 32 + ln, pn = n >> 8, c = n & 255;
        const int bj = c >> 7, wcc = (c >> 5) & 3, nn = (c >> 4) & 1, fq = (c >> 2) & 3, j = c & 3;
        const int src = COL_GATE + (2 * bj + nn) * 1024 + 64 * pn + 16 * wcc + 4 * fq + j;
        tr_item8(win, IN_W, kb * 64, src, pg8::FP8_W1_SCALE, wl + OFF_WG, 1024, nb * 32, scr, C.lane); return; } it -= 2048;
    if (it < 512) { const int b = it / 128, r = it % 128, kb = r / 32, nb = r % 32;
        tr_item(C.A->in[18] + (size_t)(l * 4 + b) * 256 * 1024, 1024, kb * 64, nb * 32 + ln, nullptr, (bf16_t*)(wl + OFF_WBR), 256, b * 1024 + nb * 32, scr, C.lane); return; } it -= 512;
    if (it < 512) { const int kb = it / 32, nb = it % 32; tr_item(C.A->in[19] + (size_t)l * DM * DM, 1024, kb * 64, nb * 32 + ln, nullptr, (bf16_t*)(wl + OFF_WOUT), 1024, nb * 32, scr, C.lane); return; } it -= 512;
    if (it < 18) { const int kb = it / 6, nb = it % 6; tr_item(C.A->in[8] + (size_t)l * 192 * 192, 192, kb * 64, nb * 32 + ln, C.A->in[7] + l * 192, (bf16_t*)(wc + OFF_WQ), 192, nb * 32, scr, C.lane); return; } it -= 18;
    { const int kb = it / 12, nb = it % 12; tr_item(C.A->in[10] + (size_t)l * 128 * 384, 384, kb * 64, nb * 32 + ln, C.A->in[9] + l * 128, (bf16_t*)(wc + OFF_WKV), 128, nb * 32, scr, C.lane); }
}
DI void ph_prologue(const Ctx& C) {
    LAS float* scr = (LAS float*)(C.lds + C.wave * 16384);
    for (int it = C.gw; it < 2 * SW_TOTAL; it += C.NGW) small_weight_item(C, it / SW_TOTAL, it % SW_TOTAL, scr);
    for (int it = C.gw; it < 2 * 2 * 4 * 2 * 4 * 2; it += C.NGW) {
        const int ks = it & 1, nt = (it >> 1) & 3, gt = (it >> 3) & 1, n = (it >> 4) & 3, dir = (it >> 6) & 1, l = it >> 7;
        const float* wp = (gt == 0 ? C.A->in[13] : C.A->in[15]) + ((size_t)((l * 2 + dir) * 4 + n) * 64) * 64;
        const int l15 = C.lane & 15, g = C.lane >> 4; u32x4 wv;
#pragma unroll
        for (int p = 0; p < 4; ++p) { const int k = 32 * ks + 8 * g + 2 * p; wv[p] = cvt_pk_bf16(wp[(size_t)k * 64 + 16 * nt + l15], wp[(size_t)(k + 1) * 64 + 16 * nt + l15]); }
        ((u32x4*)(C.ws + WS_WRG))[(size_t)it * 64 + C.lane] = wv;
    }
    bf16_t* XB0 = (bf16_t*)(C.ws + WS_XB0);
    for (int row0 = C.gw; row0 < NTOK; row0 += 4 * C.NGW) {
        f32x4 v[4][4];
#pragma unroll
        for (int i = 0; i < 4; ++i) { const int row = min(row0 + i * C.NGW, NTOK - 1);
            const float* src = row < NTOKG ? C.A->in[0] + (size_t)row * DM : C.A->in[1] + (size_t)(row - NTOKG) * DM; const f32x4* xr = (const f32x4*)src + C.lane;
#pragma unroll
            for (int j = 0; j < 4; ++j) v[i][j] = __builtin_nontemporal_load(&xr[64 * j]); }
#pragma unroll
        for (int i = 0; i < 4; ++i) { const int row = row0 + i * C.NGW; if (row < NTOK) { u32x2* o = (u32x2*)(XB0 + (size_t)row * DM) + C.lane;
#pragma unroll
            for (int j = 0; j < 4; ++j) { u32x2 w; w.x = cvt_pk_bf16(v[i][j][0], v[i][j][1]); w.y = cvt_pk_bf16(v[i][j][2], v[i][j][3]); o[64 * j] = w; } } }
    }
}
DI void expert_weight_items(const Ctx& C, int l) {
    __syncthreads();
    LAS float* scr = (LAS float*)(C.lds + C.wave * 16384);
    unsigned char* WGU = (unsigned char*)(C.ws + WS_EW + OFF_WGU8); unsigned char* WD = (unsigned char*)(C.ws + WS_EW + OFF_WD8);
    const int ln = C.lane & 31;
    const int gw0 = (C.G > 64) ? C.gw - 32 * 8 : C.gw, ngw = (C.G > 64) ? C.NGW - 32 * 8 : C.NGW;
    for (int it = gw0; it < 32768 + 16384; it += ngw) {
        if (it < 32768) { const int e = it >> 11, r = it & 2047, kb = r >> 7, nb = r & 127; const int n = nb * 32 + ln, pn = n >> 8, c = n & 255;
            const float* W = (c < 128 ? C.A->in[23] : C.A->in[24]) + (size_t)(l * NEXP + e) * DM * DEXP;
            tr_item8(W, DEXP, kb * 64, 128 * pn + (c & 127), pg8::FP8_W1_SCALE, WGU + (size_t)e * 4096 * 1024, 1024, nb * 32, scr, C.lane);
        } else { const int i2 = it - 32768, e = i2 >> 10, r = i2 & 1023, kb = r >> 5, nb = r & 31;
            tr_item8(C.A->in[25] + (size_t)(l * NEXP + e) * DEXP * DM, DM, kb * 64, nb * 32 + ln, pg8::FP8_W2_SCALE, WD + (size_t)e * 1024 * 2048, 2048, nb * 32, scr, C.lane); }
    }
}

template <bool ROUTER>
DI void ph_ln(const Ctx& C, int l, int which, bf16_t* XB) {
    LAS float* wr = (LAS float*)C.lds;
    if (ROUTER) { const float* src = C.A->in[22] + (size_t)l * DM * NEXP;
        for (int t = C.tid; t < DM * NEXP / 4; t += 512) { const int k = t >> 2, q = t & 3, ln = (k & 255) >> 2, ii = k & 3, jj = k >> 8;
            ((LAS f32x4*)wr)[((jj * 4 + ii) * 4 + q) * 64 + ln] = ((const f32x4*)src)[t]; }
        __syncthreads(); }
    const float* gp = C.A->in[20] + (size_t)(l * 2 + which) * DM; const float* bp = C.A->in[21] + (size_t)(l * 2 + which) * DM;
    f32x4 gv[4], bv[4];
#pragma unroll
    for (int j = 0; j < 4; ++j) { gv[j] = ((const f32x4*)gp)[C.lane + 64 * j]; bv[j] = ((const f32x4*)bp)[C.lane + 64 * j]; }
    float* affT = (float*)(C.ws + WS_AFF);
    f32x4 nx[4], ny[4], nz[4], nw[4];
    { const f32x4* xr0 = (const f32x4*)(C.out + (size_t)C.gw * DM) + C.lane;
#pragma unroll
      for (int j = 0; j < 4; ++j) nx[j] = __builtin_nontemporal_load(&xr0[64 * j]);
      { const f32x4* xr1 = (const f32x4*)(C.out + (size_t)min(C.gw + C.NGW, NTOK - 1) * DM) + C.lane;
#pragma unroll
          for (int j = 0; j < 4; ++j) ny[j] = __builtin_nontemporal_load(&xr1[64 * j]); }
      { const f32x4* xr2 = (const f32x4*)(C.out + (size_t)min(C.gw + 2 * C.NGW, NTOK - 1) * DM) + C.lane;
#pragma unroll
          for (int j = 0; j < 4; ++j) nz[j] = __builtin_nontemporal_load(&xr2[64 * j]); }
      { const f32x4* xr3 = (const f32x4*)(C.out + (size_t)min(C.gw + 3 * C.NGW, NTOK - 1) * DM) + C.lane;
#pragma unroll
          for (int j = 0; j < 4; ++j) nw[j] = __builtin_nontemporal_load(&xr3[64 * j]); } }
    u32x4 sm0 = {0u, 0u, 0u, 0u}, sm1 = {0u, 0u, 0u, 0u};
    if (!ROUTER) { const u32x4* smr = (const u32x4*)(C.ws + WS_SM + (size_t)C.gw * 32); sm0 = smr[0]; sm1 = smr[1]; }
    for (int row = C.gw; row < NTOK; row += C.NGW) {
        f32x4* xr = (f32x4*)(C.out + (size_t)row * DM) + C.lane;
        f32x4 v[4]; float s = 0.f;
#pragma unroll
        for (int j = 0; j < 4; ++j) v[j] = nx[j] * ALPHA;
        if (!ROUTER) {
            const unsigned sw[8] = {sm0.x, sm0.y, sm0.z, sm0.w, sm1.x, sm1.y, sm1.z, sm1.w};
            { const u32x4* smr = (const u32x4*)(C.ws + WS_SM + (size_t)min(row + C.NGW, NTOK - 1) * 32); sm0 = smr[0]; sm1 = smr[1]; }
            const bf16_t* YE = (const bf16_t*)(C.ws + WS_Y); const int gofs = (row >> 16) * CAP;
            unsigned msk = 0u;
#pragma unroll
            for (int e = 0; e < 16; ++e) { const int slot = (int)(short)((e & 1) ? (sw[e >> 1] >> 16) : (sw[e >> 1] & 0xffffu)); if (slot >= 0) msk |= 1u << e; }
            msk = (unsigned)__builtin_amdgcn_readfirstlane((int)msk);
            while (msk) {
                const int e1 = __builtin_ctz(msk); msk &= msk - 1u; const bool two = msk != 0u; const int e2 = two ? __builtin_ctz(msk) : e1; if (two) msk &= msk - 1u;
                unsigned w1 = sw[0], w2 = sw[0];
#pragma unroll
                for (int q = 1; q < 8; ++q) { w1 = ((e1 >> 1) == q) ? sw[q] : w1; w2 = ((e2 >> 1) == q) ? sw[q] : w2; }
                const int s1 = (int)((e1 & 1) ? (w1 >> 16) : (w1 & 0xffffu)), s2 = (int)((e2 & 1) ? (w2 >> 16) : (w2 & 0xffffu));
                const u32x2* y1 = (const u32x2*)(YE + ((size_t)e1 * 16384 + gofs + s1) * DM) + C.lane; const u32x2* y2 = (const u32x2*)(YE + ((size_t)e2 * 16384 + gofs + s2) * DM) + C.lane;
                u32x2 a[4], b[4];
#pragma unroll
                for (int j = 0; j < 4; ++j) { a[j] = __builtin_nontemporal_load(&y1[64 * j]); b[j] = __builtin_nontemporal_load(&y2[64 * j]); }
                const float f2 = two ? 1.f : 0.f;
#pragma unroll
                for (int j = 0; j < 4; ++j) { v[j][0] += bflo(a[j].x) + f2 * bflo(b[j].x); v[j][1] += bfhi(a[j].x) + f2 * bfhi(b[j].x); v[j][2] += bflo(a[j].y) + f2 * bflo(b[j].y); v[j][3] += bfhi(a[j].y) + f2 * bfhi(b[j].y); }
            }
        }
#pragma unroll
        for (int j = 0; j < 4; ++j) s += (v[j][0] + v[j][1]) + (v[j][2] + v[j][3]);
#pragma unroll
        for (int j = 0; j < 4; ++j) { nx[j] = ny[j]; ny[j] = nz[j]; nz[j] = nw[j]; }
        { const int rn = row + 4 * C.NGW < NTOK ? row + 4 * C.NGW : row; const f32x4* xn = (const f32x4*)(C.out + (size_t)rn * DM) + C.lane;
#pragma unroll
            for (int j = 0; j < 4; ++j) nw[j] = __builtin_nontemporal_load(&xn[64 * j]); }
        const float mean = wave_sum(s) * (1.f / DM); float s2 = 0.f;
#pragma unroll
        for (int j = 0; j < 4; ++j) { v[j] = v[j] - mean; s2 += (v[j][0] * v[j][0] + v[j][1] * v[j][1]) + (v[j][2] * v[j][2] + v[j][3] * v[j][3]); }
        const float rstd = 1.0f / sqrtf(wave_sum(s2) * (1.f / DM) + LN_EPS);
        u32x2* o8 = (u32x2*)(XB + (size_t)row * DM) + C.lane; unsigned* o4 = (unsigned*)((unsigned char*)XB + (size_t)row * DM) + C.lane;
#pragma unroll
        for (int j = 0; j < 4; ++j) { v[j] = v[j] * rstd * gv[j] + bv[j]; __builtin_nontemporal_store(v[j], &xr[64 * j]);
            if constexpr (ROUTER) { o4[64 * j] = pg8::pk4_fp8(v[j][0], v[j][1], v[j][2], v[j][3]); asm volatile("" ::: "memory"); }
            else if (XB) { u32x2 w; w.x = cvt_pk_bf16(v[j][0], v[j][1]); w.y = cvt_pk_bf16(v[j][2], v[j][3]); o8[64 * j] = w; } }
        if (ROUTER) {
            float p[16];
#pragma unroll
            for (int e = 0; e < 16; ++e) p[e] = 0.f;
#pragma unroll
            for (int j = 0; j < 4; ++j)
#pragma unroll
                for (int i = 0; i < 4; ++i) { const float xv = v[j][i];
#pragma unroll
                    for (int q = 0; q < 4; ++q) { const f32x4 w4 = ((const LAS f32x4*)wr)[((j * 4 + i) * 4 + q) * 64 + C.lane]; p[4 * q] += xv * w4[0]; p[4 * q + 1] += xv * w4[1]; p[4 * q + 2] += xv * w4[2]; p[4 * q + 3] += xv * w4[3]; } }
            const bool b5 = (C.lane & 32) != 0, b4 = (C.lane & 16) != 0, b3 = (C.lane & 8) != 0, b2 = (C.lane & 4) != 0;
            float r8[8], r4[4], r2[2], lg;
#pragma unroll
            for (int i = 0; i < 8; ++i) { const float keep = b5 ? p[8 + i] : p[i], send = b5 ? p[i] : p[8 + i]; r8[i] = keep + __shfl_xor(send, 32); }
#pragma unroll
            for (int i = 0; i < 4; ++i) { const float keep = b4 ? r8[4 + i] : r8[i], send = b4 ? r8[i] : r8[4 + i]; r4[i] = keep + __shfl_xor(send, 16); }
#pragma unroll
            for (int i = 0; i < 2; ++i) { const float keep = b3 ? r4[2 + i] : r4[i], send = b3 ? r4[i] : r4[2 + i]; r2[i] = keep + __shfl_xor(send, 8); }
            { const float keep = b2 ? r2[1] : r2[0], send = b2 ? r2[0] : r2[1]; lg = keep + __shfl_xor(send, 4); }
            lg += __shfl_xor(lg, 2); lg += __shfl_xor(lg, 1);
            float mx = lg;
            mx = fmaxf(mx, __shfl_xor(mx, 4)); mx = fmaxf(mx, __shfl_xor(mx, 8)); mx = fmaxf(mx, __shfl_xor(mx, 16)); mx = fmaxf(mx, __shfl_xor(mx, 32));
            const float ex = __expf(lg - mx); float den = ex;
            den += __shfl_xor(den, 4); den += __shfl_xor(den, 8); den += __shfl_xor(den, 16); den += __shfl_xor(den, 32);
            const int eL = (b5 ? 8 : 0) + (b4 ? 4 : 0) + (b3 ? 2 : 0) + (b2 ? 1 : 0);
            if ((C.lane & 3) == 0) affT[((size_t)(row >> 16) * 16 + eL) * NTOKG + (row & 65535)] = ex / den;
            if (C.lane < 8) ((unsigned*)(C.ws + WS_SM))[(size_t)row * 8 + C.lane] = 0xFFFFFFFFu;
        }
    }
}

namespace att {
DI int crow(int r, int hi) { return (r & 3) + 8 * (r >> 2) + 4 * hi; }
DI int v_st(int k, int c) { const int kk = (k & ~0xC) | ((k & 4) << 1) | ((k & 8) >> 1); return ((kk >> 3) * 2 + (c >> 5)) * 512 + ((kk & 7) * 32 + (c & 31)) * 2; }
DI int v_rd_base(int lane) { return ((lane & 3) << 3) | (((lane >> 2) & 3) << 6) | (((lane >> 4) & 1) << 5) | (((lane >> 5) & 1) << 8); }
constexpr int v_rd_off(int d0, int ks, int half) { return d0 * 512 + ks * 2048 + half * 1024; }
template <int OFF> DI s16x4 tr_read(int vb) { s16x4 r; asm volatile("ds_read_b64_tr_b16 %0, %1 offset:%2" : "=&v"(r) : "v"(vb), "i"(OFF) : "memory"); return r; }
template <int D0> DI void pv_one(f32x16& od, int vb, bf16x8 pa0, bf16x8 pa1, bf16x8 pa2, bf16x8 pa3) {
    const s16x4 l0 = tr_read<v_rd_off(D0, 0, 0)>(vb), h0 = tr_read<v_rd_off(D0, 0, 1)>(vb), l1 = tr_read<v_rd_off(D0, 1, 0)>(vb), h1 = tr_read<v_rd_off(D0, 1, 1)>(vb);
    const s16x4 l2 = tr_read<v_rd_off(D0, 2, 0)>(vb), h2 = tr_read<v_rd_off(D0, 2, 1)>(vb), l3 = tr_read<v_rd_off(D0, 3, 0)>(vb), h3 = tr_read<v_rd_off(D0, 3, 1)>(vb);
    asm volatile("s_waitcnt lgkmcnt(0)" ::: "memory"); __builtin_amdgcn_sched_barrier(0);
#define PKV(L, H) (bf16x8){L[0], L[1], L[2], L[3], H[0], H[1], H[2], H[3]}
    od = __builtin_amdgcn_mfma_f32_32x32x16_bf16(pa0, PKV(l0, h0), od, 0, 0, 0);
    od = __builtin_amdgcn_mfma_f32_32x32x16_bf16(pa1, PKV(l1, h1), od, 0, 0, 0);
    od = __builtin_amdgcn_mfma_f32_32x32x16_bf16(pa2, PKV(l2, h2), od, 0, 0, 0);
    od = __builtin_amdgcn_mfma_f32_32x32x16_bf16(pa3, PKV(l3, h3), od, 0, 0, 0);
#undef PKV
}
DI void pv_ones(f32x16& o2, bf16x8 pa0, bf16x8 pa1, bf16x8 pa2, bf16x8 pa3) {
    const u32x4 onesw = {0x3F803F80u, 0x3F803F80u, 0x3F803F80u, 0x3F803F80u}; const bf16x8 ones = __builtin_bit_cast(bf16x8, onesw);
    o2 = __builtin_amdgcn_mfma_f32_32x32x16_bf16(pa0, ones, o2, 0, 0, 0); o2 = __builtin_amdgcn_mfma_f32_32x32x16_bf16(pa1, ones, o2, 0, 0, 0);
    o2 = __builtin_amdgcn_mfma_f32_32x32x16_bf16(pa2, ones, o2, 0, 0, 0); o2 = __builtin_amdgcn_mfma_f32_32x32x16_bf16(pa3, ones, o2, 0, 0, 0);
}
constexpr int KROW(int KS) { return KS * 32 + 16; }
constexpr int KTILE = 64 * 112, VTILE = 8192, LDS_ATT = 2 * KTILE + 2 * VTILE + 8 * 256;

DI void split3(float x, unsigned& w_hm, unsigned& w_l0) {
    const unsigned h = f2bf(x); const float r1 = x - __builtin_bit_cast(float, h << 16);
    const unsigned m = f2bf(r1); const float r2 = r1 - __builtin_bit_cast(float, m << 16);
    const unsigned l = f2bf(r2);
    w_hm = h | (m << 16); w_l0 = l;
}
template <int KS, bool ALIBI>
DI void attn_unit(const bf16_t* __restrict__ Qb, int ldq, const bf16_t* __restrict__ Kb, int ldk, const bf16_t* __restrict__ Vb, int ldv,
                  bf16_t* __restrict__ Ob, int ldo, int seq_len, int q0, float slope2, const unsigned* __restrict__ kn2, LAS unsigned char* lds) {
    int tid = threadIdx.x; asm volatile("" : "+v"(tid));
    const int wid = tid >> 6, lane = tid & 63, r32 = lane & 31, hi = lane >> 5;
    LAS unsigned char* K_lds = lds; LAS unsigned char* V_lds = lds + 2 * KTILE;
    LAS float* wsl = (LAS float*)(lds + 2 * KTILE + 2 * VTILE) + wid * 64; LAS float* li_l = wsl; LAS float* al_l = wsl + 32;
    LAS float* blk = (LAS float*)(lds + LDS_ATT);
    LAS int* tl = (LAS int*)(lds + LDS_ATT + 128);
    constexpr int KR = KROW(KS), KP = 2 * KS;
    constexpr float THR = 8.f, SKIP = -40.f;
    float mt = 0.f; f32x16 o[3];
#pragma unroll
    for (int d = 0; d < 3; ++d)
#pragma unroll
        for (int r = 0; r < 16; ++r) o[d][r] = 0.f;
    bf16x8 qr[KS];
    const bf16_t* Qw = Qb + (size_t)(wid * 32 + r32) * ldq + hi * 8;
#pragma unroll
    for (int d0 = 0; d0 < KS; ++d0) qr[d0] = *(const bf16x8*)(Qw + d0 * 16);
    if (ALIBI) { float qn = 0.f;
#pragma unroll
        for (int d0 = 0; d0 < KS; ++d0)
#pragma unroll
            for (int j = 0; j < 8; ++j) { const float f = bf2f((unsigned short)qr[d0][j]); qn += f * f; }
        qn += __shfl_xor(qn, 32); qn = wave_max(qn); if (lane == 0) blk[wid] = qn; }
    const int vkey = tid >> 3, vcol = (tid & 7) * 8, vst = v_st(vkey, vcol);
    const bool kact = tid < 64 * KP; const int kkey = kact ? tid / KP : 0, kpc = kact ? tid % KP : 0;
    const int vb0 = (int)(uintptr_t)V_lds + v_rd_base(lane);
    const int w0 = q0 + wid * 32; const float qpos = (float)(w0 + r32);
    const int NT = seq_len / 64, jd0 = q0 >> 6;
    bf16x8 kx0, kx1;
    { u32x4 a = {0u, 0u, 0u, 0u}, b = {0u, 0u, 0u, 0u};
        if (hi == 0) {
            a.z = 0x3F803F80u; a.w = 0x00003F80u; b.z = 0x3F803F80u; b.w = 0x00003F80u;
            if (ALIBI) { const float c0 = slope2 * (float)r32, c1 = slope2 * (float)(32 + r32);
                const unsigned h0 = f2bf(c0), l0 = f2bf(c0 - __builtin_bit_cast(float, h0 << 16)), h1 = f2bf(c1), l1 = f2bf(c1 - __builtin_bit_cast(float, h1 << 16));
                a.x = h0 | (l0 << 16); a.y = (h0 | (l0 << 16)) ^ 0x80008000u; b.x = h1 | (l1 << 16); b.y = (h1 | (l1 << 16)) ^ 0x80008000u; } }
        kx0 = __builtin_bit_cast(bf16x8, a); kx1 = __builtin_bit_cast(bf16x8, b); }
    bf16x8 vs, ks_;
    bool first = true;
#define SLOAD(k0) do { vs = *(const bf16x8*)(Vb + (size_t)((k0) + vkey) * ldv + vcol); ks_ = *(const bf16x8*)(Kb + (size_t)((k0) + kkey) * ldk + kpc * 8); } while (0)
#define SWRITE(b) do { *(LAS bf16x8*)(V_lds + (b) * VTILE + vst) = vs; if (kact) *(LAS bf16x8*)(K_lds + (b) * KTILE + kkey * KR + kpc * 16) = ks_; } while (0)
#define PK4(P, BASE, OUT) do { unsigned a0 = cvt_pk_bf16_b(P[BASE + 0], P[BASE + 1]), a1 = cvt_pk_bf16_b(P[BASE + 2], P[BASE + 3]); \
        unsigned b0_ = cvt_pk_bf16_b(P[BASE + 4], P[BASE + 5]), b1_ = cvt_pk_bf16_b(P[BASE + 6], P[BASE + 7]); \
        auto r0 = __builtin_amdgcn_permlane32_swap(a0, b0_, false, false); auto r1 = __builtin_amdgcn_permlane32_swap(a1, b1_, false, false); \
        u32x4 w = {r0[0], r1[0], r0[1], r1[1]}; OUT = __builtin_bit_cast(bf16x8, w); } while (0)
#define PKV2(L, H) (bf16x8){L[0], L[1], L[2], L[3], H[0], H[1], H[2], H[3]}
#define ATT_GRP(P, BASE, VA, VC, VD, VE) do { \
        _Pragma("unroll") for (int r_ = 0; r_ < 8; ++r_) P[BASE + r_] = __builtin_amdgcn_exp2f(P[BASE + r_]); \
        bf16x8 pa_; PK4(P, BASE, pa_); \
        o[0] = __builtin_amdgcn_mfma_f32_32x32x16_bf16(pa_, PKV2(VA, VC), o[0], 0, 0, 0); o[1] = __builtin_amdgcn_mfma_f32_32x32x16_bf16(pa_, PKV2(VD, VE), o[1], 0, 0, 0); \
        o[2] = __builtin_amdgcn_mfma_f32_32x32x16_bf16(pa_, ones, o[2], 0, 0, 0); __builtin_amdgcn_sched_barrier(0); } while (0)
#define ATT_TILE(j, cur) do { \
        f32x16 p0, p1; \
        _Pragma("unroll") for (int r = 0; r < 16; ++r) { p0[r] = 0.f; p1[r] = 0.f; } \
        const LAS unsigned char* Kc = K_lds + (cur) * KTILE; \
        _Pragma("unroll") for (int d0 = 0; d0 < KS; ++d0) { const int cb = (d0 * 16 + hi * 8) * 2;     \
            const bf16x8 b0 = *(const LAS bf16x8*)(Kc + r32 * KR + cb); const bf16x8 b1 = *(const LAS bf16x8*)(Kc + (32 + r32) * KR + cb); \
            p0 = __builtin_amdgcn_mfma_f32_32x32x16_bf16(b0, qr[d0], p0, 0, 0, 0); p1 = __builtin_amdgcn_mfma_f32_32x32x16_bf16(b1, qr[d0], p1, 0, 0, 0); } \
        int cls = 0; float Bq = 0.f; \
        if (ALIBI) { if (64 * (j) + 64 <= w0) { cls = 1; Bq = slope2 * ((float)(64 * (j)) - qpos); } else if (64 * (j) >= w0 + 32) { cls = 2; Bq = slope2 * (qpos - (float)(64 * (j))); } } \
        bf16x8 qx; { u32x4 w = {0u, 0u, 0u, 0u}; if (hi == 0) { unsigned whm, wl0; split3(Bq - mt, whm, wl0); w.z = whm; w.w = wl0; w.x = (cls == 1) ? 0x3F803F80u : 0u; w.y = (cls == 2) ? 0x3F803F80u : 0u; } qx = __builtin_bit_cast(bf16x8, w); } \
        p0 = __builtin_amdgcn_mfma_f32_32x32x16_bf16(kx0, qx, p0, 0, 0, 0); p1 = __builtin_amdgcn_mfma_f32_32x32x16_bf16(kx1, qx, p1, 0, 0, 0); \
        if (ALIBI && cls == 0) { const float dq = qpos - (float)((j) * 64 + 4 * hi); \
            _Pragma("unroll") for (int r = 0; r < 16; ++r) { const float kc = (float)((r & 3) + 8 * (r >> 2)); p0[r] = fmaf(fabsf(dq - kc), -slope2, p0[r]); p1[r] = fmaf(fabsf(dq - (kc + 32.f)), -slope2, p1[r]); } } \
        float tmax = p0[0]; \
        _Pragma("unroll") for (int r = 1; r < 16; ++r) tmax = fmaxf(tmax, p0[r]); \
        _Pragma("unroll") for (int r = 0; r < 16; ++r) tmax = fmaxf(tmax, p1[r]); \
        { auto rr = __builtin_amdgcn_permlane32_swap(__float_as_uint(tmax), __float_as_uint(tmax), false, false); tmax = fmaxf(__uint_as_float(rr[0]), __uint_as_float(rr[1])); } \
        const bool skip = !first && __all(tmax < SKIP); \
        if (!skip) { \
            if (first || !__all(tmax <= THR)) { \
                const float delta = first ? tmax : fmaxf(tmax, 0.f); const float alpha = first ? 1.f : __builtin_amdgcn_exp2f(-delta); \
                mt += delta; \
                _Pragma("unroll") for (int r = 0; r < 16; ++r) { p0[r] -= delta; p1[r] -= delta; } \
                if (!first) { if (hi == 0) al_l[r32] = alpha; LDS_WAIT(); \
                    _Pragma("unroll") for (int r = 0; r < 16; ++r) { const float a = al_l[crow(r, hi)]; o[0][r] *= a; o[1][r] *= a; o[2][r] *= a; } } \
            } \
              \
            const int vb = vb0 + (cur) * VTILE; \
            const s16x4 va0 = tr_read<v_rd_off(0, 0, 0)>(vb), vc0 = tr_read<v_rd_off(0, 0, 1)>(vb), vd0 = tr_read<v_rd_off(1, 0, 0)>(vb), ve0 = tr_read<v_rd_off(1, 0, 1)>(vb); \
            const s16x4 va1 = tr_read<v_rd_off(0, 1, 0)>(vb), vc1 = tr_read<v_rd_off(0, 1, 1)>(vb), vd1 = tr_read<v_rd_off(1, 1, 0)>(vb), ve1 = tr_read<v_rd_off(1, 1, 1)>(vb); \
            const s16x4 va2 = tr_read<v_rd_off(0, 2, 0)>(vb), vc2 = tr_read<v_rd_off(0, 2, 1)>(vb), vd2 = tr_read<v_rd_off(1, 2, 0)>(vb), ve2 = tr_read<v_rd_off(1, 2, 1)>(vb); \
            const s16x4 va3 = tr_read<v_rd_off(0, 3, 0)>(vb), vc3 = tr_read<v_rd_off(0, 3, 1)>(vb), vd3 = tr_read<v_rd_off(1, 3, 0)>(vb), ve3 = tr_read<v_rd_off(1, 3, 1)>(vb); \
            const u32x4 onesw = {0x3F803F80u, 0x3F803F80u, 0x3F803F80u, 0x3F803F80u}; const bf16x8 ones = __builtin_bit_cast(bf16x8, onesw); \
            asm volatile("s_waitcnt lgkmcnt(0)" ::: "memory"); __builtin_amdgcn_sched_barrier(0); \
            ATT_GRP(p0, 0, va0, vc0, vd0, ve0); ATT_GRP(p0, 8, va1, vc1, vd1, ve1); ATT_GRP(p1, 0, va2, vc2, vd2, ve2); ATT_GRP(p1, 8, va3, vc3, vd3, ve3); \
            first = false; \
        } } while (0)
#define ATT_RUN(COUNT, TILE_EXPR) do { const int cnt_ = (COUNT); if (cnt_ > 0) { \
        { const int jj = 0; SLOAD((TILE_EXPR) * 64); } SWRITE(0); __syncthreads(); \
        if (cnt_ > 1) { const int jj = 1; SLOAD((TILE_EXPR) * 64); } \
        for (int jj0 = 0; jj0 < cnt_; ++jj0) { const int cur_ = jj0 & 1; int j_; { const int jj = jj0; j_ = (TILE_EXPR); } \
            ATT_TILE(j_, cur_); \
            if (jj0 + 1 < cnt_) SWRITE(cur_ ^ 1); \
            __syncthreads(); \
            if (jj0 + 2 < cnt_) { const int jj = jj0 + 2; SLOAD((TILE_EXPR) * 64); } } } } while (0)
    if (wid >= 4) __builtin_amdgcn_s_setprio(1);
    ATT_RUN(4, jd0 + jj);
    if (ALIBI) {
        { const float mm = -wave_max(-mt); if (lane == 0) blk[8 + wid] = mm; }
        __syncthreads();
        if (wid == 0) {
            float qn2 = blk[0], mmin = blk[8];
#pragma unroll
            for (int i = 1; i < 8; ++i) { qn2 = fmaxf(qn2, blk[i]); mmin = fminf(mmin, blk[8 + i]); }
            int base = 0;
            for (int c0 = 0; c0 < NT - 4; c0 += 64) { const int c = c0 + lane; bool act = false; int t = 0;
                if (c < NT - 4) { t = (c < jd0) ? jd0 - 1 - c : c + 4;
                    const float dist = (t < jd0) ? (float)(q0 - (64 * t + 63)) : (float)(64 * t - (q0 + 255));
                    const float kn = __builtin_bit_cast(float, kn2[t]);
                    act = (sqrtf(qn2 * kn) * 1.02f - slope2 * dist - mmin >= SKIP); }
                const unsigned long long bm = __ballot(act);
                if (act) tl[base + __builtin_popcountll(bm & ((1ull << lane) - 1ull))] = t;
                base += __builtin_popcountll(bm); }
            if (lane == 0) blk[16] = __builtin_bit_cast(float, base);
        }
        __syncthreads();
        const int nact = __builtin_bit_cast(int, blk[16]);
        ATT_RUN(nact, tl[jj]);
    } else {
        ATT_RUN(NT - 4, (jj < jd0 ? jd0 - 1 - jj : jj + 4));
    }
#undef ATT_RUN
#undef ATT_TILE
#undef ATT_GRP
#undef PKV2
#undef PK4
#undef SLOAD
#undef SWRITE
    __builtin_amdgcn_s_setprio(0);
    bf16_t* Ow = Ob + (size_t)(wid * 32) * ldo;
#pragma unroll
    for (int r = 0; r < 16; ++r) { const int orow = crow(r, hi); const float rl = __builtin_amdgcn_rcpf(o[2][r]);
#pragma unroll
        for (int d0 = 0; d0 < 2; ++d0) Ow[(size_t)orow * ldo + d0 * 32 + r32] = (bf16_t)f2bf(o[d0][r] * rl); }
    __syncthreads();
}
}

DI void ph_attn_a(const Ctx& C, int l) {
    const bf16_t* UA = (const bf16_t*)(C.ws + WS_U); bf16_t* OA = (bf16_t*)(C.ws + WS_XB1);
    GAS unsigned* head = (GAS unsigned*)(C.ws + WS_CTL) + 16384 + 64 * l;
    LAS volatile int* qslot = (LAS volatile int*)(C.lds + MISC_OFF + 64);
    if (C.tid == 0) qslot[0] = (int)__hip_atomic_fetch_add(head, 1u, __ATOMIC_RELAXED, __HIP_MEMORY_SCOPE_AGENT);
    __syncthreads();
    int u = qslot[0];
    while (u < 4096) {
        int nxt = 0;
        if (C.tid == 0) nxt = (int)__hip_atomic_fetch_add(head, 1u, __ATOMIC_RELAXED, __HIP_MEMORY_SCOPE_AGENT);
        const int k = u >> 9, j = u & 511, vhb = j >> 8;
        const bool prompt = (k == 0) || (k == 1) || (k == 4) || (k == 6);
        const int h = (k == 0 || k == 2) ? 3 : (k == 1 || k == 3) ? 2 : (k == 4 || k == 5) ? 1 : 0;
        const int vh = 2 * h + vhb;
        const int seq = prompt ? ((j >> 5) & 7) : 8 + ((j >> 3) & 31), qb = prompt ? (j & 31) : (j & 7), len = prompt ? 8192 : 2048;
        const int r0 = seq_start_row(seq);
        const float slope2 = exp2f(-2.0f * (float)(h + 1)) * LOG2E;
        att::attn_unit<2, true>(UA + (size_t)(r0 + qb * 256) * 768 + vh * 32, 768, UA + (size_t)r0 * 768 + 256 + vh * 32, 768, UA + (size_t)r0 * 768 + 512 + h * 64, 768,
                                OA + (size_t)(r0 + qb * 256) * 512 + vh * 64, 512, len, qb * 256, slope2, (const unsigned*)(C.ws + WS_KN2) + ((size_t)l * 8 + vh) * 2048 + (r0 >> 6), C.lds);
        if (C.tid == 0) qslot[0] = nxt;
        __syncthreads();
        u = qslot[0];
    }
}
DI void ph_attn_c(const Ctx& C) {
    const bf16_t* Qc = (const bf16_t*)(C.ws + WS_XB1 + OFF_QC); const bf16_t* Kc = (const bf16_t*)(C.ws + WS_XB1 + OFF_KC); const bf16_t* Vc = (const bf16_t*)(C.ws + WS_XB1 + OFF_VC);
    bf16_t* Y = (bf16_t*)(C.ws + WS_Y);
    for (int u = C.bid; u < 2048; u += C.G) {
        int qb, h, seq, len;
        if (u < 1024) { qb = u & 31; h = (u >> 5) & 3; seq = u >> 7; len = 8192; } else { const int v = u - 1024; qb = v & 7; h = (v >> 3) & 3; seq = 8 + (v >> 5); len = 2048; }
        const int r0 = seq_start_row(seq);
        att::attn_unit<3, false>(Qc + (size_t)(r0 + qb * 256) * 192 + h * 48, 192, Kc + (size_t)r0 * 192 + h * 48, 192, Vc + (size_t)r0 * 256 + h * 64, 256,
                                 Y + (size_t)(r0 + qb * 256) * DM + 512 + h * 64, DM, len, qb * 256, 0.f, nullptr, C.lds);
    }
}
DI void ph_a_post(const Ctx& C, int l) {
    const bf16_t* OA = (const bf16_t*)(C.ws + WS_XB1); bf16_t* Y = (bf16_t*)(C.ws + WS_Y);
    const float linit = 0.8f - 0.6f * expf(-0.3f * (float)l);
    const float* lp = C.A->in[3] + l * 128;
    float sa = 0.f, sb = 0.f; if (C.lane < 32) { sa = lp[C.lane] * lp[32 + C.lane]; sb = lp[64 + C.lane] * lp[96 + C.lane]; }
    const float lam = expf(wave_sum(sa)) - expf(wave_sum(sb)) + linit;
    const int h = C.lane >> 4, d4 = (C.lane & 15) * 4;
    const f32x4 gg = *(const f32x4*)(C.A->in[4] + l * 64 + d4);
    for (int row0 = C.gw; row0 < NTOK; row0 += 4 * C.NGW) {
        u32x2 a[4], b[4];
#pragma unroll
        for (int i = 0; i < 4; ++i) { const size_t row = (size_t)row0 + (size_t)i * C.NGW; a[i] = *(const u32x2*)(OA + row * 512 + (2 * h) * 64 + d4); b[i] = *(const u32x2*)(OA + row * 512 + (2 * h + 1) * 64 + d4); }
#pragma unroll
        for (int i = 0; i < 4; ++i) { const size_t row = (size_t)row0 + (size_t)i * C.NGW;
            float o0 = bflo(a[i].x) - lam * bflo(b[i].x), o1 = bfhi(a[i].x) - lam * bfhi(b[i].x), o2 = bflo(a[i].y) - lam * bflo(b[i].y), o3 = bfhi(a[i].y) - lam * bfhi(b[i].y);
            float ss = o0 * o0 + o1 * o1 + o2 * o2 + o3 * o3;
            ss += __shfl_xor(ss, 1); ss += __shfl_xor(ss, 2); ss += __shfl_xor(ss, 4); ss += __shfl_xor(ss, 8);
            const float r = (1.0f / sqrtf(ss * (1.f / 64.f) + RMS_EPS)) * (1.0f - linit);
            u32x2 w; w.x = cvt_pk_bf16(o0 * r * gg[0], o1 * r * gg[1]); w.y = cvt_pk_bf16(o2 * r * gg[2], o3 * r * gg[3]);
            *(u32x2*)(Y + row * DM + h * 64 + d4) = w; }
    }
}

DI float hgrn_lb(const Ctx& C, int l, int dir, int ch) {
    if (l == 0) return 0.f;
    const float a = C.A->in[5][(0 * 2 + dir) * 256 + ch], b = C.A->in[5][(1 * 2 + dir) * 256 + ch];
    const float m = fmaxf(a, b), ea = expf(a - m), eb = expf(b - m); return eb / (ea + eb);
}
DI float dpp_shr_add(float x, int k) {
    float y;
    if (k == 1) y = __builtin_bit_cast(float, __builtin_amdgcn_update_dpp(0, __builtin_bit_cast(int, x), 0x111, 0xF, 0xF, true));
    else if (k == 2) y = __builtin_bit_cast(float, __builtin_amdgcn_update_dpp(0, __builtin_bit_cast(int, x), 0x112, 0xF, 0xF, true));
    else if (k == 4) y = __builtin_bit_cast(float, __builtin_amdgcn_update_dpp(0, __builtin_bit_cast(int, x), 0x114, 0xF, 0xF, true));
    else y = __builtin_bit_cast(float, __builtin_amdgcn_update_dpp(0, __builtin_bit_cast(int, x), 0x118, 0xF, 0xF, true));
    return x + y;
}
DI s16x4 tr16(unsigned addr) { s16x4 r; asm volatile("ds_read_b64_tr_b16 %0, %1\n\ts_waitcnt lgkmcnt(0)" : "=&v"(r) : "v"(addr) : "memory"); return r; }
constexpr int HG_ROW = 144, HG_ARR = 16 * HG_ROW;
template <int MODE>
DI void hgrn_pass(const Ctx& C, int l, int chunk, int h, int dir, LAS unsigned char* wl, float* ofs) {
    const bf16_t* UB = (const bf16_t*)(C.ws + WS_U); float* ST = (float*)(C.ws + WS_XB1); float* GAM = (float*)(C.ws + WS_GAM); bf16_t* Y = (bf16_t*)(C.ws + WS_Y);
    const int lane = C.lane, l15 = lane & 15, g = lane >> 4, r0 = chunk * 128; const size_t sbase = (size_t)((chunk * 4 + h) * 2 + dir);
    const unsigned QLa = (unsigned)(uintptr_t)wl, FLa = QLa + HG_ARR, VLa = QLa + 2 * HG_ARR, GLa = QLa + 3 * HG_ARR;
    LAS float* lbT = (LAS float*)(wl + 4 * HG_ARR);
    lbT[lane] = hgrn_lb(C, l, dir, h * 64 + lane);
    LDS_WAIT();
    f32x4 S[4][4];
#pragma unroll
    for (int dt = 0; dt < 4; ++dt)
#pragma unroll
        for (int et = 0; et < 4; ++et)
#pragma unroll
            for (int r = 0; r < 4; ++r) S[dt][et][r] = (MODE == 0) ? 0.f : ST[sbase * 4096 + (size_t)(16 * dt + 4 * g + r) * 64 + 16 * et + l15];
    float gsum[4] = {0.f, 0.f, 0.f, 0.f};
    const float* ngp = C.A->in[6] + l * 256 + h * 64 + l15;
    const int srow = lane >> 2, spc = lane & 3;
    u32x4 pq[2], pf[2], pv[2];
#define HG_LOAD(sc) do { const int t_ = (sc) * 16 + srow; const bf16_t* rp_ = UB + (size_t)(r0 + (dir ? 127 - t_ : t_)) * 1280 + h * 64 + spc * 16; \
        pf[0] = *(const u32x4*)(rp_ + (dir ? 512 : 256)); pf[1] = *(const u32x4*)(rp_ + (dir ? 512 : 256) + 8); pv[0] = *(const u32x4*)(rp_ + 768); pv[1] = *(const u32x4*)(rp_ + 768 + 8); \
        if (MODE != 0) { pq[0] = *(const u32x4*)(rp_); pq[1] = *(const u32x4*)(rp_ + 8); } } while (0)
#define HG_STORE() do { const int o_ = srow * HG_ROW + spc * 32; \
        *(LAS u32x4*)(wl + HG_ARR + o_) = pf[0]; *(LAS u32x4*)(wl + HG_ARR + o_ + 16) = pf[1]; *(LAS u32x4*)(wl + 2 * HG_ARR + o_) = pv[0]; *(LAS u32x4*)(wl + 2 * HG_ARR + o_ + 16) = pv[1]; \
        if (MODE != 0) { *(LAS u32x4*)(wl + o_) = pq[0]; *(LAS u32x4*)(wl + o_ + 16) = pq[1]; } } while (0)
    HG_LOAD(0);
    const unsigned tr_off = (unsigned)((4 * g + (l15 >> 2)) * HG_ROW + (l15 & 3) * 8);
    for (int sc = 0; sc < 8; ++sc) {
        LDS_WAIT();
        HG_STORE();
        if (MODE == 2) {
#pragma unroll
            for (int k = 0; k < 2; ++k) { const int t_ = sc * 16 + 8 * k + (lane >> 3);
                __builtin_amdgcn_global_load_lds((const unsigned*)(UB + (size_t)(r0 + 127 - t_) * 1280 + 1024 + h * 64 + (lane & 7) * 8), (LAS unsigned*)(wl + 3 * HG_ARR + k * 1024), 16, 0, 0); } }
        if (sc + 1 < 8) HG_LOAD(sc + 1);
        LDS_WAIT();
        bf16x8 vf[4];
#pragma unroll
        for (int et = 0; et < 4; ++et) { const s16x4 t4 = tr16(VLa + tr_off + et * 32); vf[et] = (bf16x8){t4[0], t4[1], t4[2], t4[3], 0, 0, 0, 0}; }
        __builtin_amdgcn_sched_barrier(0);
        bf16x8 khf[4]; float tot[4];
#pragma unroll
        for (int dt = 0; dt < 4; ++dt) { const s16x4 t4 = tr16(FLa + tr_off + dt * 32);
            float fv[4], lf[4];
            const float lbv = lbT[16 * dt + l15];
#pragma unroll
            for (int j = 0; j < 4; ++j) { fv[j] = lbv + (1.f - lbv) * sigmoidf_(bf2f((unsigned short)t4[j])); lf[j] = __builtin_amdgcn_logf(fv[j]); }
            const float Tg = (lf[0] + lf[1]) + (lf[2] + lf[3]);
            const float T1 = __shfl_down(Tg, 16), T2 = __shfl_down(Tg, 32), T3 = __shfl_down(Tg, 48);
            const float after = (g < 3 ? T1 : 0.f) + (g < 2 ? T2 : 0.f) + (g < 1 ? T3 : 0.f);
            float tt_ = Tg; tt_ += __shfl_xor(tt_, 16); tt_ += __shfl_xor(tt_, 32); tot[dt] = tt_; gsum[dt] += tt_;
            const float c3 = after, c2 = c3 + lf[3], c1 = c2 + lf[2], c0 = c1 + lf[1];
            const unsigned w0 = cvt_pk_bf16((1.f - fv[0]) * __builtin_amdgcn_exp2f(c0), (1.f - fv[1]) * __builtin_amdgcn_exp2f(c1));
            const unsigned w1 = cvt_pk_bf16((1.f - fv[2]) * __builtin_amdgcn_exp2f(c2), (1.f - fv[3]) * __builtin_amdgcn_exp2f(c3));
            const u32x4 w = {w0, w1, 0u, 0u}; khf[dt] = __builtin_bit_cast(bf16x8, w); }
        __builtin_amdgcn_sched_barrier(0);
        f32x4 O[4];
        if (MODE != 0) {
            bf16x8 qhf[2], ktf[2];
#pragma unroll
            for (int ks = 0; ks < 2; ++ks) { float b2[8], qv[8], kv[8];
#pragma unroll
                for (int dd = 0; dd < 2; ++dd) { const int dt = 2 * ks + dd;
                    const u32x2 fw = *(const LAS u32x2*)(wl + HG_ARR + l15 * HG_ROW + (16 * dt + 4 * g) * 2); const u32x2 qw = *(const LAS u32x2*)(wl + l15 * HG_ROW + (16 * dt + 4 * g) * 2);
                    const f32x4 lb4 = *(const LAS f32x4*)(lbT + 16 * dt + 4 * g);
                    const float fl4[4] = {bflo(fw.x), bfhi(fw.x), bflo(fw.y), bfhi(fw.y)}, ql4[4] = {bflo(qw.x), bfhi(qw.x), bflo(qw.y), bfhi(qw.y)};
#pragma unroll
                    for (int r = 0; r < 4; ++r) { const int i = 4 * dd + r; const float f = lb4[r] + (1.f - lb4[r]) * sigmoidf_(fl4[r]); b2[i] = __builtin_amdgcn_logf(f); kv[i] = 1.f - f; qv[i] = siluf_(ql4[r]); } }
#pragma unroll
                for (int i = 0; i < 8; ++i) { float x = b2[i]; x = dpp_shr_add(x, 1); x = dpp_shr_add(x, 2); x = dpp_shr_add(x, 4); x = dpp_shr_add(x, 8); b2[i] = x; }
                u32x4 wq, wk;
#pragma unroll
                for (int p = 0; p < 4; ++p) { const int i = 2 * p; const float e0 = __builtin_amdgcn_exp2f(b2[i]), e1 = __builtin_amdgcn_exp2f(b2[i + 1]);
                    wq[p] = cvt_pk_bf16(qv[i] * e0, qv[i + 1] * e1); wk[p] = cvt_pk_bf16(kv[i] * __builtin_amdgcn_exp2f(fminf(-b2[i], 120.f)), kv[i + 1] * __builtin_amdgcn_exp2f(fminf(-b2[i + 1], 120.f))); }
                qhf[ks] = __builtin_bit_cast(bf16x8, wq); ktf[ks] = __builtin_bit_cast(bf16x8, wk); }
            __builtin_amdgcn_sched_barrier(0);
            f32x4 aT = (f32x4){0.f, 0.f, 0.f, 0.f};
            aT = __builtin_amdgcn_mfma_f32_16x16x32_bf16(ktf[0], qhf[0], aT, 0, 0, 0);
            aT = __builtin_amdgcn_mfma_f32_16x16x32_bf16(ktf[1], qhf[1], aT, 0, 0, 0);
#pragma unroll
            for (int r = 0; r < 4; ++r) aT[r] = (4 * g + r > l15) ? 0.f : aT[r];
            const u32x4 aw = {cvt_pk_bf16(aT[0], aT[1]), cvt_pk_bf16(aT[2], aT[3]), 0u, 0u}; const bf16x8 atf = __builtin_bit_cast(bf16x8, aw);
#pragma unroll
            for (int et = 0; et < 4; ++et) { f32x4 o = (f32x4){0.f, 0.f, 0.f, 0.f};
                o = __builtin_amdgcn_mfma_f32_16x16x32_bf16(atf, vf[et], o, 0, 0, 0);
#pragma unroll
                for (int ks = 0; ks < 2; ++ks) { const u32x4 sw = {cvt_pk_bf16(S[2 * ks][et][0], S[2 * ks][et][1]), cvt_pk_bf16(S[2 * ks][et][2], S[2 * ks][et][3]), cvt_pk_bf16(S[2 * ks + 1][et][0], S[2 * ks + 1][et][1]), cvt_pk_bf16(S[2 * ks + 1][et][2], S[2 * ks + 1][et][3])};
                    o = __builtin_amdgcn_mfma_f32_16x16x32_bf16(qhf[ks], __builtin_bit_cast(bf16x8, sw), o, 0, 0, 0); }
                O[et] = o; }
        }
        __builtin_amdgcn_sched_barrier(0);
#pragma unroll
        for (int dt = 0; dt < 4; ++dt) { float dec[4];
#pragma unroll
            for (int r = 0; r < 4; ++r) dec[r] = __builtin_amdgcn_exp2f(__shfl(tot[dt], 4 * g + r));
#pragma unroll
            for (int et = 0; et < 4; ++et) { f32x4 s = S[dt][et];
#pragma unroll
                for (int r = 0; r < 4; ++r) s[r] *= dec[r];
                S[dt][et] = __builtin_amdgcn_mfma_f32_16x16x32_bf16(khf[dt], vf[et], s, 0, 0, 0); } }
        __builtin_amdgcn_sched_barrier(0);
        if (MODE == 1) {
#pragma unroll
            for (int et = 0; et < 4; ++et)
#pragma unroll
                for (int r = 0; r < 4; ++r) ofs[(sc * 16 + 4 * g + r) * 64 + 16 * et + l15] = O[et][r];
        }
        if (MODE == 2) {
            float rr[4];
#pragma unroll
            for (int r = 0; r < 4; ++r) { const int at = 127 - (sc * 16 + 4 * g + r); float ss = 0.f;
#pragma unroll
                for (int et = 0; et < 4; ++et) { const float of = ofs[at * 64 + 16 * et + l15]; O[et][r] += of; ss += O[et][r] * O[et][r]; }
                ss += __shfl_xor(ss, 1); ss += __shfl_xor(ss, 2); ss += __shfl_xor(ss, 4); ss += __shfl_xor(ss, 8);
                rr[r] = 1.0f / sqrtf(ss * (1.f / 64.f) + RMS_EPS); }
            VM_WAIT();
#pragma unroll
            for (int et = 0; et < 4; ++et) { const s16x4 t4 = tr16(GLa + (unsigned)((4 * g + (l15 >> 2)) * 128 + (l15 & 3) * 8) + et * 32); const float ngv = ngp[16 * et];
#pragma unroll
                for (int r = 0; r < 4; ++r) { const int at = 127 - (sc * 16 + 4 * g + r);
                    Y[(size_t)(r0 + at) * DM + 256 + h * 64 + 16 * et + l15] = (bf16_t)f2bf(O[et][r] * rr[r] * ngv * siluf_(bf2f((unsigned short)t4[r]))); } }
        }
    }
#undef HG_LOAD
#undef HG_STORE
    if (MODE == 0) {
#pragma unroll
        for (int dt = 0; dt < 4; ++dt)
#pragma unroll
            for (int et = 0; et < 4; ++et)
#pragma unroll
                for (int r = 0; r < 4; ++r) ST[sbase * 4096 + (size_t)(16 * dt + 4 * g + r) * 64 + 16 * et + l15] = S[dt][et][r];
        if (g == 0) {
#pragma unroll
            for (int dt = 0; dt < 4; ++dt) GAM[sbase * 64 + 16 * dt + l15] = __builtin_amdgcn_exp2f(gsum[dt]);
        }
    }
}
DI void ph_hgrn_local(const Ctx& C, int l) {
    LAS unsigned char* wl = C.lds + C.wave * 16384;
    for (int w = C.gw; w < NCHUNK * 8; w += C.NGW) hgrn_pass<0>(C, l, w >> 3, (w >> 1) & 3, w & 1, wl, nullptr);
}
DI void ph_hgrn_scan(const Ctx& C) {
    float* ST = (float*)(C.ws + WS_XB1); const float* GAM = (const float*)(C.ws + WS_GAM);
    for (int idx = C.bid * 512 + C.tid; idx < NSEQ * 8 * 4096; idx += C.G * 512) {
        const int e = idx & 4095, hd = (idx >> 12) & 7, seq = idx >> 15, h = hd >> 1, dir = hd & 1, d = e >> 6;
        const int c0 = seq < 8 ? seq * 64 : 512 + (seq - 8) * 16, nc = seq < 8 ? 64 : 16;
        float s = 0.f;
        for (int i0 = 0; i0 < nc; i0 += 16) {
            float tmp[16], gg[16];
#pragma unroll
            for (int i = 0; i < 16; ++i) { const int c = dir ? c0 + nc - 1 - (i0 + i) : c0 + i0 + i; const size_t base = (size_t)((c * 4 + h) * 2 + dir); tmp[i] = ST[base * 4096 + e]; gg[i] = GAM[base * 64 + d]; }
#pragma unroll
            for (int i = 0; i < 16; ++i) { const float t = tmp[i]; tmp[i] = s; s = fmaf(gg[i], s, t); }
#pragma unroll
            for (int i = 0; i < 16; ++i) { const int c = dir ? c0 + nc - 1 - (i0 + i) : c0 + i0 + i; const size_t base = (size_t)((c * 4 + h) * 2 + dir); ST[base * 4096 + e] = tmp[i]; }
        }
    }
}
template <int MODE>
DI void ph_hgrn_out(const Ctx& C, int l) {
    LAS unsigned char* wl = C.lds + C.wave * 16384;
    for (int w = C.gw; w < NCHUNK * 4; w += C.NGW) hgrn_pass<MODE>(C, l, w >> 2, w & 3, MODE == 2 ? 1 : 0, wl, (float*)(C.ws + WS_EW) + (size_t)w * 8192);
}

DI void ph_c_prep(const Ctx& C, int l) {
    const bf16_t* UCD = (const bf16_t*)(C.ws + WS_U);
    const bf16_t* WQ = (const bf16_t*)(C.ws + WS_WC + (size_t)l * WC_LAYER + OFF_WQ); const bf16_t* WKV = (const bf16_t*)(C.ws + WS_WC + (size_t)l * WC_LAYER + OFF_WKV);
    bf16_t* Qc = (bf16_t*)(C.ws + WS_XB1 + OFF_QC); bf16_t* Kc = (bf16_t*)(C.ws + WS_XB1 + OFF_KC); bf16_t* Vc = (bf16_t*)(C.ws + WS_XB1 + OFF_VC);
    const int lane = C.lane, r32 = lane & 31, hi = lane >> 5;
    const float C2c = 0.14433756729740643f * LOG2E;
    constexpr int PQ = 400, PKV = 272;
    for (int i = C.tid; i < 192 * 24; i += 512) { const int r = i / 24, p = i % 24; *(LAS u32x4*)(C.lds + r * PQ + p * 16) = *(const u32x4*)(WQ + (size_t)r * 192 + p * 8); }
    __syncthreads();
    for (int w = C.gw; w < NTOK / 32; w += C.NGW) {
        const int row = w * 32 + r32; const bf16_t* xr = UCD + (size_t)row * 1024;
        float cs[4], sn[4];
        { const float pos = (float)row_pos(row); const float inv[8] = {1.0f, 0.316227766016837933f, 0.1f, 0.0316227766016837933f, 0.01f, 0.00316227766016837933f, 0.001f, 0.000316227766016837933f};
#pragma unroll
            for (int ii = 0; ii < 4; ++ii) { const float invv = hi ? inv[4 + ii] : inv[ii]; const float ang = pos * invv;
                const double ad = (double)ang; const double k = __builtin_rint(ad * 0.15915494309189535); const float red = (float)(ad - k * 6.283185307179586);
                cs[ii] = __cosf(red); sn[ii] = __sinf(red); } }
        bf16x8 xq[12]; float ssq = 0.f;
#pragma unroll
        for (int ks = 0; ks < 12; ++ks) { xq[ks] = *(const bf16x8*)(xr + ks * 16 + hi * 8);
#pragma unroll
            for (int j = 0; j < 8; ++j) { const float f = bf2f((unsigned short)xq[ks][j]); ssq += f * f; } }
        ssq += __shfl_xor(ssq, 32);
        const float rq = (1.0f / sqrtf(ssq * (1.f / 192.f) + RMS_EPS)) * C2c;
#pragma unroll 1
        for (int nt = 0; nt < 6; ++nt) {
            f32x16 acc;
#pragma unroll
            for (int r = 0; r < 16; ++r) acc[r] = 0.f;
#pragma unroll
            for (int ks = 0; ks < 12; ++ks) { const bf16x8 a = *(const LAS bf16x8*)(C.lds + (32 * nt + r32) * PQ + (ks * 16 + hi * 8) * 2); acc = __builtin_amdgcn_mfma_f32_32x32x16_bf16(a, xq[ks], acc, 0, 0, 0); }
#pragma unroll
            for (int r = 0; r < 16; ++r) acc[r] *= rq;
            if (nt == 1 || nt == 4) {
#pragma unroll
                for (int ii = 0; ii < 4; ++ii) { const float x1 = acc[ii], x2 = acc[4 + ii]; acc[ii] = x1 * cs[ii] - x2 * sn[ii]; acc[4 + ii] = x1 * sn[ii] + x2 * cs[ii]; } }
            if (nt == 2 || nt == 5) {
#pragma unroll
                for (int ii = 0; ii < 4; ++ii) { const float x1 = acc[8 + ii], x2 = acc[12 + ii]; acc[8 + ii] = x1 * cs[ii] - x2 * sn[ii]; acc[12 + ii] = x1 * sn[ii] + x2 * cs[ii]; } }
#pragma unroll
            for (int g = 0; g < 4; ++g) { u32x2 wv; wv.x = cvt_pk_bf16(acc[4 * g], acc[4 * g + 1]); wv.y = cvt_pk_bf16(acc[4 * g + 2], acc[4 * g + 3]);
                *(u32x2*)(Qc + (size_t)row * 192 + 32 * nt + 8 * g + 4 * hi) = wv; }
        }
        { const u32x2 a = *(const u32x2*)(xr + 320 + 4 * hi), b = *(const u32x2*)(xr + 328 + 4 * hi);
            const float x1[4] = {bflo(a.x), bfhi(a.x), bflo(a.y), bfhi(a.y)}, x2[4] = {bflo(b.x), bfhi(b.x), bflo(b.y), bfhi(b.y)};
            float o1[4], o2[4];
#pragma unroll
            for (int ii = 0; ii < 4; ++ii) { o1[ii] = x1[ii] * cs[ii] - x2[ii] * sn[ii]; o2[ii] = x1[ii] * sn[ii] + x2[ii] * cs[ii]; }
            u32x2 w1, w2; w1.x = cvt_pk_bf16(o1[0], o1[1]); w1.y = cvt_pk_bf16(o1[2], o1[3]); w2.x = cvt_pk_bf16(o2[0], o2[1]); w2.y = cvt_pk_bf16(o2[2], o2[3]);
#pragma unroll
            for (int h = 0; h < 4; ++h) { *(u32x2*)(Kc + (size_t)row * 192 + h * 48 + 32 + 4 * hi) = w1; *(u32x2*)(Kc + (size_t)row * 192 + h * 48 + 40 + 4 * hi) = w2; } }
    }
    __syncthreads();
    for (int i = C.tid; i < 384 * 16; i += 512) { const int r = i / 16, p = i % 16; *(LAS u32x4*)(C.lds + r * PKV + p * 16) = *(const u32x4*)(WKV + (size_t)r * 128 + p * 8); }
    __syncthreads();
    for (int w = C.gw; w < NTOK / 32; w += C.NGW) {
        const int row = w * 32 + r32; const bf16_t* xr = UCD + (size_t)row * 1024;
        bf16x8 xk[8]; float ssk = 0.f;
#pragma unroll
        for (int ks = 0; ks < 8; ++ks) { xk[ks] = *(const bf16x8*)(xr + 192 + ks * 16 + hi * 8);
#pragma unroll
            for (int j = 0; j < 8; ++j) { const float f = bf2f((unsigned short)xk[ks][j]); ssk += f * f; } }
        ssk += __shfl_xor(ssk, 32);
        const float rk = 1.0f / sqrtf(ssk * (1.f / 128.f) + RMS_EPS);
#pragma unroll 1
        for (int nt = 0; nt < 12; ++nt) {
            f32x16 acc;
#pragma unroll
            for (int r = 0; r < 16; ++r) acc[r] = 0.f;
#pragma unroll
            for (int ks = 0; ks < 8; ++ks) { const bf16x8 a = *(const LAS bf16x8*)(C.lds + (32 * nt + r32) * PKV + (ks * 16 + hi * 8) * 2); acc = __builtin_amdgcn_mfma_f32_32x32x16_bf16(a, xk[ks], acc, 0, 0, 0); }
            const int h = nt / 3, part = nt % 3;
            bf16_t* dst = (part == 0) ? Kc + (size_t)row * 192 + h * 48 : Vc + (size_t)row * 256 + h * 64 + (part - 1) * 32;
#pragma unroll
            for (int g = 0; g < 4; ++g) { u32x2 wv; wv.x = cvt_pk_bf16(acc[4 * g] * rk, acc[4 * g + 1] * rk); wv.y = cvt_pk_bf16(acc[4 * g + 2] * rk, acc[4 * g + 3] * rk);
                *(u32x2*)(dst + 8 * g + 4 * hi) = wv; }
        }
    }
}

DI float one_minus_a2(float y, float a) {
    const float p = -y * (1.0f + y * (0.5f + y * (0.16666667f + y * (0.041666668f + y * (0.0083333338f + y * 0.0013888889f)))));
    return (y > -0.25f) ? p : (1.0f - a * a);
}
template <bool FINAL, int DIR>
DI void rglru_units(const Ctx& C, int l) {
    const bf16_t* UCD = (const bf16_t*)(C.ws + WS_U); f32x2* DC = (f32x2*)(C.ws + WS_DC);
    bf16_t* HFB = (bf16_t*)(C.ws + WS_EW);
    const int lane = C.lane, l15 = lane & 15, g = lane >> 4;
    LAS unsigned char* wl = C.lds + C.wave * 16384;
    LAS unsigned char* xcb = wl;
    LAS float* gs = (LAS float*)(wl + 2304);
    const int n = C.gw & 3, ch = n * 64 + lane;
    bf16x8 Wf[2][4][2];
    { const bf16x8* fp = (const bf16x8*)(C.ws + WS_WRG) + (size_t)((((l * 2 + DIR) * 4 + n) * 2) * 8) * 64 + lane;
#pragma unroll
      for (int gt = 0; gt < 2; ++gt)
#pragma unroll
        for (int nt = 0; nt < 4; ++nt)
#pragma unroll
            for (int ks = 0; ks < 2; ++ks) Wf[gt][nt][ks] = fp[(size_t)((gt * 4 + nt) * 2 + ks) * 64]; }
    const float ba = C.A->in[14][(l * 2 + DIR) * 256 + ch], bx = C.A->in[16][(l * 2 + DIR) * 256 + ch];
    const float lam = C.A->in[17][(l * 2 + DIR) * 256 + ch];
    const float c8sp = -8.0f * log1pf(expf(-lam));
    float cw[4];
#pragma unroll
    for (int j = 0; j < 4; ++j) cw[j] = C.A->in[11][(l * 4 + j) * 256 + ch];
    const float cb = C.A->in[12][l * 256 + ch];
    for (int w = C.gw; w < NCHUNK * 4; w += C.NGW) {
        const int chunk = w >> 2;
        const int r0 = chunk * 128; const int sb = row_seq_begin(r0), se = sb + row_seq_len(r0);
        float h = FINAL ? DC[(size_t)(chunk * 2 + DIR) * 256 + ch][1] : 0.f, P = 1.f;
        float xr[19];
#define RG_LOADX(dst, sc_) do { const int tb_ = r0 + 16 * (DIR ? 7 - (sc_) : (sc_)) - 2; \
            _Pragma("unroll") for (int i_ = 0; i_ < 19; ++i_) { const int rr_ = tb_ + i_; dst[i_] = (rr_ >= sb && rr_ < se) ? bf2f(UCD[(size_t)rr_ * 1024 + 336 + ch]) : 0.f; } } while (0)
        RG_LOADX(xr, 0);
        for (int sc = 0; sc < 8; ++sc) {
            const int t0 = r0 + 16 * (DIR ? 7 - sc : sc);
            float xcr[16];
#pragma unroll
            for (int a = 0; a < 16; ++a) { const int tt = DIR ? 15 - a : a;
                xcr[tt] = cb + cw[0] * xr[a] + cw[1] * xr[a + 1] + cw[2] * xr[a + 2] + cw[3] * xr[a + 3];
                *(LAS bf16_t*)(xcb + tt * 144 + lane * 2) = (bf16_t)f2bf(xcr[tt]); }
            if (sc + 1 < 8) RG_LOADX(xr, sc + 1);
            LDS_WAIT();
            const bf16x8 A0 = *(const LAS bf16x8*)(xcb + l15 * 144 + (8 * g) * 2), A1 = *(const LAS bf16x8*)(xcb + l15 * 144 + (32 + 8 * g) * 2);
#pragma unroll
            for (int gt = 0; gt < 2; ++gt)
#pragma unroll
                for (int nt = 0; nt < 4; ++nt) { f32x4 acc = (f32x4){0.f, 0.f, 0.f, 0.f};
                    acc = __builtin_amdgcn_mfma_f32_16x16x32_bf16(A0, Wf[gt][nt][0], acc, 0, 0, 0);
                    acc = __builtin_amdgcn_mfma_f32_16x16x32_bf16(A1, Wf[gt][nt][1], acc, 0, 0, 0);
#pragma unroll
                    for (int r = 0; r < 4; ++r) gs[(gt * 16 + 4 * g + r) * 68 + 16 * nt + l15] = acc[r]; }
            LDS_WAIT();
#pragma unroll
            for (int tt = 0; tt < 16; ++tt) {
                const float ra = gs[tt * 68 + lane] + ba, ia = gs[(16 + tt) * 68 + lane] + bx;
                const float r = sigmoidf_(ra), ig = sigmoidf_(ia);
                const float la = c8sp * r, a = __expf(la), u = __builtin_amdgcn_sqrtf(one_minus_a2(2.0f * la, a)) * (ig * xcr[tt]);
                h = fmaf(a, h, u); P *= a;
                if (FINAL) { const int tok = DIR ? t0 + 15 - tt : t0 + tt; HFB[((size_t)DIR * NTOK + tok) * 256 + ch] = (bf16_t)f2bf(h); } }
            LDS_WAIT();
        }
        if (!FINAL) DC[(size_t)(chunk * 2 + DIR) * 256 + ch] = (f32x2){P, h};
#undef RG_LOADX
    }
}
template <bool FINAL>
DI void ph_rglru(const Ctx& C, int l) { rglru_units<FINAL, 0>(C, l); rglru_units<FINAL, 1>(C, l); }
DI void ph_rglru_scan(const Ctx& C) {
    f32x2* DC = (f32x2*)(C.ws + WS_DC);
    for (int idx = C.bid * 512 + C.tid; idx < NSEQ * 512; idx += C.G * 512) {
        const int ch = idx & 255, dir = (idx >> 8) & 1, seq = idx >> 9;
        const int c0 = seq < 8 ? seq * 64 : 512 + (seq - 8) * 16, nc = seq < 8 ? 64 : 16;
        float hin = 0.f;
        for (int i0 = 0; i0 < nc; i0 += 16) {
            f32x2 vv[16];
#pragma unroll
            for (int i = 0; i < 16; ++i) { const int c = dir ? c0 + nc - 1 - (i0 + i) : c0 + i0 + i; vv[i] = DC[(size_t)(c * 2 + dir) * 256 + ch]; }
#pragma unroll
            for (int i = 0; i < 16; ++i) { const float P = vv[i][0], H = vv[i][1]; vv[i][1] = hin; hin = fmaf(P, hin, H); }
#pragma unroll
            for (int i = 0; i < 16; ++i) { const int c = dir ? c0 + nc - 1 - (i0 + i) : c0 + i0 + i; DC[(size_t)(c * 2 + dir) * 256 + ch] = vv[i]; }
        }
    }
}
DI float gelu_tanh(float x) { const float u = 0.7978845608028654f * (x + 0.044715f * x * x * x); const float e = __expf(2.0f * u); const float th = 1.0f - 2.0f / (e + 1.0f); return 0.5f * x * (1.0f + th); }
DI void ph_d_post(const Ctx& C) {
    const bf16_t* UCD = (const bf16_t*)(C.ws + WS_U); const bf16_t* HF = (const bf16_t*)(C.ws + WS_EW); const bf16_t* HB = HF + (size_t)NTOK * 256; bf16_t* Y = (bf16_t*)(C.ws + WS_Y);
    const int c4 = C.lane * 4;
    for (int row0 = C.gw; row0 < NTOK; row0 += 4 * C.NGW) {
        u32x2 a[4], b[4], g[4];
#pragma unroll
        for (int i = 0; i < 4; ++i) { const size_t row = (size_t)row0 + (size_t)i * C.NGW; a[i] = *(const u32x2*)(HF + row * 256 + c4); b[i] = *(const u32x2*)(HB + row * 256 + c4); g[i] = *(const u32x2*)(UCD + row * 1024 + 592 + c4); }
#pragma unroll
        for (int i = 0; i < 4; ++i) { const size_t row = (size_t)row0 + (size_t)i * C.NGW;
            const float y0 = (bflo(a[i].x) + bflo(b[i].x)) * gelu_tanh(bflo(g[i].x)), y1 = (bfhi(a[i].x) + bfhi(b[i].x)) * gelu_tanh(bfhi(g[i].x));
            const float y2 = (bflo(a[i].y) + bflo(b[i].y)) * gelu_tanh(bflo(g[i].y)), y3 = (bfhi(a[i].y) + bfhi(b[i].y)) * gelu_tanh(bfhi(g[i].y));
            u32x2 w; w.x = cvt_pk_bf16(y0, y1); w.y = cvt_pk_bf16(y2, y3);
            *(u32x2*)(Y + row * DM + 768 + c4) = w; }
    }
}

DI void ph_topk(const Ctx& C) {
    const float* affT = (const float*)(C.ws + WS_AFF); int* idx2 = (int*)(C.ws + WS_IDX); float* gsel2 = (float*)(C.ws + WS_GSEL);
    LAS unsigned* hist = (LAS unsigned*)C.lds;
    LAS unsigned* misc = hist + 4096;
    LAS unsigned* cg = misc + 8;
    LAS unsigned* ce = cg + 512;
    for (int u = C.bid; u < 32; u += C.G) {
        const int g = u >> 4, e = u & 15; const unsigned* a = (const unsigned*)(affT + (size_t)(g * 16 + e) * NTOKG);
        const int i0 = C.tid * 128; unsigned v[128];
        { const u32x4* p = (const u32x4*)(a + i0);
#pragma unroll
          for (int j = 0; j < 32; ++j) { const u32x4 q = p[j]; v[4 * j] = q.x; v[4 * j + 1] = q.y; v[4 * j + 2] = q.z; v[4 * j + 3] = q.w; } }
        unsigned prefix = 0u, mask = 0u, krem = CAP;
#pragma unroll 1
        for (int pass = 0; pass < 3; ++pass) {
            const int shift = pass == 0 ? 19 : (pass == 1 ? 7 : 0); const unsigned dm = pass == 2 ? 127u : 4095u; const int per = pass == 2 ? 2 : 64;
            for (int i = C.tid; i < 4096; i += 512) hist[i] = 0u;
            __syncthreads();
#pragma unroll
            for (int i = 0; i < 128; ++i) {
                const unsigned bin = ((v[i] & mask) == prefix) ? ((v[i] >> shift) & dm) : (5120u + (unsigned)C.lane);
                atomicAdd((unsigned*)&hist[bin], 1u); if ((i & 7) == 7) asm volatile("" : "+v"(prefix) :: "memory"); }
            __syncthreads();
            if (C.tid < 64) {
                unsigned t = 0; for (int b = 0; b < per; ++b) t += hist[per * C.tid + b];
                unsigned S = t;
#pragma unroll
                for (int off = 1; off < 64; off <<= 1) { const unsigned y = __shfl_down(S, off); if (C.tid + off < 64) S += y; }
                const unsigned above = S - t;
                if (above < krem && krem <= above + t) { unsigned cum = above; int D = per * C.tid + per - 1;
                    for (; D > per * C.tid; --D) { const unsigned c = hist[D]; if (cum + c >= krem) break; cum += c; }
                    misc[0] = (unsigned)D; misc[1] = cum; }
            }
            __syncthreads();
            prefix |= misc[0] << shift; mask |= dm << shift; krem -= misc[1];
            __syncthreads();
        }
        unsigned ngt = 0, neq = 0;
#pragma unroll
        for (int i = 0; i < 128; ++i) { ngt += (v[i] > prefix); neq += (v[i] == prefix); if ((i & 15) == 15) asm volatile("" : "+v"(prefix)); }
        unsigned ig = ngt, ie = neq;
#pragma unroll
        for (int off = 1; off < 64; off <<= 1) { const unsigned yg = __shfl_up(ig, off), ye = __shfl_up(ie, off); if (C.lane >= off) { ig += yg; ie += ye; } }
        if (C.lane == 63) { cg[C.wave] = ig; ce[C.wave] = ie; }
        __syncthreads();
        unsigned bg = 0, be = 0, allg = 0;
#pragma unroll
        for (int w = 0; w < 8; ++w) { const unsigned x = cg[w], y = ce[w]; if (w < C.wave) { bg += x; be += y; } allg += x; }
        unsigned pg = bg + ig - ngt, pe = be + ie - neq; const unsigned ngt_all = allg;
        int* io = idx2 + (size_t)e * 16384 + g * CAP; float* go = gsel2 + (size_t)e * 16384 + g * CAP; short* sm = (short*)(C.ws + WS_SM) + (size_t)(g * NTOKG + i0) * 16 + e;
#pragma unroll
        for (int i = 0; i < 128; ++i) {
            if (v[i] > prefix) { io[pg] = g * NTOKG + i0 + i; go[pg] = __builtin_bit_cast(float, v[i]); sm[i * 16] = (short)pg; ++pg; }
            else if (v[i] == prefix) { if (pe < krem) { io[ngt_all + pe] = g * NTOKG + i0 + i; go[ngt_all + pe] = __builtin_bit_cast(float, v[i]); sm[i * 16] = (short)(ngt_all + pe); } ++pe; }
            if ((i & 3) == 3) asm volatile("" : "+v"(prefix) :: "memory"); }
        __syncthreads();
    }
}

constexpr int MERGE_CHUNKS = 8, MERGE_ROWS = NTOK / MERGE_CHUNKS;
constexpr int EPB = 2;
constexpr int NPH_LAYER = 12 + 2 * MERGE_CHUNKS + 3 + (NEXP / EPB + 1) + 1, NPH = 1 + 2 * NPH_LAYER;
__global__ void __launch_bounds__(512, 2) mk_fwd(Args args) {
    extern __shared__ __attribute__((aligned(16))) unsigned char lds_raw[];
    Ctx C;
    C.lds = (LAS unsigned char*)lds_raw; C.ws = (GAS unsigned char*)args.ws; C.out = (GAS float*)args.out;
    C.tid = threadIdx.x; C.lane = C.tid & 63; C.wave = __builtin_amdgcn_readfirstlane(C.tid >> 6); C.G = gridDim.x; C.bid = blockIdx.x;
    C.gw = C.bid * 8 + C.wave; C.NGW = C.G * 8;
    C.A = &args;
    volatile LAS unsigned* MISC = (volatile LAS unsigned*)(C.lds + MISC_OFF);
    for (int u = C.tid; u < (LDS_BYTES - RING_BYTES) / 4; u += 512) ((LAS unsigned*)(C.lds + RING_BYTES))[u] = 0u;
    __syncthreads();
    const int lo = args.ph_lo, hi = args.ph_hi;
    unsigned* barw = (unsigned*)(C.ws + WS_CTL) + 4096;
    XcdBarrier bar; bar.bar = barw; bar.x = 0; bar.st = nullptr;
    if (hi - lo > 1) bar = xcd_barrier_post(barw, MISC + 8);
    int ph = 0;
#ifndef PHASE_MASK
#define PHASE_MASK 0xFFFFFFFFu
#endif
#ifndef REPEAT_MASK
#define REPEAT_MASK 0u
#endif
#define SITE(id) if constexpr (((PHASE_MASK) >> (id)) & 1u) for (int rep_ = 0; rep_ < ((((REPEAT_MASK) >> (id)) & 1u) ? 2 : 1); ++rep_)
#define PH_BEGIN if (ph >= lo && ph < hi) { { int tz_ = threadIdx.x; asm volatile("" : "+v"(tz_)); C.tid = tz_; C.lane = tz_ & 63; C.wave = __builtin_amdgcn_readfirstlane(tz_ >> 6); C.gw = C.bid * 8 + C.wave; unsigned char* wz_ = args.ws; asm volatile("" : "+s"(wz_)); C.ws = (GAS unsigned char*)wz_; float* oz_ = args.out; asm volatile("" : "+s"(oz_)); C.out = (GAS float*)oz_; }
#define PH_END } if (ph >= lo && ph + 1 < hi) xcd_barrier(bar); ++ph;

#define XB0 ((bf16_t*)(C.ws + WS_XB0))
#define XB1 ((bf16_t*)(C.ws + WS_XB1))
#define Yb ((bf16_t*)(C.ws + WS_Y))
#define Ub ((bf16_t*)(C.ws + WS_U))
    const int big = 30;

    PH_BEGIN SITE(1) ph_prologue(C); PH_END

    for (int l = 0; l < 2; ++l) {
#define wl (C.ws + WS_WSMALL + (size_t)l * WSMALL_LAYER)
        PH_BEGIN SITE(2) { pg8::Gemm g{XB0, (const bf16_t*)(wl + OFF_WA), NTOK, 768, 1024, 1024, 1024, big, 0}; pg8::StaticOrder S; S.init(NTOK, 768, C.G, C.bid);
            pg8::EpiProj E{Ub, 768, 256, 0.17677669529663689f * LOG2E, (unsigned*)(C.ws + WS_KN2) + (size_t)l * 8 * 2048}; pg8::gemm_phase(C.lds, g, S, E); } PH_END
        PH_BEGIN SITE(3) ph_attn_a(C, l); PH_END
        PH_BEGIN SITE(4) { ph_a_post(C, l); __syncthreads();
            pg8::Gemm g{XB0, (const bf16_t*)(wl + OFF_WB), NTOK, 1280, 1024, 1024, 1024, big, 0}; pg8::StaticOrder S; S.init(NTOK, 1280, C.G, C.bid);
            pg8::EpiProj E{Ub, 1280, 0, 1.f, nullptr}; pg8::gemm_phase(C.lds, g, S, E); } PH_END
        PH_BEGIN SITE(5) ph_hgrn_local(C, l); PH_END
        PH_BEGIN SITE(6) ph_hgrn_scan(C); PH_END
        PH_BEGIN SITE(7) ph_hgrn_out<1>(C, l); PH_END
        PH_BEGIN SITE(20) ph_hgrn_out<2>(C, l); PH_END
        PH_BEGIN SITE(8) { pg8::Gemm g{XB0, (const bf16_t*)(wl + OFF_WCD), NTOK, 1024, 1024, 1024, 1024, big, 0}; pg8::StaticOrder S; S.init(NTOK, 1024, C.G, C.bid);
            pg8::EpiProj E{Ub, 1024, 0, 1.f, nullptr}; pg8::gemm_phase(C.lds, g, S, E); } PH_END
        PH_BEGIN SITE(9) { ph_c_prep(C, l); __syncthreads(); ph_rglru<false>(C, l); } PH_END
        PH_BEGIN SITE(10) { if (rep_ == 0) { ph_rglru_scan(C); __syncthreads(); } ph_attn_c(C); } PH_END
        PH_BEGIN SITE(11) ph_rglru<true>(C, l); PH_END
        PH_BEGIN SITE(12) ph_d_post(C); PH_END
        for (int q = 0; q < MERGE_CHUNKS; ++q) {
            const size_t r0 = (size_t)q * MERGE_ROWS;
            PH_BEGIN SITE(13) {
                { unsigned char* X8 = (unsigned char*)(C.ws + WS_U) + (size_t)MERGE_ROWS * 8192;
                  for (int rb = C.gw; rb < MERGE_ROWS; rb += 8 * C.NGW) {
                      u32x4 a[8], b[8];
#pragma unroll
                      for (int i = 0; i < 8; ++i) { const int r = min(rb + i * C.NGW, MERGE_ROWS - 1); const u32x4* s = (const u32x4*)(XB0 + (r0 + r) * DM) + 2 * C.lane; a[i] = __builtin_nontemporal_load(&s[0]); b[i] = __builtin_nontemporal_load(&s[1]); }
#pragma unroll
                      for (int i = 0; i < 8; ++i) { const int r = rb + i * C.NGW; if (r < MERGE_ROWS) {
                          u32x4 o; o.x = pg8::pk4_fp8(bflo(a[i].x), bfhi(a[i].x), bflo(a[i].y), bfhi(a[i].y)); o.y = pg8::pk4_fp8(bflo(a[i].z), bfhi(a[i].z), bflo(a[i].w), bfhi(a[i].w));
                          o.z = pg8::pk4_fp8(bflo(b[i].x), bfhi(b[i].x), bflo(b[i].y), bfhi(b[i].y)); o.w = pg8::pk4_fp8(bflo(b[i].z), bfhi(b[i].z), bflo(b[i].w), bfhi(b[i].w));
                          ((u32x4*)(X8 + (size_t)r * DM))[C.lane] = o; } } }
                  __syncthreads(); }
                pg8::Gemm g{Yb + r0 * DM, (const bf16_t*)(wl + OFF_WBR), MERGE_ROWS, 4096, 256, 1024, 256, 2, 512}; pg8::StaticOrder S; S.init(MERGE_ROWS, 4096, C.G, C.bid);
                pg8::EpiProj E{Ub, 4096, 0, 1.f, nullptr}; pg8::gemm_phase(C.lds, g, S, E); } PH_END
            PH_BEGIN SITE(14) { pg8::Gemm g{(const bf16_t*)(C.ws + WS_U + (size_t)MERGE_ROWS * 8192), (const bf16_t*)(wl + OFF_WG), MERGE_ROWS, 4096, 1024, 1024, 1024, big, 0}; pg8::StaticOrder S; S.init(MERGE_ROWS, 4096, C.G, C.bid);
                pg8::EpiGateMix E{Ub, XB1 + r0 * DM, 1.f / pg8::FP8_W1_SCALE}; pg8::gemm_phase<pg8::EpiGateMix, pg8::StaticOrder, true>(C.lds, g, S, E); } PH_END
        }
        PH_BEGIN SITE(15) { pg8::Gemm g{XB1, (const bf16_t*)(wl + OFF_WOUT), NTOK, 1024, 1024, 1024, 1024, big, 0}; pg8::StaticOrder S; S.init(NTOK, 1024, C.G, C.bid);
            pg8::EpiResid E{l == 0 ? C.A->in[0] : (const float*)C.out, l == 0 ? C.A->in[1] : (const float*)(C.out + (size_t)NTOKG * DM), (float*)C.out}; pg8::gemm_phase(C.lds, g, S, E); } PH_END
        PH_BEGIN SITE(16) { ph_ln<true>(C, l, 0, XB1); } PH_END
        PH_BEGIN SITE(17) { if (C.bid < 32 && C.G > 64) ph_topk(C); else expert_weight_items(C, l); if (C.G <= 64) { __syncthreads(); if (C.bid < 32) ph_topk(C); } } PH_END
        for (int k = 0; k < NEXP / EPB + 1; ++k) {
            PH_BEGIN SITE(18) {
                constexpr size_t H_B = (size_t)EPB * 16384 * 2048;
                unsigned char* Hb = (unsigned char*)(C.ws + WS_XB0);
                if (k < NEXP / EPB) { const int e0 = k * EPB;
                    pg8::Gemm g{(const bf16_t*)(C.ws + WS_XB1), (const bf16_t*)(C.ws + WS_EW + OFF_WGU8 + (size_t)e0 * 4096 * 1024), EPB * 16384, 4096, 1024, 1024, 1024, big, 0, 6, (size_t)4096 * 1024, (const int*)(C.ws + WS_IDX) + (size_t)e0 * 16384}; pg8::StaticOrder S; S.init(EPB * 16384, 4096, C.G, C.bid);
                    pg8::EpiSiluMul8 E{Hb + (size_t)(k & 1) * H_B, 2048}; pg8::gemm_phase<pg8::EpiSiluMul8, pg8::StaticOrder, true, true>(C.lds, g, S, E); }
                if (k >= 1) { const int e0 = (k - 1) * EPB; __syncthreads();
                    pg8::Gemm g{(const bf16_t*)(Hb + (size_t)((k - 1) & 1) * H_B), (const bf16_t*)(C.ws + WS_EW + OFF_WD8 + (size_t)e0 * 1024 * 2048), EPB * 16384, 1024, 2048, 2048, 2048, big, 0, 6, (size_t)1024 * 2048}; pg8::StaticOrder S; S.init(EPB * 16384, 1024, C.G, C.bid);
                    pg8::EpiYe E{(bf16_t*)(C.ws + WS_Y) + (size_t)e0 * 16384 * DM, (const float*)(C.ws + WS_GSEL) + (size_t)e0 * 16384, 1.f / (pg8::FP8_H_SCALE * pg8::FP8_W2_SCALE)}; pg8::gemm_phase<pg8::EpiYe, pg8::StaticOrder, true>(C.lds, g, S, E); }
            } PH_END
        }
        PH_BEGIN SITE(19) ph_ln<false>(C, l, 1, l + 1 < 2 ? XB0 : nullptr); PH_END
    }
#undef PH_BEGIN
#undef PH_END
#undef XB0
#undef XB1
#undef Yb
#undef Ub
#undef wl
}

extern "C" void kernel_launch(void* const* d_in, const int* in_sizes, int n_in, void* d_out, int out_size, void* d_ws, size_t ws_size, hipStream_t stream) {
    static int grid = 0;
    if (grid == 0) {
        if (n_in != 26 || out_size != NTOK * DM || ws_size < WS_END) { fprintf(stderr, "kernel_launch: unexpected shapes: n_in %d out %d ws %zu (need %zu)\n", n_in, out_size, ws_size, (size_t)WS_END); grid = -1; return; }
        int dev = 0, cus = 0, per_cu = 0;
        if (hipGetDevice(&dev) != hipSuccess || hipDeviceGetAttribute(&cus, hipDeviceAttributeMultiprocessorCount, dev) != hipSuccess) { grid = -1; return; }
        if (hipFuncSetAttribute((const void*)mk_fwd, hipFuncAttributeMaxDynamicSharedMemorySize, LDS_BYTES) != hipSuccess) { fprintf(stderr, "kernel_launch: hipFuncSetAttribute failed\n"); grid = -1; return; }
        if (hipOccupancyMaxActiveBlocksPerMultiprocessor(&per_cu, (const void*)mk_fwd, 512, LDS_BYTES) != hipSuccess || per_cu < 1) { fprintf(stderr, "kernel_launch: occupancy query says %d\n", per_cu); }
        (void)hipGetLastError();
        grid = cus;
    }
    if (grid < 0) return;
    if (hipMemsetAsync((char*)d_ws + WS_CTL, 0, CTL_ZERO_BYTES, stream) != hipSuccess) return;
    Args a{};
    for (int i = 0; i < 26; ++i) a.in[i] = (const float*)d_in[i];
    a.out = (float*)d_out; a.ws = (unsigned char*)d_ws;
#if MK_PER_PHASE_LAUNCH
    for (int p = 0; p < NPH; ++p) { a.ph_lo = p; a.ph_hi = p + 1; hipLaunchKernelGGL(mk_fwd, dim3(grid), dim3(512), LDS_BYTES, stream, a); }
#else
    a.ph_lo = 0; a.ph_hi = NPH; hipLaunchKernelGGL(mk_fwd, dim3(grid), dim3(512), LDS_BYTES, stream, a);
#endif
    const hipError_t le = hipPeekAtLastError();
    if (le != hipSuccess) fprintf(stderr, "kernel_launch: launch failed: %s\n", hipGetErrorName(le));
}
```

```cpp
#include <hip/hip_runtime.h>
#include <cstdio>
#include <cstdint>

#ifndef MK_PER_PHASE_LAUNCH
#define MK_PER_PHASE_LAUNCH 0
#endif

#define LAS __attribute__((address_space(3)))
#define GAS __attribute__((address_space(1)))
typedef unsigned short bf16_t;
typedef short bf16x8 __attribute__((ext_vector_type(8)));
typedef short s16x4 __attribute__((ext_vector_type(4)));
typedef float f32x2 __attribute__((ext_vector_type(2)));
typedef float f32x4 __attribute__((ext_vector_type(4)));
typedef float f32x16 __attribute__((ext_vector_type(16)));
typedef unsigned u32x2 __attribute__((ext_vector_type(2)));
typedef unsigned u32x4 __attribute__((ext_vector_type(4)));
#define DI __device__ __forceinline__
#define LDS_WAIT() asm volatile("s_waitcnt lgkmcnt(0)" ::: "memory")
#define VM_WAIT() asm volatile("s_waitcnt vmcnt(0)" ::: "memory")

constexpr int DM = 1024, NTOK = 131072, NTOKG = 65536, NSEQ = 40, NCHUNK = 1024  ;
constexpr int IN_W = 6992, COL_B = 768, COL_CD = 2048, COL_GATE = 2896;
constexpr int NEXP = 16, DEXP = 2048, CAP = 8192;
constexpr float ALPHA = 1.41421356237309515f, INV_ALPHA = 0.70710678118654752f;
constexpr float LOG2E = 1.4426950408889634f;
constexpr float LN_EPS = 1e-5f, RMS_EPS = 1e-6f;

constexpr size_t MiB = (size_t)1 << 20;
constexpr size_t WS_CTL = 0, CTL_ZERO_BYTES = 1 * MiB;
constexpr size_t WS_KN2 = 256 * 1024;
constexpr size_t WS_WSMALL = 2 * MiB, WSMALL_LAYER = 18 * MiB;
constexpr size_t OFF_WA = 0, OFF_WB = (size_t)768 * 1024 * 2, OFF_WCD = OFF_WB + (size_t)1280 * 1024 * 2, OFF_WG = OFF_WCD + (size_t)1024 * 1024 * 2,
                 OFF_WBR = OFF_WG + (size_t)4096 * 1024 * 2, OFF_WOUT = OFF_WBR + (size_t)4096 * 256 * 2;
static_assert(OFF_WOUT + (size_t)1024 * 1024 * 2 <= WSMALL_LAYER, "small weights");
constexpr size_t WS_WC = 38 * MiB, WC_LAYER = 256 * 1024;
constexpr size_t OFF_WQ = 0, OFF_WKV = 96 * 1024;
constexpr size_t WS_WRG = 39 * MiB;
constexpr size_t WS_AFF = 40 * MiB;
constexpr size_t WS_IDX = 48 * MiB, WS_GSEL = 49 * MiB;
constexpr size_t WS_GAM = 50 * MiB;
constexpr size_t WS_DC = 52 * MiB;
constexpr size_t WS_SM = 56 * MiB;
constexpr size_t WS_XB0 = 64 * MiB, WS_XB1 = 320 * MiB, WS_Y = 576 * MiB, WS_U = 832 * MiB, WS_EW = 1152 * MiB, WS_END = 1344 * MiB;
constexpr size_t OFF_QC = 0, OFF_KC = 48 * MiB, OFF_VC = 96 * MiB;
constexpr size_t OFF_WGU8 = 0, OFF_WD8 = (size_t)16 * 4096 * 1024;

DI unsigned f2bf(float f) { unsigned u = __builtin_bit_cast(unsigned, f); return (u + 0x7fffu + ((u >> 16) & 1u)) >> 16; }
DI unsigned pk2(float lo, float hi) { return f2bf(lo) | (f2bf(hi) << 16); }
DI float bf2f(unsigned short b) { return __builtin_bit_cast(float, ((unsigned)b) << 16); }
DI float bflo(unsigned w) { return __builtin_bit_cast(float, w << 16); }
DI float bfhi(unsigned w) { return __builtin_bit_cast(float, w & 0xffff0000u); }
DI unsigned cvt_pk_bf16(float lo, float hi) { unsigned r; asm volatile("v_cvt_pk_bf16_f32 %0, %1, %2" : "=v"(r) : "v"(lo), "v"(hi)); return r; }
typedef __bf16 bf16x2_t __attribute__((ext_vector_type(2)));
DI unsigned cvt_pk_bf16_b(float lo, float hi) { const f32x2 v = {lo, hi}; const bf16x2_t b = __builtin_convertvector(v, bf16x2_t); return __builtin_bit_cast(unsigned, b); }
DI float sigmoidf_(float x) { return __builtin_amdgcn_rcpf(1.0f + __builtin_amdgcn_exp2f(-x * LOG2E)); }
DI float siluf_(float x) { return x * sigmoidf_(x); }
DI float wave_sum(float v) {
#pragma unroll
    for (int o = 1; o < 64; o <<= 1) v += __shfl_xor(v, o);
    return v;
}
DI float wave_max(float v) {
#pragma unroll
    for (int o = 1; o < 64; o <<= 1) v = fmaxf(v, __shfl_xor(v, o));
    return v;
}
DI int seq_start_row(int s) { return s < 8 ? s * 8192 : 65536 + (s - 8) * 2048; }
DI int row_pos(int row) { return row < 65536 ? (row & 8191) : (row & 2047); }
DI int row_seq_begin(int row) { return row < 65536 ? (row & ~8191) : (row & ~2047); }
DI int row_seq_len(int row) { return row < 65536 ? 8192 : 2048; }

namespace pg8 {
constexpr int BM = 256, BK = 64, HALF = 128, HTB = HALF * BK * 2, STAGE_BYTES = 8 * HTB, NXCD = 8, WGM = 8;
DI int lds_byte(int r, int c) { const int st = (r >> 4) * 2 + (c >> 5), rr = r & 15, cc = c & 31, ob = rr * 64 + cc * 2; return st * 1024 + (ob ^ (((ob >> 9) & 1) << 5)); }
DI void stage_rc(int b, int& R, int& C) { const int st = b / 1024, sb = b % 1024, swz = sb ^ (((sb >> 9) & 1) << 5); R = (st >> 1) * 16 + swz / 64; C = (st & 1) * 32 + (swz % 64) / 2; }
DI int perm32(int rho) { const int n = rho >> 4, i = rho & 15; return 8 * (i >> 2) + 4 * n + (i & 3); }

struct Unit { int pm, pn; };
struct Gemm { const bf16_t* A; const bf16_t* Bt; int M, N, K, lda, ldb, an_shift; size_t an_off; int bm_shift = 30; size_t bm_off = 0; const int* gidx = nullptr; };

struct StaticOrder {
    int nM, nN, nwg, G, c;
    DI void init(int M, int N, int G_, int c_) { nM = M / BM; nN = N / BM; nwg = nM * nN; G = G_; c = c_; }
    DI bool next(int i, Unit& u) const {
        const long L = (long)i * G + c; if (L >= nwg) return false;
        int wgid = (int)L; { const int q = nwg / NXCD, r = nwg % NXCD, xcd = wgid % NXCD, off = wgid / NXCD; wgid = (xcd < r ? xcd * (q + 1) : r * (q + 1) + (xcd - r) * q) + off; }
        const int nig = WGM * nN, gid = wgid / nig, fm = gid * WGM, gsz = (nM - fm) < WGM ? (nM - fm) : WGM;
        u.pm = fm + ((wgid % nig) % gsz); u.pn = (wgid % nig) / gsz; return true;
    }
};

typedef f32x4 Acc[2][2][4][2];

typedef int v8i_t __attribute__((ext_vector_type(8)));
DI void mfma8_tied(f32x4& c, const v8i_t& a, const v8i_t& b) { asm volatile("v_mfma_f32_16x16x128_f8f6f4 %0, %1, %2, %0" : "+v"(c) : "v"(a), "v"(b)); }
DI void glds_sv(const void* sbase, unsigned voff, unsigned lds_dst) { unsigned keep;
    asm volatile("s_mov_b32 %0, m0\n\ts_mov_b32 m0, %3\n\ts_nop 0\n\tglobal_load_lds_dwordx4 %1, %2\n\ts_mov_b32 m0, %0" : "=&s"(keep) : "v"(voff), "s"(sbase), "s"(lds_dst) : "memory"); }
constexpr int GIDX_OFF = 131072 + 1024, GIDX_TILES = 14;
template <class Epi, class Sched, bool FP8 = false, bool GATHER = false>
DI void gemm_phase(LAS unsigned char* lds, const Gemm g, const Sched& S, const Epi& E) {
    int tid = threadIdx.x; asm volatile("" : "+v"(tid));
    const int wid = __builtin_amdgcn_readfirstlane(tid >> 6), lane = tid & 63, wr = wid >> 2, wc = wid & 3, fr = lane & 15, fq = lane >> 4;
    const int K = g.K, nt = FP8 ? K / 128 : K / BK;
    const int pitchA = FP8 ? g.lda : g.lda * 2, pitchB = FP8 ? g.ldb : g.ldb * 2;
    unsigned voffA[2], voffB[2];
#pragma unroll
    for (int i = 0; i < 2; ++i) { int R, C; stage_rc(tid * 16 + i * 8192, R, C); const int Rb = Epi::PERM ? ((R & ~31) + perm32(R & 31)) : R;
        voffA[i] = (unsigned)(R * pitchA + C * 2); voffB[i] = (unsigned)(Rb * pitchB + C * 2); }
    const size_t kstep = (size_t)(BK * 2);
    const size_t hstepA = (size_t)HALF * pitchA, hstepB = (size_t)HALF * pitchB;
    const size_t tstepA = 2 * hstepA, tstepB = 2 * hstepB;
    const unsigned ldsw = (unsigned)wid * 1024u;
    const int aoff = lds_byte(wr * 64 + fr, fq * 8), boff = lds_byte(wc * 32 + fr, fq * 8);
#define PG8_SA(b, h) (((b) * 2 + (h)) * HTB)
#define PG8_SB(b, h) ((4 + (b) * 2 + (h)) * HTB)
#define PG8_STAGE(bufoff, gbase, voff) do { _Pragma("unroll") for (int _i = 0; _i < 2; ++_i) \
        glds_sv((const void*)(gbase), (voff)[_i], (unsigned)(uintptr_t)(lds + (bufoff) + ldsw + _i * 8192)); } while (0)
#define PG8_LD1(p) ([&]() { if constexpr (FP8) { const u32x4 lo_ = *(const LAS u32x4*)(p), hi_ = *(const LAS u32x4*)((p) + 1024); return Frag{__builtin_bit_cast(v8i_t, __builtin_shufflevector(lo_, hi_, 0, 1, 2, 3, 4, 5, 6, 7))}; } \
        else { Frag f_; f_.h[0] = *(const LAS bf16x8*)(p); f_.h[1] = *(const LAS bf16x8*)((p) + 1024); return f_; } }())
#define PG8_LDA(dst, b, h) do { _Pragma("unroll") for (int m = 0; m < 4; ++m) dst[m] = PG8_LD1(lds + PG8_SA(b, h) + aoff + m * 2048); } while (0)
#define PG8_LDB(dst, b, h) do { _Pragma("unroll") for (int n = 0; n < 2; ++n) dst[n] = PG8_LD1(lds + PG8_SB(b, h) + boff + n * 2048); } while (0)
#define PG8_MMA(ai, bj, At, Bt) do { __builtin_amdgcn_s_setprio(1); _Pragma("unroll") for (int m = 0; m < 4; ++m) _Pragma("unroll") for (int n = 0; n < 2; ++n) { \
        if constexpr (FP8) mfma8_tied(acc[ai][bj][m][n], Bt[n].w, At[m].w); \
        else { _Pragma("unroll") for (int k = 0; k < 2; ++k) acc[ai][bj][m][n] = __builtin_amdgcn_mfma_f32_16x16x32_bf16(Bt[n].h[k], At[m].h[k], acc[ai][bj][m][n], 0, 0, 0); } } \
        __builtin_amdgcn_s_setprio(0); } while (0)
#define PG8_WAIT_V(n) asm volatile("s_waitcnt vmcnt(" #n ")" ::: "memory")
#define PG8_WAIT_L(n) asm volatile("s_waitcnt lgkmcnt(" #n ")" ::: "memory")
#define PG8_BAR __builtin_amdgcn_s_barrier()
#define PG8_SCHED __builtin_amdgcn_sched_barrier(0)
    Unit cur, nxt; int ui = 0;
    unsigned vg[2][2] = {{0u, 0u}, {0u, 0u}};
    if constexpr (GATHER) { LAS unsigned* tab = (LAS unsigned*)(lds + GIDX_OFF); Unit u_;
        for (int i = 0; i < GIDX_TILES && S.next(i, u_); ++i) { if (tid < 256) tab[i * 256 + tid] = (unsigned)g.gidx[u_.pm * BM + tid]; }
        __syncthreads(); }
#define PG8_GOFF(ord) do { int tq_ = tid; asm volatile("" : "+v"(tq_)); int R_, C_; stage_rc(tq_ * 16, R_, C_); const LAS unsigned* tb_ = (const LAS unsigned*)(lds + GIDX_OFF) + (ord) * 256 + R_; \
        _Pragma("unroll") for (int h_ = 0; h_ < 2; ++h_) _Pragma("unroll") for (int i_ = 0; i_ < 2; ++i_) vg[h_][i_] = tb_[h_ * 128 + i_ * 64] * (unsigned)pitchA + (unsigned)(C_ * 2); } while (0)
#define PG8_STAGE_A(bufoff, base, h) do { if constexpr (GATHER) PG8_STAGE(bufoff, base, vg[h]); else PG8_STAGE(bufoff, (base) + (h) * hstepA, voffA); } while (0)
    if (!S.next(0, cur)) return;
    if constexpr (GATHER) PG8_GOFF(0);
    float zf = 0.f; asm volatile("" : "+v"(zf));
    Acc acc;
#pragma unroll
    for (int a = 0; a < 2; ++a)
#pragma unroll
        for (int b = 0; b < 2; ++b)
#pragma unroll
            for (int m = 0; m < 4; ++m)
#pragma unroll
                for (int n = 0; n < 2; ++n) acc[a][b][m][n] = (f32x4){zf, zf, zf, zf};
    union Frag { v8i_t w; bf16x8 h[2]; };
    Frag At[4], B0[2], B1[2];
    const char* cA = GATHER ? (const char*)g.A : (const char*)g.A + (size_t)cur.pm * tstepA + (size_t)(cur.pn >> g.an_shift) * g.an_off; const char* cB = (const char*)g.Bt + (size_t)cur.pn * tstepB + (size_t)(cur.pm >> g.bm_shift) * g.bm_off;
    PG8_STAGE(PG8_SB(0, 0), cB, voffB); PG8_STAGE(PG8_SB(0, 1), cB + hstepB, voffB); PG8_STAGE_A(PG8_SA(0, 0), cA, 0); PG8_STAGE_A(PG8_SA(0, 1), cA, 1);
    if (wr == 1) PG8_BAR;
    PG8_WAIT_V(2); PG8_BAR;
    PG8_STAGE(PG8_SB(1, 0), cB + kstep, voffB); PG8_STAGE_A(PG8_SA(1, 0), cA + kstep, 0); PG8_STAGE(PG8_SB(1, 1), cB + hstepB + kstep, voffB);
    PG8_WAIT_V(6); PG8_BAR;
    for (;;) {
        const bool has_next = S.next(ui + 1, nxt);
        const char* nA = (has_next && !GATHER) ? (const char*)g.A + (size_t)nxt.pm * tstepA + (size_t)(nxt.pn >> g.an_shift) * g.an_off : cA;
        const char* nB = has_next ? (const char*)g.Bt + (size_t)nxt.pn * tstepB + (size_t)(nxt.pm >> g.bm_shift) * g.bm_off : cB;
#pragma unroll 1
        for (int t = 0; t < nt; t += 2) {
            const bool last = (t == nt - 2);
            const char* a1 = cA + (size_t)(t + 1) * kstep;
            const char* a2 = last ? nA : cA + (size_t)(t + 2) * kstep; const char* b2 = last ? nB : cB + (size_t)(t + 2) * kstep;
            const char* a3 = a2 + kstep; const char* b3 = b2 + kstep;
            PG8_LDB(B0, 0, 0); PG8_LDB(B1, 0, 1); PG8_SCHED; PG8_LDA(At, 0, 0); PG8_STAGE_A(PG8_SA(1, 1), a1, 1);
            if constexpr (GATHER) { if (last && has_next) PG8_GOFF(ui + 1); }
            PG8_WAIT_V(8); PG8_WAIT_L(0); PG8_BAR; PG8_MMA(0, 0, At, B0); PG8_MMA(0, 1, At, B1); PG8_BAR; PG8_SCHED;
            PG8_LDA(At, 0, 1); PG8_STAGE(PG8_SB(0, 0), b2, voffB); PG8_STAGE(PG8_SB(0, 1), b2 + hstepB, voffB); PG8_STAGE_A(PG8_SA(0, 0), a2, 0);
            PG8_WAIT_V(8); PG8_WAIT_L(0); PG8_BAR; PG8_MMA(1, 0, At, B0); PG8_MMA(1, 1, At, B1); PG8_BAR; PG8_SCHED;
            PG8_LDB(B0, 1, 0); PG8_LDB(B1, 1, 1); PG8_SCHED; PG8_LDA(At, 1, 0); PG8_STAGE_A(PG8_SA(0, 1), a2, 1);
            PG8_WAIT_V(8); PG8_WAIT_L(0); PG8_BAR; PG8_MMA(0, 0, At, B0); PG8_MMA(0, 1, At, B1); PG8_BAR; PG8_SCHED;
            PG8_LDA(At, 1, 1); PG8_STAGE(PG8_SB(1, 0), b3, voffB); PG8_STAGE(PG8_SB(1, 1), b3 + hstepB, voffB); PG8_STAGE_A(PG8_SA(1, 0), a3, 0);
            PG8_WAIT_V(8); PG8_WAIT_L(0); PG8_BAR; PG8_MMA(1, 0, At, B0); PG8_MMA(1, 1, At, B1); PG8_BAR; PG8_SCHED;
        }
        if (wr == 0) PG8_BAR;
        if constexpr (FP8) asm volatile("s_nop 15\n\ts_nop 15" ::: "memory");
        { int tz = tid; asm volatile("" : "+v"(tz));
          const int lz = tz & 63; E(acc, cur, wr, wc, lz & 15, lz >> 4); }
        if (!has_next) break;
#pragma unroll
        for (int a = 0; a < 2; ++a)
#pragma unroll
            for (int b = 0; b < 2; ++b)
#pragma unroll
                for (int m = 0; m < 4; ++m)
#pragma unroll
                    for (int n = 0; n < 2; ++n) acc[a][b][m][n] = (f32x4){0.f, 0.f, 0.f, 0.f};
        cur = nxt; cA = nA; cB = nB; ++ui;
        if (wr == 1) PG8_BAR;
    }
    PG8_WAIT_V(0);
    PG8_BAR;
#undef PG8_SA
#undef PG8_SB
#undef PG8_STAGE
#undef PG8_STAGE_A
#undef PG8_GOFF
#undef PG8_LDA
#undef PG8_LDB
#undef PG8_MMA
#undef PG8_LD1
#undef PG8_WAIT_V
#undef PG8_WAIT_L
#undef PG8_BAR
#undef PG8_SCHED
}

struct EpiProj {
    static constexpr bool PERM = true;
    bf16_t* O; int ldc; int scale_cols; float scale; unsigned* kn2;
    DI void operator()(const Acc& acc, const Unit& u, int wr, int wc, int fr, int fq) const {
        const int row0 = u.pm * BM + wr * 64 + fr, colt = u.pn * BM, col0 = colt + wc * 32 + 8 * fq;
        const float sc = (colt < scale_cols) ? scale : 1.f;
        const bool donorm = (kn2 != nullptr) && (colt == 256);
#pragma unroll
        for (int ai = 0; ai < 2; ++ai) { float mx0 = 0.f, mx1 = 0.f;
#pragma unroll
            for (int m = 0; m < 4; ++m) { bf16_t* rowp = O + (size_t)(row0 + ai * HALF + m * 16) * ldc + col0;
#pragma unroll
                for (int bj = 0; bj < 2; ++bj) { const f32x4 v0 = acc[ai][bj][m][0] * sc, v1 = acc[ai][bj][m][1] * sc;
                    u32x4 w; w.x = cvt_pk_bf16(v0[0], v0[1]); w.y = cvt_pk_bf16(v0[2], v0[3]); w.z = cvt_pk_bf16(v1[0], v1[1]); w.w = cvt_pk_bf16(v1[2], v1[3]);
                    *(u32x4*)(rowp + bj * HALF) = w;
                    if (donorm) { float ss = bflo(w.x) * bflo(w.x) + bfhi(w.x) * bfhi(w.x) + bflo(w.y) * bflo(w.y) + bfhi(w.y) * bfhi(w.y) + bflo(w.z) * bflo(w.z) + bfhi(w.z) * bfhi(w.z) + bflo(w.w) * bflo(w.w) + bfhi(w.w) * bfhi(w.w);
                        ss += __shfl_xor(ss, 16); ss += __shfl_xor(ss, 32); if (bj == 0) mx0 = fmaxf(mx0, ss); else mx1 = fmaxf(mx1, ss); } } }
            if (donorm) {
#pragma unroll
                for (int o = 1; o < 16; o <<= 1) { mx0 = fmaxf(mx0, __shfl_xor(mx0, o)); mx1 = fmaxf(mx1, __shfl_xor(mx1, o)); }
                if (fr == 0 && fq == 0) { const int tile = 4 * u.pm + 2 * ai + wr;
                    atomicMax(kn2 + (size_t)(wc) * 2048 + tile, __builtin_bit_cast(unsigned, mx0)); atomicMax(kn2 + (size_t)(4 + wc) * 2048 + tile, __builtin_bit_cast(unsigned, mx1)); } } }
    }
};
struct EpiSiluMul {
    static constexpr bool PERM = true;
    bf16_t* H; int ldh;
    DI void operator()(const Acc& acc, const Unit& u, int wr, int wc, int fr, int fq) const {
        const int row0 = u.pm * BM + wr * 64 + fr, col0 = u.pn * HALF + wc * 32 + 8 * fq;
#pragma unroll
        for (int ai = 0; ai < 2; ++ai)
#pragma unroll
            for (int m = 0; m < 4; ++m) { bf16_t* rowp = H + (size_t)(row0 + ai * HALF + m * 16) * ldh + col0;
                float h[8];
#pragma unroll
                for (int n = 0; n < 2; ++n)
#pragma unroll
                    for (int j = 0; j < 4; ++j) h[n * 4 + j] = siluf_(acc[ai][0][m][n][j]) * acc[ai][1][m][n][j];
                u32x4 w; w.x = cvt_pk_bf16(h[0], h[1]); w.y = cvt_pk_bf16(h[2], h[3]); w.z = cvt_pk_bf16(h[4], h[5]); w.w = cvt_pk_bf16(h[6], h[7]);
                *(u32x4*)rowp = w; }
    }
};
DI unsigned pk4_fp8(float a, float b, float c, float d) { int w = 0; a = __builtin_amdgcn_fmed3f(a, -448.f, 448.f); b = __builtin_amdgcn_fmed3f(b, -448.f, 448.f); c = __builtin_amdgcn_fmed3f(c, -448.f, 448.f); d = __builtin_amdgcn_fmed3f(d, -448.f, 448.f);     w = __builtin_amdgcn_cvt_pk_fp8_f32(a, b, w, false); w = __builtin_amdgcn_cvt_pk_fp8_f32(c, d, w, true); return (unsigned)w; }
constexpr float FP8_W1_SCALE = 32.f, FP8_W2_SCALE = 64.f, FP8_H_SCALE = 4.f;
struct EpiSiluMul8 {
    static constexpr bool PERM = true;
    unsigned char* H; int ldh;
    DI void operator()(const Acc& acc, const Unit& u, int wr, int wc, int fr, int fq) const {
        const int row0 = u.pm * BM + wr * 64 + fr, col0 = u.pn * HALF + wc * 32 + 8 * fq;
        constexpr float k1 = -LOG2E / FP8_W1_SCALE; static_assert(FP8_W1_SCALE * FP8_W1_SCALE / FP8_H_SCALE == 256.f, "scale folding");
#pragma unroll
        for (int ai = 0; ai < 2; ++ai)
#pragma unroll
            for (int m = 0; m < 4; ++m) { unsigned char* rowp = H + (size_t)(row0 + ai * HALF + m * 16) * ldh + col0;
                float t[8], h[8];
#pragma unroll
                for (int q = 0; q < 8; ++q) t[q] = __builtin_fmaf(acc[ai][0][m][q >> 2][q & 3], k1, 8.f);
#pragma unroll
                for (int q = 0; q < 8; ++q) t[q] = __builtin_amdgcn_exp2f(t[q]);
#pragma unroll
                for (int q = 0; q < 8; ++q) { t[q] += 256.f; h[q] = acc[ai][0][m][q >> 2][q & 3] * acc[ai][1][m][q >> 2][q & 3]; }
#pragma unroll
                for (int q = 0; q < 8; ++q) t[q] = __builtin_amdgcn_rcpf(t[q]);
#pragma unroll
                for (int q = 0; q < 8; ++q) h[q] *= t[q];
                u32x2 w; w.x = pk4_fp8(h[0], h[1], h[2], h[3]); w.y = pk4_fp8(h[4], h[5], h[6], h[7]);
                *(u32x2*)rowp = w; }
    }
};
struct EpiMoeDown {
    static constexpr bool PERM = false;
    float* out; const int* idx; const float* gs; float sc;
    DI void operator()(const Acc& acc, const Unit& u, int wr, int wc, int fr, int fq) const {
        const int row0 = u.pm * BM + wr * 64 + fr, col0 = u.pn * BM + wc * 32 + 4 * fq;
#pragma unroll
        for (int ai = 0; ai < 2; ++ai)
#pragma unroll
            for (int m = 0; m < 4; ++m) { const int rl = row0 + ai * HALF + m * 16; const int tok = idx[rl]; const float g = gs[rl] * sc;
                float* rowp = out + (size_t)tok * DM + col0;
#pragma unroll
                for (int bj = 0; bj < 2; ++bj)
#pragma unroll
                    for (int n = 0; n < 2; ++n) { f32x4* p = (f32x4*)(rowp + bj * HALF + n * 16); f32x4 v = *p; v += acc[ai][bj][m][n] * g; *p = v; }
                asm volatile("" ::: "memory"); }
    }
};
struct EpiYe {
    static constexpr bool PERM = true;
    bf16_t* O; const float* gs; float sc;
    DI void operator()(const Acc& acc, const Unit& u, int wr, int wc, int fr, int fq) const {
        const int row0 = u.pm * BM + wr * 64 + fr, col0 = u.pn * BM + wc * 32 + 8 * fq;
        float gv[8];
#pragma unroll
        for (int c = 0; c < 8; ++c) gv[c] = gs[row0 + (c >> 2) * HALF + (c & 3) * 16];
#pragma unroll
        for (int ai = 0; ai < 2; ++ai)
#pragma unroll
            for (int m = 0; m < 4; ++m) { const int rl = row0 + ai * HALF + m * 16; const float g = gv[ai * 4 + m] * sc; bf16_t* rowp = O + (size_t)rl * DM + col0;
#pragma unroll
                for (int bj = 0; bj < 2; ++bj) { const f32x4 v0 = acc[ai][bj][m][0] * g, v1 = acc[ai][bj][m][1] * g;
                    u32x4 w; w.x = cvt_pk_bf16(v0[0], v0[1]); w.y = cvt_pk_bf16(v0[2], v0[3]); w.z = cvt_pk_bf16(v1[0], v1[1]); w.w = cvt_pk_bf16(v1[2], v1[3]);
                    __builtin_nontemporal_store(w, (u32x4*)(rowp + bj * HALF)); } }
    }
};
struct EpiResid {
    static constexpr bool PERM = false;
    const float* xa; const float* xb; float* out;
    DI void operator()(const Acc& acc, const Unit& u, int wr, int wc, int fr, int fq) const {
        const int row0 = u.pm * BM + wr * 64 + fr, col0 = u.pn * BM + wc * 32 + 4 * fq;
#pragma unroll
        for (int ai = 0; ai < 2; ++ai) {
            f32x4 sv[4][4];
#pragma unroll
            for (int m = 0; m < 4; ++m) { const int r = row0 + ai * HALF + m * 16;
                const float* srow = (r < NTOKG ? xa + (size_t)r * DM : xb + (size_t)(r - NTOKG) * DM) + col0;
#pragma unroll
                for (int q = 0; q < 4; ++q) sv[m][q] = __builtin_nontemporal_load((const f32x4*)(srow + (q >> 1) * HALF + (q & 1) * 16)); }
#pragma unroll
            for (int m = 0; m < 4; ++m) { const int r = row0 + ai * HALF + m * 16; float* orow = out + (size_t)r * DM + col0;
#pragma unroll
                for (int q = 0; q < 4; ++q) __builtin_nontemporal_store(sv[m][q] + acc[ai][q >> 1][m][q & 1] * INV_ALPHA, (f32x4*)(orow + (q >> 1) * HALF + (q & 1) * 16)); } }
    }
};
struct EpiGateMix {
    static constexpr bool PERM = false;
    const bf16_t* Z; bf16_t* mix; float si;
    DI void operator()(const Acc& acc, const Unit& u, int wr, int wc, int fr, int fq) const {
        const int row0 = u.pm * BM + wr * 64 + fr, J0 = u.pn * 64 + wc * 16 + fq * 4;
        u32x2 zall[8][4];
#pragma unroll
        for (int c = 0; c < 8; ++c) { const bf16_t* zrow = Z + (size_t)(row0 + (c >> 2) * HALF + (c & 3) * 16) * 4096 + J0;
#pragma unroll
            for (int b = 0; b < 4; ++b) zall[c][b] = *(const u32x2*)(zrow + b * 1024); }
#pragma unroll
        for (int ai = 0; ai < 2; ++ai)
#pragma unroll
            for (int m = 0; m < 4; ++m) { const int r = row0 + ai * HALF + m * 16;
                u32x2 zw[4];
#pragma unroll
                for (int b = 0; b < 4; ++b) zw[b] = zall[ai * 4 + m][b];
                const float kq = -si * LOG2E; float t[16];
#pragma unroll
                for (int q = 0; q < 16; ++q) t[q] = acc[ai][q >> 3][m][(q >> 2) & 1][q & 3] * kq;
#pragma unroll
                for (int q = 0; q < 16; ++q) t[q] = __builtin_amdgcn_exp2f(t[q]);
#pragma unroll
                for (int q = 0; q < 16; ++q) t[q] += 1.f;
#pragma unroll
                for (int q = 0; q < 16; ++q) t[q] = __builtin_amdgcn_rcpf(t[q]);
                f32x4 s = (f32x4){0.f, 0.f, 0.f, 0.f};
#pragma unroll
                for (int b = 0; b < 4; ++b) { s[0] += t[4 * b] * bflo(zw[b].x); s[1] += t[4 * b + 1] * bfhi(zw[b].x); s[2] += t[4 * b + 2] * bflo(zw[b].y); s[3] += t[4 * b + 3] * bfhi(zw[b].y); }
                u32x2 w; w.x = cvt_pk_bf16(s[0], s[1]); w.y = cvt_pk_bf16(s[2], s[3]);
                *(u32x2*)(mix + (size_t)r * DM + J0) = w; }
    }
};
}

#define XB_TMO      128
#define XB_XCNT(j)  (256  + 64 * (j))
#define XB_XSUB(j)  (1280 + 64 * (j))
#define XB_XGEN(j)  (2304 + 64 * (j))
#define XB_TOP      3328
#define XB_TOPGEN   3392
#define XCD_BAR_WORDS 3456
#define XB_SPIN_CAP (1u << 24)
DI unsigned xb_ld(unsigned* p)              { return __hip_atomic_load(p, __ATOMIC_RELAXED, __HIP_MEMORY_SCOPE_AGENT); }
DI unsigned xb_add(unsigned* p, unsigned v) { return __hip_atomic_fetch_add(p, v, __ATOMIC_RELAXED, __HIP_MEMORY_SCOPE_AGENT); }
DI unsigned xb_xcc_id() { return (unsigned)__builtin_amdgcn_s_getreg((3 << 11) | 20) & 0xFu; }
#define XB_SPIN(cond, bar) do { unsigned _sp = 0; while (cond) { __builtin_amdgcn_s_sleep(1); \
    if ((++_sp & 255u) == 0u) { if (xb_ld(&(bar)[XB_TMO])) break; if (_sp > XB_SPIN_CAP) { atomicAdd(&(bar)[XB_TMO], 1u); break; } } } } while (0)
struct XcdBarrier { unsigned* bar; unsigned x; volatile LAS unsigned* st; };
DI XcdBarrier xcd_barrier_post(unsigned* bar, volatile LAS unsigned* st) {
    XcdBarrier b; b.bar = bar; b.x = xb_xcc_id(); b.st = st;
    if (threadIdx.x == 0) (void)xb_add(&bar[XB_XCNT(b.x)], 1u);
    return b;
}
DI void xcd_barrier_complete(unsigned* bar, unsigned x, unsigned& nloc, unsigned& nx) {
    const unsigned G = gridDim.x * gridDim.y * gridDim.z;
    unsigned sum, cnt, mine, sp = 0u;
    for (;;) {
        sum = 0u; cnt = 0u; mine = 0u;
#pragma unroll
        for (unsigned j = 0; j < 16; ++j) { const unsigned c = xb_ld(&bar[XB_XCNT(j)]); sum += c; cnt += (c > 0u) ? 1u : 0u; mine = (j == x) ? c : mine; }
        if (sum == G) break;
        __builtin_amdgcn_s_sleep(1);
        if ((++sp & 255u) == 0u) { if (xb_ld(&bar[XB_TMO])) break; if (sp > XB_SPIN_CAP) { atomicAdd(&bar[XB_TMO], 1u); break; } }
    }
    nloc = mine > 0u ? mine : 1u; nx = cnt > 0u ? cnt : 1u;
}
DI void xcd_barrier(const XcdBarrier& b) {
    asm volatile("s_waitcnt vmcnt(0)" ::: "memory");
    __syncthreads();
    if (threadIdx.x == 0) {
        unsigned* bar = b.bar;
        __builtin_amdgcn_s_waitcnt(0);
        unsigned nloc = b.st[0], nx = b.st[1];
        if (nloc == 0u) { xcd_barrier_complete(bar, b.x, nloc, nx); b.st[0] = nloc; b.st[1] = nx; }
        const unsigned old = xb_add(&bar[XB_XSUB(b.x)], 1u);
        const unsigned gen = old / nloc;
        if (old + 1u == (gen + 1u) * nloc) {
            __builtin_amdgcn_fence(__ATOMIC_RELEASE, "agent");
            asm volatile("s_waitcnt vmcnt(0)" ::: "memory");
            const unsigned og = xb_add(&bar[XB_TOP], 1u);
            const unsigned tg = og / nx;
            if (og + 1u == (tg + 1u) * nx) xb_add(&bar[XB_TOPGEN], 1u);
            else XB_SPIN(xb_ld(&bar[XB_TOPGEN]) == tg, bar);
            __builtin_amdgcn_fence(__ATOMIC_ACQUIRE, "agent");
            xb_add(&bar[XB_XGEN(b.x)], 1u);
            asm volatile("s_waitcnt vmcnt(0)" ::: "memory");
        } else {
            XB_SPIN(xb_ld(&bar[XB_XGEN(b.x)]) == gen, bar);
            __builtin_amdgcn_fence(__ATOMIC_ACQUIRE, "agent");
            asm volatile("s_waitcnt vmcnt(0)" ::: "memory");
        }
    }
    __syncthreads();
}

struct Args { const float* in[26]; float* out; unsigned char* ws; int ph_lo, ph_hi; };
struct Ctx {
    LAS unsigned char* lds;
    GAS unsigned char* ws;
    int tid, lane, wave, G, bid, gw, NGW;
    const struct Args* A;
    GAS float* out;
};
constexpr int RING_BYTES = 131072, MISC_OFF = RING_BYTES + 320, LDS_BYTES = 147456;

DI void tr_item(const float* __restrict__ W, int ldw, int k0, int src, const float* kscale, bf16_t* WT, int ldt, int orow0, LAS float* scr, int lane) {
    float tv[32];
#pragma unroll
    for (int i = 0; i < 32; ++i) { const int kk = 2 * i + (lane >> 5); tv[i] = (src >= 0) ? W[(size_t)(k0 + kk) * ldw + src] : 0.f; }
#pragma unroll
    for (int i = 0; i < 32; ++i) { const int kk = 2 * i + (lane >> 5); float v = tv[i]; if (kscale) v *= kscale[k0 + kk]; scr[kk * 33 + (lane & 31)] = v; }
    LDS_WAIT();
    const int c = lane & 7;
#pragma unroll
    for (int j = 0; j < 4; ++j) { const int n = (lane >> 3) + 8 * j; const LAS float* s = scr + (8 * c) * 33 + n;
        u32x4 o; o.x = pk2(s[0 * 33], s[1 * 33]); o.y = pk2(s[2 * 33], s[3 * 33]); o.z = pk2(s[4 * 33], s[5 * 33]); o.w = pk2(s[6 * 33], s[7 * 33]);
        *(u32x4*)(WT + (size_t)(orow0 + n) * ldt + k0 + 8 * c) = o; }
    LDS_WAIT();
}
DI void tr_item8(const float* __restrict__ W, int ldw, int k0, int src, float scale, unsigned char* WT, int ldt, int orow0, LAS float* scr, int lane) {
    float tv[32];
#pragma unroll
    for (int i = 0; i < 32; ++i) { const int kk = 2 * i + (lane >> 5); tv[i] = __builtin_nontemporal_load(&W[(size_t)(k0 + kk) * ldw + src]); }
#pragma unroll
    for (int i = 0; i < 32; ++i) { const int kk = 2 * i + (lane >> 5); scr[kk * 33 + (lane & 31)] = tv[i] * scale; }
    LDS_WAIT();
    const int c = lane & 7;
#pragma unroll
    for (int j = 0; j < 4; ++j) { const int n = (lane >> 3) + 8 * j; const LAS float* s = scr + (8 * c) * 33 + n;
        u32x2 o; o.x = pg8::pk4_fp8(s[0 * 33], s[1 * 33], s[2 * 33], s[3 * 33]); o.y = pg8::pk4_fp8(s[4 * 33], s[5 * 33], s[6 * 33], s[7 * 33]);
        *(u32x2*)(WT + (size_t)(orow0 + n) * ldt + k0 + 8 * c) = o; }
    LDS_WAIT();
}
constexpr int SW_ITEMS[8] = {16 * 24, 16 * 40, 16 * 32, 16 * 128, 4 * 4 * 32, 16 * 32, 3 * 6, 2 * 12};
constexpr int SW_TOTAL = 16 * 24 + 16 * 40 + 16 * 32 + 16 * 128 + 4 * 4 * 32 + 16 * 32 + 3 * 6 + 2 * 12;
DI void small_weight_item(const Ctx& C, int l, int it, LAS float* scr) {
    unsigned char* wl = (unsigned char*)(C.ws + WS_WSMALL + (size_t)l * WSMALL_LAYER); unsigned char* wc = (unsigned char*)(C.ws + WS_WC + (size_t)l * WC_LAYER);
    const float* win = C.A->in[2] + (size_t)l * DM * IN_W; const int ln = C.lane & 31;
    if (it < 384) { const int kb = it / 24, nb = it % 24; tr_item(win, IN_W, kb * 64, nb * 32 + ln, nullptr, (bf16_t*)(wl + OFF_WA), 1024, nb * 32, scr, C.lane); return; } it -= 384;
    if (it < 640) { const int kb = it / 40, nb = it % 40; tr_item(win, IN_W, kb * 64, COL_B + nb * 32 + ln, nullptr, (bf16_t*)(wl + OFF_WB), 1024, nb * 32, scr, C.lane); return; } it -= 640;
    if (it < 512) { const int kb = it / 32, nb = it % 32; const int n = nb * 32 + ln; tr_item(win, IN_W, kb * 64, n < 848 ? COL_CD + n : -1, nullptr, (bf16_t*)(wl + OFF_WCD), 1024, nb * 32, scr, C.lane); return; } it -= 512;
    if (it < 2048) { const int kb = it / 128, nb = it % 128; const int n = nb * 32 + ln, pn = n >> 8, c = n & 255;
        const int bj = c >> 7, wcc = (c >> 5) & 3, nn = (c >> 4) & 1, fq = (c >> 2) & 3, j = c & 3;
        const int src = COL_GATE + (2 * bj + nn) * 1024 + 64 * pn + 16 * wcc + 4 * fq + j;
        tr_item8(win, IN_W, kb * 64, src, pg8::FP8_W1_SCALE, wl + OFF_WG, 1024, nb * 32, scr, C.lane); return; } it -= 2048;
    if (it < 512) { const int b = it / 128, r = it % 128, kb = r / 32, nb = r % 32;
        tr_item(C.A->in[18] + (size_t)(l * 4 + b) * 256 * 1024, 1024, kb * 64, nb * 32 + ln, nullptr, (bf16_t*)(wl + OFF_WBR), 256, b * 1024 + nb * 32, scr, C.lane); return; } it -= 512;
    if (it < 512) { const int kb = it / 32, nb = it % 32; tr_item(C.A->in[19] + (size_t)l * DM * DM, 1024, kb * 64, nb * 32 + ln, nullptr, (bf16_t*)(wl + OFF_WOUT), 1024, nb * 32, scr, C.lane); return; } it -= 512;
    if (it < 18) { const int kb = it / 6, nb = it % 6; tr_item(C.A->in[8] + (size_t)l * 192 * 192, 192, kb * 64, nb * 32 + ln, C.A->in[7] + l * 192, (bf16_t*)(wc + OFF_WQ), 192, nb * 32, scr, C.lane); return; } it -= 18;
    { const int kb = it / 12, nb = it % 12; tr_item(C.A->in[10] + (size_t)l * 128 * 384, 384, kb * 64, nb * 32 + ln, C.A->in[9] + l * 128, (bf16_t*)(wc + OFF_WKV), 128, nb * 32, scr, C.lane); }
}
DI void ph_prologue(const Ctx& C) {
    LAS float* scr = (LAS float*)(C.lds + C.wave * 16384);
    for (int it = C.gw; it < 2 * SW_TOTAL; it += C.NGW) small_weight_item(C, it / SW_TOTAL, it % SW_TOTAL, scr);
    for (int it = C.gw; it < 2 * 2 * 4 * 2 * 4 * 2; it += C.NGW) {
        const int ks = it & 1, nt = (it >> 1) & 3, gt = (it >> 3) & 1, n = (it >> 4) & 3, dir = (it >> 6) & 1, l = it >> 7;
        const float* wp = (gt == 0 ? C.A->in[13] : C.A->in[15]) + ((size_t)((l * 2 + dir) * 4 + n) * 64) * 64;
        const int l15 = C.lane & 15, g = C.lane >> 4; u32x4 wv;
#pragma unroll
        for (int p = 0; p < 4; ++p) { const int k = 32 * ks + 8 * g + 2 * p; wv[p] = cvt_pk_bf16(wp[(size_t)k * 64 + 16 * nt + l15], wp[(size_t)(k + 1) * 64 + 16 * nt + l15]); }
        ((u32x4*)(C.ws + WS_WRG))[(size_t)it * 64 + C.lane] = wv;
    }
    bf16_t* XB0 = (bf16_t*)(C.ws + WS_XB0);
    for (int row0 = C.gw; row0 < NTOK; row0 += 4 * C.NGW) {
        f32x4 v[4][4];
#pragma unroll
        for (int i = 0; i < 4; ++i) { const int row = min(row0 + i * C.NGW, NTOK - 1);
            const float* src = row < NTOKG ? C.A->in[0] + (size_t)row * DM : C.A->in[1] + (size_t)(row - NTOKG) * DM; const f32x4* xr = (const f32x4*)src + C.lane;
#pragma unroll
            for (int j = 0; j < 4; ++j) v[i][j] = __builtin_nontemporal_load(&xr[64 * j]); }
#pragma unroll
        for (int i = 0; i < 4; ++i) { const int row = row0 + i * C.NGW; if (row < NTOK) { u32x2* o = (u32x2*)(XB0 + (size_t)row * DM) + C.lane;
#pragma unroll
            for (int j = 0; j < 4; ++j) { u32x2 w; w.x = cvt_pk_bf16(v[i][j][0], v[i][j][1]); w.y = cvt_pk_bf16(v[i][j][2], v[i][j][3]); o[64 * j] = w; } } }
    }
}
DI void expert_weight_items(const Ctx& C, int l) {
    __syncthreads();
    LAS float* scr = (LAS float*)(C.lds + C.wave * 16384);
    unsigned char* WGU = (unsigned char*)(C.ws + WS_EW + OFF_WGU8); unsigned char* WD = (unsigned char*)(C.ws + WS_EW + OFF_WD8);
    const int ln = C.lane & 31;
    const int gw0 = (C.G > 64) ? C.gw - 32 * 8 : C.gw, ngw = (C.G > 64) ? C.NGW - 32 * 8 : C.NGW;
    for (int it = gw0; it < 32768 + 16384; it += ngw) {
        if (it < 32768) { const int e = it >> 11, r = it & 2047, kb = r >> 7, nb = r & 127; const int n = nb * 32 + ln, pn = n >> 8, c = n & 255;
            const float* W = (c < 128 ? C.A->in[23] : C.A->in[24]) + (size_t)(l * NEXP + e) * DM * DEXP;
            tr_item8(W, DEXP, kb * 64, 128 * pn + (c & 127), pg8::FP8_W1_SCALE, WGU + (size_t)e * 4096 * 1024, 1024, nb * 32, scr, C.lane);
        } else { const int i2 = it - 32768, e = i2 >> 10, r = i2 & 1023, kb = r >> 5, nb = r & 31;
            tr_item8(C.A->in[25] + (size_t)(l * NEXP + e) * DEXP * DM, DM, kb * 64, nb * 32 + ln, pg8::FP8_W2_SCALE, WD + (size_t)e * 1024 * 2048, 2048, nb * 32, scr, C.lane); }
    }
}

template <bool ROUTER>
DI void ph_ln(const Ctx& C, int l, int which, bf16_t* XB) {
    LAS float* wr = (LAS float*)C.lds;
    if (ROUTER) { const float* src = C.A->in[22] + (size_t)l * DM * NEXP;
        for (int t = C.tid; t < DM * NEXP / 4; t += 512) { const int k = t >> 2, q = t & 3, ln = (k & 255) >> 2, ii = k & 3, jj = k >> 8;
            ((LAS f32x4*)wr)[((jj * 4 + ii) * 4 + q) * 64 + ln] = ((const f32x4*)src)[t]; }
        __syncthreads(); }
    const float* gp = C.A->in[20] + (size_t)(l * 2 + which) * DM; const float* bp = C.A->in[21] + (size_t)(l * 2 + which) * DM;
    f32x4 gv[4], bv[4];
#pragma unroll
    for (int j = 0; j < 4; ++j) { gv[j] = ((const f32x4*)gp)[C.lane + 64 * j]; bv[j] = ((const f32x4*)bp)[C.lane + 64 * j]; }
    float* affT = (float*)(C.ws + WS_AFF);
    f32x4 nx[4], ny[4], nz[4], nw[4];
    { const f32x4* xr0 = (const f32x4*)(C.out + (size_t)C.gw * DM) + C.lane;
#pragma unroll
      for (int j = 0; j < 4; ++j) nx[j] = __builtin_nontemporal_load(&xr0[64 * j]);
      { const f32x4* xr1 = (const f32x4*)(C.out + (size_t)min(C.gw + C.NGW, NTOK - 1) * DM) + C.lane;
#pragma unroll
          for (int j = 0; j < 4; ++j) ny[j] = __builtin_nontemporal_load(&xr1[64 * j]); }
      { const f32x4* xr2 = (const f32x4*)(C.out + (size_t)min(C.gw + 2 * C.NGW, NTOK - 1) * DM) + C.lane;
#pragma unroll
          for (int j = 0; j < 4; ++j) nz[j] = __builtin_nontemporal_load(&xr2[64 * j]); }
      { const f32x4* xr3 = (const f32x4*)(C.out + (size_t)min(C.gw + 3 * C.NGW, NTOK - 1) * DM) + C.lane;
#pragma unroll
          for (int j = 0; j < 4; ++j) nw[j] = __builtin_nontemporal_load(&xr3[64 * j]); } }
    u32x4 sm0 = {0u, 0u, 0u, 0u}, sm1 = {0u, 0u, 0u, 0u};
    if (!ROUTER) { const u32x4* smr = (const u32x4*)(C.ws + WS_SM + (size_t)C.gw * 32); sm0 = smr[0]; sm1 = smr[1]; }
    for (int row = C.gw; row < NTOK; row += C.NGW) {
        f32x4* xr = (f32x4*)(C.out + (size_t)row * DM) + C.lane;
        f32x4 v[4]; float s = 0.f;
#pragma unroll
        for (int j = 0; j < 4; ++j) v[j] = nx[j] * ALPHA;
        if (!ROUTER) {
            const unsigned sw[8] = {sm0.x, sm0.y, sm0.z, sm0.w, sm1.x, sm1.y, sm1.z, sm1.w};
            { const u32x4* smr = (const u32x4*)(C.ws + WS_SM + (size_t)min(row + C.NGW, NTOK - 1) * 32); sm0 = smr[0]; sm1 = smr[1]; }
            const bf16_t* YE = (const bf16_t*)(C.ws + WS_Y); const int gofs = (row >> 16) * CAP;
            unsigned msk = 0u;
#pragma unroll
            for (int e = 0; e < 16; ++e) { const int slot = (int)(short)((e & 1) ? (sw[e >> 1] >> 16) : (sw[e >> 1] & 0xffffu)); if (slot >= 0) msk |= 1u << e; }
            msk = (unsigned)__builtin_amdgcn_readfirstlane((int)msk);
            while (msk) {
                const int e1 = __builtin_ctz(msk); msk &= msk - 1u; const bool two = msk != 0u; const int e2 = two ? __builtin_ctz(msk) : e1; if (two) msk &= msk - 1u;
                unsigned w1 = sw[0], w2 = sw[0];
#pragma unroll
                for (int q = 1; q < 8; ++q) { w1 = ((e1 >> 1) == q) ? sw[q] : w1; w2 = ((e2 >> 1) == q) ? sw[q] : w2; }
                const int s1 = (int)((e1 & 1) ? (w1 >> 16) : (w1 & 0xffffu)), s2 = (int)((e2 & 1) ? (w2 >> 16) : (w2 & 0xffffu));
                const u32x2* y1 = (const u32x2*)(YE + ((size_t)e1 * 16384 + gofs + s1) * DM) + C.lane; const u32x2* y2 = (const u32x2*)(YE + ((size_t)e2 * 16384 + gofs + s2) * DM) + C.lane;
                u32x2 a[4], b[4];
#pragma unroll
                for (int j = 0; j < 4; ++j) { a[j] = __builtin_nontemporal_load(&y1[64 * j]); b[j] = __builtin_nontemporal_load(&y2[64 * j]); }
                const float f2 = two ? 1.f : 0.f;
#pragma unroll
                for (int j = 0; j < 4; ++j) { v[j][0] += bflo(a[j].x) + f2 * bflo(b[j].x); v[j][1] += bfhi(a[j].x) + f2 * bfhi(b[j].x); v[j][2] += bflo(a[j].y) + f2 * bflo(b[j].y); v[j][3] += bfhi(a[j].y) + f2 * bfhi(b[j].y); }
            }
        }
#pragma unroll
        for (int j = 0; j < 4; ++j) s += (v[j][0] + v[j][1]) + (v[j][2] + v[j][3]);
#pragma unroll
        for (int j = 0; j < 4; ++j) { nx[j] = ny[j]; ny[j] = nz[j]; nz[j] = nw[j]; }
        { const int rn = row + 4 * C.NGW < NTOK ? row + 4 * C.NGW : row; const f32x4* xn = (const f32x4*)(C.out + (size_t)rn * DM) + C.lane;
#pragma unroll
            for (int j = 0; j < 4; ++j) nw[j] = __builtin_nontemporal_load(&xn[64 * j]); }
        const float mean = wave_sum(s) * (1.f / DM); float s2 = 0.f;
#pragma unroll
        for (int j = 0; j < 4; ++j) { v[j] = v[j] - mean; s2 += (v[j][0] * v[j][0] + v[j][1] * v[j][1]) + (v[j][2] * v[j][2] + v[j][3] * v[j][3]); }
        const float rstd = 1.0f / sqrtf(wave_sum(s2) * (1.f / DM) + LN_EPS);
        u32x2* o8 = (u32x2*)(XB + (size_t)row * DM) + C.lane; unsigned* o4 = (unsigned*)((unsigned char*)XB + (size_t)row * DM) + C.lane;
#pragma unroll
        for (int j = 0; j < 4; ++j) { v[j] = v[j] * rstd * gv[j] + bv[j]; __builtin_nontemporal_store(v[j], &xr[64 * j]);
            if constexpr (ROUTER) { o4[64 * j] = pg8::pk4_fp8(v[j][0], v[j][1], v[j][2], v[j][3]); asm volatile("" ::: "memory"); }
            else if (XB) { u32x2 w; w.x = cvt_pk_bf16(v[j][0], v[j][1]); w.y = cvt_pk_bf16(v[j][2], v[j][3]); o8[64 * j] = w; } }
        if (ROUTER) {
            float p[16];
#pragma unroll
            for (int e = 0; e < 16; ++e) p[e] = 0.f;
#pragma unroll
            for (int j = 0; j < 4; ++j)
#pragma unroll
                for (int i = 0; i < 4; ++i) { const float xv = v[j][i];
#pragma unroll
                    for (int q = 0; q < 4; ++q) { const f32x4 w4 = ((const LAS f32x4*)wr)[((j * 4 + i) * 4 + q) * 64 + C.lane]; p[4 * q] += xv * w4[0]; p[4 * q + 1] += xv * w4[1]; p[4 * q + 2] += xv * w4[2]; p[4 * q + 3] += xv * w4[3]; } }
            const bool b5 = (C.lane & 32) != 0, b4 = (C.lane & 16) != 0, b3 = (C.lane & 8) != 0, b2 = (C.lane & 4) != 0;
            float r8[8], r4[4], r2[2], lg;
#pragma unroll
            for (int i = 0; i < 8; ++i) { const float keep = b5 ? p[8 + i] : p[i], send = b5 ? p[i] : p[8 + i]; r8[i] = keep + __shfl_xor(send, 32); }
#pragma unroll
            for (int i = 0; i < 4; ++i) { const float keep = b4 ? r8[4 + i] : r8[i], send = b4 ? r8[i] : r8[4 + i]; r4[i] = keep + __shfl_xor(send, 16); }
#pragma unroll
            for (int i = 0; i < 2; ++i) { const float keep = b3 ? r4[2 + i] : r4[i], send = b3 ? r4[i] : r4[2 + i]; r2[i] = keep + __shfl_xor(send, 8); }
            { const float keep = b2 ? r2[1] : r2[0], send = b2 ? r2[0] : r2[1]; lg = keep + __shfl_xor(send, 4); }
            lg += __shfl_xor(lg, 2); lg += __shfl_xor(lg, 1);
            float mx = lg;
            mx = fmaxf(mx, __shfl_xor(mx, 4)); mx = fmaxf(mx, __shfl_xor(mx, 8)); mx = fmaxf(mx, __shfl_xor(mx, 16)); mx = fmaxf(mx, __shfl_xor(mx, 32));
            const float ex = __expf(lg - mx); float den = ex;
            den += __shfl_xor(den, 4); den += __shfl_xor(den, 8); den += __shfl_xor(den, 16); den += __shfl_xor(den, 32);
            const int eL = (b5 ? 8 : 0) + (b4 ? 4 : 0) + (b3 ? 2 : 0) + (b2 ? 1 : 0);
            if ((C.lane & 3) == 0) affT[((size_t)(row >> 16) * 16 + eL) * NTOKG + (row & 65535)] = ex / den;
            if (C.lane < 8) ((unsigned*)(C.ws + WS_SM))[(size_t)row * 8 + C.lane] = 0xFFFFFFFFu;
        }
    }
}

namespace att {
DI int crow(int r, int hi) { return (r & 3) + 8 * (r >> 2) + 4 * hi; }
DI int v_st(int k, int c) { const int kk = (k & ~0xC) | ((k & 4) << 1) | ((k & 8) >> 1); return ((kk >> 3) * 2 + (c >> 5)) * 512 + ((kk & 7) * 32 + (c & 31)) * 2; }
DI int v_rd_base(int lane) { return ((lane & 3) << 3) | (((lane >> 2) & 3) << 6) | (((lane >> 4) & 1) << 5) | (((lane >> 5) & 1) << 8); }
constexpr int v_rd_off(int d0, int ks, int half) { return d0 * 512 + ks * 2048 + half * 1024; }
template <int OFF> DI s16x4 tr_read(int vb) { s16x4 r; asm volatile("ds_read_b64_tr_b16 %0, %1 offset:%2" : "=&v"(r) : "v"(vb), "i"(OFF) : "memory"); return r; }
template <int D0> DI void pv_one(f32x16& od, int vb, bf16x8 pa0, bf16x8 pa1, bf16x8 pa2, bf16x8 pa3) {
    const s16x4 l0 = tr_read<v_rd_off(D0, 0, 0)>(vb), h0 = tr_read<v_rd_off(D0, 0, 1)>(vb), l1 = tr_read<v_rd_off(D0, 1, 0)>(vb), h1 = tr_read<v_rd_off(D0, 1, 1)>(vb);
    const s16x4 l2 = tr_read<v_rd_off(D0, 2, 0)>(vb), h2 = tr_read<v_rd_off(D0, 2, 1)>(vb), l3 = tr_read<v_rd_off(D0, 3, 0)>(vb), h3 = tr_read<v_rd_off(D0, 3, 1)>(vb);
    asm volatile("s_waitcnt lgkmcnt(0)" ::: "memory"); __builtin_amdgcn_sched_barrier(0);
#define PKV(L, H) (bf16x8){L[0], L[1], L[2], L[3], H[0], H[1], H[2], H[3]}
    od = __builtin_amdgcn_mfma_f32_32x32x16_bf16(pa0, PKV(l0, h0), od, 0, 0, 0);
    od = __builtin_amdgcn_mfma_f32_32x32x16_bf16(pa1, PKV(l1, h1), od, 0, 0, 0);
    od = __builtin_amdgcn_mfma_f32_32x32x16_bf16(pa2, PKV(l2, h2), od, 0, 0, 0);
    od = __builtin_amdgcn_mfma_f32_32x32x16_bf16(pa3, PKV(l3, h3), od, 0, 0, 0);
#undef PKV
}
DI void pv_ones(f32x16& o2, bf16x8 pa0, bf16x8 pa1, bf16x8 pa2, bf16x8 pa3) {
    const u32x4 onesw = {0x3F803F80u, 0x3F803F80u, 0x3F803F80u, 0x3F803F80u}; const bf16x8 ones = __builtin_bit_cast(bf16x8, onesw);
    o2 = __builtin_amdgcn_mfma_f32_32x32x16_bf16(pa0, ones, o2, 0, 0, 0); o2 = __builtin_amdgcn_mfma_f32_32x32x16_bf16(pa1, ones, o2, 0, 0, 0);
    o2 = __builtin_amdgcn_mfma_f32_32x32x16_bf16(pa2, ones, o2, 0, 0, 0); o2 = __builtin_amdgcn_mfma_f32_32x32x16_bf16(pa3, ones, o2, 0, 0, 0);
}
constexpr int KROW(int KS) { return KS * 32 + 16; }
constexpr int KTILE = 64 * 112, VTILE = 8192, LDS_ATT = 2 * KTILE + 2 * VTILE + 8 * 256;

DI void split3(float x, unsigned& w_hm, unsigned& w_l0) {
    const unsigned h = f2bf(x); const float r1 = x - __builtin_bit_cast(float, h << 16);
    const unsigned m = f2bf(r1); const float r2 = r1 - __builtin_bit_cast(float, m << 16);
    const unsigned l = f2bf(r2);
    w_hm = h | (m << 16); w_l0 = l;
}
template <int KS, bool ALIBI>
DI void attn_unit(const bf16_t* __restrict__ Qb, int ldq, const bf16_t* __restrict__ Kb, int ldk, const bf16_t* __restrict__ Vb, int ldv,
                  bf16_t* __restrict__ Ob, int ldo, int seq_len, int q0, float slope2, const unsigned* __restrict__ kn2, LAS unsigned char* lds) {
    int tid = threadIdx.x; asm volatile("" : "+v"(tid));
    const int wid = tid >> 6, lane = tid & 63, r32 = lane & 31, hi = lane >> 5;
    LAS unsigned char* K_lds = lds; LAS unsigned char* V_lds = lds + 2 * KTILE;
    LAS float* wsl = (LAS float*)(lds + 2 * KTILE + 2 * VTILE) + wid * 64; LAS float* li_l = wsl; LAS float* al_l = wsl + 32;
    LAS float* blk = (LAS float*)(lds + LDS_ATT);
    LAS int* tl = (LAS int*)(lds + LDS_ATT + 128);
    constexpr int KR = KROW(KS), KP = 2 * KS;
    constexpr float THR = 8.f, SKIP = -40.f;
    float mt = 0.f; f32x16 o[3];
#pragma unroll
    for (int d = 0; d < 3; ++d)
#pragma unroll
        for (int r = 0; r < 16; ++r) o[d][r] = 0.f;
    bf16x8 qr[KS];
    const bf16_t* Qw = Qb + (size_t)(wid * 32 + r32) * ldq + hi * 8;
#pragma unroll
    for (int d0 = 0; d0 < KS; ++d0) qr[d0] = *(const bf16x8*)(Qw + d0 * 16);
    if (ALIBI) { float qn = 0.f;
#pragma unroll
        for (int d0 = 0; d0 < KS; ++d0)
#pragma unroll
            for (int j = 0; j < 8; ++j) { const float f = bf2f((unsigned short)qr[d0][j]); qn += f * f; }
        qn += __shfl_xor(qn, 32); qn = wave_max(qn); if (lane == 0) blk[wid] = qn; }
    const int vkey = tid >> 3, vcol = (tid & 7) * 8, vst = v_st(vkey, vcol);
    const bool kact = tid < 64 * KP; const int kkey = kact ? tid / KP : 0, kpc = kact ? tid % KP : 0;
    const int vb0 = (int)(uintptr_t)V_lds + v_rd_base(lane);
    const int w0 = q0 + wid * 32; const float qpos = (float)(w0 + r32);
    const int NT = seq_len / 64, jd0 = q0 >> 6;
    bf16x8 kx0, kx1;
    { u32x4 a = {0u, 0u, 0u, 0u}, b = {0u, 0u, 0u, 0u};
        if (hi == 0) {
            a.z = 0x3F803F80u; a.w = 0x00003F80u; b.z = 0x3F803F80u; b.w = 0x00003F80u;
            if (ALIBI) { const float c0 = slope2 * (float)r32, c1 = slope2 * (float)(32 + r32);
                const unsigned h0 = f2bf(c0), l0 = f2bf(c0 - __builtin_bit_cast(float, h0 << 16)), h1 = f2bf(c1), l1 = f2bf(c1 - __builtin_bit_cast(float, h1 << 16));
                a.x = h0 | (l0 << 16); a.y = (h0 | (l0 << 16)) ^ 0x80008000u; b.x = h1 | (l1 << 16); b.y = (h1 | (l1 << 16)) ^ 0x80008000u; } }
        kx0 = __builtin_bit_cast(bf16x8, a); kx1 = __builtin_bit_cast(bf16x8, b); }
    bf16x8 vs, ks_;
    bool first = true;
#define SLOAD(k0) do { vs = *(const bf16x8*)(Vb + (size_t)((k0) + vkey) * ldv + vcol); ks_ = *(const bf16x8*)(Kb + (size_t)((k0) + kkey) * ldk + kpc * 8); } while (0)
#define SWRITE(b) do { *(LAS bf16x8*)(V_lds + (b) * VTILE + vst) = vs; if (kact) *(LAS bf16x8*)(K_lds + (b) * KTILE + kkey * KR + kpc * 16) = ks_; } while (0)
#define PK4(P, BASE, OUT) do { unsigned a0 = cvt_pk_bf16_b(P[BASE + 0], P[BASE + 1]), a1 = cvt_pk_bf16_b(P[BASE + 2], P[BASE + 3]); \
        unsigned b0_ = cvt_pk_bf16_b(P[BASE + 4], P[BASE + 5]), b1_ = cvt_pk_bf16_b(P[BASE + 6], P[BASE + 7]); \
        auto r0 = __builtin_amdgcn_permlane32_swap(a0, b0_, false, false); auto r1 = __builtin_amdgcn_permlane32_swap(a1, b1_, false, false); \
        u32x4 w = {r0[0], r1[0], r0[1], r1[1]}; OUT = __builtin_bit_cast(bf16x8, w); } while (0)
#define PKV2(L, H) (bf16x8){L[0], L[1], L[2], L[3], H[0], H[1], H[2], H[3]}
#define ATT_GRP(P, BASE, VA, VC, VD, VE) do { \
        _Pragma("unroll") for (int r_ = 0; r_ < 8; ++r_) P[BASE + r_] = __builtin_amdgcn_exp2f(P[BASE + r_]); \
        bf16x8 pa_; PK4(P, BASE, pa_); \
        o[0] = __builtin_amdgcn_mfma_f32_32x32x16_bf16(pa_, PKV2(VA, VC), o[0], 0, 0, 0); o[1] = __builtin_amdgcn_mfma_f32_32x32x16_bf16(pa_, PKV2(VD, VE), o[1], 0, 0, 0); \
        o[2] = __builtin_amdgcn_mfma_f32_32x32x16_bf16(pa_, ones, o[2], 0, 0, 0); __builtin_amdgcn_sched_barrier(0); } while (0)
#define ATT_TILE(j, cur) do { \
        f32x16 p0, p1; \
        _Pragma("unroll") for (int r = 0; r < 16; ++r) { p0[r] = 0.f; p1[r] = 0.f; } \
        const LAS unsigned char* Kc = K_lds + (cur) * KTILE; \
        _Pragma("unroll") for (int d0 = 0; d0 < KS; ++d0) { const int cb = (d0 * 16 + hi * 8) * 2;     \
            const bf16x8 b0 = *(const LAS bf16x8*)(Kc + r32 * KR + cb); const bf16x8 b1 = *(const LAS bf16x8*)(Kc + (32 + r32) * KR + cb); \
            p0 = __builtin_amdgcn_mfma_f32_32x32x16_bf16(b0, qr[d0], p0, 0, 0, 0); p1 = __builtin_amdgcn_mfma_f32_32x32x16_bf16(b1, qr[d0], p1, 0, 0, 0); } \
        int cls = 0; float Bq = 0.f; \
        if (ALIBI) { if (64 * (j) + 64 <= w0) { cls = 1; Bq = slope2 * ((float)(64 * (j)) - qpos); } else if (64 * (j) >= w0 + 32) { cls = 2; Bq = slope2 * (qpos - (float)(64 * (j))); } } \
        bf16x8 qx; { u32x4 w = {0u, 0u, 0u, 0u}; if (hi == 0) { unsigned whm, wl0; split3(Bq - mt, whm, wl0); w.z = whm; w.w = wl0; w.x = (cls == 1) ? 0x3F803F80u : 0u; w.y = (cls == 2) ? 0x3F803F80u : 0u; } qx = __builtin_bit_cast(bf16x8, w); } \
        p0 = __builtin_amdgcn_mfma_f32_32x32x16_bf16(kx0, qx, p0, 0, 0, 0); p1 = __builtin_amdgcn_mfma_f32_32x32x16_bf16(kx1, qx, p1, 0, 0, 0); \
        if (ALIBI && cls == 0) { const float dq = qpos - (float)((j) * 64 + 4 * hi); \
            _Pragma("unroll") for (int r = 0; r < 16; ++r) { const float kc = (float)((r & 3) + 8 * (r >> 2)); p0[r] = fmaf(fabsf(dq - kc), -slope2, p0[r]); p1[r] = fmaf(fabsf(dq - (kc + 32.f)), -slope2, p1[r]); } } \
        float tmax = p0[0]; \
        _Pragma("unroll") for (int r = 1; r < 16; ++r) tmax = fmaxf(tmax, p0[r]); \
        _Pragma("unroll") for (int r = 0; r < 16; ++r) tmax = fmaxf(tmax, p1[r]); \
        { auto rr = __builtin_amdgcn_permlane32_swap(__float_as_uint(tmax), __float_as_uint(tmax), false, false); tmax = fmaxf(__uint_as_float(rr[0]), __uint_as_float(rr[1])); } \
        const bool skip = !first && __all(tmax < SKIP); \
        if (!skip) { \
            if (first || !__all(tmax <= THR)) { \
                const float delta = first ? tmax : fmaxf(tmax, 0.f); const float alpha = first ? 1.f : __builtin_amdgcn_exp2f(-delta); \
                mt += delta; \
                _Pragma("unroll") for (int r = 0; r < 16; ++r) { p0[r] -= delta; p1[r] -= delta; } \
                if (!first) { if (hi == 0) al_l[r32] = alpha; LDS_WAIT(); \
                    _Pragma("unroll") for (int r = 0; r < 16; ++r) { const float a = al_l[crow(r, hi)]; o[0][r] *= a; o[1][r] *= a; o[2][r] *= a; } } \
            } \
              \
            const int vb = vb0 + (cur) * VTILE; \
            const s16x4 va0 = tr_read<v_rd_off(0, 0, 0)>(vb), vc0 = tr_read<v_rd_off(0, 0, 1)>(vb), vd0 = tr_read<v_rd_off(1, 0, 0)>(vb), ve0 = tr_read<v_rd_off(1, 0, 1)>(vb); \
            const s16x4 va1 = tr_read<v_rd_off(0, 1, 0)>(vb), vc1 = tr_read<v_rd_off(0, 1, 1)>(vb), vd1 = tr_read<v_rd_off(1, 1, 0)>(vb), ve1 = tr_read<v_rd_off(1, 1, 1)>(vb); \
            const s16x4 va2 = tr_read<v_rd_off(0, 2, 0)>(vb), vc2 = tr_read<v_rd_off(0, 2, 1)>(vb), vd2 = tr_read<v_rd_off(1, 2, 0)>(vb), ve2 = tr_read<v_rd_off(1, 2, 1)>(vb); \
            const s16x4 va3 = tr_read<v_rd_off(0, 3, 0)>(vb), vc3 = tr_read<v_rd_off(0, 3, 1)>(vb), vd3 = tr_read<v_rd_off(1, 3, 0)>(vb), ve3 = tr_read<v_rd_off(1, 3, 1)>(vb); \
            const u32x4 onesw = {0x3F803F80u, 0x3F803F80u, 0x3F803F80u, 0x3F803F80u}; const bf16x8 ones = __builtin_bit_cast(bf16x8, onesw); \
            asm volatile("s_waitcnt lgkmcnt(0)" ::: "memory"); __builtin_amdgcn_sched_barrier(0); \
            ATT_GRP(p0, 0, va0, vc0, vd0, ve0); ATT_GRP(p0, 8, va1, vc1, vd1, ve1); ATT_GRP(p1, 0, va2, vc2, vd2, ve2); ATT_GRP(p1, 8, va3, vc3, vd3, ve3); \
            first = false; \
        } } while (0)
#define ATT_RUN(COUNT, TILE_EXPR) do { const int cnt_ = (COUNT); if (cnt_ > 0) { \
        { const int jj = 0; SLOAD((TILE_EXPR) * 64); } SWRITE(0); __syncthreads(); \
        if (cnt_ > 1) { const int jj = 1; SLOAD((TILE_EXPR) * 64); } \
        for (int jj0 = 0; jj0 < cnt_; ++jj0) { const int cur_ = jj0 & 1; int j_; { const int jj = jj0; j_ = (TILE_EXPR); } \
            ATT_TILE(j_, cur_); \
            if (jj0 + 1 < cnt_) SWRITE(cur_ ^ 1); \
            __syncthreads(); \
            if (jj0 + 2 < cnt_) { const int jj = jj0 + 2; SLOAD((TILE_EXPR) * 64); } } } } while (0)
    if (wid >= 4) __builtin_amdgcn_s_setprio(1);
    ATT_RUN(4, jd0 + jj);
    if (ALIBI) {
        { const float mm = -wave_max(-mt); if (lane == 0) blk[8 + wid] = mm; }
        __syncthreads();
        if (wid == 0) {
            float qn2 = blk[0], mmin = blk[8];
#pragma unroll
            for (int i = 1; i < 8; ++i) { qn2 = fmaxf(qn2, blk[i]); mmin = fminf(mmin, blk[8 + i]); }
            int base = 0;
            for (int c0 = 0; c0 < NT - 4; c0 += 64) { const int c = c0 + lane; bool act = false; int t = 0;
                if (c < NT - 4) { t = (c < jd0) ? jd0 - 1 - c : c + 4;
                    const float dist = (t < jd0) ? (float)(q0 - (64 * t + 63)) : (float)(64 * t - (q0 + 255));
                    const float kn = __builtin_bit_cast(float, kn2[t]);
                    act = (sqrtf(qn2 * kn) * 1.02f - slope2 * dist - mmin >= SKIP); }
                const unsigned long long bm = __ballot(act);
                if (act) tl[base + __builtin_popcountll(bm & ((1ull << lane) - 1ull))] = t;
                base += __builtin_popcountll(bm); }
            if (lane == 0) blk[16] = __builtin_bit_cast(float, base);
        }
        __syncthreads();
        const int nact = __builtin_bit_cast(int, blk[16]);
        ATT_RUN(nact, tl[jj]);
    } else {
        ATT_RUN(NT - 4, (jj < jd0 ? jd0 - 1 - jj : jj + 4));
    }
#undef ATT_RUN
#undef ATT_TILE
#undef ATT_GRP
#undef PKV2
#undef PK4
#undef SLOAD
#undef SWRITE
    __builtin_amdgcn_s_setprio(0);
    bf16_t* Ow = Ob + (size_t)(wid * 32) * ldo;
#pragma unroll
    for (int r = 0; r < 16; ++r) { const int orow = crow(r, hi); const float rl = __builtin_amdgcn_rcpf(o[2][r]);
#pragma unroll
        for (int d0 = 0; d0 < 2; ++d0) Ow[(size_t)orow * ldo + d0 * 32 + r32] = (bf16_t)f2bf(o[d0][r] * rl); }
    __syncthreads();
}
}

DI void ph_attn_a(const Ctx& C, int l) {
    const bf16_t* UA = (const bf16_t*)(C.ws + WS_U); bf16_t* OA = (bf16_t*)(C.ws + WS_XB1);
    GAS unsigned* head = (GAS unsigned*)(C.ws + WS_CTL) + 16384 + 64 * l;
    LAS volatile int* qslot = (LAS volatile int*)(C.lds + MISC_OFF + 64);
    if (C.tid == 0) qslot[0] = (int)__hip_atomic_fetch_add(head, 1u, __ATOMIC_RELAXED, __HIP_MEMORY_SCOPE_AGENT);
    __syncthreads();
    int u = qslot[0];
    while (u < 4096) {
        int nxt = 0;
        if (C.tid == 0) nxt = (int)__hip_atomic_fetch_add(head, 1u, __ATOMIC_RELAXED, __HIP_MEMORY_SCOPE_AGENT);
        const int k = u >> 9, j = u & 511, vhb = j >> 8;
        const bool prompt = (k == 0) || (k == 1) || (k == 4) || (k == 6);
        const int h = (k == 0 || k == 2) ? 3 : (k == 1 || k == 3) ? 2 : (k == 4 || k == 5) ? 1 : 0;
        const int vh = 2 * h + vhb;
        const int seq = prompt ? ((j >> 5) & 7) : 8 + ((j >> 3) & 31), qb = prompt ? (j & 31) : (j & 7), len = prompt ? 8192 : 2048;
        const int r0 = seq_start_row(seq);
        const float slope2 = exp2f(-2.0f * (float)(h + 1)) * LOG2E;
        att::attn_unit<2, true>(UA + (size_t)(r0 + qb * 256) * 768 + vh * 32, 768, UA + (size_t)r0 * 768 + 256 + vh * 32, 768, UA + (size_t)r0 * 768 + 512 + h * 64, 768,
                                OA + (size_t)(r0 + qb * 256) * 512 + vh * 64, 512, len, qb * 256, slope2, (const unsigned*)(C.ws + WS_KN2) + ((size_t)l * 8 + vh) * 2048 + (r0 >> 6), C.lds);
        if (C.tid == 0) qslot[0] = nxt;
        __syncthreads();
        u = qslot[0];
    }
}
DI void ph_attn_c(const Ctx& C) {
    const bf16_t* Qc = (const bf16_t*)(C.ws + WS_XB1 + OFF_QC); const bf16_t* Kc = (const bf16_t*)(C.ws + WS_XB1 + OFF_KC); const bf16_t* Vc = (const bf16_t*)(C.ws + WS_XB1 + OFF_VC);
    bf16_t* Y = (bf16_t*)(C.ws + WS_Y);
    for (int u = C.bid; u < 2048; u += C.G) {
        int qb, h, seq, len;
        if (u < 1024) { qb = u & 31; h = (u >> 5) & 3; seq = u >> 7; len = 8192; } else { const int v = u - 1024; qb = v & 7; h = (v >> 3) & 3; seq = 8 + (v >> 5); len = 2048; }
        const int r0 = seq_start_row(seq);
        att::attn_unit<3, false>(Qc + (size_t)(r0 + qb * 256) * 192 + h * 48, 192, Kc + (size_t)r0 * 192 + h * 48, 192, Vc + (size_t)r0 * 256 + h * 64, 256,
                                 Y + (size_t)(r0 + qb * 256) * DM + 512 + h * 64, DM, len, qb * 256, 0.f, nullptr, C.lds);
    }
}
DI void ph_a_post(const Ctx& C, int l) {
    const bf16_t* OA = (const bf16_t*)(C.ws + WS_XB1); bf16_t* Y = (bf16_t*)(C.ws + WS_Y);
    const float linit = 0.8f - 0.6f * expf(-0.3f * (float)l);
    const float* lp = C.A->in[3] + l * 128;
    float sa = 0.f, sb = 0.f; if (C.lane < 32) { sa = lp[C.lane] * lp[32 + C.lane]; sb = lp[64 + C.lane] * lp[96 + C.lane]; }
    const float lam = expf(wave_sum(sa)) - expf(wave_sum(sb)) + linit;
    const int h = C.lane >> 4, d4 = (C.lane & 15) * 4;
    const f32x4 gg = *(const f32x4*)(C.A->in[4] + l * 64 + d4);
    for (int row0 = C.gw; row0 < NTOK; row0 += 4 * C.NGW) {
        u32x2 a[4], b[4];
#pragma unroll
        for (int i = 0; i < 4; ++i) { const size_t row = (size_t)row0 + (size_t)i * C.NGW; a[i] = __builtin_nontemporal_load((const u32x2*)(OA + row * 512 + (2 * h) * 64 + d4)); b[i] = __builtin_nontemporal_load((const u32x2*)(OA + row * 512 + (2 * h + 1) * 64 + d4)); }
#pragma unroll
        for (int i = 0; i < 4; ++i) { const size_t row = (size_t)row0 + (size_t)i * C.NGW;
            float o0 = bflo(a[i].x) - lam * bflo(b[i].x), o1 = bfhi(a[i].x) - lam * bfhi(b[i].x), o2 = bflo(a[i].y) - lam * bflo(b[i].y), o3 = bfhi(a[i].y) - lam * bfhi(b[i].y);
            float ss = o0 * o0 + o1 * o1 + o2 * o2 + o3 * o3;
            ss += __shfl_xor(ss, 1); ss += __shfl_xor(ss, 2); ss += __shfl_xor(ss, 4); ss += __shfl_xor(ss, 8);
            const float r = (1.0f / sqrtf(ss * (1.f / 64.f) + RMS_EPS)) * (1.0f - linit);
            u32x2 w; w.x = cvt_pk_bf16(o0 * r * gg[0], o1 * r * gg[1]); w.y = cvt_pk_bf16(o2 * r * gg[2], o3 * r * gg[3]);
            *(u32x2*)(Y + row * DM + h * 64 + d4) = w; }
    }
}

DI float hgrn_lb(const Ctx& C, int l, int dir, int ch) {
    if (l == 0) return 0.f;
    const float a = C.A->in[5][(0 * 2 + dir) * 256 + ch], b = C.A->in[5][(1 * 2 + dir) * 256 + ch];
    const float m = fmaxf(a, b), ea = expf(a - m), eb = expf(b - m); return eb / (ea + eb);
}
DI float dpp_shr_add(float x, int k) {
    float y;
    if (k == 1) y = __builtin_bit_cast(float, __builtin_amdgcn_update_dpp(0, __builtin_bit_cast(int, x), 0x111, 0xF, 0xF, true));
    else if (k == 2) y = __builtin_bit_cast(float, __builtin_amdgcn_update_dpp(0, __builtin_bit_cast(int, x), 0x112, 0xF, 0xF, true));
    else if (k == 4) y = __builtin_bit_cast(float, __builtin_amdgcn_update_dpp(0, __builtin_bit_cast(int, x), 0x114, 0xF, 0xF, true));
    else y = __builtin_bit_cast(float, __builtin_amdgcn_update_dpp(0, __builtin_bit_cast(int, x), 0x118, 0xF, 0xF, true));
    return x + y;
}
DI s16x4 tr16(unsigned addr) { s16x4 r; asm volatile("ds_read_b64_tr_b16 %0, %1\n\ts_waitcnt lgkmcnt(0)" : "=&v"(r) : "v"(addr) : "memory"); return r; }
constexpr int HG_ROW = 144, HG_ARR = 16 * HG_ROW;
template <int MODE>
DI void hgrn_pass(const Ctx& C, int l, int chunk, int h, int dir, LAS unsigned char* wl, float* ofs) {
    const bf16_t* UB = (const bf16_t*)(C.ws + WS_U); float* ST = (float*)(C.ws + WS_XB1); float* GAM = (float*)(C.ws + WS_GAM); bf16_t* Y = (bf16_t*)(C.ws + WS_Y);
    const int lane = C.lane, l15 = lane & 15, g = lane >> 4, r0 = chunk * 128; const size_t sbase = (size_t)((chunk * 4 + h) * 2 + dir);
    const unsigned QLa = (unsigned)(uintptr_t)wl, FLa = QLa + HG_ARR, VLa = QLa + 2 * HG_ARR, GLa = QLa + 3 * HG_ARR;
    LAS float* lbT = (LAS float*)(wl + 4 * HG_ARR);
    lbT[lane] = hgrn_lb(C, l, dir, h * 64 + lane);
    LDS_WAIT();
    f32x4 S[4][4];
#pragma unroll
    for (int dt = 0; dt < 4; ++dt)
#pragma unroll
        for (int et = 0; et < 4; ++et)
#pragma unroll
            for (int r = 0; r < 4; ++r) S[dt][et][r] = (MODE == 0) ? 0.f : ST[sbase * 4096 + (size_t)(16 * dt + 4 * g + r) * 64 + 16 * et + l15];
    float gsum[4] = {0.f, 0.f, 0.f, 0.f};
    const float* ngp = C.A->in[6] + l * 256 + h * 64 + l15;
    const int srow = lane >> 2, spc = lane & 3;
    u32x4 pq[2], pf[2], pv[2];
#define HG_LOAD(sc) do { const int t_ = (sc) * 16 + srow; const bf16_t* rp_ = UB + (size_t)(r0 + (dir ? 127 - t_ : t_)) * 1280 + h * 64 + spc * 16; \
        pf[0] = *(const u32x4*)(rp_ + (dir ? 512 : 256)); pf[1] = *(const u32x4*)(rp_ + (dir ? 512 : 256) + 8); pv[0] = *(const u32x4*)(rp_ + 768); pv[1] = *(const u32x4*)(rp_ + 768 + 8); \
        if (MODE != 0) { pq[0] = *(const u32x4*)(rp_); pq[1] = *(const u32x4*)(rp_ + 8); } } while (0)
#define HG_STORE() do { const int o_ = srow * HG_ROW + spc * 32; \
        *(LAS u32x4*)(wl + HG_ARR + o_) = pf[0]; *(LAS u32x4*)(wl + HG_ARR + o_ + 16) = pf[1]; *(LAS u32x4*)(wl + 2 * HG_ARR + o_) = pv[0]; *(LAS u32x4*)(wl + 2 * HG_ARR + o_ + 16) = pv[1]; \
        if (MODE != 0) { *(LAS u32x4*)(wl + o_) = pq[0]; *(LAS u32x4*)(wl + o_ + 16) = pq[1]; } } while (0)
    HG_LOAD(0);
    const unsigned tr_off = (unsigned)((4 * g + (l15 >> 2)) * HG_ROW + (l15 & 3) * 8);
    for (int sc = 0; sc < 8; ++sc) {
        LDS_WAIT();
        HG_STORE();
        if (MODE == 2) {
#pragma unroll
            for (int k = 0; k < 2; ++k) { const int t_ = sc * 16 + 8 * k + (lane >> 3);
                __builtin_amdgcn_global_load_lds((const unsigned*)(UB + (size_t)(r0 + 127 - t_) * 1280 + 1024 + h * 64 + (lane & 7) * 8), (LAS unsigned*)(wl + 3 * HG_ARR + k * 1024), 16, 0, 0); } }
        if (sc + 1 < 8) HG_LOAD(sc + 1);
        LDS_WAIT();
        bf16x8 vf[4];
#pragma unroll
        for (int et = 0; et < 4; ++et) { const s16x4 t4 = tr16(VLa + tr_off + et * 32); vf[et] = (bf16x8){t4[0], t4[1], t4[2], t4[3], 0, 0, 0, 0}; }
        __builtin_amdgcn_sched_barrier(0);
        bf16x8 khf[4]; float tot[4];
#pragma unroll
        for (int dt = 0; dt < 4; ++dt) { const s16x4 t4 = tr16(FLa + tr_off + dt * 32);
            float fv[4], lf[4];
            const float lbv = lbT[16 * dt + l15];
#pragma unroll
            for (int j = 0; j < 4; ++j) { fv[j] = lbv + (1.f - lbv) * sigmoidf_(bf2f((unsigned short)t4[j])); lf[j] = __builtin_amdgcn_logf(fv[j]); }
            const float Tg = (lf[0] + lf[1]) + (lf[2] + lf[3]);
            const float T1 = __shfl_down(Tg, 16), T2 = __shfl_down(Tg, 32), T3 = __shfl_down(Tg, 48);
            const float after = (g < 3 ? T1 : 0.f) + (g < 2 ? T2 : 0.f) + (g < 1 ? T3 : 0.f);
            float tt_ = Tg; tt_ += __shfl_xor(tt_, 16); tt_ += __shfl_xor(tt_, 32); tot[dt] = tt_; gsum[dt] += tt_;
            const float c3 = after, c2 = c3 + lf[3], c1 = c2 + lf[2], c0 = c1 + lf[1];
            const unsigned w0 = cvt_pk_bf16((1.f - fv[0]) * __builtin_amdgcn_exp2f(c0), (1.f - fv[1]) * __builtin_amdgcn_exp2f(c1));
            const unsigned w1 = cvt_pk_bf16((1.f - fv[2]) * __builtin_amdgcn_exp2f(c2), (1.f - fv[3]) * __builtin_amdgcn_exp2f(c3));
            const u32x4 w = {w0, w1, 0u, 0u}; khf[dt] = __builtin_bit_cast(bf16x8, w); }
        __builtin_amdgcn_sched_barrier(0);
        f32x4 O[4];
        if (MODE != 0) {
            bf16x8 qhf[2], ktf[2];
#pragma unroll
            for (int ks = 0; ks < 2; ++ks) { float b2[8], qv[8], kv[8];
#pragma unroll
                for (int dd = 0; dd < 2; ++dd) { const int dt = 2 * ks + dd;
                    const u32x2 fw = *(const LAS u32x2*)(wl + HG_ARR + l15 * HG_ROW + (16 * dt + 4 * g) * 2); const u32x2 qw = *(const LAS u32x2*)(wl + l15 * HG_ROW + (16 * dt + 4 * g) * 2);
                    const f32x4 lb4 = *(const LAS f32x4*)(lbT + 16 * dt + 4 * g);
                    const float fl4[4] = {bflo(fw.x), bfhi(fw.x), bflo(fw.y), bfhi(fw.y)}, ql4[4] = {bflo(qw.x), bfhi(qw.x), bflo(qw.y), bfhi(qw.y)};
#pragma unroll
                    for (int r = 0; r < 4; ++r) { const int i = 4 * dd + r; const float f = lb4[r] + (1.f - lb4[r]) * sigmoidf_(fl4[r]); b2[i] = __builtin_amdgcn_logf(f); kv[i] = 1.f - f; qv[i] = siluf_(ql4[r]); } }
#pragma unroll
                for (int i = 0; i < 8; ++i) { float x = b2[i]; x = dpp_shr_add(x, 1); x = dpp_shr_add(x, 2); x = dpp_shr_add(x, 4); x = dpp_shr_add(x, 8); b2[i] = x; }
                u32x4 wq, wk;
#pragma unroll
                for (int p = 0; p < 4; ++p) { const int i = 2 * p; const float e0 = __builtin_amdgcn_exp2f(b2[i]), e1 = __builtin_amdgcn_exp2f(b2[i + 1]);
                    wq[p] = cvt_pk_bf16(qv[i] * e0, qv[i + 1] * e1); wk[p] = cvt_pk_bf16(kv[i] * __builtin_amdgcn_exp2f(fminf(-b2[i], 120.f)), kv[i + 1] * __builtin_amdgcn_exp2f(fminf(-b2[i + 1], 120.f))); }
                qhf[ks] = __builtin_bit_cast(bf16x8, wq); ktf[ks] = __builtin_bit_cast(bf16x8, wk); }
            __builtin_amdgcn_sched_barrier(0);
            f32x4 aT = (f32x4){0.f, 0.f, 0.f, 0.f};
            aT = __builtin_amdgcn_mfma_f32_16x16x32_bf16(ktf[0], qhf[0], aT, 0, 0, 0);
            aT = __builtin_amdgcn_mfma_f32_16x16x32_bf16(ktf[1], qhf[1], aT, 0, 0, 0);
#pragma unroll
            for (int r = 0; r < 4; ++r) aT[r] = (4 * g + r > l15) ? 0.f : aT[r];
            const u32x4 aw = {cvt_pk_bf16(aT[0], aT[1]), cvt_pk_bf16(aT[2], aT[3]), 0u, 0u}; const bf16x8 atf = __builtin_bit_cast(bf16x8, aw);
#pragma unroll
            for (int et = 0; et < 4; ++et) { f32x4 o = (f32x4){0.f, 0.f, 0.f, 0.f};
                o = __builtin_amdgcn_mfma_f32_16x16x32_bf16(atf, vf[et], o, 0, 0, 0);
#pragma unroll
                for (int ks = 0; ks < 2; ++ks) { const u32x4 sw = {cvt_pk_bf16(S[2 * ks][et][0], S[2 * ks][et][1]), cvt_pk_bf16(S[2 * ks][et][2], S[2 * ks][et][3]), cvt_pk_bf16(S[2 * ks + 1][et][0], S[2 * ks + 1][et][1]), cvt_pk_bf16(S[2 * ks + 1][et][2], S[2 * ks + 1][et][3])};
                    o = __builtin_amdgcn_mfma_f32_16x16x32_bf16(qhf[ks], __builtin_bit_cast(bf16x8, sw), o, 0, 0, 0); }
                O[et] = o; }
        }
        __builtin_amdgcn_sched_barrier(0);
#pragma unroll
        for (int dt = 0; dt < 4; ++dt) { float dec[4];
#pragma unroll
            for (int r = 0; r < 4; ++r) dec[r] = __builtin_amdgcn_exp2f(__shfl(tot[dt], 4 * g + r));
#pragma unroll
            for (int et = 0; et < 4; ++et) { f32x4 s = S[dt][et];
#pragma unroll
                for (int r = 0; r < 4; ++r) s[r] *= dec[r];
                S[dt][et] = __builtin_amdgcn_mfma_f32_16x16x32_bf16(khf[dt], vf[et], s, 0, 0, 0); } }
        __builtin_amdgcn_sched_barrier(0);
        if (MODE == 1) {
#pragma unroll
            for (int et = 0; et < 4; ++et)
#pragma unroll
                for (int r = 0; r < 4; ++r) ofs[(sc * 16 + 4 * g + r) * 64 + 16 * et + l15] = O[et][r];
        }
        if (MODE == 2) {
            float rr[4];
#pragma unroll
            for (int r = 0; r < 4; ++r) { const int at = 127 - (sc * 16 + 4 * g + r); float ss = 0.f;
#pragma unroll
                for (int et = 0; et < 4; ++et) { const float of = ofs[at * 64 + 16 * et + l15]; O[et][r] += of; ss += O[et][r] * O[et][r]; }
                ss += __shfl_xor(ss, 1); ss += __shfl_xor(ss, 2); ss += __shfl_xor(ss, 4); ss += __shfl_xor(ss, 8);
                rr[r] = 1.0f / sqrtf(ss * (1.f / 64.f) + RMS_EPS); }
            VM_WAIT();
#pragma unroll
            for (int et = 0; et < 4; ++et) { const s16x4 t4 = tr16(GLa + (unsigned)((4 * g + (l15 >> 2)) * 128 + (l15 & 3) * 8) + et * 32); const float ngv = ngp[16 * et];
#pragma unroll
                for (int r = 0; r < 4; ++r) { const int at = 127 - (sc * 16 + 4 * g + r);
                    Y[(size_t)(r0 + at) * DM + 256 + h * 64 + 16 * et + l15] = (bf16_t)f2bf(O[et][r] * rr[r] * ngv * siluf_(bf2f((unsigned short)t4[r]))); } }
        }
    }
#undef HG_LOAD
#undef HG_STORE
    if (MODE == 0) {
#pragma unroll
        for (int dt = 0; dt < 4; ++dt)
#pragma unroll
            for (int et = 0; et < 4; ++et)
#pragma unroll
                for (int r = 0; r < 4; ++r) ST[sbase * 4096 + (size_t)(16 * dt + 4 * g + r) * 64 + 16 * et + l15] = S[dt][et][r];
        if (g == 0) {
#pragma unroll
            for (int dt = 0; dt < 4; ++dt) GAM[sbase * 64 + 16 * dt + l15] = __builtin_amdgcn_exp2f(gsum[dt]);
        }
    }
}
DI void ph_hgrn_local(const Ctx& C, int l) {
    LAS unsigned char* wl = C.lds + C.wave * 16384;
    for (int w = C.gw; w < NCHUNK * 8; w += C.NGW) hgrn_pass<0>(C, l, w >> 3, (w >> 1) & 3, w & 1, wl, nullptr);
}
DI void ph_hgrn_scan(const Ctx& C) {
    float* ST = (float*)(C.ws + WS_XB1); const float* GAM = (const float*)(C.ws + WS_GAM);
    for (int idx = C.bid * 512 + C.tid; idx < NSEQ * 8 * 4096; idx += C.G * 512) {
        const int e = idx & 4095, hd = (idx >> 12) & 7, seq = idx >> 15, h = hd >> 1, dir = hd & 1, d = e >> 6;
        const int c0 = seq < 8 ? seq * 64 : 512 + (seq - 8) * 16, nc = seq < 8 ? 64 : 16;
        float s = 0.f;
        for (int i0 = 0; i0 < nc; i0 += 16) {
            float tmp[16], gg[16];
#pragma unroll
            for (int i = 0; i < 16; ++i) { const int c = dir ? c0 + nc - 1 - (i0 + i) : c0 + i0 + i; const size_t base = (size_t)((c * 4 + h) * 2 + dir); tmp[i] = ST[base * 4096 + e]; gg[i] = GAM[base * 64 + d]; }
#pragma unroll
            for (int i = 0; i < 16; ++i) { const float t = tmp[i]; tmp[i] = s; s = fmaf(gg[i], s, t); }
#pragma unroll
            for (int i = 0; i < 16; ++i) { const int c = dir ? c0 + nc - 1 - (i0 + i) : c0 + i0 + i; const size_t base = (size_t)((c * 4 + h) * 2 + dir); ST[base * 4096 + e] = tmp[i]; }
        }
    }
}
template <int MODE>
DI void ph_hgrn_out(const Ctx& C, int l) {
    LAS unsigned char* wl = C.lds + C.wave * 16384;
    for (int w = C.gw; w < NCHUNK * 4; w += C.NGW) hgrn_pass<MODE>(C, l, w >> 2, w & 3, MODE == 2 ? 1 : 0, wl, (float*)(C.ws + WS_EW) + (size_t)w * 8192);
}

DI void ph_c_prep(const Ctx& C, int l) {
    const bf16_t* UCD = (const bf16_t*)(C.ws + WS_U);
    const bf16_t* WQ = (const bf16_t*)(C.ws + WS_WC + (size_t)l * WC_LAYER + OFF_WQ); const bf16_t* WKV = (const bf16_t*)(C.ws + WS_WC + (size_t)l * WC_LAYER + OFF_WKV);
    bf16_t* Qc = (bf16_t*)(C.ws + WS_XB1 + OFF_QC); bf16_t* Kc = (bf16_t*)(C.ws + WS_XB1 + OFF_KC); bf16_t* Vc = (bf16_t*)(C.ws + WS_XB1 + OFF_VC);
    const int lane = C.lane, r32 = lane & 31, hi = lane >> 5;
    const float C2c = 0.14433756729740643f * LOG2E;
    constexpr int PQ = 400, PKV = 272;
    for (int i = C.tid; i < 192 * 24; i += 512) { const int r = i / 24, p = i % 24; *(LAS u32x4*)(C.lds + r * PQ + p * 16) = *(const u32x4*)(WQ + (size_t)r * 192 + p * 8); }
    __syncthreads();
    for (int w = C.gw; w < NTOK / 32; w += C.NGW) {
        const int row = w * 32 + r32; const bf16_t* xr = UCD + (size_t)row * 1024;
        float cs[4], sn[4];
        { const float pos = (float)row_pos(row); const float inv[8] = {1.0f, 0.316227766016837933f, 0.1f, 0.0316227766016837933f, 0.01f, 0.00316227766016837933f, 0.001f, 0.000316227766016837933f};
#pragma unroll
            for (int ii = 0; ii < 4; ++ii) { const float invv = hi ? inv[4 + ii] : inv[ii]; const float ang = pos * invv;
                const double ad = (double)ang; const double k = __builtin_rint(ad * 0.15915494309189535); const float red = (float)(ad - k * 6.283185307179586);
                cs[ii] = __cosf(red); sn[ii] = __sinf(red); } }
        bf16x8 xq[12]; float ssq = 0.f;
#pragma unroll
        for (int ks = 0; ks < 12; ++ks) { xq[ks] = *(const bf16x8*)(xr + ks * 16 + hi * 8);
#pragma unroll
            for (int j = 0; j < 8; ++j) { const float f = bf2f((unsigned short)xq[ks][j]); ssq += f * f; } }
        ssq += __shfl_xor(ssq, 32);
        const float rq = (1.0f / sqrtf(ssq * (1.f / 192.f) + RMS_EPS)) * C2c;
#pragma unroll 1
        for (int nt = 0; nt < 6; ++nt) {
            f32x16 acc;
#pragma unroll
            for (int r = 0; r < 16; ++r) acc[r] = 0.f;
#pragma unroll
            for (int ks = 0; ks < 12; ++ks) { const bf16x8 a = *(const LAS bf16x8*)(C.lds + (32 * nt + r32) * PQ + (ks * 16 + hi * 8) * 2); acc = __builtin_amdgcn_mfma_f32_32x32x16_bf16(a, xq[ks], acc, 0, 0, 0); }
#pragma unroll
            for (int r = 0; r < 16; ++r) acc[r] *= rq;
            if (nt == 1 || nt == 4) {
#pragma unroll
                for (int ii = 0; ii < 4; ++ii) { const float x1 = acc[ii], x2 = acc[4 + ii]; acc[ii] = x1 * cs[ii] - x2 * sn[ii]; acc[4 + ii] = x1 * sn[ii] + x2 * cs[ii]; } }
            if (nt == 2 || nt == 5) {
#pragma unroll
                for (int ii = 0; ii < 4; ++ii) { const float x1 = acc[8 + ii], x2 = acc[12 + ii]; acc[8 + ii] = x1 * cs[ii] - x2 * sn[ii]; acc[12 + ii] = x1 * sn[ii] + x2 * cs[ii]; } }
#pragma unroll
            for (int g = 0; g < 4; ++g) { u32x2 wv; wv.x = cvt_pk_bf16(acc[4 * g], acc[4 * g + 1]); wv.y = cvt_pk_bf16(acc[4 * g + 2], acc[4 * g + 3]);
                *(u32x2*)(Qc + (size_t)row * 192 + 32 * nt + 8 * g + 4 * hi) = wv; }
        }
        { const u32x2 a = *(const u32x2*)(xr + 320 + 4 * hi), b = *(const u32x2*)(xr + 328 + 4 * hi);
            const float x1[4] = {bflo(a.x), bfhi(a.x), bflo(a.y), bfhi(a.y)}, x2[4] = {bflo(b.x), bfhi(b.x), bflo(b.y), bfhi(b.y)};
            float o1[4], o2[4];
#pragma unroll
            for (int ii = 0; ii < 4; ++ii) { o1[ii] = x1[ii] * cs[ii] - x2[ii] * sn[ii]; o2[ii] = x1[ii] * sn[ii] + x2[ii] * cs[ii]; }
            u32x2 w1, w2; w1.x = cvt_pk_bf16(o1[0], o1[1]); w1.y = cvt_pk_bf16(o1[2], o1[3]); w2.x = cvt_pk_bf16(o2[0], o2[1]); w2.y = cvt_pk_bf16(o2[2], o2[3]);
#pragma unroll
            for (int h = 0; h < 4; ++h) { *(u32x2*)(Kc + (size_t)row * 192 + h * 48 + 32 + 4 * hi) = w1; *(u32x2*)(Kc + (size_t)row * 192 + h * 48 + 40 + 4 * hi) = w2; } }
    }
    __syncthreads();
    for (int i = C.tid; i < 384 * 16; i += 512) { const int r = i / 16, p = i % 16; *(LAS u32x4*)(C.lds + r * PKV + p * 16) = *(const u32x4*)(WKV + (size_t)r * 128 + p * 8); }
    __syncthreads();
    for (int w = C.gw; w < NTOK / 32; w += C.NGW) {
        const int row = w * 32 + r32; const bf16_t* xr = UCD + (size_t)row * 1024;
        bf16x8 xk[8]; float ssk = 0.f;
#pragma unroll
        for (int ks = 0; ks < 8; ++ks) { xk[ks] = *(const bf16x8*)(xr + 192 + ks * 16 + hi * 8);
#pragma unroll
            for (int j = 0; j < 8; ++j) { const float f = bf2f((unsigned short)xk[ks][j]); ssk += f * f; } }
        ssk += __shfl_xor(ssk, 32);
        const float rk = 1.0f / sqrtf(ssk * (1.f / 128.f) + RMS_EPS);
#pragma unroll 1
        for (int nt = 0; nt < 12; ++nt) {
            f32x16 acc;
#pragma unroll
            for (int r = 0; r < 16; ++r) acc[r] = 0.f;
#pragma unroll
            for (int ks = 0; ks < 8; ++ks) { const bf16x8 a = *(const LAS bf16x8*)(C.lds + (32 * nt + r32) * PKV + (ks * 16 + hi * 8) * 2); acc = __builtin_amdgcn_mfma_f32_32x32x16_bf16(a, xk[ks], acc, 0, 0, 0); }
            const int h = nt / 3, part = nt % 3;
            bf16_t* dst = (part == 0) ? Kc + (size_t)row * 192 + h * 48 : Vc + (size_t)row * 256 + h * 64 + (part - 1) * 32;
#pragma unroll
            for (int g = 0; g < 4; ++g) { u32x2 wv; wv.x = cvt_pk_bf16(acc[4 * g] * rk, acc[4 * g + 1] * rk); wv.y = cvt_pk_bf16(acc[4 * g + 2] * rk, acc[4 * g + 3] * rk);
                *(u32x2*)(dst + 8 * g + 4 * hi) = wv; }
        }
    }
}

DI float one_minus_a2(float y, float a) {
    const float p = -y * (1.0f + y * (0.5f + y * (0.16666667f + y * (0.041666668f + y * (0.0083333338f + y * 0.0013888889f)))));
    return (y > -0.25f) ? p : (1.0f - a * a);
}
template <bool FINAL, int DIR>
DI void rglru_units(const Ctx& C, int l) {
    const bf16_t* UCD = (const bf16_t*)(C.ws + WS_U); f32x2* DC = (f32x2*)(C.ws + WS_DC);
    bf16_t* HFB = (bf16_t*)(C.ws + WS_EW);
    const int lane = C.lane, l15 = lane & 15, g = lane >> 4;
    LAS unsigned char* wl = C.lds + C.wave * 16384;
    LAS unsigned char* xcb = wl;
    LAS float* gs = (LAS float*)(wl + 2304);
    const int n = C.gw & 3, ch = n * 64 + lane;
    bf16x8 Wf[2][4][2];
    { const bf16x8* fp = (const bf16x8*)(C.ws + WS_WRG) + (size_t)((((l * 2 + DIR) * 4 + n) * 2) * 8) * 64 + lane;
#pragma unroll
      for (int gt = 0; gt < 2; ++gt)
#pragma unroll
        for (int nt = 0; nt < 4; ++nt)
#pragma unroll
            for (int ks = 0; ks < 2; ++ks) Wf[gt][nt][ks] = fp[(size_t)((gt * 4 + nt) * 2 + ks) * 64]; }
    const float ba = C.A->in[14][(l * 2 + DIR) * 256 + ch], bx = C.A->in[16][(l * 2 + DIR) * 256 + ch];
    const float lam = C.A->in[17][(l * 2 + DIR) * 256 + ch];
    const float c8sp = -8.0f * log1pf(expf(-lam));
    float cw[4];
#pragma unroll
    for (int j = 0; j < 4; ++j) cw[j] = C.A->in[11][(l * 4 + j) * 256 + ch];
    const float cb = C.A->in[12][l * 256 + ch];
    for (int w = C.gw; w < NCHUNK * 4; w += C.NGW) {
        const int chunk = w >> 2;
        const int r0 = chunk * 128; const int sb = row_seq_begin(r0), se = sb + row_seq_len(r0);
        float h = FINAL ? DC[(size_t)(chunk * 2 + DIR) * 256 + ch][1] : 0.f, P = 1.f;
        float xr[19];
#define RG_LOADX(dst, sc_) do { const int tb_ = r0 + 16 * (DIR ? 7 - (sc_) : (sc_)) - 2; \
            _Pragma("unroll") for (int i_ = 0; i_ < 19; ++i_) { const int rr_ = tb_ + i_; dst[i_] = (rr_ >= sb && rr_ < se) ? bf2f(UCD[(size_t)rr_ * 1024 + 336 + ch]) : 0.f; } } while (0)
        RG_LOADX(xr, 0);
        for (int sc = 0; sc < 8; ++sc) {
            const int t0 = r0 + 16 * (DIR ? 7 - sc : sc);
            float xcr[16];
#pragma unroll
            for (int a = 0; a < 16; ++a) { const int tt = DIR ? 15 - a : a;
                xcr[tt] = cb + cw[0] * xr[a] + cw[1] * xr[a + 1] + cw[2] * xr[a + 2] + cw[3] * xr[a + 3];
                *(LAS bf16_t*)(xcb + tt * 144 + lane * 2) = (bf16_t)f2bf(xcr[tt]); }
            if (sc + 1 < 8) RG_LOADX(xr, sc + 1);
            LDS_WAIT();
            const bf16x8 A0 = *(const LAS bf16x8*)(xcb + l15 * 144 + (8 * g) * 2), A1 = *(const LAS bf16x8*)(xcb + l15 * 144 + (32 + 8 * g) * 2);
#pragma unroll
            for (int gt = 0; gt < 2; ++gt)
#pragma unroll
                for (int nt = 0; nt < 4; ++nt) { f32x4 acc = (f32x4){0.f, 0.f, 0.f, 0.f};
                    acc = __builtin_amdgcn_mfma_f32_16x16x32_bf16(A0, Wf[gt][nt][0], acc, 0, 0, 0);
                    acc = __builtin_amdgcn_mfma_f32_16x16x32_bf16(A1, Wf[gt][nt][1], acc, 0, 0, 0);
#pragma unroll
                    for (int r = 0; r < 4; ++r) gs[(gt * 16 + 4 * g + r) * 68 + 16 * nt + l15] = acc[r]; }
            LDS_WAIT();
#pragma unroll
            for (int tt = 0; tt < 16; ++tt) {
                const float ra = gs[tt * 68 + lane] + ba, ia = gs[(16 + tt) * 68 + lane] + bx;
                const float r = sigmoidf_(ra), ig = sigmoidf_(ia);
                const float la = c8sp * r, a = __expf(la), u = __builtin_amdgcn_sqrtf(one_minus_a2(2.0f * la, a)) * (ig * xcr[tt]);
                h = fmaf(a, h, u); P *= a;
                if (FINAL) { const int tok = DIR ? t0 + 15 - tt : t0 + tt; HFB[((size_t)DIR * NTOK + tok) * 256 + ch] = (bf16_t)f2bf(h); } }
            LDS_WAIT();
        }
        if (!FINAL) DC[(size_t)(chunk * 2 + DIR) * 256 + ch] = (f32x2){P, h};
#undef RG_LOADX
    }
}
template <bool FINAL>
DI void ph_rglru(const Ctx& C, int l) { rglru_units<FINAL, 0>(C, l); rglru_units<FINAL, 1>(C, l); }
DI void ph_rglru_scan(const Ctx& C) {
    f32x2* DC = (f32x2*)(C.ws + WS_DC);
    for (int idx = C.bid * 512 + C.tid; idx < NSEQ * 512; idx += C.G * 512) {
        const int ch = idx & 255, dir = (idx >> 8) & 1, seq = idx >> 9;
        const int c0 = seq < 8 ? seq * 64 : 512 + (seq - 8) * 16, nc = seq < 8 ? 64 : 16;
        float hin = 0.f;
        for (int i0 = 0; i0 < nc; i0 += 16) {
            f32x2 vv[16];
#pragma unroll
            for (int i = 0; i < 16; ++i) { const int c = dir ? c0 + nc - 1 - (i0 + i) : c0 + i0 + i; vv[i] = DC[(size_t)(c * 2 + dir) * 256 + ch]; }
#pragma unroll
            for (int i = 0; i < 16; ++i) { const float P = vv[i][0], H = vv[i][1]; vv[i][1] = hin; hin = fmaf(P, hin, H); }
#pragma unroll
            for (int i = 0; i < 16; ++i) { const int c = dir ? c0 + nc - 1 - (i0 + i) : c0 + i0 + i; DC[(size_t)(c * 2 + dir) * 256 + ch] = vv[i]; }
        }
    }
}
DI float gelu_tanh(float x) { const float u = 0.7978845608028654f * (x + 0.044715f * x * x * x); const float e = __expf(2.0f * u); const float th = 1.0f - 2.0f / (e + 1.0f); return 0.5f * x * (1.0f + th); }
DI void ph_d_post(const Ctx& C) {
    const bf16_t* UCD = (const bf16_t*)(C.ws + WS_U); const bf16_t* HF = (const bf16_t*)(C.ws + WS_EW); const bf16_t* HB = HF + (size_t)NTOK * 256; bf16_t* Y = (bf16_t*)(C.ws + WS_Y);
    const int c4 = C.lane * 4;
    for (int row0 = C.gw; row0 < NTOK; row0 += 4 * C.NGW) {
        u32x2 a[4], b[4], g[4];
#pragma unroll
        for (int i = 0; i < 4; ++i) { const size_t row = (size_t)row0 + (size_t)i * C.NGW; a[i] = __builtin_nontemporal_load((const u32x2*)(HF + row * 256 + c4)); b[i] = __builtin_nontemporal_load((const u32x2*)(HB + row * 256 + c4)); g[i] = __builtin_nontemporal_load((const u32x2*)(UCD + row * 1024 + 592 + c4)); }
#pragma unroll
        for (int i = 0; i < 4; ++i) { const size_t row = (size_t)row0 + (size_t)i * C.NGW;
            const float y0 = (bflo(a[i].x) + bflo(b[i].x)) * gelu_tanh(bflo(g[i].x)), y1 = (bfhi(a[i].x) + bfhi(b[i].x)) * gelu_tanh(bfhi(g[i].x));
            const float y2 = (bflo(a[i].y) + bflo(b[i].y)) * gelu_tanh(bflo(g[i].y)), y3 = (bfhi(a[i].y) + bfhi(b[i].y)) * gelu_tanh(bfhi(g[i].y));
            u32x2 w; w.x = cvt_pk_bf16(y0, y1); w.y = cvt_pk_bf16(y2, y3);
            *(u32x2*)(Y + row * DM + 768 + c4) = w; }
    }
}

DI void ph_topk(const Ctx& C) {
    const float* affT = (const float*)(C.ws + WS_AFF); int* idx2 = (int*)(C.ws + WS_IDX); float* gsel2 = (float*)(C.ws + WS_GSEL);
    LAS unsigned* hist = (LAS unsigned*)C.lds;
    LAS unsigned* misc = hist + 4096;
    LAS unsigned* cg = misc + 8;
    LAS unsigned* ce = cg + 512;
    for (int u = C.bid; u < 32; u += C.G) {
        const int g = u >> 4, e = u & 15; const unsigned* a = (const unsigned*)(affT + (size_t)(g * 16 + e) * NTOKG);
        const int i0 = C.tid * 128; unsigned v[128];
        { const u32x4* p = (const u32x4*)(a + i0);
#pragma unroll
          for (int j = 0; j < 32; ++j) { const u32x4 q = p[j]; v[4 * j] = q.x; v[4 * j + 1] = q.y; v[4 * j + 2] = q.z; v[4 * j + 3] = q.w; } }
        unsigned prefix = 0u, mask = 0u, krem = CAP;
#pragma unroll 1
        for (int pass = 0; pass < 3; ++pass) {
            const int shift = pass == 0 ? 19 : (pass == 1 ? 7 : 0); const unsigned dm = pass == 2 ? 127u : 4095u; const int per = pass == 2 ? 2 : 64;
            for (int i = C.tid; i < 4096; i += 512) hist[i] = 0u;
            __syncthreads();
#pragma unroll
            for (int i = 0; i < 128; ++i) {
                const unsigned bin = ((v[i] & mask) == prefix) ? ((v[i] >> shift) & dm) : (5120u + (unsigned)C.lane);
                atomicAdd((unsigned*)&hist[bin], 1u); if ((i & 7) == 7) asm volatile("" : "+v"(prefix) :: "memory"); }
            __syncthreads();
            if (C.tid < 64) {
                unsigned t = 0; for (int b = 0; b < per; ++b) t += hist[per * C.tid + b];
                unsigned S = t;
#pragma unroll
                for (int off = 1; off < 64; off <<= 1) { const unsigned y = __shfl_down(S, off); if (C.tid + off < 64) S += y; }
                const unsigned above = S - t;
                if (above < krem && krem <= above + t) { unsigned cum = above; int D = per * C.tid + per - 1;
                    for (; D > per * C.tid; --D) { const unsigned c = hist[D]; if (cum + c >= krem) break; cum += c; }
                    misc[0] = (unsigned)D; misc[1] = cum; }
            }
            __syncthreads();
            prefix |= misc[0] << shift; mask |= dm << shift; krem -= misc[1];
            __syncthreads();
        }
        unsigned ngt = 0, neq = 0;
#pragma unroll
        for (int i = 0; i < 128; ++i) { ngt += (v[i] > prefix); neq += (v[i] == prefix); if ((i & 15) == 15) asm volatile("" : "+v"(prefix)); }
        unsigned ig = ngt, ie = neq;
#pragma unroll
        for (int off = 1; off < 64; off <<= 1) { const unsigned yg = __shfl_up(ig, off), ye = __shfl_up(ie, off); if (C.lane >= off) { ig += yg; ie += ye; } }
        if (C.lane == 63) { cg[C.wave] = ig; ce[C.wave] = ie; }
        __syncthreads();
        unsigned bg = 0, be = 0, allg = 0;
#pragma unroll
        for (int w = 0; w < 8; ++w) { const unsigned x = cg[w], y = ce[w]; if (w < C.wave) { bg += x; be += y; } allg += x; }
        unsigned pg = bg + ig - ngt, pe = be + ie - neq; const unsigned ngt_all = allg;
        int* io = idx2 + (size_t)e * 16384 + g * CAP; float* go = gsel2 + (size_t)e * 16384 + g * CAP; short* sm = (short*)(C.ws + WS_SM) + (size_t)(g * NTOKG + i0) * 16 + e;
#pragma unroll
        for (int i = 0; i < 128; ++i) {
            if (v[i] > prefix) { io[pg] = g * NTOKG + i0 + i; go[pg] = __builtin_bit_cast(float, v[i]); sm[i * 16] = (short)pg; ++pg; }
            else if (v[i] == prefix) { if (pe < krem) { io[ngt_all + pe] = g * NTOKG + i0 + i; go[ngt_all + pe] = __builtin_bit_cast(float, v[i]); sm[i * 16] = (short)(ngt_all + pe); } ++pe; }
            if ((i & 3) == 3) asm volatile("" : "+v"(prefix) :: "memory"); }
        __syncthreads();
    }
}

constexpr int MERGE_CHUNKS = 8, MERGE_ROWS = NTOK / MERGE_CHUNKS;
constexpr int EPB = 2;
constexpr int NPH_LAYER = 12 + 2 * MERGE_CHUNKS + 3 + (NEXP / EPB + 1) + 1, NPH = 1 + 2 * NPH_LAYER;
__global__ void __launch_bounds__(512, 2) mk_fwd(Args args) {
    extern __shared__ __attribute__((aligned(16))) unsigned char lds_raw[];
    Ctx C;
    C.lds = (LAS unsigned char*)lds_raw; C.ws = (GAS unsigned char*)args.ws; C.out = (GAS float*)args.out;
    C.tid = threadIdx.x; C.lane = C.tid & 63; C.wave = __builtin_amdgcn_readfirstlane(C.tid >> 6); C.G = gridDim.x; C.bid = blockIdx.x;
    C.gw = C.bid * 8 + C.wave; C.NGW = C.G * 8;
    C.A = &args;
    volatile LAS unsigned* MISC = (volatile LAS unsigned*)(C.lds + MISC_OFF);
    for (int u = C.tid; u < (LDS_BYTES - RING_BYTES) / 4; u += 512) ((LAS unsigned*)(C.lds + RING_BYTES))[u] = 0u;
    __syncthreads();
    const int lo = args.ph_lo, hi = args.ph_hi;
    unsigned* barw = (unsigned*)(C.ws + WS_CTL) + 4096;
    XcdBarrier bar; bar.bar = barw; bar.x = 0; bar.st = nullptr;
    if (hi - lo > 1) bar = xcd_barrier_post(barw, MISC + 8);
    int ph = 0;
#ifndef PHASE_MASK
#define PHASE_MASK 0xFFFFFFFFu
#endif
#ifndef REPEAT_MASK
#define REPEAT_MASK 0u
#endif
#define SITE(id) if constexpr (((PHASE_MASK) >> (id)) & 1u) for (int rep_ = 0; rep_ < ((((REPEAT_MASK) >> (id)) & 1u) ? 2 : 1); ++rep_)
#define PH_BEGIN if (ph >= lo && ph < hi) { { int tz_ = threadIdx.x; asm volatile("" : "+v"(tz_)); C.tid = tz_; C.lane = tz_ & 63; C.wave = __builtin_amdgcn_readfirstlane(tz_ >> 6); C.gw = C.bid * 8 + C.wave; unsigned char* wz_ = args.ws; asm volatile("" : "+s"(wz_)); C.ws = (GAS unsigned char*)wz_; float* oz_ = args.out; asm volatile("" : "+s"(oz_)); C.out = (GAS float*)oz_; }
#define PH_END } if (ph >= lo && ph + 1 < hi) xcd_barrier(bar); ++ph;

#define XB0 ((bf16_t*)(C.ws + WS_XB0))
#define XB1 ((bf16_t*)(C.ws + WS_XB1))
#define Yb ((bf16_t*)(C.ws + WS_Y))
#define Ub ((bf16_t*)(C.ws + WS_U))
    const int big = 30;

    PH_BEGIN SITE(1) ph_prologue(C); PH_END

    for (int l = 0; l < 2; ++l) {
#define wl (C.ws + WS_WSMALL + (size_t)l * WSMALL_LAYER)
        PH_BEGIN SITE(2) { pg8::Gemm g{XB0, (const bf16_t*)(wl + OFF_WA), NTOK, 768, 1024, 1024, 1024, big, 0}; pg8::StaticOrder S; S.init(NTOK, 768, C.G, C.bid);
            pg8::EpiProj E{Ub, 768, 256, 0.17677669529663689f * LOG2E, (unsigned*)(C.ws + WS_KN2) + (size_t)l * 8 * 2048}; pg8::gemm_phase(C.lds, g, S, E); } PH_END
        PH_BEGIN SITE(3) ph_attn_a(C, l); PH_END
        PH_BEGIN SITE(4) { ph_a_post(C, l); __syncthreads();
            pg8::Gemm g{XB0, (const bf16_t*)(wl + OFF_WB), NTOK, 1280, 1024, 1024, 1024, big, 0}; pg8::StaticOrder S; S.init(NTOK, 1280, C.G, C.bid);
            pg8::EpiProj E{Ub, 1280, 0, 1.f, nullptr}; pg8::gemm_phase(C.lds, g, S, E); } PH_END
        PH_BEGIN SITE(5) ph_hgrn_local(C, l); PH_END
        PH_BEGIN SITE(6) ph_hgrn_scan(C); PH_END
        PH_BEGIN SITE(7) ph_hgrn_out<1>(C, l); PH_END
        PH_BEGIN SITE(20) ph_hgrn_out<2>(C, l); PH_END
        PH_BEGIN SITE(8) { pg8::Gemm g{XB0, (const bf16_t*)(wl + OFF_WCD), NTOK, 1024, 1024, 1024, 1024, big, 0}; pg8::StaticOrder S; S.init(NTOK, 1024, C.G, C.bid);
            pg8::EpiProj E{Ub, 1024, 0, 1.f, nullptr}; pg8::gemm_phase(C.lds, g, S, E); } PH_END
        PH_BEGIN SITE(9) { ph_c_prep(C, l); __syncthreads(); ph_rglru<false>(C, l); } PH_END
        PH_BEGIN SITE(10) { if (rep_ == 0) { ph_rglru_scan(C); __syncthreads(); } ph_attn_c(C); } PH_END
        PH_BEGIN SITE(11) ph_rglru<true>(C, l); PH_END
        PH_BEGIN SITE(12) ph_d_post(C); PH_END
        for (int q = 0; q < MERGE_CHUNKS; ++q) {
            const size_t r0 = (size_t)q * MERGE_ROWS;
            PH_BEGIN SITE(13) {
                { unsigned char* X8 = (unsigned char*)(C.ws + WS_U) + (size_t)MERGE_ROWS * 8192;
                  for (int rb = C.gw; rb < MERGE_ROWS; rb += 8 * C.NGW) {
                      u32x4 a[8], b[8];
#pragma unroll
                      for (int i = 0; i < 8; ++i) { const int r = min(rb + i * C.NGW, MERGE_ROWS - 1); const u32x4* s = (const u32x4*)(XB0 + (r0 + r) * DM) + 2 * C.lane; a[i] = __builtin_nontemporal_load(&s[0]); b[i] = __builtin_nontemporal_load(&s[1]); }
#pragma unroll
                      for (int i = 0; i < 8; ++i) { const int r = rb + i * C.NGW; if (r < MERGE_ROWS) {
                          u32x4 o; o.x = pg8::pk4_fp8(bflo(a[i].x), bfhi(a[i].x), bflo(a[i].y), bfhi(a[i].y)); o.y = pg8::pk4_fp8(bflo(a[i].z), bfhi(a[i].z), bflo(a[i].w), bfhi(a[i].w));
                          o.z = pg8::pk4_fp8(bflo(b[i].x), bfhi(b[i].x), bflo(b[i].y), bfhi(b[i].y)); o.w = pg8::pk4_fp8(bflo(b[i].z), bfhi(b[i].z), bflo(b[i].w), bfhi(b[i].w));
                          ((u32x4*)(X8 + (size_t)r * DM))[C.lane] = o; } } }
                  __syncthreads(); }
                pg8::Gemm g{Yb + r0 * DM, (const bf16_t*)(wl + OFF_WBR), MERGE_ROWS, 4096, 256, 1024, 256, 2, 512}; pg8::StaticOrder S; S.init(MERGE_ROWS, 4096, C.G, C.bid);
                pg8::EpiProj E{Ub, 4096, 0, 1.f, nullptr}; pg8::gemm_phase(C.lds, g, S, E); } PH_END
            PH_BEGIN SITE(14) { pg8::Gemm g{(const bf16_t*)(C.ws + WS_U + (size_t)MERGE_ROWS * 8192), (const bf16_t*)(wl + OFF_WG), MERGE_ROWS, 4096, 1024, 1024, 1024, big, 0}; pg8::StaticOrder S; S.init(MERGE_ROWS, 4096, C.G, C.bid);
                pg8::EpiGateMix E{Ub, XB1 + r0 * DM, 1.f / pg8::FP8_W1_SCALE}; pg8::gemm_phase<pg8::EpiGateMix, pg8::StaticOrder, true>(C.lds, g, S, E); } PH_END
        }
        PH_BEGIN SITE(15) { pg8::Gemm g{XB1, (const bf16_t*)(wl + OFF_WOUT), NTOK, 1024, 1024, 1024, 1024, big, 0}; pg8::StaticOrder S; S.init(NTOK, 1024, C.G, C.bid);
            pg8::EpiResid E{l == 0 ? C.A->in[0] : (const float*)C.out, l == 0 ? C.A->in[1] : (const float*)(C.out + (size_t)NTOKG * DM), (float*)C.out}; pg8::gemm_phase(C.lds, g, S, E); } PH_END
        PH_BEGIN SITE(16) { ph_ln<true>(C, l, 0, XB1); } PH_END
        PH_BEGIN SITE(17) { if (C.bid < 32 && C.G > 64) ph_topk(C); else expert_weight_items(C, l); if (C.G <= 64) { __syncthreads(); if (C.bid < 32) ph_topk(C); } } PH_END
        for (int k = 0; k < NEXP / EPB + 1; ++k) {
            PH_BEGIN SITE(18) {
                constexpr size_t H_B = (size_t)EPB * 16384 * 2048;
                unsigned char* Hb = (unsigned char*)(C.ws + WS_XB0);
                if (k < NEXP / EPB) { const int e0 = k * EPB;
                    pg8::Gemm g{(const bf16_t*)(C.ws + WS_XB1), (const bf16_t*)(C.ws + WS_EW + OFF_WGU8 + (size_t)e0 * 4096 * 1024), EPB * 16384, 4096, 1024, 1024, 1024, big, 0, 6, (size_t)4096 * 1024, (const int*)(C.ws + WS_IDX) + (size_t)e0 * 16384}; pg8::StaticOrder S; S.init(EPB * 16384, 4096, C.G, C.bid);
                    pg8::EpiSiluMul8 E{Hb + (size_t)(k & 1) * H_B, 2048}; pg8::gemm_phase<pg8::EpiSiluMul8, pg8::StaticOrder, true, true>(C.lds, g, S, E); }
                if (k >= 1) { const int e0 = (k - 1) * EPB; __syncthreads();
                    pg8::Gemm g{(const bf16_t*)(Hb + (size_t)((k - 1) & 1) * H_B), (const bf16_t*)(C.ws + WS_EW + OFF_WD8 + (size_t)e0 * 1024 * 2048), EPB * 16384, 1024, 2048, 2048, 2048, big, 0, 6, (size_t)1024 * 2048}; pg8::StaticOrder S; S.init(EPB * 16384, 1024, C.G, C.bid);
                    pg8::EpiYe E{(bf16_t*)(C.ws + WS_Y) + (size_t)e0 * 16384 * DM, (const float*)(C.ws + WS_GSEL) + (size_t)e0 * 16384, 1.f / (pg8::FP8_H_SCALE * pg8::FP8_W2_SCALE)}; pg8::gemm_phase<pg8::EpiYe, pg8::StaticOrder, true>(C.lds, g, S, E); }
            } PH_END
        }
        PH_BEGIN SITE(19) ph_ln<false>(C, l, 1, l + 1 < 2 ? XB0 : nullptr); PH_END
    }
#undef PH_BEGIN
#undef PH_END
#undef XB0
#undef XB1
#undef Yb
#undef Ub
#undef wl
}

extern "C" void kernel_launch(void* const* d_in, const int* in_sizes, int n_in, void* d_out, int out_size, void* d_ws, size_t ws_size, hipStream_t stream) {
    static int grid = 0;
    if (grid == 0) {
        if (n_in != 26 || out_size != NTOK * DM || ws_size < WS_END) { fprintf(stderr, "kernel_launch: unexpected shapes: n_in %d out %d ws %zu (need %zu)\n", n_in, out_size, ws_size, (size_t)WS_END); grid = -1; return; }
        int dev = 0, cus = 0, per_cu = 0;
        if (hipGetDevice(&dev) != hipSuccess || hipDeviceGetAttribute(&cus, hipDeviceAttributeMultiprocessorCount, dev) != hipSuccess) { grid = -1; return; }
        if (hipFuncSetAttribute((const void*)mk_fwd, hipFuncAttributeMaxDynamicSharedMemorySize, LDS_BYTES) != hipSuccess) { fprintf(stderr, "kernel_launch: hipFuncSetAttribute failed\n"); grid = -1; return; }
        if (hipOccupancyMaxActiveBlocksPerMultiprocessor(&per_cu, (const void*)mk_fwd, 512, LDS_BYTES) != hipSuccess || per_cu < 1) { fprintf(stderr, "kernel_launch: occupancy query says %d\n", per_cu); }
        (void)hipGetLastError();
        grid = cus;
    }
    if (grid < 0) return;
    if (hipMemsetAsync((char*)d_ws + WS_CTL, 0, CTL_ZERO_BYTES, stream) != hipSuccess) return;
    Args a{};
    for (int i = 0; i < 26; ++i) a.in[i] = (const float*)d_in[i];
    a.out = (float*)d_out; a.ws = (unsigned char*)d_ws;
#if MK_PER_PHASE_LAUNCH
    for (int p = 0; p < NPH; ++p) { a.ph_lo = p; a.ph_hi = p + 1; hipLaunchKernelGGL(mk_fwd, dim3(grid), dim3(512), LDS_BYTES, stream, a); }
#else
    a.ph_lo = 0; a.ph_hi = NPH; hipLaunchKernelGGL(mk_fwd, dim3(grid), dim3(512), LDS_BYTES, stream, a);
#endif
    const hipError_t le = hipPeekAtLastError();
    if (le != hipSuccess) fprintf(stderr, "kernel_launch: launch failed: %s\n", hipGetErrorName(le));
}
```

```cpp
#include <hip/hip_runtime.h>
#include <cstdio>
#include <cstdint>

#ifndef MK_PER_PHASE_LAUNCH
#define MK_PER_PHASE_LAUNCH 0
#endif

#define LAS __attribute__((address_space(3)))
#define GAS __attribute__((address_space(1)))
typedef unsigned short bf16_t;
typedef short bf16x8 __attribute__((ext_vector_type(8)));
typedef short s16x4 __attribute__((ext_vector_type(4)));
typedef float f32x2 __attribute__((ext_vector_type(2)));
typedef float f32x4 __attribute__((ext_vector_type(4)));
typedef float f32x16 __attribute__((ext_vector_type(16)));
typedef unsigned u32x2 __attribute__((ext_vector_type(2)));
typedef unsigned u32x4 __attribute__((ext_vector_type(4)));
#define DI __device__ __forceinline__
#define LDS_WAIT() asm volatile("s_waitcnt lgkmcnt(0)" ::: "memory")
#define VM_WAIT() asm volatile("s_waitcnt vmcnt(0)" ::: "memory")

constexpr int DM = 1024, NTOK = 131072, NTOKG = 65536, NSEQ = 40, NCHUNK = 1024  ;
constexpr int IN_W = 6992, COL_B = 768, COL_CD = 2048, COL_GATE = 2896;
constexpr int NEXP = 16, DEXP = 2048, CAP = 8192;
constexpr float ALPHA = 1.41421356237309515f, INV_ALPHA = 0.70710678118654752f;
constexpr float LOG2E = 1.4426950408889634f;
constexpr float LN_EPS = 1e-5f, RMS_EPS = 1e-6f;

constexpr size_t MiB = (size_t)1 << 20;
constexpr size_t WS_CTL = 0, CTL_ZERO_BYTES = 1 * MiB;
constexpr size_t WS_KN2 = 256 * 1024;
constexpr size_t WS_WSMALL = 2 * MiB, WSMALL_LAYER = 18 * MiB;
constexpr size_t OFF_WA = 0, OFF_WB = (size_t)768 * 1024 * 2, OFF_WCD = OFF_WB + (size_t)1280 * 1024 * 2, OFF_WG = OFF_WCD + (size_t)1024 * 1024 * 2,
                 OFF_WBR = OFF_WG + (size_t)4096 * 1024 * 2, OFF_WOUT = OFF_WBR + (size_t)4096 * 256 * 2;
static_assert(OFF_WOUT + (size_t)1024 * 1024 * 2 <= WSMALL_LAYER, "small weights");
constexpr size_t WS_WC = 38 * MiB, WC_LAYER = 256 * 1024;
constexpr size_t OFF_WQ = 0, OFF_WKV = 96 * 1024;
constexpr size_t WS_WRG = 39 * MiB;
constexpr size_t WS_AFF = 40 * MiB;
constexpr size_t WS_IDX = 48 * MiB, WS_GSEL = 49 * MiB;
constexpr size_t WS_GAM = 50 * MiB;
constexpr size_t WS_DC = 52 * MiB;
constexpr size_t WS_SM = 56 * MiB;
constexpr size_t WS_XB0 = 64 * MiB, WS_XB1 = 320 * MiB, WS_Y = 576 * MiB, WS_U = 832 * MiB, WS_EW = 1152 * MiB, WS_END = 1344 * MiB;
constexpr size_t OFF_QC = 0, OFF_KC = 48 * MiB, OFF_VC = 96 * MiB;
constexpr size_t OFF_WGU8 = 0, OFF_WD8 = (size_t)16 * 4096 * 1024;

DI unsigned f2bf(float f) { unsigned u = __builtin_bit_cast(unsigned, f); return (u + 0x7fffu + ((u >> 16) & 1u)) >> 16; }
DI unsigned pk2(float lo, float hi) { return f2bf(lo) | (f2bf(hi) << 16); }
DI float bf2f(unsigned short b) { return __builtin_bit_cast(float, ((unsigned)b) << 16); }
DI float bflo(unsigned w) { return __builtin_bit_cast(float, w << 16); }
DI float bfhi(unsigned w) { return __builtin_bit_cast(float, w & 0xffff0000u); }
DI unsigned cvt_pk_bf16(float lo, float hi) { unsigned r; asm volatile("v_cvt_pk_bf16_f32 %0, %1, %2" : "=v"(r) : "v"(lo), "v"(hi)); return r; }
typedef __bf16 bf16x2_t __attribute__((ext_vector_type(2)));
DI unsigned cvt_pk_bf16_b(float lo, float hi) { const f32x2 v = {lo, hi}; const bf16x2_t b = __builtin_convertvector(v, bf16x2_t); return __builtin_bit_cast(unsigned, b); }
DI float sigmoidf_(float x) { return __builtin_amdgcn_rcpf(1.0f + __builtin_amdgcn_exp2f(-x * LOG2E)); }
DI float siluf_(float x) { return x * sigmoidf_(x); }
DI float wave_sum(float v) {
#pragma unroll
    for (int o = 1; o < 64; o <<= 1) v += __shfl_xor(v, o);
    return v;
}
DI float wave_max(float v) {
#pragma unroll
    for (int o = 1; o < 64; o <<= 1) v = fmaxf(v, __shfl_xor(v, o));
    return v;
}
DI int seq_start_row(int s) { return s < 8 ? s * 8192 : 65536 + (s - 8) * 2048; }
DI int row_pos(int row) { return row < 65536 ? (row & 8191) : (row & 2047); }
DI int row_seq_begin(int row) { return row < 65536 ? (row & ~8191) : (row & ~2047); }
DI int row_seq_len(int row) { return row < 65536 ? 8192 : 2048; }

namespace pg8 {
constexpr int BM = 256, BK = 64, HALF = 128, HTB = HALF * BK * 2, STAGE_BYTES = 8 * HTB, NXCD = 8, WGM = 8;
DI int lds_byte(int r, int c) { const int st = (r >> 4) * 2 + (c >> 5), rr = r & 15, cc = c & 31, ob = rr * 64 + cc * 2; return st * 1024 + (ob ^ (((ob >> 9) & 1) << 5)); }
DI void stage_rc(int b, int& R, int& C) { const int st = b / 1024, sb = b % 1024, swz = sb ^ (((sb >> 9) & 1) << 5); R = (st >> 1) * 16 + swz / 64; C = (st & 1) * 32 + (swz % 64) / 2; }
DI int perm32(int rho) { const int n = rho >> 4, i = rho & 15; return 8 * (i >> 2) + 4 * n + (i & 3); }

struct Unit { int pm, pn; };
struct Gemm { const bf16_t* A; const bf16_t* Bt; int M, N, K, lda, ldb, an_shift; size_t an_off; int bm_shift = 30; size_t bm_off = 0; const int* gidx = nullptr; };

struct StaticOrder {
    int nM, nN, nwg, G, c;
    DI void init(int M, int N, int G_, int c_) { nM = M / BM; nN = N / BM; nwg = nM * nN; G = G_; c = c_; }
    DI bool next(int i, Unit& u) const {
        const long L = (long)i * G + c; if (L >= nwg) return false;
        int wgid = (int)L; { const int q = nwg / NXCD, r = nwg % NXCD, xcd = wgid % NXCD, off = wgid / NXCD; wgid = (xcd < r ? xcd * (q + 1) : r * (q + 1) + (xcd - r) * q) + off; }
        const int nig = WGM * nN, gid = wgid / nig, fm = gid * WGM, gsz = (nM - fm) < WGM ? (nM - fm) : WGM;
        u.pm = fm + ((wgid % nig) % gsz); u.pn = (wgid % nig) / gsz; return true;
    }
};

typedef f32x4 Acc[2][2][4][2];

typedef int v8i_t __attribute__((ext_vector_type(8)));
DI void mfma8_tied(f32x4& c, const v8i_t& a, const v8i_t& b) { asm volatile("v_mfma_f32_16x16x128_f8f6f4 %0, %1, %2, %0" : "+v"(c) : "v"(a), "v"(b)); }
DI void glds_sv(const void* sbase, unsigned voff, unsigned lds_dst) { unsigned keep;
    asm volatile("s_mov_b32 %0, m0\n\ts_mov_b32 m0, %3\n\ts_nop 0\n\tglobal_load_lds_dwordx4 %1, %2\n\ts_mov_b32 m0, %0" : "=&s"(keep) : "v"(voff), "s"(sbase), "s"(lds_dst) : "memory"); }
constexpr int GIDX_OFF = 131072 + 1024, GIDX_TILES = 14;
template <class Epi, class Sched, bool FP8 = false, bool GATHER = false>
DI void gemm_phase(LAS unsigned char* lds, const Gemm g, const Sched& S, const Epi& E) {
    int tid = threadIdx.x; asm volatile("" : "+v"(tid));
    const int wid = __builtin_amdgcn_readfirstlane(tid >> 6), lane = tid & 63, wr = wid >> 2, wc = wid & 3, fr = lane & 15, fq = lane >> 4;
    const int K = g.K, nt = FP8 ? K / 128 : K / BK;
    const int pitchA = FP8 ? g.lda : g.lda * 2, pitchB = FP8 ? g.ldb : g.ldb * 2;
    unsigned voffA[2], voffB[2];
#pragma unroll
    for (int i = 0; i < 2; ++i) { int R, C; stage_rc(tid * 16 + i * 8192, R, C); const int Rb = Epi::PERM ? ((R & ~31) + perm32(R & 31)) : R;
        voffA[i] = (unsigned)(R * pitchA + C * 2); voffB[i] = (unsigned)(Rb * pitchB + C * 2); }
    const size_t kstep = (size_t)(BK * 2);
    const size_t hstepA = (size_t)HALF * pitchA, hstepB = (size_t)HALF * pitchB;
    const size_t tstepA = 2 * hstepA, tstepB = 2 * hstepB;
    const unsigned ldsw = (unsigned)wid * 1024u;
    const int aoff = lds_byte(wr * 64 + fr, fq * 8), boff = lds_byte(wc * 32 + fr, fq * 8);
#define PG8_SA(b, h) (((b) * 2 + (h)) * HTB)
#define PG8_SB(b, h) ((4 + (b) * 2 + (h)) * HTB)
#define PG8_STAGE(bufoff, gbase, voff) do { _Pragma("unroll") for (int _i = 0; _i < 2; ++_i) \
        glds_sv((const void*)(gbase), (voff)[_i], (unsigned)(uintptr_t)(lds + (bufoff) + ldsw + _i * 8192)); } while (0)
#define PG8_LD1(p) ([&]() { if constexpr (FP8) { const u32x4 lo_ = *(const LAS u32x4*)(p), hi_ = *(const LAS u32x4*)((p) + 1024); return Frag{__builtin_bit_cast(v8i_t, __builtin_shufflevector(lo_, hi_, 0, 1, 2, 3, 4, 5, 6, 7))}; } \
        else { Frag f_; f_.h[0] = *(const LAS bf16x8*)(p); f_.h[1] = *(const LAS bf16x8*)((p) + 1024); return f_; } }())
#define PG8_LDA(dst, b, h) do { _Pragma("unroll") for (int m = 0; m < 4; ++m) dst[m] = PG8_LD1(lds + PG8_SA(b, h) + aoff + m * 2048); } while (0)
#define PG8_LDB(dst, b, h) do { _Pragma("unroll") for (int n = 0; n < 2; ++n) dst[n] = PG8_LD1(lds + PG8_SB(b, h) + boff + n * 2048); } while (0)
#define PG8_MMA(ai, bj, At, Bt) do { __builtin_amdgcn_s_setprio(1); _Pragma("unroll") for (int m = 0; m < 4; ++m) _Pragma("unroll") for (int n = 0; n < 2; ++n) { \
        if constexpr (FP8) mfma8_tied(acc[ai][bj][m][n], Bt[n].w, At[m].w); \
        else { _Pragma("unroll") for (int k = 0; k < 2; ++k) acc[ai][bj][m][n] = __builtin_amdgcn_mfma_f32_16x16x32_bf16(Bt[n].h[k], At[m].h[k], acc[ai][bj][m][n], 0, 0, 0); } } \
        __builtin_amdgcn_s_setprio(0); } while (0)
#define PG8_WAIT_V(n) asm volatile("s_waitcnt vmcnt(" #n ")" ::: "memory")
#define PG8_WAIT_L(n) asm volatile("s_waitcnt lgkmcnt(" #n ")" ::: "memory")
#define PG8_BAR __builtin_amdgcn_s_barrier()
#define PG8_SCHED __builtin_amdgcn_sched_barrier(0)
    Unit cur, nxt; int ui = 0;
    unsigned vg[2][2] = {{0u, 0u}, {0u, 0u}};
    if constexpr (GATHER) { LAS unsigned* tab = (LAS unsigned*)(lds + GIDX_OFF); Unit u_;
        for (int i = 0; i < GIDX_TILES && S.next(i, u_); ++i) { if (tid < 256) tab[i * 256 + tid] = (unsigned)g.gidx[u_.pm * BM + tid]; }
        __syncthreads(); }
#define PG8_GOFF(ord) do { int tq_ = tid; asm volatile("" : "+v"(tq_)); int R_, C_; stage_rc(tq_ * 16, R_, C_); const LAS unsigned* tb_ = (const LAS unsigned*)(lds + GIDX_OFF) + (ord) * 256 + R_; \
        _Pragma("unroll") for (int h_ = 0; h_ < 2; ++h_) _Pragma("unroll") for (int i_ = 0; i_ < 2; ++i_) vg[h_][i_] = tb_[h_ * 128 + i_ * 64] * (unsigned)pitchA + (unsigned)(C_ * 2); } while (0)
#define PG8_STAGE_A(bufoff, base, h) do { if constexpr (GATHER) PG8_STAGE(bufoff, base, vg[h]); else PG8_STAGE(bufoff, (base) + (h) * hstepA, voffA); } while (0)
    if (!S.next(0, cur)) return;
    if constexpr (GATHER) PG8_GOFF(0);
    float zf = 0.f; asm volatile("" : "+v"(zf));
    Acc acc;
#pragma unroll
    for (int a = 0; a < 2; ++a)
#pragma unroll
        for (int b = 0; b < 2; ++b)
#pragma unroll
            for (int m = 0; m < 4; ++m)
#pragma unroll
                for (int n = 0; n < 2; ++n) acc[a][b][m][n] = (f32x4){zf, zf, zf, zf};
    union Frag { v8i_t w; bf16x8 h[2]; };
    Frag At[4], B0[2], B1[2];
    const char* cA = GATHER ? (const char*)g.A : (const char*)g.A + (size_t)cur.pm * tstepA + (size_t)(cur.pn >> g.an_shift) * g.an_off; const char* cB = (const char*)g.Bt + (size_t)cur.pn * tstepB + (size_t)(cur.pm >> g.bm_shift) * g.bm_off;
    PG8_STAGE(PG8_SB(0, 0), cB, voffB); PG8_STAGE(PG8_SB(0, 1), cB + hstepB, voffB); PG8_STAGE_A(PG8_SA(0, 0), cA, 0); PG8_STAGE_A(PG8_SA(0, 1), cA, 1);
    if (wr == 1) PG8_BAR;
    PG8_WAIT_V(2); PG8_BAR;
    PG8_STAGE(PG8_SB(1, 0), cB + kstep, voffB); PG8_STAGE_A(PG8_SA(1, 0), cA + kstep, 0); PG8_STAGE(PG8_SB(1, 1), cB + hstepB + kstep, voffB);
    PG8_WAIT_V(6); PG8_BAR;
    for (;;) {
        const bool has_next = S.next(ui + 1, nxt);
        const char* nA = (has_next && !GATHER) ? (const char*)g.A + (size_t)nxt.pm * tstepA + (size_t)(nxt.pn >> g.an_shift) * g.an_off : cA;
        const char* nB = has_next ? (const char*)g.Bt + (size_t)nxt.pn * tstepB + (size_t)(nxt.pm >> g.bm_shift) * g.bm_off : cB;
#pragma unroll 1
        for (int t = 0; t < nt; t += 2) {
            const bool last = (t == nt - 2);
            const char* a1 = cA + (size_t)(t + 1) * kstep;
            const char* a2 = last ? nA : cA + (size_t)(t + 2) * kstep; const char* b2 = last ? nB : cB + (size_t)(t + 2) * kstep;
            const char* a3 = a2 + kstep; const char* b3 = b2 + kstep;
            PG8_LDB(B0, 0, 0); PG8_LDB(B1, 0, 1); PG8_SCHED; PG8_LDA(At, 0, 0); PG8_STAGE_A(PG8_SA(1, 1), a1, 1);
            if constexpr (GATHER) { if (last && has_next) PG8_GOFF(ui + 1); }
            PG8_WAIT_V(8); PG8_WAIT_L(0); PG8_BAR; PG8_MMA(0, 0, At, B0); PG8_MMA(0, 1, At, B1); PG8_BAR; PG8_SCHED;
            PG8_LDA(At, 0, 1); PG8_STAGE(PG8_SB(0, 0), b2, voffB); PG8_STAGE(PG8_SB(0, 1), b2 + hstepB, voffB); PG8_STAGE_A(PG8_SA(0, 0), a2, 0);
            PG8_WAIT_V(8); PG8_WAIT_L(0); PG8_BAR; PG8_MMA(1, 0, At, B0); PG8_MMA(1, 1, At, B1); PG8_BAR; PG8_SCHED;
            PG8_LDB(B0, 1, 0); PG8_LDB(B1, 1, 1); PG8_SCHED; PG8_LDA(At, 1, 0); PG8_STAGE_A(PG8_SA(0, 1), a2, 1);
            PG8_WAIT_V(8); PG8_WAIT_L(0); PG8_BAR; PG8_MMA(0, 0, At, B0); PG8_MMA(0, 1, At, B1); PG8_BAR; PG8_SCHED;
            PG8_LDA(At, 1, 1); PG8_STAGE(PG8_SB(1, 0), b3, voffB); PG8_STAGE(PG8_SB(1, 1), b3 + hstepB, voffB); PG8_STAGE_A(PG8_SA(1, 0), a3, 0);
            PG8_WAIT_V(8); PG8_WAIT_L(0); PG8_BAR; PG8_MMA(1, 0, At, B0); PG8_MMA(1, 1, At, B1); PG8_BAR; PG8_SCHED;
        }
        if (wr == 0) PG8_BAR;
        if constexpr (FP8) asm volatile("s_nop 15\n\ts_nop 15" ::: "memory");
        { int tz = tid; asm volatile("" : "+v"(tz));
          const int lz = tz & 63; E(acc, cur, wr, wc, lz & 15, lz >> 4); }
        if (!has_next) break;
#pragma unroll
        for (int a = 0; a < 2; ++a)
#pragma unroll
            for (int b = 0; b < 2; ++b)
#pragma unroll
                for (int m = 0; m < 4; ++m)
#pragma unroll
                    for (int n = 0; n < 2; ++n) acc[a][b][m][n] = (f32x4){0.f, 0.f, 0.f, 0.f};
        cur = nxt; cA = nA; cB = nB; ++ui;
        if (wr == 1) PG8_BAR;
    }
    PG8_WAIT_V(0);
    PG8_BAR;
#undef PG8_SA
#undef PG8_SB
#undef PG8_STAGE
#undef PG8_STAGE_A
#undef PG8_GOFF
#undef PG8_LDA
#undef PG8_LDB
#undef PG8_MMA
#undef PG8_LD1
#undef PG8_WAIT_V
#undef PG8_WAIT_L
#undef PG8_BAR
#undef PG8_SCHED
}

struct EpiProj {
    static constexpr bool PERM = true;
    bf16_t* O; int ldc; int scale_cols; float scale; unsigned* kn2;
    DI void operator()(const Acc& acc, const Unit& u, int wr, int wc, int fr, int fq) const {
        const int row0 = u.pm * BM + wr * 64 + fr, colt = u.pn * BM, col0 = colt + wc * 32 + 8 * fq;
        const float sc = (colt < scale_cols) ? scale : 1.f;
        const bool donorm = (kn2 != nullptr) && (colt == 256);
#pragma unroll
        for (int ai = 0; ai < 2; ++ai) { float mx0 = 0.f, mx1 = 0.f;
#pragma unroll
            for (int m = 0; m < 4; ++m) { bf16_t* rowp = O + (size_t)(row0 + ai * HALF + m * 16) * ldc + col0;
#pragma unroll
                for (int bj = 0; bj < 2; ++bj) { const f32x4 v0 = acc[ai][bj][m][0] * sc, v1 = acc[ai][bj][m][1] * sc;
                    u32x4 w; w.x = cvt_pk_bf16(v0[0], v0[1]); w.y = cvt_pk_bf16(v0[2], v0[3]); w.z = cvt_pk_bf16(v1[0], v1[1]); w.w = cvt_pk_bf16(v1[2], v1[3]);
                    *(u32x4*)(rowp + bj * HALF) = w;
                    if (donorm) { float ss = bflo(w.x) * bflo(w.x) + bfhi(w.x) * bfhi(w.x) + bflo(w.y) * bflo(w.y) + bfhi(w.y) * bfhi(w.y) + bflo(w.z) * bflo(w.z) + bfhi(w.z) * bfhi(w.z) + bflo(w.w) * bflo(w.w) + bfhi(w.w) * bfhi(w.w);
                        ss += __shfl_xor(ss, 16); ss += __shfl_xor(ss, 32); if (bj == 0) mx0 = fmaxf(mx0, ss); else mx1 = fmaxf(mx1, ss); } } }
            if (donorm) {
#pragma unroll
                for (int o = 1; o < 16; o <<= 1) { mx0 = fmaxf(mx0, __shfl_xor(mx0, o)); mx1 = fmaxf(mx1, __shfl_xor(mx1, o)); }
                if (fr == 0 && fq == 0) { const int tile = 4 * u.pm + 2 * ai + wr;
                    atomicMax(kn2 + (size_t)(wc) * 2048 + tile, __builtin_bit_cast(unsigned, mx0)); atomicMax(kn2 + (size_t)(4 + wc) * 2048 + tile, __builtin_bit_cast(unsigned, mx1)); } } }
    }
};
struct EpiSiluMul {
    static constexpr bool PERM = true;
    bf16_t* H; int ldh;
    DI void operator()(const Acc& acc, const Unit& u, int wr, int wc, int fr, int fq) const {
        const int row0 = u.pm * BM + wr * 64 + fr, col0 = u.pn * HALF + wc * 32 + 8 * fq;
#pragma unroll
        for (int ai = 0; ai < 2; ++ai)
#pragma unroll
            for (int m = 0; m < 4; ++m) { bf16_t* rowp = H + (size_t)(row0 + ai * HALF + m * 16) * ldh + col0;
                float h[8];
#pragma unroll
                for (int n = 0; n < 2; ++n)
#pragma unroll
                    for (int j = 0; j < 4; ++j) h[n * 4 + j] = siluf_(acc[ai][0][m][n][j]) * acc[ai][1][m][n][j];
                u32x4 w; w.x = cvt_pk_bf16(h[0], h[1]); w.y = cvt_pk_bf16(h[2], h[3]); w.z = cvt_pk_bf16(h[4], h[5]); w.w = cvt_pk_bf16(h[6], h[7]);
                *(u32x4*)rowp = w; }
    }
};
DI unsigned pk4_fp8(float a, float b, float c, float d) { int w = 0; a = __builtin_amdgcn_fmed3f(a, -448.f, 448.f); b = __builtin_amdgcn_fmed3f(b, -448.f, 448.f); c = __builtin_amdgcn_fmed3f(c, -448.f, 448.f); d = __builtin_amdgcn_fmed3f(d, -448.f, 448.f);     w = __builtin_amdgcn_cvt_pk_fp8_f32(a, b, w, false); w = __builtin_amdgcn_cvt_pk_fp8_f32(c, d, w, true); return (unsigned)w; }
constexpr float FP8_W1_SCALE = 32.f, FP8_W2_SCALE = 64.f, FP8_H_SCALE = 4.f;
struct EpiSiluMul8 {
    static constexpr bool PERM = true;
    unsigned char* H; int ldh;
    DI void operator()(const Acc& acc, const Unit& u, int wr, int wc, int fr, int fq) const {
        const int row0 = u.pm * BM + wr * 64 + fr, col0 = u.pn * HALF + wc * 32 + 8 * fq;
        constexpr float k1 = -LOG2E / FP8_W1_SCALE; static_assert(FP8_W1_SCALE * FP8_W1_SCALE / FP8_H_SCALE == 256.f, "scale folding");
#pragma unroll
        for (int ai = 0; ai < 2; ++ai)
#pragma unroll
            for (int m = 0; m < 4; ++m) { unsigned char* rowp = H + (size_t)(row0 + ai * HALF + m * 16) * ldh + col0;
                float t[8], h[8];
#pragma unroll
                for (int q = 0; q < 8; ++q) t[q] = __builtin_fmaf(acc[ai][0][m][q >> 2][q & 3], k1, 8.f);
#pragma unroll
                for (int q = 0; q < 8; ++q) t[q] = __builtin_amdgcn_exp2f(t[q]);
#pragma unroll
                for (int q = 0; q < 8; ++q) { t[q] += 256.f; h[q] = acc[ai][0][m][q >> 2][q & 3] * acc[ai][1][m][q >> 2][q & 3]; }
#pragma unroll
                for (int q = 0; q < 8; ++q) t[q] = __builtin_amdgcn_rcpf(t[q]);
#pragma unroll
                for (int q = 0; q < 8; ++q) h[q] *= t[q];
                u32x2 w; w.x = pk4_fp8(h[0], h[1], h[2], h[3]); w.y = pk4_fp8(h[4], h[5], h[6], h[7]);
                *(u32x2*)rowp = w; }
    }
};
struct EpiMoeDown {
    static constexpr bool PERM = false;
    float* out; const int* idx; const float* gs; float sc;
    DI void operator()(const Acc& acc, const Unit& u, int wr, int wc, int fr, int fq) const {
        const int row0 = u.pm * BM + wr * 64 + fr, col0 = u.pn * BM + wc * 32 + 4 * fq;
#pragma unroll
        for (int ai = 0; ai < 2; ++ai)
#pragma unroll
            for (int m = 0; m < 4; ++m) { const int rl = row0 + ai * HALF + m * 16; const int tok = idx[rl]; const float g = gs[rl] * sc;
                float* rowp = out + (size_t)tok * DM + col0;
#pragma unroll
                for (int bj = 0; bj < 2; ++bj)
#pragma unroll
                    for (int n = 0; n < 2; ++n) { f32x4* p = (f32x4*)(rowp + bj * HALF + n * 16); f32x4 v = *p; v += acc[ai][bj][m][n] * g; *p = v; }
                asm volatile("" ::: "memory"); }
    }
};
struct EpiYe {
    static constexpr bool PERM = true;
    bf16_t* O; const float* gs; float sc;
    DI void operator()(const Acc& acc, const Unit& u, int wr, int wc, int fr, int fq) const {
        const int row0 = u.pm * BM + wr * 64 + fr, col0 = u.pn * BM + wc * 32 + 8 * fq;
        float gv[8];
#pragma unroll
        for (int c = 0; c < 8; ++c) gv[c] = gs[row0 + (c >> 2) * HALF + (c & 3) * 16];
#pragma unroll
        for (int ai = 0; ai < 2; ++ai)
#pragma unroll
            for (int m = 0; m < 4; ++m) { const int rl = row0 + ai * HALF + m * 16; const float g = gv[ai * 4 + m] * sc; bf16_t* rowp = O + (size_t)rl * DM + col0;
#pragma unroll
                for (int bj = 0; bj < 2; ++bj) { const f32x4 v0 = acc[ai][bj][m][0] * g, v1 = acc[ai][bj][m][1] * g;
                    u32x4 w; w.x = cvt_pk_bf16(v0[0], v0[1]); w.y = cvt_pk_bf16(v0[2], v0[3]); w.z = cvt_pk_bf16(v1[0], v1[1]); w.w = cvt_pk_bf16(v1[2], v1[3]);
                    __builtin_nontemporal_store(w, (u32x4*)(rowp + bj * HALF)); } }
    }
};
struct EpiResid {
    static constexpr bool PERM = false;
    const float* xa; const float* xb; float* out;
    DI void operator()(const Acc& acc, const Unit& u, int wr, int wc, int fr, int fq) const {
        const int row0 = u.pm * BM + wr * 64 + fr, col0 = u.pn * BM + wc * 32 + 4 * fq;
#pragma unroll
        for (int ai = 0; ai < 2; ++ai) {
            f32x4 sv[4][4];
#pragma unroll
            for (int m = 0; m < 4; ++m) { const int r = row0 + ai * HALF + m * 16;
                const float* srow = (r < NTOKG ? xa + (size_t)r * DM : xb + (size_t)(r - NTOKG) * DM) + col0;
#pragma unroll
                for (int q = 0; q < 4; ++q) sv[m][q] = __builtin_nontemporal_load((const f32x4*)(srow + (q >> 1) * HALF + (q & 1) * 16)); }
#pragma unroll
            for (int m = 0; m < 4; ++m) { const int r = row0 + ai * HALF + m * 16; float* orow = out + (size_t)r * DM + col0;
#pragma unroll
                for (int q = 0; q < 4; ++q) __builtin_nontemporal_store(sv[m][q] + acc[ai][q >> 1][m][q & 1] * INV_ALPHA, (f32x4*)(orow + (q >> 1) * HALF + (q & 1) * 16)); } }
    }
};
struct EpiGateMix {
    static constexpr bool PERM = false;
    const bf16_t* Z; bf16_t* mix; float si;
    DI void operator()(const Acc& acc, const Unit& u, int wr, int wc, int fr, int fq) const {
        const int row0 = u.pm * BM + wr * 64 + fr, J0 = u.pn * 64 + wc * 16 + fq * 4;
        u32x2 zall[8][4];
#pragma unroll
        for (int c = 0; c < 8; ++c) { const bf16_t* zrow = Z + (size_t)(row0 + (c >> 2) * HALF + (c & 3) * 16) * 4096 + J0;
#pragma unroll
            for (int b = 0; b < 4; ++b) zall[c][b] = *(const u32x2*)(zrow + b * 1024); }
#pragma unroll
        for (int ai = 0; ai < 2; ++ai)
#pragma unroll
            for (int m = 0; m < 4; ++m) { const int r = row0 + ai * HALF + m * 16;
                u32x2 zw[4];
#pragma unroll
                for (int b = 0; b < 4; ++b) zw[b] = zall[ai * 4 + m][b];
                const float kq = -si * LOG2E; float t[16];
#pragma unroll
                for (int q = 0; q < 16; ++q) t[q] = acc[ai][q >> 3][m][(q >> 2) & 1][q & 3] * kq;
#pragma unroll
                for (int q = 0; q < 16; ++q) t[q] = __builtin_amdgcn_exp2f(t[q]);
#pragma unroll
                for (int q = 0; q < 16; ++q) t[q] += 1.f;
#pragma unroll
                for (int q = 0; q < 16; ++q) t[q] = __builtin_amdgcn_rcpf(t[q]);
                f32x4 s = (f32x4){0.f, 0.f, 0.f, 0.f};
#pragma unroll
                for (int b = 0; b < 4; ++b) { s[0] += t[4 * b] * bflo(zw[b].x); s[1] += t[4 * b + 1] * bfhi(zw[b].x); s[2] += t[4 * b + 2] * bflo(zw[b].y); s[3] += t[4 * b + 3] * bfhi(zw[b].y); }
                u32x2 w; w.x = cvt_pk_bf16(s[0], s[1]); w.y = cvt_pk_bf16(s[2], s[3]);
                *(u32x2*)(mix + (size_t)r * DM + J0) = w; }
    }
};
}

#define XB_TMO      128
#define XB_XCNT(j)  (256  + 64 * (j))
#define XB_XSUB(j)  (1280 + 64 * (j))
#define XB_XGEN(j)  (2304 + 64 * (j))
#define XB_TOP      3328
#define XB_TOPGEN   3392
#define XCD_BAR_WORDS 3456
#define XB_SPIN_CAP (1u << 24)
DI unsigned xb_ld(unsigned* p)              { return __hip_atomic_load(p, __ATOMIC_RELAXED, __HIP_MEMORY_SCOPE_AGENT); }
DI unsigned xb_add(unsigned* p, unsigned v) { return __hip_atomic_fetch_add(p, v, __ATOMIC_RELAXED, __HIP_MEMORY_SCOPE_AGENT); }
DI unsigned xb_xcc_id() { return (unsigned)__builtin_amdgcn_s_getreg((3 << 11) | 20) & 0xFu; }
#define XB_SPIN(cond, bar) do { unsigned _sp = 0; while (cond) { __builtin_amdgcn_s_sleep(1); \
    if ((++_sp & 255u) == 0u) { if (xb_ld(&(bar)[XB_TMO])) break; if (_sp > XB_SPIN_CAP) { atomicAdd(&(bar)[XB_TMO], 1u); break; } } } } while (0)
struct XcdBarrier { unsigned* bar; unsigned x; volatile LAS unsigned* st; };
DI XcdBarrier xcd_barrier_post(unsigned* bar, volatile LAS unsigned* st) {
    XcdBarrier b; b.bar = bar; b.x = xb_xcc_id(); b.st = st;
    if (threadIdx.x == 0) (void)xb_add(&bar[XB_XCNT(b.x)], 1u);
    return b;
}
DI void xcd_barrier_complete(unsigned* bar, unsigned x, unsigned& nloc, unsigned& nx) {
    const unsigned G = gridDim.x * gridDim.y * gridDim.z;
    unsigned sum, cnt, mine, sp = 0u;
    for (;;) {
        sum = 0u; cnt = 0u; mine = 0u;
#pragma unroll
        for (unsigned j = 0; j < 16; ++j) { const unsigned c = xb_ld(&bar[XB_XCNT(j)]); sum += c; cnt += (c > 0u) ? 1u : 0u; mine = (j == x) ? c : mine; }
        if (sum == G) break;
        __builtin_amdgcn_s_sleep(1);
        if ((++sp & 255u) == 0u) { if (xb_ld(&bar[XB_TMO])) break; if (sp > XB_SPIN_CAP) { atomicAdd(&bar[XB_TMO], 1u); break; } }
    }
    nloc = mine > 0u ? mine : 1u; nx = cnt > 0u ? cnt : 1u;
}
DI void xcd_barrier(const XcdBarrier& b) {
    asm volatile("s_waitcnt vmcnt(0)" ::: "memory");
    __syncthreads();
    if (threadIdx.x == 0) {
        unsigned* bar = b.bar;
        __builtin_amdgcn_s_waitcnt(0);
        unsigned nloc = b.st[0], nx = b.st[1];
        if (nloc == 0u) { xcd_barrier_complete(bar, b.x, nloc, nx); b.st[0] = nloc; b.st[1] = nx; }
        const unsigned old = xb_add(&bar[XB_XSUB(b.x)], 1u);
        const unsigned gen = old / nloc;
        if (old + 1u == (gen + 1u) * nloc) {
            __builtin_amdgcn_fence(__ATOMIC_RELEASE, "agent");
            asm volatile("s_waitcnt vmcnt(0)" ::: "memory");
            const unsigned og = xb_add(&bar[XB_TOP], 1u);
            const unsigned tg = og / nx;
            if (og + 1u == (tg + 1u) * nx) xb_add(&bar[XB_TOPGEN], 1u);
            else XB_SPIN(xb_ld(&bar[XB_TOPGEN]) == tg, bar);
            __builtin_amdgcn_fence(__ATOMIC_ACQUIRE, "agent");
            xb_add(&bar[XB_XGEN(b.x)], 1u);
            asm volatile("s_waitcnt vmcnt(0)" ::: "memory");
        } else {
            XB_SPIN(xb_ld(&bar[XB_XGEN(b.x)]) == gen, bar);
            __builtin_amdgcn_fence(__ATOMIC_ACQUIRE, "agent");
            asm volatile("s_waitcnt vmcnt(0)" ::: "memory");
        }
    }
    __syncthreads();
}

struct Args { const float* in[26]; float* out; unsigned char* ws; int ph_lo, ph_hi; };
struct Ctx {
    LAS unsigned char* lds;
    GAS unsigned char* ws;
    int tid, lane, wave, G, bid, gw, NGW;
    const struct Args* A;
    GAS float* out;
};
constexpr int RING_BYTES = 131072, MISC_OFF = RING_BYTES + 320, LDS_BYTES = 147456;

DI void tr_item(const float* __restrict__ W, int ldw, int k0, int src, const float* kscale, bf16_t* WT, int ldt, int orow0, LAS float* scr, int lane) {
    float tv[32];
#pragma unroll
    for (int i = 0; i < 32; ++i) { const int kk = 2 * i + (lane >> 5); tv[i] = (src >= 0) ? W[(size_t)(k0 + kk) * ldw + src] : 0.f; }
#pragma unroll
    for (int i = 0; i < 32; ++i) { const int kk = 2 * i + (lane >> 5); float v = tv[i]; if (kscale) v *= kscale[k0 + kk]; scr[kk * 33 + (lane & 31)] = v; }
    LDS_WAIT();
    const int c = lane & 7;
#pragma unroll
    for (int j = 0; j < 4; ++j) { const int n = (lane >> 3) + 8 * j; const LAS float* s = scr + (8 * c) * 33 + n;
        u32x4 o; o.x = pk2(s[0 * 33], s[1 * 33]); o.y = pk2(s[2 * 33], s[3 * 33]); o.z = pk2(s[4 * 33], s[5 * 33]); o.w = pk2(s[6 * 33], s[7 * 33]);
        *(u32x4*)(WT + (size_t)(orow0 + n) * ldt + k0 + 8 * c) = o; }
    LDS_WAIT();
}
DI void tr_item8(const float* __restrict__ W, int ldw, int k0, int src, float scale, unsigned char* WT, int ldt, int orow0, LAS float* scr, int lane) {
    float tv[32];
#pragma unroll
    for (int i = 0; i < 32; ++i) { const int kk = 2 * i + (lane >> 5); tv[i] = __builtin_nontemporal_load(&W[(size_t)(k0 + kk) * ldw + src]); }
#pragma unroll
    for (int i = 0; i < 32; ++i) { const int kk = 2 * i + (lane >> 5); scr[kk * 33 + (lane & 31)] = tv[i] * scale; }
    LDS_WAIT();
    const int c = lane & 7;
#pragma unroll
    for (int j = 0; j < 4; ++j) { const int n = (lane >> 3) + 8 * j; const LAS float* s = scr + (8 * c) * 33 + n;
        u32x2 o; o.x = pg8::pk4_fp8(s[0 * 33], s[1 * 33], s[2 * 33], s[3 * 33]); o.y = pg8::pk4_fp8(s[4 * 33], s[5 * 33], s[6 * 33], s[7 * 33]);
        *(u32x2*)(WT + (size_t)(orow0 + n) * ldt + k0 + 8 * c) = o; }
    LDS_WAIT();
}
constexpr int SW_ITEMS[8] = {16 * 24, 16 * 40, 16 * 32, 16 * 128, 4 * 4 * 32, 16 * 32, 3 * 6, 2 * 12};
constexpr int SW_TOTAL = 16 * 24 + 16 * 40 + 16 * 32 + 16 * 128 + 4 * 4 * 32 + 16 * 32 + 3 * 6 + 2 * 12;
DI void small_weight_item(const Ctx& C, int l, int it, LAS float* scr) {
    unsigned char* wl = (unsigned char*)(C.ws + WS_WSMALL + (size_t)l * WSMALL_LAYER); unsigned char* wc = (unsigned char*)(C.ws + WS_WC + (size_t)l * WC_LAYER);
    const float* win = C.A->in[2] + (size_t)l * DM * IN_W; const int ln = C.lane & 31;
    if (it < 384) { const int kb = it / 24, nb = it % 24; tr_item(win, IN_W, kb * 64, nb * 32 + ln, nullptr, (bf16_t*)(wl + OFF_WA), 1024, nb * 32, scr, C.lane); return; } it -= 384;
    if (it < 640) { const int kb = it / 40, nb = it % 40; tr_item(win, IN_W, kb * 64, COL_B + nb * 32 + ln, nullptr, (bf16_t*)(wl + OFF_WB), 1024, nb * 32, scr, C.lane); return; } it -= 640;
    if (it < 512) { const int kb = it / 32, nb = it % 32; const int n = nb * 32 + ln; tr_item(win, IN_W, kb * 64, n < 848 ? COL_CD + n : -1, nullptr, (bf16_t*)(wl + OFF_WCD), 1024, nb * 32, scr, C.lane); return; } it -= 512;
    if (it < 2048) { const int kb = it / 128, nb = it % 128; const int n = nb * 32 + ln, pn = n >> 8, c = n & 255;
        const int bj = c >> 7, wcc = (c >> 5) & 3, nn = (c >> 4) & 1, fq = (c >> 2) & 3, j = c & 3;
        const int src = COL_GATE + (2 * bj + nn) * 1024 + 64 * pn + 16 * wcc + 4 * fq + j;
        tr_item8(win, IN_W, kb * 64, src, pg8::FP8_W1_SCALE, wl + OFF_WG, 1024, nb * 32, scr, C.lane); return; } it -= 2048;
    if (it < 512) { const int b = it / 128, r = it % 128, kb = r / 32, nb = r % 32;
        tr_item(C.A->in[18] + (size_t)(l * 4 + b) * 256 * 1024, 1024, kb * 64, nb * 32 + ln, nullptr, (bf16_t*)(wl + OFF_WBR), 256, b * 1024 + nb * 32, scr, C.lane); return; } it -= 512;
    if (it < 512) { const int kb = it / 32, nb = it % 32; tr_item(C.A->in[19] + (size_t)l * DM * DM, 1024, kb * 64, nb * 32 + ln, nullptr, (bf16_t*)(wl + OFF_WOUT), 1024, nb * 32, scr, C.lane); return; } it -= 512;
    if (it < 18) { const int kb = it / 6, nb = it % 6; tr_item(C.A->in[8] + (size_t)l * 192 * 192, 192, kb * 64, nb * 32 + ln, C.A->in[7] + l * 192, (bf16_t*)(wc + OFF_WQ), 192, nb * 32, scr, C.lane); return; } it -= 18;
    { const int kb = it / 12, nb = it % 12; tr_item(C.A->in[10] + (size_t)l * 128 * 384, 384, kb * 64, nb * 32 + ln, C.A->in[9] + l * 128, (bf16_t*)(wc + OFF_WKV), 128, nb * 32, scr, C.lane); }
}
DI void ph_prologue(const Ctx& C) {
    LAS float* scr = (LAS float*)(C.lds + C.wave * 16384);
    for (int it = C.gw; it < 2 * SW_TOTAL; it += C.NGW) small_weight_item(C, it / SW_TOTAL, it % SW_TOTAL, scr);
    for (int it = C.gw; it < 2 * 2 * 4 * 2 * 4 * 2; it += C.NGW) {
        const int ks = it & 1, nt = (it >> 1) & 3, gt = (it >> 3) & 1, n = (it >> 4) & 3, dir = (it >> 6) & 1, l = it >> 7;
        const float* wp = (gt == 0 ? C.A->in[13] : C.A->in[15]) + ((size_t)((l * 2 + dir) * 4 + n) * 64) * 64;
        const int l15 = C.lane & 15, g = C.lane >> 4; u32x4 wv;
#pragma unroll
        for (int p = 0; p < 4; ++p) { const int k = 32 * ks + 8 * g + 2 * p; wv[p] = cvt_pk_bf16(wp[(size_t)k * 64 + 16 * nt + l15], wp[(size_t)(k + 1) * 64 + 16 * nt + l15]); }
        ((u32x4*)(C.ws + WS_WRG))[(size_t)it * 64 + C.lane] = wv;
    }
    bf16_t* XB0 = (bf16_t*)(C.ws + WS_XB0);
    for (int row0 = C.gw; row0 < NTOK; row0 += 4 * C.NGW) {
        f32x4 v[4][4];
#pragma unroll
        for (int i = 0; i < 4; ++i) { const int row = min(row0 + i * C.NGW, NTOK - 1);
            const float* src = row < NTOKG ? C.A->in[0] + (size_t)row * DM : C.A->in[1] + (size_t)(row - NTOKG) * DM; const f32x4* xr = (const f32x4*)src + C.lane;
#pragma unroll
            for (int j = 0; j < 4; ++j) v[i][j] = __builtin_nontemporal_load(&xr[64 * j]); }
#pragma unroll
        for (int i = 0; i < 4; ++i) { const int row = row0 + i * C.NGW; if (row < NTOK) { u32x2* o = (u32x2*)(XB0 + (size_t)row * DM) + C.lane;
#pragma unroll
            for (int j = 0; j < 4; ++j) { u32x2 w; w.x = cvt_pk_bf16(v[i][j][0], v[i][j][1]); w.y = cvt_pk_bf16(v[i][j][2], v[i][j][3]); o[64 * j] = w; } } }
    }
}
DI void expert_weight_items(const Ctx& C, int l) {
    __syncthreads();
    LAS float* scr = (LAS float*)(C.lds + C.wave * 16384);
    unsigned char* WGU = (unsigned char*)(C.ws + WS_EW + OFF_WGU8); unsigned char* WD = (unsigned char*)(C.ws + WS_EW + OFF_WD8);
    const int ln = C.lane & 31;
    const int gw0 = (C.G > 64) ? C.gw - 32 * 8 : C.gw, ngw = (C.G > 64) ? C.NGW - 32 * 8 : C.NGW;
    for (int it = gw0; it < 32768 + 16384; it += ngw) {
        if (it < 32768) { const int e = it >> 11, r = it & 2047, kb = r >> 7, nb = r & 127; const int n = nb * 32 + ln, pn = n >> 8, c = n & 255;
            const float* W = (c < 128 ? C.A->in[23] : C.A->in[24]) + (size_t)(l * NEXP + e) * DM * DEXP;
            tr_item8(W, DEXP, kb * 64, 128 * pn + (c & 127), pg8::FP8_W1_SCALE, WGU + (size_t)e * 4096 * 1024, 1024, nb * 32, scr, C.lane);
        } else { const int i2 = it - 32768, e = i2 >> 10, r = i2 & 1023, kb = r >> 5, nb = r & 31;
            tr_item8(C.A->in[25] + (size_t)(l * NEXP + e) * DEXP * DM, DM, kb * 64, nb * 32 + ln, pg8::FP8_W2_SCALE, WD + (size_t)e * 1024 * 2048, 2048, nb * 32, scr, C.lane); }
    }
}

template <bool ROUTER>
DI void ph_ln(const Ctx& C, int l, int which, bf16_t* XB) {
    LAS float* wr = (LAS float*)C.lds;
    if (ROUTER) { const float* src = C.A->in[22] + (size_t)l * DM * NEXP;
        for (int t = C.tid; t < DM * NEXP / 4; t += 512) { const int k = t >> 2, q = t & 3, ln = (k & 255) >> 2, ii = k & 3, jj = k >> 8;
            ((LAS f32x4*)wr)[((jj * 4 + ii) * 4 + q) * 64 + ln] = ((const f32x4*)src)[t]; }
        __syncthreads(); }
    const float* gp = C.A->in[20] + (size_t)(l * 2 + which) * DM; const float* bp = C.A->in[21] + (size_t)(l * 2 + which) * DM;
    f32x4 gv[4], bv[4];
#pragma unroll
    for (int j = 0; j < 4; ++j) { gv[j] = ((const f32x4*)gp)[C.lane + 64 * j]; bv[j] = ((const f32x4*)bp)[C.lane + 64 * j]; }
    float* affT = (float*)(C.ws + WS_AFF);
    f32x4 nx[4], ny[4], nz[4], nw[4];
    { const f32x4* xr0 = (const f32x4*)(C.out + (size_t)C.gw * DM) + C.lane;
#pragma unroll
      for (int j = 0; j < 4; ++j) nx[j] = __builtin_nontemporal_load(&xr0[64 * j]);
      { const f32x4* xr1 = (const f32x4*)(C.out + (size_t)min(C.gw + C.NGW, NTOK - 1) * DM) + C.lane;
#pragma unroll
          for (int j = 0; j < 4; ++j) ny[j] = __builtin_nontemporal_load(&xr1[64 * j]); }
      { const f32x4* xr2 = (const f32x4*)(C.out + (size_t)min(C.gw + 2 * C.NGW, NTOK - 1) * DM) + C.lane;
#pragma unroll
          for (int j = 0; j < 4; ++j) nz[j] = __builtin_nontemporal_load(&xr2[64 * j]); }
      { const f32x4* xr3 = (const f32x4*)(C.out + (size_t)min(C.gw + 3 * C.NGW, NTOK - 1) * DM) + C.lane;
#pragma unroll
          for (int j = 0; j < 4; ++j) nw[j] = __builtin_nontemporal_load(&xr3[64 * j]); } }
    u32x4 sm0 = {0u, 0u, 0u, 0u}, sm1 = {0u, 0u, 0u, 0u};
    if (!ROUTER) { const u32x4* smr = (const u32x4*)(C.ws + WS_SM + (size_t)C.gw * 32); sm0 = smr[0]; sm1 = smr[1]; }
    for (int row = C.gw; row < NTOK; row += C.NGW) {
        f32x4* xr = (f32x4*)(C.out + (size_t)row * DM) + C.lane;
        f32x4 v[4]; float s = 0.f;
#pragma unroll
        for (int j = 0; j < 4; ++j) v[j] = nx[j] * ALPHA;
        if (!ROUTER) {
            const unsigned sw[8] = {sm0.x, sm0.y, sm0.z, sm0.w, sm1.x, sm1.y, sm1.z, sm1.w};
            { const u32x4* smr = (const u32x4*)(C.ws + WS_SM + (size_t)min(row + C.NGW, NTOK - 1) * 32); sm0 = smr[0]; sm1 = smr[1]; }
            const bf16_t* YE = (const bf16_t*)(C.ws + WS_Y); const int gofs = (row >> 16) * CAP;
            unsigned msk = 0u;
#pragma unroll
            for (int e = 0; e < 16; ++e) { const int slot = (int)(short)((e & 1) ? (sw[e >> 1] >> 16) : (sw[e >> 1] & 0xffffu)); if (slot >= 0) msk |= 1u << e; }
            msk = (unsigned)__builtin_amdgcn_readfirstlane((int)msk);
            while (msk) {
                const int e1 = __builtin_ctz(msk); msk &= msk - 1u; const bool two = msk != 0u; const int e2 = two ? __builtin_ctz(msk) : e1; if (two) msk &= msk - 1u;
                unsigned w1 = sw[0], w2 = sw[0];
#pragma unroll
                for (int q = 1; q < 8; ++q) { w1 = ((e1 >> 1) == q) ? sw[q] : w1; w2 = ((e2 >> 1) == q) ? sw[q] : w2; }
                const int s1 = (int)((e1 & 1) ? (w1 >> 16) : (w1 & 0xffffu)), s2 = (int)((e2 & 1) ? (w2 >> 16) : (w2 & 0xffffu));
                const u32x2* y1 = (const u32x2*)(YE + ((size_t)e1 * 16384 + gofs + s1) * DM) + C.lane; const u32x2* y2 = (const u32x2*)(YE + ((size_t)e2 * 16384 + gofs + s2) * DM) + C.lane;
                u32x2 a[4], b[4];
#pragma unroll
                for (int j = 0; j < 4; ++j) { a[j] = __builtin_nontemporal_load(&y1[64 * j]); b[j] = __builtin_nontemporal_load(&y2[64 * j]); }
                const float f2 = two ? 1.f : 0.f;
#pragma unroll
                for (int j = 0; j < 4; ++j) { v[j][0] += bflo(a[j].x) + f2 * bflo(b[j].x); v[j][1] += bfhi(a[j].x) + f2 * bfhi(b[j].x); v[j][2] += bflo(a[j].y) + f2 * bflo(b[j].y); v[j][3] += bfhi(a[j].y) + f2 * bfhi(b[j].y); }
            }
        }
#pragma unroll
        for (int j = 0; j < 4; ++j) s += (v[j][0] + v[j][1]) + (v[j][2] + v[j][3]);
#pragma unroll
        for (int j = 0; j < 4; ++j) { nx[j] = ny[j]; ny[j] = nz[j]; nz[j] = nw[j]; }
        { const int rn = row + 4 * C.NGW < NTOK ? row + 4 * C.NGW : row; const f32x4* xn = (const f32x4*)(C.out + (size_t)rn * DM) + C.lane;
#pragma unroll
            for (int j = 0; j < 4; ++j) nw[j] = __builtin_nontemporal_load(&xn[64 * j]); }
        const float mean = wave_sum(s) * (1.f / DM); float s2 = 0.f;
#pragma unroll
        for (int j = 0; j < 4; ++j) { v[j] = v[j] - mean; s2 += (v[j][0] * v[j][0] + v[j][1] * v[j][1]) + (v[j][2] * v[j][2] + v[j][3] * v[j][3]); }
        const float rstd = 1.0f / sqrtf(wave_sum(s2) * (1.f / DM) + LN_EPS);
        u32x2* o8 = (u32x2*)(XB + (size_t)row * DM) + C.lane; unsigned* o4 = (unsigned*)((unsigned char*)XB + (size_t)row * DM) + C.lane;
#pragma unroll
        for (int j = 0; j < 4; ++j) { v[j] = v[j] * rstd * gv[j] + bv[j]; __builtin_nontemporal_store(v[j], &xr[64 * j]);
            if constexpr (ROUTER) { o4[64 * j] = pg8::pk4_fp8(v[j][0], v[j][1], v[j][2], v[j][3]); asm volatile("" ::: "memory"); }
            else if (XB) { u32x2 w; w.x = cvt_pk_bf16(v[j][0], v[j][1]); w.y = cvt_pk_bf16(v[j][2], v[j][3]); o8[64 * j] = w; } }
        if (ROUTER) {
            float p[16];
#pragma unroll
            for (int e = 0; e < 16; ++e) p[e] = 0.f;
#pragma unroll
            for (int j = 0; j < 4; ++j)
#pragma unroll
                for (int i = 0; i < 4; ++i) { const float xv = v[j][i];
#pragma unroll
                    for (int q = 0; q < 4; ++q) { const f32x4 w4 = ((const LAS f32x4*)wr)[((j * 4 + i) * 4 + q) * 64 + C.lane]; p[4 * q] += xv * w4[0]; p[4 * q + 1] += xv * w4[1]; p[4 * q + 2] += xv * w4[2]; p[4 * q + 3] += xv * w4[3]; } }
            const bool b5 = (C.lane & 32) != 0, b4 = (C.lane & 16) != 0, b3 = (C.lane & 8) != 0, b2 = (C.lane & 4) != 0;
            float r8[8], r4[4], r2[2], lg;
#pragma unroll
            for (int i = 0; i < 8; ++i) { const float keep = b5 ? p[8 + i] : p[i], send = b5 ? p[i] : p[8 + i]; r8[i] = keep + __shfl_xor(send, 32); }
#pragma unroll
            for (int i = 0; i < 4; ++i) { const float keep = b4 ? r8[4 + i] : r8[i], send = b4 ? r8[i] : r8[4 + i]; r4[i] = keep + __shfl_xor(send, 16); }
#pragma unroll
            for (int i = 0; i < 2; ++i) { const float keep = b3 ? r4[2 + i] : r4[i], send = b3 ? r4[i] : r4[2 + i]; r2[i] = keep + __shfl_xor(send, 8); }
            { const float keep = b2 ? r2[1] : r2[0], send = b2 ? r2[0] : r2[1]; lg = keep + __shfl_xor(send, 4); }
            lg += __shfl_xor(lg, 2); lg += __shfl_xor(lg, 1);
            float mx = lg;
            mx = fmaxf(mx, __shfl_xor(mx, 4)); mx = fmaxf(mx, __shfl_xor(mx, 8)); mx = fmaxf(mx, __shfl_xor(mx, 16)); mx = fmaxf(mx, __shfl_xor(mx, 32));
            const float ex = __expf(lg - mx); float den = ex;
            den += __shfl_xor(den, 4); den += __shfl_xor(den, 8); den += __shfl_xor(den, 16); den += __shfl_xor(den, 32);
            const int eL = (b5 ? 8 : 0) + (b4 ? 4 : 0) + (b3 ? 2 : 0) + (b2 ? 1 : 0);
            if ((C.lane & 3) == 0) affT[((size_t)(row >> 16) * 16 + eL) * NTOKG + (row & 65535)] = ex / den;
            if (C.lane < 8) ((unsigned*)(C.ws + WS_SM))[(size_t)row * 8 + C.lane] = 0xFFFFFFFFu;
        }
    }
}

namespace att {
DI int crow(int r, int hi) { return (r & 3) + 8 * (r >> 2) + 4 * hi; }
DI int v_st(int k, int c) { const int kk = (k & ~0xC) | ((k & 4) << 1) | ((k & 8) >> 1); return ((kk >> 3) * 2 + (c >> 5)) * 512 + ((kk & 7) * 32 + (c & 31)) * 2; }
DI int v_rd_base(int lane) { return ((lane & 3) << 3) | (((lane >> 2) & 3) << 6) | (((lane >> 4) & 1) << 5) | (((lane >> 5) & 1) << 8); }
constexpr int v_rd_off(int d0, int ks, int half) { return d0 * 512 + ks * 2048 + half * 1024; }
template <int OFF> DI s16x4 tr_read(int vb) { s16x4 r; asm volatile("ds_read_b64_tr_b16 %0, %1 offset:%2" : "=&v"(r) : "v"(vb), "i"(OFF) : "memory"); return r; }
template <int D0> DI void pv_one(f32x16& od, int vb, bf16x8 pa0, bf16x8 pa1, bf16x8 pa2, bf16x8 pa3) {
    const s16x4 l0 = tr_read<v_rd_off(D0, 0, 0)>(vb), h0 = tr_read<v_rd_off(D0, 0, 1)>(vb), l1 = tr_read<v_rd_off(D0, 1, 0)>(vb), h1 = tr_read<v_rd_off(D0, 1, 1)>(vb);
    const s16x4 l2 = tr_read<v_rd_off(D0, 2, 0)>(vb), h2 = tr_read<v_rd_off(D0, 2, 1)>(vb), l3 = tr_read<v_rd_off(D0, 3, 0)>(vb), h3 = tr_read<v_rd_off(D0, 3, 1)>(vb);
    asm volatile("s_waitcnt lgkmcnt(0)" ::: "memory"); __builtin_amdgcn_sched_barrier(0);
#define PKV(L, H) (bf16x8){L[0], L[1], L[2], L[3], H[0], H[1], H[2], H[3]}
    od = __builtin_amdgcn_mfma_f32_32x32x16_bf16(pa0, PKV(l0, h0), od, 0, 0, 0);
    od = __builtin_amdgcn_mfma_f32_32x32x16_bf16(pa1, PKV(l1, h1), od, 0, 0, 0);
    od = __builtin_amdgcn_mfma_f32_32x32x16_bf16(pa2, PKV(l2, h2), od, 0, 0, 0);
    od = __builtin_amdgcn_mfma_f32_32x32x16_bf16(pa3, PKV(l3, h3), od, 0, 0, 0);
#undef PKV
}
DI void pv_ones(f32x16& o2, bf16x8 pa0, bf16x8 pa1, bf16x8 pa2, bf16x8 pa3) {
    const u32x4 onesw = {0x3F803F80u, 0x3F803F80u, 0x3F803F80u, 0x3F803F80u}; const bf16x8 ones = __builtin_bit_cast(bf16x8, onesw);
    o2 = __builtin_amdgcn_mfma_f32_32x32x16_bf16(pa0, ones, o2, 0, 0, 0); o2 = __builtin_amdgcn_mfma_f32_32x32x16_bf16(pa1, ones, o2, 0, 0, 0);
    o2 = __builtin_amdgcn_mfma_f32_32x32x16_bf16(pa2, ones, o2, 0, 0, 0); o2 = __builtin_amdgcn_mfma_f32_32x32x16_bf16(pa3, ones, o2, 0, 0, 0);
}
constexpr int KROW(int KS) { return KS * 32 + 16; }
constexpr int KTILE = 64 * 112, VTILE = 8192, LDS_ATT = 2 * KTILE + 2 * VTILE + 8 * 256;

DI void split3(float x, unsigned& w_hm, unsigned& w_l0) {
    const unsigned h = f2bf(x); const float r1 = x - __builtin_bit_cast(float, h << 16);
    const unsigned m = f2bf(r1); const float r2 = r1 - __builtin_bit_cast(float, m << 16);
    const unsigned l = f2bf(r2);
    w_hm = h | (m << 16); w_l0 = l;
}
template <int KS, bool ALIBI>
DI void attn_unit(const bf16_t* __restrict__ Qb, int ldq, const bf16_t* __restrict__ Kb, int ldk, const bf16_t* __restrict__ Vb, int ldv,
                  bf16_t* __restrict__ Ob, int ldo, int seq_len, int q0, float slope2, const unsigned* __restrict__ kn2, LAS unsigned char* lds) {
    int tid = threadIdx.x; asm volatile("" : "+v"(tid));
    const int wid = tid >> 6, lane = tid & 63, r32 = lane & 31, hi = lane >> 5;
    LAS unsigned char* K_lds = lds; LAS unsigned char* V_lds = lds + 2 * KTILE;
    LAS float* wsl = (LAS float*)(lds + 2 * KTILE + 2 * VTILE) + wid * 64; LAS float* li_l = wsl; LAS float* al_l = wsl + 32;
    LAS float* blk = (LAS float*)(lds + LDS_ATT);
    LAS int* tl = (LAS int*)(lds + LDS_ATT + 128);
    constexpr int KR = KROW(KS), KP = 2 * KS;
    constexpr float THR = 8.f, SKIP = -40.f;
    float mt = 0.f; f32x16 o[3];
#pragma unroll
    for (int d = 0; d < 3; ++d)
#pragma unroll
        for (int r = 0; r < 16; ++r) o[d][r] = 0.f;
    bf16x8 qr[KS];
    const bf16_t* Qw = Qb + (size_t)(wid * 32 + r32) * ldq + hi * 8;
#pragma unroll
    for (int d0 = 0; d0 < KS; ++d0) qr[d0] = *(const bf16x8*)(Qw + d0 * 16);
    if (ALIBI) { float qn = 0.f;
#pragma unroll
        for (int d0 = 0; d0 < KS; ++d0)
#pragma unroll
            for (int j = 0; j < 8; ++j) { const float f = bf2f((unsigned short)qr[d0][j]); qn += f * f; }
        qn += __shfl_xor(qn, 32); qn = wave_max(qn); if (lane == 0) blk[wid] = qn; }
    const int vkey = tid >> 3, vcol = (tid & 7) * 8, vst = v_st(vkey, vcol);
    const bool kact = tid < 64 * KP; const int kkey = kact ? tid / KP : 0, kpc = kact ? tid % KP : 0;
    const int vb0 = (int)(uintptr_t)V_lds + v_rd_base(lane);
    const int w0 = q0 + wid * 32; const float qpos = (float)(w0 + r32);
    const int NT = seq_len / 64, jd0 = q0 >> 6;
    bf16x8 kx0, kx1;
    { u32x4 a = {0u, 0u, 0u, 0u}, b = {0u, 0u, 0u, 0u};
        if (hi == 0) {
            a.z = 0x3F803F80u; a.w = 0x00003F80u; b.z = 0x3F803F80u; b.w = 0x00003F80u;
            if (ALIBI) { const float c0 = slope2 * (float)r32, c1 = slope2 * (float)(32 + r32);
                const unsigned h0 = f2bf(c0), l0 = f2bf(c0 - __builtin_bit_cast(float, h0 << 16)), h1 = f2bf(c1), l1 = f2bf(c1 - __builtin_bit_cast(float, h1 << 16));
                a.x = h0 | (l0 << 16); a.y = (h0 | (l0 << 16)) ^ 0x80008000u; b.x = h1 | (l1 << 16); b.y = (h1 | (l1 << 16)) ^ 0x80008000u; } }
        kx0 = __builtin_bit_cast(bf16x8, a); kx1 = __builtin_bit_cast(bf16x8, b); }
    bf16x8 vs, ks_;
    bool first = true;
#define SLOAD(k0) do { vs = *(const bf16x8*)(Vb + (size_t)((k0) + vkey) * ldv + vcol); ks_ = *(const bf16x8*)(Kb + (size_t)((k0) + kkey) * ldk + kpc * 8); } while (0)
#define SWRITE(b) do { *(LAS bf16x8*)(V_lds + (b) * VTILE + vst) = vs; if (kact) *(LAS bf16x8*)(K_lds + (b) * KTILE + kkey * KR + kpc * 16) = ks_; } while (0)
#define PK4(P, BASE, OUT) do { unsigned a0 = cvt_pk_bf16_b(P[BASE + 0], P[BASE + 1]), a1 = cvt_pk_bf16_b(P[BASE + 2], P[BASE + 3]); \
        unsigned b0_ = cvt_pk_bf16_b(P[BASE + 4], P[BASE + 5]), b1_ = cvt_pk_bf16_b(P[BASE + 6], P[BASE + 7]); \
        auto r0 = __builtin_amdgcn_permlane32_swap(a0, b0_, false, false); auto r1 = __builtin_amdgcn_permlane32_swap(a1, b1_, false, false); \
        u32x4 w = {r0[0], r1[0], r0[1], r1[1]}; OUT = __builtin_bit_cast(bf16x8, w); } while (0)
#define PKV2(L, H) (bf16x8){L[0], L[1], L[2], L[3], H[0], H[1], H[2], H[3]}
#define ATT_GRP(P, BASE, VA, VC, VD, VE) do { \
        _Pragma("unroll") for (int r_ = 0; r_ < 8; ++r_) P[BASE + r_] = __builtin_amdgcn_exp2f(P[BASE + r_]); \
        bf16x8 pa_; PK4(P, BASE, pa_); \
        o[0] = __builtin_amdgcn_mfma_f32_32x32x16_bf16(pa_, PKV2(VA, VC), o[0], 0, 0, 0); o[1] = __builtin_amdgcn_mfma_f32_32x32x16_bf16(pa_, PKV2(VD, VE), o[1], 0, 0, 0); \
        o[2] = __builtin_amdgcn_mfma_f32_32x32x16_bf16(pa_, ones, o[2], 0, 0, 0); __builtin_amdgcn_sched_barrier(0); } while (0)
#define ATT_TILE(j, cur) do { \
        f32x16 p0, p1; \
        _Pragma("unroll") for (int r = 0; r < 16; ++r) { p0[r] = 0.f; p1[r] = 0.f; } \
        const LAS unsigned char* Kc = K_lds + (cur) * KTILE; \
        _Pragma("unroll") for (int d0 = 0; d0 < KS; ++d0) { const int cb = (d0 * 16 + hi * 8) * 2;     \
            const bf16x8 b0 = *(const LAS bf16x8*)(Kc + r32 * KR + cb); const bf16x8 b1 = *(const LAS bf16x8*)(Kc + (32 + r32) * KR + cb); \
            p0 = __builtin_amdgcn_mfma_f32_32x32x16_bf16(b0, qr[d0], p0, 0, 0, 0); p1 = __builtin_amdgcn_mfma_f32_32x32x16_bf16(b1, qr[d0], p1, 0, 0, 0); } \
        int cls = 0; float Bq = 0.f; \
        if (ALIBI) { if (64 * (j) + 64 <= w0) { cls = 1; Bq = slope2 * ((float)(64 * (j)) - qpos); } else if (64 * (j) >= w0 + 32) { cls = 2; Bq = slope2 * (qpos - (float)(64 * (j))); } } \
        bf16x8 qx; { u32x4 w = {0u, 0u, 0u, 0u}; if (hi == 0) { unsigned whm, wl0; split3(Bq - mt, whm, wl0); w.z = whm; w.w = wl0; w.x = (cls == 1) ? 0x3F803F80u : 0u; w.y = (cls == 2) ? 0x3F803F80u : 0u; } qx = __builtin_bit_cast(bf16x8, w); } \
        p0 = __builtin_amdgcn_mfma_f32_32x32x16_bf16(kx0, qx, p0, 0, 0, 0); p1 = __builtin_amdgcn_mfma_f32_32x32x16_bf16(kx1, qx, p1, 0, 0, 0); \
        if (ALIBI && cls == 0) { const float dq = qpos - (float)((j) * 64 + 4 * hi); \
            _Pragma("unroll") for (int r = 0; r < 16; ++r) { const float kc = (float)((r & 3) + 8 * (r >> 2)); p0[r] = fmaf(fabsf(dq - kc), -slope2, p0[r]); p1[r] = fmaf(fabsf(dq - (kc + 32.f)), -slope2, p1[r]); } } \
        float tmax = p0[0]; \
        _Pragma("unroll") for (int r = 1; r < 16; ++r) tmax = fmaxf(tmax, p0[r]); \
        _Pragma("unroll") for (int r = 0; r < 16; ++r) tmax = fmaxf(tmax, p1[r]); \
        { auto rr = __builtin_amdgcn_permlane32_swap(__float_as_uint(tmax), __float_as_uint(tmax), false, false); tmax = fmaxf(__uint_as_float(rr[0]), __uint_as_float(rr[1])); } \
        const bool skip = !first && __all(tmax < SKIP); \
        if (!skip) { \
            if (first || !__all(tmax <= THR)) { \
                const float delta = first ? tmax : fmaxf(tmax, 0.f); const float alpha = first ? 1.f : __builtin_amdgcn_exp2f(-delta); \
                mt += delta; \
                _Pragma("unroll") for (int r = 0; r < 16; ++r) { p0[r] -= delta; p1[r] -= delta; } \
                if (!first) { if (hi == 0) al_l[r32] = alpha; LDS_WAIT(); \
                    _Pragma("unroll") for (int r = 0; r < 16; ++r) { const float a = al_l[crow(r, hi)]; o[0][r] *= a; o[1][r] *= a; o[2][r] *= a; } } \
            } \
              \
            const int vb = vb0 + (cur) * VTILE; \
            const s16x4 va0 = tr_read<v_rd_off(0, 0, 0)>(vb), vc0 = tr_read<v_rd_off(0, 0, 1)>(vb), vd0 = tr_read<v_rd_off(1, 0, 0)>(vb), ve0 = tr_read<v_rd_off(1, 0, 1)>(vb); \
            const s16x4 va1 = tr_read<v_rd_off(0, 1, 0)>(vb), vc1 = tr_read<v_rd_off(0, 1, 1)>(vb), vd1 = tr_read<v_rd_off(1, 1, 0)>(vb), ve1 = tr_read<v_rd_off(1, 1, 1)>(vb); \
            const s16x4 va2 = tr_read<v_rd_off(0, 2, 0)>(vb), vc2 = tr_read<v_rd_off(0, 2, 1)>(vb), vd2 = tr_read<v_rd_off(1, 2, 0)>(vb), ve2 = tr_read<v_rd_off(1, 2, 1)>(vb); \
            const s16x4 va3 = tr_read<v_rd_off(0, 3, 0)>(vb), vc3 = tr_read<v_rd_off(0, 3, 1)>(vb), vd3 = tr_read<v_rd_off(1, 3, 0)>(vb), ve3 = tr_read<v_rd_off(1, 3, 1)>(vb); \
            const u32x4 onesw = {0x3F803F80u, 0x3F803F80u, 0x3F803F80u, 0x3F803F80u}; const bf16x8 ones = __builtin_bit_cast(bf16x8, onesw); \
            asm volatile("s_waitcnt lgkmcnt(0)" ::: "memory"); __builtin_amdgcn_sched_barrier(0); \
            ATT_GRP(p0, 0, va0, vc0, vd0, ve0); ATT_GRP(p0, 8, va1, vc1, vd1, ve1); ATT_GRP(p1, 0, va2, vc2, vd2, ve2); ATT_GRP(p1, 8, va3, vc3, vd3, ve3); \
            first = false; \
        } } while (0)
#define ATT_RUN(COUNT, TILE_EXPR) do { const int cnt_ = (COUNT); if (cnt_ > 0) { \
        { const int jj = 0; SLOAD((TILE_EXPR) * 64); } SWRITE(0); __syncthreads(); \
        if (cnt_ > 1) { const int jj = 1; SLOAD((TILE_EXPR) * 64); } \
        for (int jj0 = 0; jj0 < cnt_; ++jj0) { const int cur_ = jj0 & 1; int j_; { const int jj = jj0; j_ = (TILE_EXPR); } \
            ATT_TILE(j_, cur_); \
            if (jj0 + 1 < cnt_) SWRITE(cur_ ^ 1); \
            __syncthreads(); \
            if (jj0 + 2 < cnt_) { const int jj = jj0 + 2; SLOAD((TILE_EXPR) * 64); } } } } while (0)
    if (wid >= 4) __builtin_amdgcn_s_setprio(1);
    ATT_RUN(4, jd0 + jj);
    if (ALIBI) {
        { const float mm = -wave_max(-mt); if (lane == 0) blk[8 + wid] = mm; }
        __syncthreads();
        if (wid == 0) {
            float qn2 = blk[0], mmin = blk[8];
#pragma unroll
            for (int i = 1; i < 8; ++i) { qn2 = fmaxf(qn2, blk[i]); mmin = fminf(mmin, blk[8 + i]); }
            int base = 0;
            for (int c0 = 0; c0 < NT - 4; c0 += 64) { const int c = c0 + lane; bool act = false; int t = 0;
                if (c < NT - 4) { t = (c < jd0) ? jd0 - 1 - c : c + 4;
                    const float dist = (t < jd0) ? (float)(q0 - (64 * t + 63)) : (float)(64 * t - (q0 + 255));
                    const float kn = __builtin_bit_cast(float, kn2[t]);
                    act = (sqrtf(qn2 * kn) * 1.02f - slope2 * dist - mmin >= SKIP); }
                const unsigned long long bm = __ballot(act);
                if (act) tl[base + __builtin_popcountll(bm & ((1ull << lane) - 1ull))] = t;
                base += __builtin_popcountll(bm); }
            if (lane == 0) blk[16] = __builtin_bit_cast(float, base);
        }
        __syncthreads();
        const int nact = __builtin_bit_cast(int, blk[16]);
        ATT_RUN(nact, tl[jj]);
    } else {
        ATT_RUN(NT - 4, (jj < jd0 ? jd0 - 1 - jj : jj + 4));
    }
#undef ATT_RUN
#undef ATT_TILE
#undef ATT_GRP
#undef PKV2
#undef PK4
#undef SLOAD
#undef SWRITE
    __builtin_amdgcn_s_setprio(0);
    bf16_t* Ow = Ob + (size_t)(wid * 32) * ldo;
#pragma unroll
    for (int r = 0; r < 16; ++r) { const int orow = crow(r, hi); const float rl = __builtin_amdgcn_rcpf(o[2][r]);
#pragma unroll
        for (int d0 = 0; d0 < 2; ++d0) Ow[(size_t)orow * ldo + d0 * 32 + r32] = (bf16_t)f2bf(o[d0][r] * rl); }
    __syncthreads();
}
}

DI void ph_attn_a(const Ctx& C, int l) {
    const bf16_t* UA = (const bf16_t*)(C.ws + WS_U); bf16_t* OA = (bf16_t*)(C.ws + WS_XB1);
    GAS unsigned* head = (GAS unsigned*)(C.ws + WS_CTL) + 16384 + 64 * l;
    LAS volatile int* qslot = (LAS volatile int*)(C.lds + MISC_OFF + 64);
    if (C.tid == 0) qslot[0] = (int)__hip_atomic_fetch_add(head, 1u, __ATOMIC_RELAXED, __HIP_MEMORY_SCOPE_AGENT);
    __syncthreads();
    int u = qslot[0];
    while (u < 4096) {
        int nxt = 0;
        if (C.tid == 0) nxt = (int)__hip_atomic_fetch_add(head, 1u, __ATOMIC_RELAXED, __HIP_MEMORY_SCOPE_AGENT);
        const int k = u >> 9, j = u & 511, vhb = j >> 8;
        const bool prompt = (k == 0) || (k == 1) || (k == 4) || (k == 6);
        const int h = (k == 0 || k == 2) ? 3 : (k == 1 || k == 3) ? 2 : (k == 4 || k == 5) ? 1 : 0;
        const int vh = 2 * h + vhb;
        const int seq = prompt ? ((j >> 5) & 7) : 8 + ((j >> 3) & 31), qb = prompt ? (j & 31) : (j & 7), len = prompt ? 8192 : 2048;
        const int r0 = seq_start_row(seq);
        const float slope2 = exp2f(-2.0f * (float)(h + 1)) * LOG2E;
        att::attn_unit<2, true>(UA + (size_t)(r0 + qb * 256) * 768 + vh * 32, 768, UA + (size_t)r0 * 768 + 256 + vh * 32, 768, UA + (size_t)r0 * 768 + 512 + h * 64, 768,
                                OA + (size_t)(r0 + qb * 256) * 512 + vh * 64, 512, len, qb * 256, slope2, (const unsigned*)(C.ws + WS_KN2) + ((size_t)l * 8 + vh) * 2048 + (r0 >> 6), C.lds);
        if (C.tid == 0) qslot[0] = nxt;
        __syncthreads();
        u = qslot[0];
    }
}
DI void ph_attn_c(const Ctx& C) {
    const bf16_t* Qc = (const bf16_t*)(C.ws + WS_XB1 + OFF_QC); const bf16_t* Kc = (const bf16_t*)(C.ws + WS_XB1 + OFF_KC); const bf16_t* Vc = (const bf16_t*)(C.ws + WS_XB1 + OFF_VC);
    bf16_t* Y = (bf16_t*)(C.ws + WS_Y);
    for (int u = C.bid; u < 2048; u += C.G) {
        int qb, h, seq, len;
        if (u < 1024) { qb = u & 31; h = (u >> 5) & 3; seq = u >> 7; len = 8192; } else { const int v = u - 1024; qb = v & 7; h = (v >> 3) & 3; seq = 8 + (v >> 5); len = 2048; }
        const int r0 = seq_start_row(seq);
        att::attn_unit<3, false>(Qc + (size_t)(r0 + qb * 256) * 192 + h * 48, 192, Kc + (size_t)r0 * 192 + h * 48, 192, Vc + (size_t)r0 * 256 + h * 64, 256,
                                 Y + (size_t)(r0 + qb * 256) * DM + 512 + h * 64, DM, len, qb * 256, 0.f, nullptr, C.lds);
    }
}
DI void ph_a_post(const Ctx& C, int l) {
    const bf16_t* OA = (const bf16_t*)(C.ws + WS_XB1); bf16_t* Y = (bf16_t*)(C.ws + WS_Y);
    const float linit = 0.8f - 0.6f * expf(-0.3f * (float)l);
    const float* lp = C.A->in[3] + l * 128;
    float sa = 0.f, sb = 0.f; if (C.lane < 32) { sa = lp[C.lane] * lp[32 + C.lane]; sb = lp[64 + C.lane] * lp[96 + C.lane]; }
    const float lam = expf(wave_sum(sa)) - expf(wave_sum(sb)) + linit;
    const int h = C.lane >> 4, d4 = (C.lane & 15) * 4;
    const f32x4 gg = *(const f32x4*)(C.A->in[4] + l * 64 + d4);
    for (int row0 = C.gw; row0 < NTOK; row0 += 4 * C.NGW) {
        u32x2 a[4], b[4];
#pragma unroll
        for (int i = 0; i < 4; ++i) { const size_t row = (size_t)row0 + (size_t)i * C.NGW; a[i] = __builtin_nontemporal_load((const u32x2*)(OA + row * 512 + (2 * h) * 64 + d4)); b[i] = __builtin_nontemporal_load((const u32x2*)(OA + row * 512 + (2 * h + 1) * 64 + d4)); }
#pragma unroll
        for (int i = 0; i < 4; ++i) { const size_t row = (size_t)row0 + (size_t)i * C.NGW;
            float o0 = bflo(a[i].x) - lam * bflo(b[i].x), o1 = bfhi(a[i].x) - lam * bfhi(b[i].x), o2 = bflo(a[i].y) - lam * bflo(b[i].y), o3 = bfhi(a[i].y) - lam * bfhi(b[i].y);
            float ss = o0 * o0 + o1 * o1 + o2 * o2 + o3 * o3;
            ss += __shfl_xor(ss, 1); ss += __shfl_xor(ss, 2); ss += __shfl_xor(ss, 4); ss += __shfl_xor(ss, 8);
            const float r = (1.0f / sqrtf(ss * (1.f / 64.f) + RMS_EPS)) * (1.0f - linit);
            u32x2 w; w.x = cvt_pk_bf16(o0 * r * gg[0], o1 * r * gg[1]); w.y = cvt_pk_bf16(o2 * r * gg[2], o3 * r * gg[3]);
            *(u32x2*)(Y + row * DM + h * 64 + d4) = w; }
    }
}

DI float hgrn_lb(const Ctx& C, int l, int dir, int ch) {
    if (l == 0) return 0.f;
    const float a = C.A->in[5][(0 * 2 + dir) * 256 + ch], b = C.A->in[5][(1 * 2 + dir) * 256 + ch];
    const float m = fmaxf(a, b), ea = expf(a - m), eb = expf(b - m); return eb / (ea + eb);
}
DI float dpp_shr_add(float x, int k) {
    float y;
    if (k == 1) y = __builtin_bit_cast(float, __builtin_amdgcn_update_dpp(0, __builtin_bit_cast(int, x), 0x111, 0xF, 0xF, true));
    else if (k == 2) y = __builtin_bit_cast(float, __builtin_amdgcn_update_dpp(0, __builtin_bit_cast(int, x), 0x112, 0xF, 0xF, true));
    else if (k == 4) y = __builtin_bit_cast(float, __builtin_amdgcn_update_dpp(0, __builtin_bit_cast(int, x), 0x114, 0xF, 0xF, true));
    else y = __builtin_bit_cast(float, __builtin_amdgcn_update_dpp(0, __builtin_bit_cast(int, x), 0x118, 0xF, 0xF, true));
    return x + y;
}
DI s16x4 tr16(unsigned addr) { s16x4 r; asm volatile("ds_read_b64_tr_b16 %0, %1\n\ts_waitcnt lgkmcnt(0)" : "=&v"(r) : "v"(addr) : "memory"); return r; }
constexpr int HG_ROW = 144, HG_ARR = 16 * HG_ROW;
template <int MODE>
DI void hgrn_pass(const Ctx& C, int l, int chunk, int h, int dir, LAS unsigned char* wl, float* ofs) {
    const bf16_t* UB = (const bf16_t*)(C.ws + WS_U); float* ST = (float*)(C.ws + WS_XB1); float* GAM = (float*)(C.ws + WS_GAM); bf16_t* Y = (bf16_t*)(C.ws + WS_Y);
    const int lane = C.lane, l15 = lane & 15, g = lane >> 4, r0 = chunk * 128; const size_t sbase = (size_t)((chunk * 4 + h) * 2 + dir);
    const unsigned QLa = (unsigned)(uintptr_t)wl, FLa = QLa + HG_ARR, VLa = QLa + 2 * HG_ARR, GLa = QLa + 3 * HG_ARR;
    LAS float* lbT = (LAS float*)(wl + 4 * HG_ARR);
    lbT[lane] = hgrn_lb(C, l, dir, h * 64 + lane);
    LDS_WAIT();
    f32x4 S[4][4];
#pragma unroll
    for (int dt = 0; dt < 4; ++dt)
#pragma unroll
        for (int et = 0; et < 4; ++et)
#pragma unroll
            for (int r = 0; r < 4; ++r) S[dt][et][r] = (MODE == 0) ? 0.f : ST[sbase * 4096 + (size_t)(16 * dt + 4 * g + r) * 64 + 16 * et + l15];
    float gsum[4] = {0.f, 0.f, 0.f, 0.f};
    const float* ngp = C.A->in[6] + l * 256 + h * 64 + l15;
    const int srow = lane >> 2, spc = lane & 3;
    u32x4 pq[2], pf[2], pv[2];
#define HG_LOAD(sc) do { const int t_ = (sc) * 16 + srow; const bf16_t* rp_ = UB + (size_t)(r0 + (dir ? 127 - t_ : t_)) * 1280 + h * 64 + spc * 16; \
        pf[0] = *(const u32x4*)(rp_ + (dir ? 512 : 256)); pf[1] = *(const u32x4*)(rp_ + (dir ? 512 : 256) + 8); pv[0] = *(const u32x4*)(rp_ + 768); pv[1] = *(const u32x4*)(rp_ + 768 + 8); \
        if (MODE != 0) { pq[0] = *(const u32x4*)(rp_); pq[1] = *(const u32x4*)(rp_ + 8); } } while (0)
#define HG_STORE() do { const int o_ = srow * HG_ROW + spc * 32; \
        *(LAS u32x4*)(wl + HG_ARR + o_) = pf[0]; *(LAS u32x4*)(wl + HG_ARR + o_ + 16) = pf[1]; *(LAS u32x4*)(wl + 2 * HG_ARR + o_) = pv[0]; *(LAS u32x4*)(wl + 2 * HG_ARR + o_ + 16) = pv[1]; \
        if (MODE != 0) { *(LAS u32x4*)(wl + o_) = pq[0]; *(LAS u32x4*)(wl + o_ + 16) = pq[1]; } } while (0)
    HG_LOAD(0);
    const unsigned tr_off = (unsigned)((4 * g + (l15 >> 2)) * HG_ROW + (l15 & 3) * 8);
    for (int sc = 0; sc < 8; ++sc) {
        LDS_WAIT();
        HG_STORE();
        if (MODE == 2) {
#pragma unroll
            for (int k = 0; k < 2; ++k) { const int t_ = sc * 16 + 8 * k + (lane >> 3);
                __builtin_amdgcn_global_load_lds((const unsigned*)(UB + (size_t)(r0 + 127 - t_) * 1280 + 1024 + h * 64 + (lane & 7) * 8), (LAS unsigned*)(wl + 3 * HG_ARR + k * 1024), 16, 0, 0); } }
        if (sc + 1 < 8) HG_LOAD(sc + 1);
        LDS_WAIT();
        bf16x8 vf[4];
#pragma unroll
        for (int et = 0; et < 4; ++et) { const s16x4 t4 = tr16(VLa + tr_off + et * 32); vf[et] = (bf16x8){t4[0], t4[1], t4[2], t4[3], 0, 0, 0, 0}; }
        __builtin_amdgcn_sched_barrier(0);
        bf16x8 khf[4]; float tot[4];
#pragma unroll
        for (int dt = 0; dt < 4; ++dt) { const s16x4 t4 = tr16(FLa + tr_off + dt * 32);
            float fv[4], lf[4];
            const float lbv = lbT[16 * dt + l15];
#pragma unroll
            for (int j = 0; j < 4; ++j) { fv[j] = lbv + (1.f - lbv) * sigmoidf_(bf2f((unsigned short)t4[j])); lf[j] = __builtin_amdgcn_logf(fv[j]); }
            const float Tg = (lf[0] + lf[1]) + (lf[2] + lf[3]);
            const float T1 = __shfl_down(Tg, 16), T2 = __shfl_down(Tg, 32), T3 = __shfl_down(Tg, 48);
            const float after = (g < 3 ? T1 : 0.f) + (g < 2 ? T2 : 0.f) + (g < 1 ? T3 : 0.f);
            float tt_ = Tg; tt_ += __shfl_xor(tt_, 16); tt_ += __shfl_xor(tt_, 32); tot[dt] = tt_; gsum[dt] += tt_;
            const float c3 = after, c2 = c3 + lf[3], c1 = c2 + lf[2], c0 = c1 + lf[1];
            const unsigned w0 = cvt_pk_bf16((1.f - fv[0]) * __builtin_amdgcn_exp2f(c0), (1.f - fv[1]) * __builtin_amdgcn_exp2f(c1));
            const unsigned w1 = cvt_pk_bf16((1.f - fv[2]) * __builtin_amdgcn_exp2f(c2), (1.f - fv[3]) * __builtin_amdgcn_exp2f(c3));
            const u32x4 w = {w0, w1, 0u, 0u}; khf[dt] = __builtin_bit_cast(bf16x8, w); }
        __builtin_amdgcn_sched_barrier(0);
        f32x4 O[4];
        if (MODE != 0) {
            bf16x8 qhf[2], ktf[2];
#pragma unroll
            for (int ks = 0; ks < 2; ++ks) { float b2[8], qv[8], kv[8];
#pragma unroll
                for (int dd = 0; dd < 2; ++dd) { const int dt = 2 * ks + dd;
                    const u32x2 fw = *(const LAS u32x2*)(wl + HG_ARR + l15 * HG_ROW + (16 * dt + 4 * g) * 2); const u32x2 qw = *(const LAS u32x2*)(wl + l15 * HG_ROW + (16 * dt + 4 * g) * 2);
                    const f32x4 lb4 = *(const LAS f32x4*)(lbT + 16 * dt + 4 * g);
                    const float fl4[4] = {bflo(fw.x), bfhi(fw.x), bflo(fw.y), bfhi(fw.y)}, ql4[4] = {bflo(qw.x), bfhi(qw.x), bflo(qw.y), bfhi(qw.y)};
#pragma unroll
                    for (int r = 0; r < 4; ++r) { const int i = 4 * dd + r; const float f = lb4[r] + (1.f - lb4[r]) * sigmoidf_(fl4[r]); b2[i] = __builtin_amdgcn_logf(f); kv[i] = 1.f - f; qv[i] = siluf_(ql4[r]); } }
#pragma unroll
                for (int i = 0; i < 8; ++i) { float x = b2[i]; x = dpp_shr_add(x, 1); x = dpp_shr_add(x, 2); x = dpp_shr_add(x, 4); x = dpp_shr_add(x, 8); b2[i] = x; }
                u32x4 wq, wk;
#pragma unroll
                for (int p = 0; p < 4; ++p) { const int i = 2 * p; const float e0 = __builtin_amdgcn_exp2f(b2[i]), e1 = __builtin_amdgcn_exp2f(b2[i + 1]);
                    wq[p] = cvt_pk_bf16(qv[i] * e0, qv[i + 1] * e1); wk[p] = cvt_pk_bf16(kv[i] * __builtin_amdgcn_exp2f(fminf(-b2[i], 120.f)), kv[i + 1] * __builtin_amdgcn_exp2f(fminf(-b2[i + 1], 120.f))); }
                qhf[ks] = __builtin_bit_cast(bf16x8, wq); ktf[ks] = __builtin_bit_cast(bf16x8, wk); }
            __builtin_amdgcn_sched_barrier(0);
            f32x4 aT = (f32x4){0.f, 0.f, 0.f, 0.f};
            aT = __builtin_amdgcn_mfma_f32_16x16x32_bf16(ktf[0], qhf[0], aT, 0, 0, 0);
            aT = __builtin_amdgcn_mfma_f32_16x16x32_bf16(ktf[1], qhf[1], aT, 0, 0, 0);
#pragma unroll
            for (int r = 0; r < 4; ++r) aT[r] = (4 * g + r > l15) ? 0.f : aT[r];
            const u32x4 aw = {cvt_pk_bf16(aT[0], aT[1]), cvt_pk_bf16(aT[2], aT[3]), 0u, 0u}; const bf16x8 atf = __builtin_bit_cast(bf16x8, aw);
#pragma unroll
            for (int et = 0; et < 4; ++et) { f32x4 o = (f32x4){0.f, 0.f, 0.f, 0.f};
                o = __builtin_amdgcn_mfma_f32_16x16x32_bf16(atf, vf[et], o, 0, 0, 0);
#pragma unroll
                for (int ks = 0; ks < 2; ++ks) { const u32x4 sw = {cvt_pk_bf16(S[2 * ks][et][0], S[2 * ks][et][1]), cvt_pk_bf16(S[2 * ks][et][2], S[2 * ks][et][3]), cvt_pk_bf16(S[2 * ks + 1][et][0], S[2 * ks + 1][et][1]), cvt_pk_bf16(S[2 * ks + 1][et][2], S[2 * ks + 1][et][3])};
                    o = __builtin_amdgcn_mfma_f32_16x16x32_bf16(qhf[ks], __builtin_bit_cast(bf16x8, sw), o, 0, 0, 0); }
                O[et] = o; }
        }
        __builtin_amdgcn_sched_barrier(0);
#pragma unroll
        for (int dt = 0; dt < 4; ++dt) { float dec[4];
#pragma unroll
            for (int r = 0; r < 4; ++r) dec[r] = __builtin_amdgcn_exp2f(__shfl(tot[dt], 4 * g + r));
#pragma unroll
            for (int et = 0; et < 4; ++et) { f32x4 s = S[dt][et];
#pragma unroll
                for (int r = 0; r < 4; ++r) s[r] *= dec[r];
                S[dt][et] = __builtin_amdgcn_mfma_f32_16x16x32_bf16(khf[dt], vf[et], s, 0, 0, 0); } }
        __builtin_amdgcn_sched_barrier(0);
        if (MODE == 1) {
#pragma unroll
            for (int et = 0; et < 4; ++et)
#pragma unroll
                for (int r = 0; r < 4; ++r) ofs[(sc * 16 + 4 * g + r) * 64 + 16 * et + l15] = O[et][r];
        }
        if (MODE == 2) {
            float rr[4];
#pragma unroll
            for (int r = 0; r < 4; ++r) { const int at = 127 - (sc * 16 + 4 * g + r); float ss = 0.f;
#pragma unroll
                for (int et = 0; et < 4; ++et) { const float of = ofs[at * 64 + 16 * et + l15]; O[et][r] += of; ss += O[et][r] * O[et][r]; }
                ss += __shfl_xor(ss, 1); ss += __shfl_xor(ss, 2); ss += __shfl_xor(ss, 4); ss += __shfl_xor(ss, 8);
                rr[r] = 1.0f / sqrtf(ss * (1.f / 64.f) + RMS_EPS); }
            VM_WAIT();
#pragma unroll
            for (int et = 0; et < 4; ++et) { const s16x4 t4 = tr16(GLa + (unsigned)((4 * g + (l15 >> 2)) * 128 + (l15 & 3) * 8) + et * 32); const float ngv = ngp[16 * et];
#pragma unroll
                for (int r = 0; r < 4; ++r) { const int at = 127 - (sc * 16 + 4 * g + r);
                    Y[(size_t)(r0 + at) * DM + 256 + h * 64 + 16 * et + l15] = (bf16_t)f2bf(O[et][r] * rr[r] * ngv * siluf_(bf2f((unsigned short)t4[r]))); } }
        }
    }
#undef HG_LOAD
#undef HG_STORE
    if (MODE == 0) {
#pragma unroll
        for (int dt = 0; dt < 4; ++dt)
#pragma unroll
            for (int et = 0; et < 4; ++et)
#pragma unroll
                for (int r = 0; r < 4; ++r) ST[sbase * 4096 + (size_t)(16 * dt + 4 * g + r) * 64 + 16 * et + l15] = S[dt][et][r];
        if (g == 0) {
#pragma unroll
            for (int dt = 0; dt < 4; ++dt) GAM[sbase * 64 + 16 * dt + l15] = __builtin_amdgcn_exp2f(gsum[dt]);
        }
    }
}
DI void ph_hgrn_local(const Ctx& C, int l) {
    LAS unsigned char* wl = C.lds + C.wave * 16384;
    for (int w = C.gw; w < NCHUNK * 8; w += C.NGW) hgrn_pass<0>(C, l, w >> 3, (w >> 1) & 3, w & 1, wl, nullptr);
}
DI void ph_hgrn_scan(const Ctx& C) {
    float* ST = (float*)(C.ws + WS_XB1); const float* GAM = (const float*)(C.ws + WS_GAM);
    for (int idx = C.bid * 512 + C.tid; idx < NSEQ * 8 * 4096; idx += C.G * 512) {
        const int e = idx & 4095, hd = (idx >> 12) & 7, seq = idx >> 15, h = hd >> 1, dir = hd & 1, d = e >> 6;
        const int c0 = seq < 8 ? seq * 64 : 512 + (seq - 8) * 16, nc = seq < 8 ? 64 : 16;
        float s = 0.f;
        for (int i0 = 0; i0 < nc; i0 += 16) {
            float tmp[16], gg[16];
#pragma unroll
            for (int i = 0; i < 16; ++i) { const int c = dir ? c0 + nc - 1 - (i0 + i) : c0 + i0 + i; const size_t base = (size_t)((c * 4 + h) * 2 + dir); tmp[i] = ST[base * 4096 + e]; gg[i] = GAM[base * 64 + d]; }
#pragma unroll
            for (int i = 0; i < 16; ++i) { const float t = tmp[i]; tmp[i] = s; s = fmaf(gg[i], s, t); }
#pragma unroll
            for (int i = 0; i < 16; ++i) { const int c = dir ? c0 + nc - 1 - (i0 + i) : c0 + i0 + i; const size_t base = (size_t)((c * 4 + h) * 2 + dir); ST[base * 4096 + e] = tmp[i]; }
        }
    }
}
template <int MODE>
DI void ph_hgrn_out(const Ctx& C, int l) {
    LAS unsigned char* wl = C.lds + C.wave * 16384;
    for (int w0 = C.gw; w0 < NCHUNK * 4; w0 += C.NGW) { const int w = (MODE == 1) ? NCHUNK * 4 - 1 - w0 : w0; hgrn_pass<MODE>(C, l, w >> 2, w & 3, MODE == 2 ? 1 : 0, wl, (float*)(C.ws + WS_EW) + (size_t)w * 8192); }
}

DI void ph_c_prep(const Ctx& C, int l) {
    const bf16_t* UCD = (const bf16_t*)(C.ws + WS_U);
    const bf16_t* WQ = (const bf16_t*)(C.ws + WS_WC + (size_t)l * WC_LAYER + OFF_WQ); const bf16_t* WKV = (const bf16_t*)(C.ws + WS_WC + (size_t)l * WC_LAYER + OFF_WKV);
    bf16_t* Qc = (bf16_t*)(C.ws + WS_XB1 + OFF_QC); bf16_t* Kc = (bf16_t*)(C.ws + WS_XB1 + OFF_KC); bf16_t* Vc = (bf16_t*)(C.ws + WS_XB1 + OFF_VC);
    const int lane = C.lane, r32 = lane & 31, hi = lane >> 5;
    const float C2c = 0.14433756729740643f * LOG2E;
    constexpr int PQ = 400, PKV = 272;
    for (int i = C.tid; i < 192 * 24; i += 512) { const int r = i / 24, p = i % 24; *(LAS u32x4*)(C.lds + r * PQ + p * 16) = *(const u32x4*)(WQ + (size_t)r * 192 + p * 8); }
    __syncthreads();
    for (int w = C.gw; w < NTOK / 32; w += C.NGW) {
        const int row = w * 32 + r32; const bf16_t* xr = UCD + (size_t)row * 1024;
        float cs[4], sn[4];
        { const float pos = (float)row_pos(row); const float inv[8] = {1.0f, 0.316227766016837933f, 0.1f, 0.0316227766016837933f, 0.01f, 0.00316227766016837933f, 0.001f, 0.000316227766016837933f};
#pragma unroll
            for (int ii = 0; ii < 4; ++ii) { const float invv = hi ? inv[4 + ii] : inv[ii]; const float ang = pos * invv;
                const double ad = (double)ang; const double k = __builtin_rint(ad * 0.15915494309189535); const float red = (float)(ad - k * 6.283185307179586);
                cs[ii] = __cosf(red); sn[ii] = __sinf(red); } }
        bf16x8 xq[12]; float ssq = 0.f;
#pragma unroll
        for (int ks = 0; ks < 12; ++ks) { xq[ks] = *(const bf16x8*)(xr + ks * 16 + hi * 8);
#pragma unroll
            for (int j = 0; j < 8; ++j) { const float f = bf2f((unsigned short)xq[ks][j]); ssq += f * f; } }
        ssq += __shfl_xor(ssq, 32);
        const float rq = (1.0f / sqrtf(ssq * (1.f / 192.f) + RMS_EPS)) * C2c;
#pragma unroll 1
        for (int nt = 0; nt < 6; ++nt) {
            f32x16 acc;
#pragma unroll
            for (int r = 0; r < 16; ++r) acc[r] = 0.f;
#pragma unroll
            for (int ks = 0; ks < 12; ++ks) { const bf16x8 a = *(const LAS bf16x8*)(C.lds + (32 * nt + r32) * PQ + (ks * 16 + hi * 8) * 2); acc = __builtin_amdgcn_mfma_f32_32x32x16_bf16(a, xq[ks], acc, 0, 0, 0); }
#pragma unroll
            for (int r = 0; r < 16; ++r) acc[r] *= rq;
            if (nt == 1 || nt == 4) {
#pragma unroll
                for (int ii = 0; ii < 4; ++ii) { const float x1 = acc[ii], x2 = acc[4 + ii]; acc[ii] = x1 * cs[ii] - x2 * sn[ii]; acc[4 + ii] = x1 * sn[ii] + x2 * cs[ii]; } }
            if (nt == 2 || nt == 5) {
#pragma unroll
                for (int ii = 0; ii < 4; ++ii) { const float x1 = acc[8 + ii], x2 = acc[12 + ii]; acc[8 + ii] = x1 * cs[ii] - x2 * sn[ii]; acc[12 + ii] = x1 * sn[ii] + x2 * cs[ii]; } }
#pragma unroll
            for (int g = 0; g < 4; ++g) { u32x2 wv; wv.x = cvt_pk_bf16(acc[4 * g], acc[4 * g + 1]); wv.y = cvt_pk_bf16(acc[4 * g + 2], acc[4 * g + 3]);
                *(u32x2*)(Qc + (size_t)row * 192 + 32 * nt + 8 * g + 4 * hi) = wv; }
        }
        { const u32x2 a = *(const u32x2*)(xr + 320 + 4 * hi), b = *(const u32x2*)(xr + 328 + 4 * hi);
            const float x1[4] = {bflo(a.x), bfhi(a.x), bflo(a.y), bfhi(a.y)}, x2[4] = {bflo(b.x), bfhi(b.x), bflo(b.y), bfhi(b.y)};
            float o1[4], o2[4];
#pragma unroll
            for (int ii = 0; ii < 4; ++ii) { o1[ii] = x1[ii] * cs[ii] - x2[ii] * sn[ii]; o2[ii] = x1[ii] * sn[ii] + x2[ii] * cs[ii]; }
            u32x2 w1, w2; w1.x = cvt_pk_bf16(o1[0], o1[1]); w1.y = cvt_pk_bf16(o1[2], o1[3]); w2.x = cvt_pk_bf16(o2[0], o2[1]); w2.y = cvt_pk_bf16(o2[2], o2[3]);
#pragma unroll
            for (int h = 0; h < 4; ++h) { *(u32x2*)(Kc + (size_t)row * 192 + h * 48 + 32 + 4 * hi) = w1; *(u32x2*)(Kc + (size_t)row * 192 + h * 48 + 40 + 4 * hi) = w2; } }
    }
    __syncthreads();
    for (int i = C.tid; i < 384 * 16; i += 512) { const int r = i / 16, p = i % 16; *(LAS u32x4*)(C.lds + r * PKV + p * 16) = *(const u32x4*)(WKV + (size_t)r * 128 + p * 8); }
    __syncthreads();
    for (int w = C.gw; w < NTOK / 32; w += C.NGW) {
        const int row = w * 32 + r32; const bf16_t* xr = UCD + (size_t)row * 1024;
        bf16x8 xk[8]; float ssk = 0.f;
#pragma unroll
        for (int ks = 0; ks < 8; ++ks) { xk[ks] = *(const bf16x8*)(xr + 192 + ks * 16 + hi * 8);
#pragma unroll
            for (int j = 0; j < 8; ++j) { const float f = bf2f((unsigned short)xk[ks][j]); ssk += f * f; } }
        ssk += __shfl_xor(ssk, 32);
        const float rk = 1.0f / sqrtf(ssk * (1.f / 128.f) + RMS_EPS);
#pragma unroll 1
        for (int nt = 0; nt < 12; ++nt) {
            f32x16 acc;
#pragma unroll
            for (int r = 0; r < 16; ++r) acc[r] = 0.f;
#pragma unroll
            for (int ks = 0; ks < 8; ++ks) { const bf16x8 a = *(const LAS bf16x8*)(C.lds + (32 * nt + r32) * PKV + (ks * 16 + hi * 8) * 2); acc = __builtin_amdgcn_mfma_f32_32x32x16_bf16(a, xk[ks], acc, 0, 0, 0); }
            const int h = nt / 3, part = nt % 3;
            bf16_t* dst = (part == 0) ? Kc + (size_t)row * 192 + h * 48 : Vc + (size_t)row * 256 + h * 64 + (part - 1) * 32;
#pragma unroll
            for (int g = 0; g < 4; ++g) { u32x2 wv; wv.x = cvt_pk_bf16(acc[4 * g] * rk, acc[4 * g + 1] * rk); wv.y = cvt_pk_bf16(acc[4 * g + 2] * rk, acc[4 * g + 3] * rk);
                *(u32x2*)(dst + 8 * g + 4 * hi) = wv; }
        }
    }
}

DI float one_minus_a2(float y, float a) {
    const float p = -y * (1.0f + y * (0.5f + y * (0.16666667f + y * (0.041666668f + y * (0.0083333338f + y * 0.0013888889f)))));
    return (y > -0.25f) ? p : (1.0f - a * a);
}
template <bool FINAL, int DIR>
DI void rglru_units(const Ctx& C, int l) {
    const bf16_t* UCD = (const bf16_t*)(C.ws + WS_U); f32x2* DC = (f32x2*)(C.ws + WS_DC);
    bf16_t* HFB = (bf16_t*)(C.ws + WS_EW);
    const int lane = C.lane, l15 = lane & 15, g = lane >> 4;
    LAS unsigned char* wl = C.lds + C.wave * 16384;
    LAS unsigned char* xcb = wl;
    LAS float* gs = (LAS float*)(wl + 2304);
    const int n = C.gw & 3, ch = n * 64 + lane;
    bf16x8 Wf[2][4][2];
    { const bf16x8* fp = (const bf16x8*)(C.ws + WS_WRG) + (size_t)((((l * 2 + DIR) * 4 + n) * 2) * 8) * 64 + lane;
#pragma unroll
      for (int gt = 0; gt < 2; ++gt)
#pragma unroll
        for (int nt = 0; nt < 4; ++nt)
#pragma unroll
            for (int ks = 0; ks < 2; ++ks) Wf[gt][nt][ks] = fp[(size_t)((gt * 4 + nt) * 2 + ks) * 64]; }
    const float ba = C.A->in[14][(l * 2 + DIR) * 256 + ch], bx = C.A->in[16][(l * 2 + DIR) * 256 + ch];
    const float lam = C.A->in[17][(l * 2 + DIR) * 256 + ch];
    const float c8sp = -8.0f * log1pf(expf(-lam));
    float cw[4];
#pragma unroll
    for (int j = 0; j < 4; ++j) cw[j] = C.A->in[11][(l * 4 + j) * 256 + ch];
    const float cb = C.A->in[12][l * 256 + ch];
    for (int w = C.gw; w < NCHUNK * 4; w += C.NGW) {
        const int chunk = w >> 2;
        const int r0 = chunk * 128; const int sb = row_seq_begin(r0), se = sb + row_seq_len(r0);
        float h = FINAL ? DC[(size_t)(chunk * 2 + DIR) * 256 + ch][1] : 0.f, P = 1.f;
        float xr[19];
#define RG_LOADX(dst, sc_) do { const int tb_ = r0 + 16 * (DIR ? 7 - (sc_) : (sc_)) - 2; \
            _Pragma("unroll") for (int i_ = 0; i_ < 19; ++i_) { const int rr_ = tb_ + i_; dst[i_] = (rr_ >= sb && rr_ < se) ? bf2f(UCD[(size_t)rr_ * 1024 + 336 + ch]) : 0.f; } } while (0)
        RG_LOADX(xr, 0);
        for (int sc = 0; sc < 8; ++sc) {
            const int t0 = r0 + 16 * (DIR ? 7 - sc : sc);
            float xcr[16];
#pragma unroll
            for (int a = 0; a < 16; ++a) { const int tt = DIR ? 15 - a : a;
                xcr[tt] = cb + cw[0] * xr[a] + cw[1] * xr[a + 1] + cw[2] * xr[a + 2] + cw[3] * xr[a + 3];
                *(LAS bf16_t*)(xcb + tt * 144 + lane * 2) = (bf16_t)f2bf(xcr[tt]); }
            if (sc + 1 < 8) RG_LOADX(xr, sc + 1);
            LDS_WAIT();
            const bf16x8 A0 = *(const LAS bf16x8*)(xcb + l15 * 144 + (8 * g) * 2), A1 = *(const LAS bf16x8*)(xcb + l15 * 144 + (32 + 8 * g) * 2);
#pragma unroll
            for (int gt = 0; gt < 2; ++gt)
#pragma unroll
                for (int nt = 0; nt < 4; ++nt) { f32x4 acc = (f32x4){0.f, 0.f, 0.f, 0.f};
                    acc = __builtin_amdgcn_mfma_f32_16x16x32_bf16(A0, Wf[gt][nt][0], acc, 0, 0, 0);
                    acc = __builtin_amdgcn_mfma_f32_16x16x32_bf16(A1, Wf[gt][nt][1], acc, 0, 0, 0);
#pragma unroll
                    for (int r = 0; r < 4; ++r) gs[(gt * 16 + 4 * g + r) * 68 + 16 * nt + l15] = acc[r]; }
            LDS_WAIT();
#pragma unroll
            for (int tt = 0; tt < 16; ++tt) {
                const float ra = gs[tt * 68 + lane] + ba, ia = gs[(16 + tt) * 68 + lane] + bx;
                const float r = sigmoidf_(ra), ig = sigmoidf_(ia);
                const float la = c8sp * r, a = __expf(la), u = __builtin_amdgcn_sqrtf(one_minus_a2(2.0f * la, a)) * (ig * xcr[tt]);
                h = fmaf(a, h, u); P *= a;
                if (FINAL) { const int tok = DIR ? t0 + 15 - tt : t0 + tt; HFB[((size_t)DIR * NTOK + tok) * 256 + ch] = (bf16_t)f2bf(h); } }
            LDS_WAIT();
        }
        if (!FINAL) DC[(size_t)(chunk * 2 + DIR) * 256 + ch] = (f32x2){P, h};
#undef RG_LOADX
    }
}
template <bool FINAL>
DI void ph_rglru(const Ctx& C, int l) { rglru_units<FINAL, 0>(C, l); rglru_units<FINAL, 1>(C, l); }
DI void ph_rglru_scan(const Ctx& C) {
    f32x2* DC = (f32x2*)(C.ws + WS_DC);
    for (int idx = C.bid * 512 + C.tid; idx < NSEQ * 512; idx += C.G * 512) {
        const int ch = idx & 255, dir = (idx >> 8) & 1, seq = idx >> 9;
        const int c0 = seq < 8 ? seq * 64 : 512 + (seq - 8) * 16, nc = seq < 8 ? 64 : 16;
        float hin = 0.f;
        for (int i0 = 0; i0 < nc; i0 += 16) {
            f32x2 vv[16];
#pragma unroll
            for (int i = 0; i < 16; ++i) { const int c = dir ? c0 + nc - 1 - (i0 + i) : c0 + i0 + i; vv[i] = DC[(size_t)(c * 2 + dir) * 256 + ch]; }
#pragma unroll
            for (int i = 0; i < 16; ++i) { const float P = vv[i][0], H = vv[i][1]; vv[i][1] = hin; hin = fmaf(P, hin, H); }
#pragma unroll
            for (int i = 0; i < 16; ++i) { const int c = dir ? c0 + nc - 1 - (i0 + i) : c0 + i0 + i; DC[(size_t)(c * 2 + dir) * 256 + ch] = vv[i]; }
        }
    }
}
DI float gelu_tanh(float x) { const float u = 0.7978845608028654f * (x + 0.044715f * x * x * x); const float e = __expf(2.0f * u); const float th = 1.0f - 2.0f / (e + 1.0f); return 0.5f * x * (1.0f + th); }
DI void ph_d_post(const Ctx& C) {
    const bf16_t* UCD = (const bf16_t*)(C.ws + WS_U); const bf16_t* HF = (const bf16_t*)(C.ws + WS_EW); const bf16_t* HB = HF + (size_t)NTOK * 256; bf16_t* Y = (bf16_t*)(C.ws + WS_Y);
    const int c4 = C.lane * 4;
    for (int row0 = C.gw; row0 < NTOK; row0 += 4 * C.NGW) {
        u32x2 a[4], b[4], g[4];
#pragma unroll
        for (int i = 0; i < 4; ++i) { const size_t row = (size_t)row0 + (size_t)i * C.NGW; a[i] = __builtin_nontemporal_load((const u32x2*)(HF + row * 256 + c4)); b[i] = __builtin_nontemporal_load((const u32x2*)(HB + row * 256 + c4)); g[i] = __builtin_nontemporal_load((const u32x2*)(UCD + row * 1024 + 592 + c4)); }
#pragma unroll
        for (int i = 0; i < 4; ++i) { const size_t row = (size_t)row0 + (size_t)i * C.NGW;
            const float y0 = (bflo(a[i].x) + bflo(b[i].x)) * gelu_tanh(bflo(g[i].x)), y1 = (bfhi(a[i].x) + bfhi(b[i].x)) * gelu_tanh(bfhi(g[i].x));
            const float y2 = (bflo(a[i].y) + bflo(b[i].y)) * gelu_tanh(bflo(g[i].y)), y3 = (bfhi(a[i].y) + bfhi(b[i].y)) * gelu_tanh(bfhi(g[i].y));
            u32x2 w; w.x = cvt_pk_bf16(y0, y1); w.y = cvt_pk_bf16(y2, y3);
            *(u32x2*)(Y + row * DM + 768 + c4) = w; }
    }
}

DI void ph_topk(const Ctx& C) {
    const float* affT = (const float*)(C.ws + WS_AFF); int* idx2 = (int*)(C.ws + WS_IDX); float* gsel2 = (float*)(C.ws + WS_GSEL);
    LAS unsigned* hist = (LAS unsigned*)C.lds;
    LAS unsigned* misc = hist + 4096;
    LAS unsigned* cg = misc + 8;
    LAS unsigned* ce = cg + 512;
    for (int u = C.bid; u < 32; u += C.G) {
        const int g = u >> 4, e = u & 15; const unsigned* a = (const unsigned*)(affT + (size_t)(g * 16 + e) * NTOKG);
        const int i0 = C.tid * 128; unsigned v[128];
        { const u32x4* p = (const u32x4*)(a + i0);
#pragma unroll
          for (int j = 0; j < 32; ++j) { const u32x4 q = p[j]; v[4 * j] = q.x; v[4 * j + 1] = q.y; v[4 * j + 2] = q.z; v[4 * j + 3] = q.w; } }
        unsigned prefix = 0u, mask = 0u, krem = CAP;
#pragma unroll 1
        for (int pass = 0; pass < 3; ++pass) {
            const int shift = pass == 0 ? 19 : (pass == 1 ? 7 : 0); const unsigned dm = pass == 2 ? 127u : 4095u; const int per = pass == 2 ? 2 : 64;
            for (int i = C.tid; i < 4096; i += 512) hist[i] = 0u;
            __syncthreads();
#pragma unroll
            for (int i = 0; i < 128; ++i) {
                const unsigned bin = ((v[i] & mask) == prefix) ? ((v[i] >> shift) & dm) : (5120u + (unsigned)C.lane);
                atomicAdd((unsigned*)&hist[bin], 1u); if ((i & 7) == 7) asm volatile("" : "+v"(prefix) :: "memory"); }
            __syncthreads();
            if (C.tid < 64) {
                unsigned t = 0; for (int b = 0; b < per; ++b) t += hist[per * C.tid + b];
                unsigned S = t;
#pragma unroll
                for (int off = 1; off < 64; off <<= 1) { const unsigned y = __shfl_down(S, off); if (C.tid + off < 64) S += y; }
                const unsigned above = S - t;
                if (above < krem && krem <= above + t) { unsigned cum = above; int D = per * C.tid + per - 1;
                    for (; D > per * C.tid; --D) { const unsigned c = hist[D]; if (cum + c >= krem) break; cum += c; }
                    misc[0] = (unsigned)D; misc[1] = cum; }
            }
            __syncthreads();
            prefix |= misc[0] << shift; mask |= dm << shift; krem -= misc[1];
            __syncthreads();
        }
        unsigned ngt = 0, neq = 0;
#pragma unroll
        for (int i = 0; i < 128; ++i) { ngt += (v[i] > prefix); neq += (v[i] == prefix); if ((i & 15) == 15) asm volatile("" : "+v"(prefix)); }
        unsigned ig = ngt, ie = neq;
#pragma unroll
        for (int off = 1; off < 64; off <<= 1) { const unsigned yg = __shfl_up(ig, off), ye = __shfl_up(ie, off); if (C.lane >= off) { ig += yg; ie += ye; } }
        if (C.lane == 63) { cg[C.wave] = ig; ce[C.wave] = ie; }
        __syncthreads();
        unsigned bg = 0, be = 0, allg = 0;
#pragma unroll
        for (int w = 0; w < 8; ++w) { const unsigned x = cg[w], y = ce[w]; if (w < C.wave) { bg += x; be += y; } allg += x; }
        unsigned pg = bg + ig - ngt, pe = be + ie - neq; const unsigned ngt_all = allg;
        int* io = idx2 + (size_t)e * 16384 + g * CAP; float* go = gsel2 + (size_t)e * 16384 + g * CAP; short* sm = (short*)(C.ws + WS_SM) + (size_t)(g * NTOKG + i0) * 16 + e;
#pragma unroll
        for (int i = 0; i < 128; ++i) {
            if (v[i] > prefix) { io[pg] = g * NTOKG + i0 + i; go[pg] = __builtin_bit_cast(float, v[i]); sm[i * 16] = (short)pg; ++pg; }
            else if (v[i] == prefix) { if (pe < krem) { io[ngt_all + pe] = g * NTOKG + i0 + i; go[ngt_all + pe] = __builtin_bit_cast(float, v[i]); sm[i * 16] = (short)(ngt_all + pe); } ++pe; }
            if ((i & 3) == 3) asm volatile("" : "+v"(prefix) :: "memory"); }
        __syncthreads();
    }
}

constexpr int MERGE_CHUNKS = 8, MERGE_ROWS = NTOK / MERGE_CHUNKS;
constexpr int EPB = 2;
constexpr int NPH_LAYER = 12 + 2 * MERGE_CHUNKS + 3 + (NEXP / EPB + 1) + 1, NPH = 1 + 2 * NPH_LAYER;
__global__ void __launch_bounds__(512, 2) mk_fwd(Args args) {
    extern __shared__ __attribute__((aligned(16))) unsigned char lds_raw[];
    Ctx C;
    C.lds = (LAS unsigned char*)lds_raw; C.ws = (GAS unsigned char*)args.ws; C.out = (GAS float*)args.out;
    C.tid = threadIdx.x; C.lane = C.tid & 63; C.wave = __builtin_amdgcn_readfirstlane(C.tid >> 6); C.G = gridDim.x; C.bid = blockIdx.x;
    C.gw = C.bid * 8 + C.wave; C.NGW = C.G * 8;
    C.A = &args;
    volatile LAS unsigned* MISC = (volatile LAS unsigned*)(C.lds + MISC_OFF);
    for (int u = C.tid; u < (LDS_BYTES - RING_BYTES) / 4; u += 512) ((LAS unsigned*)(C.lds + RING_BYTES))[u] = 0u;
    __syncthreads();
    const int lo = args.ph_lo, hi = args.ph_hi;
    unsigned* barw = (unsigned*)(C.ws + WS_CTL) + 4096;
    XcdBarrier bar; bar.bar = barw; bar.x = 0; bar.st = nullptr;
    if (hi - lo > 1) bar = xcd_barrier_post(barw, MISC + 8);
    int ph = 0;
#ifndef PHASE_MASK
#define PHASE_MASK 0xFFFFFFFFu
#endif
#ifndef REPEAT_MASK
#define REPEAT_MASK 0u
#endif
#define SITE(id) if constexpr (((PHASE_MASK) >> (id)) & 1u) for (int rep_ = 0; rep_ < ((((REPEAT_MASK) >> (id)) & 1u) ? 2 : 1); ++rep_)
#define PH_BEGIN if (ph >= lo && ph < hi) { { int tz_ = threadIdx.x; asm volatile("" : "+v"(tz_)); C.tid = tz_; C.lane = tz_ & 63; C.wave = __builtin_amdgcn_readfirstlane(tz_ >> 6); C.gw = C.bid * 8 + C.wave; unsigned char* wz_ = args.ws; asm volatile("" : "+s"(wz_)); C.ws = (GAS unsigned char*)wz_; float* oz_ = args.out; asm volatile("" : "+s"(oz_)); C.out = (GAS float*)oz_; }
#define PH_END } if (ph >= lo && ph + 1 < hi) xcd_barrier(bar); ++ph;

#define XB0 ((bf16_t*)(C.ws + WS_XB0))
#define XB1 ((bf16_t*)(C.ws + WS_XB1))
#define Yb ((bf16_t*)(C.ws + WS_Y))
#define Ub ((bf16_t*)(C.ws + WS_U))
    const int big = 30;

    PH_BEGIN SITE(1) ph_prologue(C); PH_END

    for (int l = 0; l < 2; ++l) {
#define wl (C.ws + WS_WSMALL + (size_t)l * WSMALL_LAYER)
        PH_BEGIN SITE(2) { pg8::Gemm g{XB0, (const bf16_t*)(wl + OFF_WA), NTOK, 768, 1024, 1024, 1024, big, 0}; pg8::StaticOrder S; S.init(NTOK, 768, C.G, C.bid);
            pg8::EpiProj E{Ub, 768, 256, 0.17677669529663689f * LOG2E, (unsigned*)(C.ws + WS_KN2) + (size_t)l * 8 * 2048}; pg8::gemm_phase(C.lds, g, S, E); } PH_END
        PH_BEGIN SITE(3) ph_attn_a(C, l); PH_END
        PH_BEGIN SITE(4) { ph_a_post(C, l); __syncthreads();
            pg8::Gemm g{XB0, (const bf16_t*)(wl + OFF_WB), NTOK, 1280, 1024, 1024, 1024, big, 0}; pg8::StaticOrder S; S.init(NTOK, 1280, C.G, C.bid);
            pg8::EpiProj E{Ub, 1280, 0, 1.f, nullptr}; pg8::gemm_phase(C.lds, g, S, E); } PH_END
        PH_BEGIN SITE(5) ph_hgrn_local(C, l); PH_END
        PH_BEGIN SITE(6) ph_hgrn_scan(C); PH_END
        PH_BEGIN SITE(7) ph_hgrn_out<1>(C, l); PH_END
        PH_BEGIN SITE(20) ph_hgrn_out<2>(C, l); PH_END
        PH_BEGIN SITE(8) { pg8::Gemm g{XB0, (const bf16_t*)(wl + OFF_WCD), NTOK, 1024, 1024, 1024, 1024, big, 0}; pg8::StaticOrder S; S.init(NTOK, 1024, C.G, C.bid);
            pg8::EpiProj E{Ub, 1024, 0, 1.f, nullptr}; pg8::gemm_phase(C.lds, g, S, E); } PH_END
        PH_BEGIN SITE(9) { ph_c_prep(C, l); __syncthreads(); ph_rglru<false>(C, l); } PH_END
        PH_BEGIN SITE(10) { if (rep_ == 0) { ph_rglru_scan(C); __syncthreads(); } ph_attn_c(C); } PH_END
        PH_BEGIN SITE(11) ph_rglru<true>(C, l); PH_END
        PH_BEGIN SITE(12) ph_d_post(C); PH_END
        for (int q = 0; q < MERGE_CHUNKS; ++q) {
            const size_t r0 = (size_t)q * MERGE_ROWS;
            PH_BEGIN SITE(13) {
                { unsigned char* X8 = (unsigned char*)(C.ws + WS_U) + (size_t)MERGE_ROWS * 8192;
                  for (int rb = C.gw; rb < MERGE_ROWS; rb += 8 * C.NGW) {
                      u32x4 a[8], b[8];
#pragma unroll
                      for (int i = 0; i < 8; ++i) { const int r = min(rb + i * C.NGW, MERGE_ROWS - 1); const u32x4* s = (const u32x4*)(XB0 + (r0 + r) * DM) + 2 * C.lane; a[i] = __builtin_nontemporal_load(&s[0]); b[i] = __builtin_nontemporal_load(&s[1]); }
#pragma unroll
                      for (int i = 0; i < 8; ++i) { const int r = rb + i * C.NGW; if (r < MERGE_ROWS) {
                          u32x4 o; o.x = pg8::pk4_fp8(bflo(a[i].x), bfhi(a[i].x), bflo(a[i].y), bfhi(a[i].y)); o.y = pg8::pk4_fp8(bflo(a[i].z), bfhi(a[i].z), bflo(a[i].w), bfhi(a[i].w));
                          o.z = pg8::pk4_fp8(bflo(b[i].x), bfhi(b[i].x), bflo(b[i].y), bfhi(b[i].y)); o.w = pg8::pk4_fp8(bflo(b[i].z), bfhi(b[i].z), bflo(b[i].w), bfhi(b[i].w));
                          ((u32x4*)(X8 + (size_t)r * DM))[C.lane] = o; } } }
                  __syncthreads(); }
                pg8::Gemm g{Yb + r0 * DM, (const bf16_t*)(wl + OFF_WBR), MERGE_ROWS, 4096, 256, 1024, 256, 2, 512}; pg8::StaticOrder S; S.init(MERGE_ROWS, 4096, C.G, C.bid);
                pg8::EpiProj E{Ub, 4096, 0, 1.f, nullptr}; pg8::gemm_phase(C.lds, g, S, E); } PH_END
            PH_BEGIN SITE(14) { pg8::Gemm g{(const bf16_t*)(C.ws + WS_U + (size_t)MERGE_ROWS * 8192), (const bf16_t*)(wl + OFF_WG), MERGE_ROWS, 4096, 1024, 1024, 1024, big, 0}; pg8::StaticOrder S; S.init(MERGE_ROWS, 4096, C.G, C.bid);
                pg8::EpiGateMix E{Ub, XB1 + r0 * DM, 1.f / pg8::FP8_W1_SCALE}; pg8::gemm_phase<pg8::EpiGateMix, pg8::StaticOrder, true>(C.lds, g, S, E); } PH_END
        }
        PH_BEGIN SITE(15) { pg8::Gemm g{XB1, (const bf16_t*)(wl + OFF_WOUT), NTOK, 1024, 1024, 1024, 1024, big, 0}; pg8::StaticOrder S; S.init(NTOK, 1024, C.G, C.bid);
            pg8::EpiResid E{l == 0 ? C.A->in[0] : (const float*)C.out, l == 0 ? C.A->in[1] : (const float*)(C.out + (size_t)NTOKG * DM), (float*)C.out}; pg8::gemm_phase(C.lds, g, S, E); } PH_END
        PH_BEGIN SITE(16) { ph_ln<true>(C, l, 0, XB1); } PH_END
        PH_BEGIN SITE(17) { if (C.bid < 32 && C.G > 64) ph_topk(C); else expert_weight_items(C, l); if (C.G <= 64) { __syncthreads(); if (C.bid < 32) ph_topk(C); } } PH_END
        for (int k = 0; k < NEXP / EPB + 1; ++k) {
            PH_BEGIN SITE(18) {
                constexpr size_t H_B = (size_t)EPB * 16384 * 2048;
                unsigned char* Hb = (unsigned char*)(C.ws + WS_XB0);
                if (k < NEXP / EPB) { const int e0 = k * EPB;
                    pg8::Gemm g{(const bf16_t*)(C.ws + WS_XB1), (const bf16_t*)(C.ws + WS_EW + OFF_WGU8 + (size_t)e0 * 4096 * 1024), EPB * 16384, 4096, 1024, 1024, 1024, big, 0, 6, (size_t)4096 * 1024, (const int*)(C.ws + WS_IDX) + (size_t)e0 * 16384}; pg8::StaticOrder S; S.init(EPB * 16384, 4096, C.G, C.bid);
                    pg8::EpiSiluMul8 E{Hb + (size_t)(k & 1) * H_B, 2048}; pg8::gemm_phase<pg8::EpiSiluMul8, pg8::StaticOrder, true, true>(C.lds, g, S, E); }
                if (k >= 1) { const int e0 = (k - 1) * EPB; __syncthreads();
                    pg8::Gemm g{(const bf16_t*)(Hb + (size_t)((k - 1) & 1) * H_B), (const bf16_t*)(C.ws + WS_EW + OFF_WD8 + (size_t)e0 * 1024 * 2048), EPB * 16384, 1024, 2048, 2048, 2048, big, 0, 6, (size_t)1024 * 2048}; pg8::StaticOrder S; S.init(EPB * 16384, 1024, C.G, C.bid);
                    pg8::EpiYe E{(bf16_t*)(C.ws + WS_Y) + (size_t)e0 * 16384 * DM, (const float*)(C.ws + WS_GSEL) + (size_t)e0 * 16384, 1.f / (pg8::FP8_H_SCALE * pg8::FP8_W2_SCALE)}; pg8::gemm_phase<pg8::EpiYe, pg8::StaticOrder, true>(C.lds, g, S, E); }
            } PH_END
        }
        PH_BEGIN SITE(19) ph_ln<false>(C, l, 1, l + 1 < 2 ? XB0 : nullptr); PH_END
    }
#undef PH_BEGIN
#undef PH_END
#undef XB0
#undef XB1
#undef Yb
#undef Ub
#undef wl
}

extern "C" void kernel_launch(void* const* d_in, const int* in_sizes, int n_in, void* d_out, int out_size, void* d_ws, size_t ws_size, hipStream_t stream) {
    static int grid = 0;
    if (grid == 0) {
        if (n_in != 26 || out_size != NTOK * DM || ws_size < WS_END) { fprintf(stderr, "kernel_launch: unexpected shapes: n_in %d out %d ws %zu (need %zu)\n", n_in, out_size, ws_size, (size_t)WS_END); grid = -1; return; }
        int dev = 0, cus = 0, per_cu = 0;
        if (hipGetDevice(&dev) != hipSuccess || hipDeviceGetAttribute(&cus, hipDeviceAttributeMultiprocessorCount, dev) != hipSuccess) { grid = -1; return; }
        if (hipFuncSetAttribute((const void*)mk_fwd, hipFuncAttributeMaxDynamicSharedMemorySize, LDS_BYTES) != hipSuccess) { fprintf(stderr, "kernel_launch: hipFuncSetAttribute failed\n"); grid = -1; return; }
        if (hipOccupancyMaxActiveBlocksPerMultiprocessor(&per_cu, (const void*)mk_fwd, 512, LDS_BYTES) != hipSuccess || per_cu < 1) { fprintf(stderr, "kernel_launch: occupancy query says %d\n", per_cu); }
        (void)hipGetLastError();
        grid = cus;
    }
    if (grid < 0) return;
    if (hipMemsetAsync((char*)d_ws + WS_CTL, 0, CTL_ZERO_BYTES, stream) != hipSuccess) return;
    Args a{};
    for (int i = 0; i < 26; ++i) a.in[i] = (const float*)d_in[i];
    a.out = (float*)d_out; a.ws = (unsigned char*)d_ws;
#if MK_PER_PHASE_LAUNCH
    for (int p = 0; p < NPH; ++p) { a.ph_lo = p; a.ph_hi = p + 1; hipLaunchKernelGGL(mk_fwd, dim3(grid), dim3(512), LDS_BYTES, stream, a); }
#else
    a.ph_lo = 0; a.ph_hi = NPH; hipLaunchKernelGGL(mk_fwd, dim3(grid), dim3(512), LDS_BYTES, stream, a);
#endif
    const hipError_t le = hipPeekAtLastError();
    if (le != hipSuccess) fprintf(stderr, "kernel_launch: launch failed: %s\n", hipGetErrorName(le));
}
```
